# Optimizing an MI355X kernel written in HIP

```python
import math
import jax, jax.numpy as jnp
from jax import lax
import numpy as np

D_MODEL = 1024
BATCH = 32
SEQ = 256
DEPTH = 1
DEC_BATCH = 8
DEC_SEQ = 1024
PAST_LEN = 256

GRID_W = 64
D_S5 = D_MODEL
S5_GROUP = 16
N_S5_GROUPS = D_S5 // S5_GROUP
S5_STATE = 64
D_POOL = D_MODEL // 2
POOL_WINDOWS = (2, 4, 8, 16)
N_POOL_GROUPS = len(POOL_WINDOWS)
POOL_GROUP = D_POOL // N_POOL_GROUPS
D_IN = D_S5 + D_POOL + 2 * D_MODEL
D_FF = 4 * D_MODEL
N_MOD = 6
DEEPNORM_ALPHA = (2.0 * DEPTH) ** 0.25
DEEPNORM_BETA = (8.0 * DEPTH) ** -0.25
LN_EPS = 1e-6

kernel_name = 'hybrid_s5_pool_diffusion_step'


def layer_norm(x, g=None, b=None):
    xf = x.astype(jnp.float32)
    mu = jnp.mean(xf, axis=-1, keepdims=True)
    var = jnp.mean(jnp.square(xf - mu), axis=-1, keepdims=True)
    y = (xf - mu) * lax.rsqrt(var + LN_EPS)
    if g is not None:
        y = y * g.astype(jnp.float32) + b.astype(jnp.float32)
    return y.astype(x.dtype)


def adaln(cvec, w, b):
    m = jax.nn.silu(cvec) @ w + b
    return m.reshape(cvec.shape[0], N_MOD, 1, D_MODEL)


def _combine(e1, e2):
    a1, b1 = e1
    a2, b2 = e2
    return a1 * a2, a2 * b1 + b2


def s5_direction(u, s0, lam_re, lam_im, log_dt, b_re, b_im, c_re, c_im, d, reverse):
    f32 = jnp.float32
    bsz, n, _ = u.shape
    uf = u.astype(f32).reshape(bsz, n, N_S5_GROUPS, S5_GROUP)
    lam = lax.complex(lam_re.astype(f32), lam_im.astype(f32))
    dt = jnp.exp(log_dt.astype(f32))[:, None]
    lam_bar = jnp.exp(lam * dt)
    b_mat = lax.complex(b_re.astype(f32), b_im.astype(f32))
    c_mat = lax.complex(c_re.astype(f32), c_im.astype(f32))
    b_bar = ((lam_bar - 1.0) / lam)[:, :, None] * b_mat
    bu = jnp.einsum('blgh,gph->blgp', uf.astype(jnp.complex64), b_bar)
    first, last = (n - 1, 0) if reverse else (0, n - 1)
    if s0 is not None:
        bu = bu.at[:, first].add(lam_bar * s0)
    a = jnp.broadcast_to(lam_bar, bu.shape)
    _, s = lax.associative_scan(_combine, (a, bu), reverse=reverse, axis=1)
    y = jnp.einsum('blgp,ghp->blgh', s, c_mat).real + d.astype(f32).reshape(N_S5_GROUPS, S5_GROUP) * uf
    return y.reshape(bsz, n, D_S5), s[:, last]


def pool_mix(u, w_pool, pool_scale, grid_w):
    bsz, n_tok, _ = u.shape
    if grid_w is not None:
        rows = n_tok // grid_w
        v = u.reshape(bsz, rows, grid_w, D_POOL)
    else:
        v = u
    vf = v.astype(jnp.float32)
    n = vf.shape[-2]
    cs = jnp.cumsum(vf, axis=-2)
    cs = jnp.concatenate([jnp.zeros_like(cs[..., :1, :]), cs], axis=-2)
    t = jnp.arange(n)
    outs = []
    for gi, w in enumerate(POOL_WINDOWS):
        lo = jnp.clip(t - w // 2, 0, n)
        hi = jnp.clip(t - w // 2 + w, 0, n)
        cg = cs[..., gi * POOL_GROUP:(gi + 1) * POOL_GROUP]
        mean = (jnp.take(cg, hi, axis=-2) - jnp.take(cg, lo, axis=-2)) / (hi - lo).astype(jnp.float32)[:, None]
        outs.append(mean - vf[..., gi * POOL_GROUP:(gi + 1) * POOL_GROUP])
    p = jnp.stack(outs, axis=-2)
    p = jnp.einsum('...gi,gio->...go', p, w_pool).reshape(vf.shape) * pool_scale
    return p.reshape(bsz, n_tok, D_POOL)


def token_mixer(h, s0_f, s0_b, grid_w, lp):
    z = h @ lp['w_in'] + lp['b_in']
    u_a = z[..., :D_S5]
    u_b = z[..., D_S5:D_S5 + D_POOL]
    g_a = z[..., D_S5 + D_POOL:D_S5 + D_POOL + D_MODEL]
    g_b = z[..., D_S5 + D_POOL + D_MODEL:]
    s5 = lp['s5']
    y_f, sf = s5_direction(u_a, s0_f, *[p[0] for p in s5], reverse=False)
    y_b, sb = s5_direction(u_a, s0_b, *[p[1] for p in s5], reverse=True)
    v = jax.nn.gelu(y_f + y_b)
    v = v * jax.nn.sigmoid(v @ lp['w_glu'] + lp['b_glu'])
    ya = v @ lp['w_proj_a']
    yb = pool_mix(u_b, lp['w_pool'], lp['pool_scale'], grid_w) @ lp['w_proj_b']
    merged = jax.nn.sigmoid(g_a) * ya + jax.nn.sigmoid(g_b) * yb
    return merged @ lp['w_out'] + lp['b_out'], sf, sb


def trunk_layer(x, mod, s0_f, s0_b, grid_w, lp):
    h = layer_norm(x) * (1.0 + mod[:, 1]) + mod[:, 0]
    tm, sf, sb = token_mixer(h, s0_f, s0_b, grid_w, lp)
    x = layer_norm(DEEPNORM_ALPHA * x + mod[:, 2] * tm, lp['ln1_g'], lp['ln1_b'])
    h2 = layer_norm(x) * (1.0 + mod[:, 4]) + mod[:, 3]
    f = jnp.square(jax.nn.relu(h2 @ lp['w_mlp1'] + lp['b_mlp1'])) @ lp['w_mlp2'] + lp['b_mlp2']
    x = layer_norm(DEEPNORM_ALPHA * x + mod[:, 5] * f, lp['ln2_g'], lp['ln2_b'])
    return x, sf, sb


def setup_inputs(seed: int = 0) -> dict:
    key = jax.random.key(seed)
    ks = jax.random.split(key, 40)
    f32 = jnp.float32

    def nrm(k, shape, scale):
        return jax.random.normal(k, shape, f32) * scale

    L, G, P, H = DEPTH, N_S5_GROUPS, S5_STATE, S5_GROUP
    lam_im_base = (math.pi * jnp.arange(P, dtype=f32))[None, None, None, :]
    return {
        'x_prompt': nrm(ks[0], (BATCH, SEQ, D_MODEL), 1.0),
        'x_sample': nrm(ks[1], (DEC_BATCH, DEC_SEQ, D_MODEL), 1.0),
        'state_s5': nrm(ks[2], (DEC_BATCH, L, 2, 2, G, P), 0.1),
        'c': nrm(ks[3], (DEC_BATCH, D_MODEL), 1.0),
        'c_ctx': nrm(ks[4], (D_MODEL,), 1.0),
        'w_ada': nrm(ks[5], (L, D_MODEL, N_MOD * D_MODEL), D_MODEL ** -0.5),
        'b_ada': nrm(ks[6], (L, N_MOD * D_MODEL), 0.01),
        'w_in': nrm(ks[7], (L, D_MODEL, D_IN), D_MODEL ** -0.5),
        'b_in': nrm(ks[8], (L, D_IN), 0.01),
        's5_lam_re': -0.5 + nrm(ks[9], (L, 2, G, P), 0.01),
        's5_lam_im': lam_im_base + nrm(ks[10], (L, 2, G, P), 0.01),
        's5_log_dt': jax.random.uniform(ks[11], (L, 2, G), f32, math.log(1e-3), math.log(1e-1)),
        's5_b_re': nrm(ks[12], (L, 2, G, P, H), (2.0 * H) ** -0.5),
        's5_b_im': nrm(ks[13], (L, 2, G, P, H), (2.0 * H) ** -0.5),
        's5_c_re': nrm(ks[14], (L, 2, G, H, P), P ** -0.5),
        's5_c_im': nrm(ks[15], (L, 2, G, H, P), P ** -0.5),
        's5_d': nrm(ks[16], (L, 2, D_S5), 1.0),
        'w_glu': nrm(ks[17], (L, D_S5, D_S5), D_S5 ** -0.5),
        'b_glu': nrm(ks[18], (L, D_S5), 0.01),
        'w_proj_a': nrm(ks[19], (L, D_S5, D_MODEL), D_S5 ** -0.5),
        'w_pool': nrm(ks[20], (L, N_POOL_GROUPS, POOL_GROUP, POOL_GROUP), POOL_GROUP ** -0.5),
        'pool_scale': 1.0 + nrm(ks[21], (L, D_POOL), 0.1),
        'w_proj_b': nrm(ks[22], (L, D_POOL, D_MODEL), D_POOL ** -0.5),
        'w_out': nrm(ks[23], (L, D_MODEL, D_MODEL), D_MODEL ** -0.5 * DEEPNORM_BETA),
        'b_out': nrm(ks[24], (L, D_MODEL), 0.01),
        'ln1_g': 1.0 + nrm(ks[25], (L, D_MODEL), 0.01),
        'ln1_b': nrm(ks[26], (L, D_MODEL), 0.01),
        'w_mlp1': nrm(ks[27], (L, D_MODEL, D_FF), D_MODEL ** -0.5),
        'b_mlp1': nrm(ks[28], (L, D_FF), 0.01),
        'w_mlp2': nrm(ks[29], (L, D_FF, D_MODEL), D_FF ** -0.5 * DEEPNORM_BETA),
        'b_mlp2': nrm(ks[30], (L, D_MODEL), 0.01),
        'ln2_g': 1.0 + nrm(ks[31], (L, D_MODEL), 0.01),
        'ln2_b': nrm(ks[32], (L, D_MODEL), 0.01),
    }


def reference(x_prompt, x_sample, state_s5, c, c_ctx, w_ada, b_ada, w_in, b_in,
              s5_lam_re, s5_lam_im, s5_log_dt, s5_b_re, s5_b_im, s5_c_re, s5_c_im, s5_d,
              w_glu, b_glu, w_proj_a, w_pool, pool_scale, w_proj_b, w_out, b_out,
              ln1_g, ln1_b, w_mlp1, b_mlp1, w_mlp2, b_mlp2, ln2_g, ln2_b):
    f32 = jnp.float32
    yp = x_prompt
    ys = x_sample
    new_states = []
    for l in range(DEPTH):
        lp = {
            'w_in': w_in[l], 'b_in': b_in[l],
            's5': (s5_lam_re[l], s5_lam_im[l], s5_log_dt[l], s5_b_re[l], s5_b_im[l],
                   s5_c_re[l], s5_c_im[l], s5_d[l]),
            'w_glu': w_glu[l], 'b_glu': b_glu[l], 'w_proj_a': w_proj_a[l],
            'w_pool': w_pool[l], 'pool_scale': pool_scale[l], 'w_proj_b': w_proj_b[l],
            'w_out': w_out[l], 'b_out': b_out[l],
            'ln1_g': ln1_g[l], 'ln1_b': ln1_b[l],
            'w_mlp1': w_mlp1[l], 'b_mlp1': b_mlp1[l], 'w_mlp2': w_mlp2[l], 'b_mlp2': b_mlp2[l],
            'ln2_g': ln2_g[l], 'ln2_b': ln2_b[l],
        }
        mod_ctx = adaln(c_ctx[None, :], w_ada[l], b_ada[l])
        yp, sf, sb = trunk_layer(yp, mod_ctx, None, None, None, lp)
        new_states.append(jnp.stack([jnp.stack([sf.real, sf.imag], axis=1),
                                     jnp.stack([sb.real, sb.imag], axis=1)], axis=1))
        st = state_s5[:, l].astype(f32)
        s0_f = lax.complex(st[:, 0, 0], st[:, 0, 1])
        s0_b = lax.complex(st[:, 1, 0], st[:, 1, 1])
        mod_lat = adaln(c, w_ada[l], b_ada[l])
        ys, _, _ = trunk_layer(ys, mod_lat, s0_f, s0_b, GRID_W, lp)
    new_state_s5 = jnp.stack(new_states, axis=1)
    return (yp, ys, new_state_s5)
```

```cpp
#include <hip/hip_runtime.h>
#include <cstdio>
#include <cstdint>
#ifndef MK_DEBUG
#define MK_DEBUG 0
#endif
#ifndef MK_DEBUG_FORCE
#define MK_DEBUG_FORCE 0
#endif
namespace pg8 {
#define PG8_LAS __attribute__((address_space(3)))
typedef unsigned short bf16_t;
typedef short bf16x8 __attribute__((ext_vector_type(8)));
typedef float f32x4 __attribute__((ext_vector_type(4)));
typedef unsigned u32x4 __attribute__((ext_vector_type(4)));
constexpr int BM = 256, BK = 64, HALF = 128, HTB = HALF * BK * 2  , STAGE_BYTES = 8 * HTB, NXCD = 8, WGM = 8;

__host__ __device__ __forceinline__ int lds_byte(int r, int c) { const int st = (r >> 4) * 2 + (c >> 5), rr = r & 15, cc = c & 31, ob = rr * 64 + cc * 2; return st * 1024 + (ob ^ (((ob >> 9) & 1) << 5)); }
__host__ __device__ __forceinline__ void stage_rc(int b, int& R, int& C) { const int st = b / 1024, sb = b % 1024, swz = sb ^ (((sb >> 9) & 1) << 5); R = (st >> 1) * 16 + swz / 64; C = (st & 1) * 32 + (swz % 64) / 2; }
__host__ __device__ __forceinline__ int perm32(int rho) { const int n = rho >> 4, i = rho & 15; return 8 * (i >> 2) + 4 * n + (i & 3); }

struct Unit { int pm, pn, part; };
struct Gemm { const bf16_t *A0, *A1, *B0, *B1; int nt0, nt1, ld;
    __device__ __forceinline__ const char* a(int part) const { return (const char*)(part ? A1 : A0); }
    __device__ __forceinline__ const char* b(int part) const { return (const char*)(part ? B1 : B0); }
    __device__ __forceinline__ int nt(int part) const { return part ? nt1 : nt0; } };

struct StaticOrder {
    int nM, nN, nwg, G, c, np;
    __host__ __device__ void init(int M, int N, int G_, int c_, int np_ = 1) { nM = M / BM; nN = N / BM; nwg = nM * nN; G = G_; c = c_; np = np_; }
    __host__ __device__ bool next(int ii, Unit& u) const {
        const int i = (np == 2) ? (ii >> 1) : ii; u.part = (np == 2) ? (ii & 1) : 0;
        const long L = (long)i * G + c; if (L >= nwg) return false;
        int wgid = (int)L; { const int q = nwg / NXCD, r = nwg % NXCD, xcd = wgid % NXCD, off = wgid / NXCD; wgid = (xcd < r ? xcd * (q + 1) : r * (q + 1) + (xcd - r) * q) + off; }
        const int nig = WGM * nN, gid = wgid / nig, fm = gid * WGM, gsz = (nM - fm) < WGM ? (nM - fm) : WGM;
        u.pm = fm + ((wgid % nig) % gsz); u.pn = (wgid % nig) / gsz; return true;
    }
    __device__ __forceinline__ void a_ready(const Unit&) const {}
    __device__ __forceinline__ void done(const Unit&) const {}
};
__device__ __forceinline__ unsigned cvt_pk_bf16(float lo, float hi) { unsigned r; asm volatile("v_cvt_pk_bf16_f32 %0, %1, %2" : "=v"(r) : "v"(lo), "v"(hi)); return r; }
typedef float f32x2 __attribute__((ext_vector_type(2)));
template <class Epi, class Sched, bool ALIGN_EPI = false, bool SP2 = false>
__device__ __forceinline__ void gemm_phase(PG8_LAS unsigned char* lds, const Gemm g, const Sched& S, const Epi& E) {
    const int tid = threadIdx.x, wid = __builtin_amdgcn_readfirstlane(tid >> 6), lane = tid & 63, wr = wid >> 2, wc = wid & 3, fr = lane & 15, fq = lane >> 4;
    const int K = g.ld;
    unsigned voffA[2], voffB[2];
#pragma unroll
    for (int i = 0; i < 2; ++i) { int R, C; stage_rc(tid * 16 + i * 8192, R, C); const int Rb = Epi::PERM ? ((R & ~31) + perm32(R & 31)) : R;
        voffA[i] = (unsigned)(R * K + C) * 2u; voffB[i] = (unsigned)(Rb * K + C) * 2u; }
    const size_t kstep = (size_t)(BK * 2);
    const size_t hstep = (size_t)HALF * K * 2;
    const size_t tstep = 2 * hstep;
    const unsigned ldsw = (unsigned)wid * 1024u;
    const int aoff = lds_byte(wr * 64 + fr, fq * 8), boff = lds_byte(wc * 32 + fr, fq * 8);
#define PG8_SA(b, h) (((b) * 2 + (h)) * HTB)
#define PG8_SB(b, h) ((4 + (b) * 2 + (h)) * HTB)
#define PG8_STAGE(bufoff, gbase, voff) do { _Pragma("unroll") for (int _i = 0; _i < 2; ++_i) \
        __builtin_amdgcn_global_load_lds((const unsigned*)((const char*)(gbase) + (voff)[_i]), (PG8_LAS unsigned*)(lds + (bufoff) + ldsw + _i * 8192), 16, 0, 0); } while (0)
#define PG8_LDA(dst, b, h) do { _Pragma("unroll") for (int m = 0; m < 4; ++m) _Pragma("unroll") for (int k = 0; k < 2; ++k) dst[m][k] = *(const PG8_LAS bf16x8*)(lds + PG8_SA(b, h) + aoff + m * 2048 + k * 1024); } while (0)
#define PG8_LDB(dst, b, h) do { _Pragma("unroll") for (int n = 0; n < 2; ++n) _Pragma("unroll") for (int k = 0; k < 2; ++k) dst[n][k] = *(const PG8_LAS bf16x8*)(lds + PG8_SB(b, h) + boff + n * 2048 + k * 1024); } while (0)
#define PG8_MMA(ai, bj, At, Bt) do { __builtin_amdgcn_s_setprio(1); _Pragma("unroll") for (int m = 0; m < 4; ++m) _Pragma("unroll") for (int n = 0; n < 2; ++n) _Pragma("unroll") for (int k = 0; k < 2; ++k) \
        acc[ai][bj][m][n] = __builtin_amdgcn_mfma_f32_16x16x32_bf16(Bt[n][k], At[m][k], acc[ai][bj][m][n], 0, 0, 0); __builtin_amdgcn_s_setprio(0); } while (0)
#define PG8_WAIT_V(n) asm volatile("s_waitcnt vmcnt(" #n ")" ::: "memory")
#define PG8_WAIT_L(n) asm volatile("s_waitcnt lgkmcnt(" #n ")" ::: "memory")
#define PG8_BAR __builtin_amdgcn_s_barrier()
#define PG8_SCHED __builtin_amdgcn_sched_barrier(0)
    Unit cur, nxt; int ui = 0;
    if (!S.next(0, cur)) return;
    f32x4 acc[2][2][4][2];
#pragma unroll
    for (int a = 0; a < 2; ++a)
#pragma unroll
        for (int b = 0; b < 2; ++b)
#pragma unroll
            for (int m = 0; m < 4; ++m)
#pragma unroll
                for (int n = 0; n < 2; ++n) acc[a][b][m][n] = (f32x4){0.f, 0.f, 0.f, 0.f};
    bf16x8 At[4][2], B0[2][2], B1[2][2];
    const char* cA = g.a(cur.part) + (size_t)cur.pm * tstep; const char* cB = g.b(cur.part) + (size_t)cur.pn * tstep;
    S.a_ready(cur);
    if constexpr (SP2) {
        PG8_STAGE(PG8_SB(0, 0), cB, voffB); PG8_STAGE(PG8_SB(0, 1), cB + hstep, voffB); PG8_STAGE(PG8_SA(0, 0), cA, voffA); PG8_STAGE(PG8_SA(0, 1), cA + hstep, voffA);
        if (wr == 1) PG8_BAR;
        PG8_WAIT_V(2); PG8_BAR;
        PG8_STAGE(PG8_SB(1, 0), cB + kstep, voffB); PG8_STAGE(PG8_SA(1, 0), cA + kstep, voffA); PG8_STAGE(PG8_SB(1, 1), cB + hstep + kstep, voffB);
        PG8_WAIT_V(6); PG8_BAR;
    } else {
        PG8_STAGE(PG8_SB(0, 0), cB, voffB); PG8_STAGE(PG8_SA(0, 0), cA, voffA); PG8_STAGE(PG8_SB(0, 1), cB + hstep, voffB); PG8_STAGE(PG8_SA(0, 1), cA + hstep, voffA);
        if (wr == 1) PG8_BAR;
        PG8_WAIT_V(4); PG8_BAR;
        PG8_STAGE(PG8_SB(1, 0), cB + kstep, voffB); PG8_STAGE(PG8_SA(1, 0), cA + kstep, voffA); PG8_STAGE(PG8_SB(1, 1), cB + hstep + kstep, voffB);
        PG8_WAIT_V(6); PG8_BAR;
    }
    for (;;) {
        const bool has_next = S.next(ui + 1, nxt);
        const char* nA = has_next ? g.a(nxt.part) + (size_t)nxt.pm * tstep : cA; const char* nB = has_next ? g.b(nxt.part) + (size_t)nxt.pn * tstep : cB;
        const int nt = g.nt(cur.part);
        for (int t = 0; t < nt; t += 2) {
            const bool last = (t == nt - 2);
            const char* a1 = cA + (size_t)(t + 1) * kstep;
            const char* a2 = last ? nA : cA + (size_t)(t + 2) * kstep; const char* b2 = last ? nB : cB + (size_t)(t + 2) * kstep;
            const char* a3 = a2 + kstep; const char* b3 = b2 + kstep;
            if (last && has_next) S.a_ready(nxt);
            if constexpr (SP2) {
            PG8_LDB(B0, 0, 0); PG8_LDB(B1, 0, 1); PG8_SCHED; PG8_LDA(At, 0, 0); PG8_STAGE(PG8_SA(1, 1), a1 + hstep, voffA);
            PG8_WAIT_V(8); PG8_WAIT_L(0); PG8_BAR; PG8_MMA(0, 0, At, B0); PG8_MMA(0, 1, At, B1); PG8_BAR; PG8_SCHED;
            PG8_LDA(At, 0, 1); PG8_STAGE(PG8_SB(0, 0), b2, voffB); PG8_STAGE(PG8_SB(0, 1), b2 + hstep, voffB); PG8_STAGE(PG8_SA(0, 0), a2, voffA);
            PG8_WAIT_V(8); PG8_WAIT_L(0); PG8_BAR; PG8_MMA(1, 0, At, B0); PG8_MMA(1, 1, At, B1); PG8_BAR; PG8_SCHED;
            PG8_LDB(B0, 1, 0); PG8_LDB(B1, 1, 1); PG8_SCHED; PG8_LDA(At, 1, 0); PG8_STAGE(PG8_SA(0, 1), a2 + hstep, voffA);
            PG8_WAIT_V(8); PG8_WAIT_L(0); PG8_BAR; PG8_MMA(0, 0, At, B0); PG8_MMA(0, 1, At, B1); PG8_BAR; PG8_SCHED;
            PG8_LDA(At, 1, 1); PG8_STAGE(PG8_SB(1, 0), b3, voffB); PG8_STAGE(PG8_SB(1, 1), b3 + hstep, voffB); PG8_STAGE(PG8_SA(1, 0), a3, voffA);
            PG8_WAIT_V(8); PG8_WAIT_L(0); PG8_BAR; PG8_MMA(1, 0, At, B0); PG8_MMA(1, 1, At, B1); PG8_BAR; PG8_SCHED;
            } else {
            PG8_LDB(B0, 0, 0); PG8_SCHED; PG8_LDA(At, 0, 0); PG8_STAGE(PG8_SA(1, 1), a1 + hstep, voffA);
            PG8_WAIT_L(8); PG8_BAR; PG8_WAIT_L(0); PG8_MMA(0, 0, At, B0); PG8_BAR; PG8_SCHED;
            PG8_LDB(B1, 0, 1); PG8_STAGE(PG8_SB(0, 0), b2, voffB);
            PG8_BAR; PG8_WAIT_L(0); PG8_MMA(0, 1, At, B1); PG8_BAR;
            PG8_LDA(At, 0, 1); PG8_STAGE(PG8_SA(0, 0), a2, voffA);
            PG8_BAR; PG8_WAIT_L(0); PG8_MMA(1, 0, At, B0); PG8_BAR; PG8_SCHED;
            PG8_STAGE(PG8_SB(0, 1), b2 + hstep, voffB);
            PG8_WAIT_V(6); PG8_BAR; PG8_MMA(1, 1, At, B1); PG8_BAR;
            PG8_LDB(B0, 1, 0); PG8_SCHED; PG8_LDA(At, 1, 0); PG8_STAGE(PG8_SA(0, 1), a2 + hstep, voffA);
            PG8_WAIT_L(8); PG8_BAR; PG8_WAIT_L(0); PG8_MMA(0, 0, At, B0); PG8_BAR; PG8_SCHED;
            PG8_LDB(B1, 1, 1); PG8_STAGE(PG8_SB(1, 0), b3, voffB);
            PG8_BAR; PG8_WAIT_L(0); PG8_MMA(0, 1, At, B1); PG8_BAR;
            PG8_LDA(At, 1, 1); PG8_STAGE(PG8_SA(1, 0), a3, voffA);
            PG8_BAR; PG8_WAIT_L(0); PG8_MMA(1, 0, At, B0); PG8_BAR; PG8_SCHED;
            PG8_STAGE(PG8_SB(1, 1), b3 + hstep, voffB);
            PG8_WAIT_V(6); PG8_BAR; PG8_MMA(1, 1, At, B1); PG8_BAR;
            }
        }
        if constexpr (ALIGN_EPI) { if (wr == 0) PG8_BAR; }
        if constexpr (!Epi::AFTER_DRAIN) { E(acc, cur, wr, wc, fr, fq); S.done(cur); }
        if (!has_next) break;
        if (!E.keep(cur)) {
#pragma unroll
        for (int a = 0; a < 2; ++a)
#pragma unroll
            for (int b = 0; b < 2; ++b)
#pragma unroll
                for (int m = 0; m < 4; ++m)
#pragma unroll
                    for (int n = 0; n < 2; ++n) acc[a][b][m][n] = (f32x4){0.f, 0.f, 0.f, 0.f};
        }
        cur = nxt; cA = nA; cB = nB; ++ui;
        if constexpr (ALIGN_EPI) { if (wr == 1) PG8_BAR; }
    }
    PG8_WAIT_V(0);
    if constexpr (!ALIGN_EPI) { if (wr == 0) PG8_BAR; }
    PG8_BAR;
    if constexpr (Epi::AFTER_DRAIN) { E.fused(acc, cur, wr, wc, fr, fq, lds, wid, lane); S.done(cur); }
#undef PG8_SA
#undef PG8_SB
#undef PG8_STAGE
#undef PG8_LDA
#undef PG8_LDB
#undef PG8_MMA
#undef PG8_WAIT_V
#undef PG8_WAIT_L
#undef PG8_BAR
#undef PG8_SCHED
}
}
#define GAS __attribute__((address_space(1)))
#define LAS __attribute__((address_space(3)))
typedef unsigned short bf16;
typedef unsigned v4u __attribute__((ext_vector_type(4)));
typedef float f32x4 __attribute__((ext_vector_type(4)));
typedef short bf16x8 __attribute__((ext_vector_type(8)));
typedef GAS unsigned gu32;
typedef GAS unsigned long long gu64;
#define RLX_AGENT __ATOMIC_RELAXED, __HIP_MEMORY_SCOPE_AGENT
#define LDS_WAIT() asm volatile("s_waitcnt lgkmcnt(0)" ::: "memory")
#define VM_WAIT() asm volatile("s_waitcnt vmcnt(0)" ::: "memory")
__device__ __forceinline__ unsigned long long rt() { return __builtin_amdgcn_s_memrealtime(); }
__device__ __forceinline__ unsigned f2bf(float f) { unsigned u = __builtin_bit_cast(unsigned, f); return (u + 0x7fffu + ((u >> 16) & 1u)) >> 16; }
__device__ __forceinline__ unsigned pk2(float lo, float hi) { return f2bf(lo) | (f2bf(hi) << 16); }

#define XB_TMO      128
#define XB_XCNT(j)  (256  + 64 * (j))
#define XB_XSUB(j)  (1280 + 64 * (j))
#define XB_XGEN(j)  (2304 + 64 * (j))
#define XB_TOP      3328
#define XB_TOPGEN   3392
#define XCD_BAR_WORDS 3456
#define XB_SPIN_CAP (1u << 18)

__device__ __forceinline__ unsigned xb_ld(unsigned* p)              { return __hip_atomic_load(p, __ATOMIC_RELAXED, __HIP_MEMORY_SCOPE_AGENT); }
__device__ __forceinline__ unsigned xb_add(unsigned* p, unsigned v) { return __hip_atomic_fetch_add(p, v, __ATOMIC_RELAXED, __HIP_MEMORY_SCOPE_AGENT); }
__device__ __forceinline__ unsigned xb_xcc_id() { return (unsigned)__builtin_amdgcn_s_getreg((3 << 11) | 20) & 0xFu; }
#define XB_SPIN(cond, bar) do { unsigned _sp = 0; while (cond) { __builtin_amdgcn_s_sleep(1); \
    if ((++_sp & 255u) == 0u) { if (xb_ld(&(bar)[XB_TMO])) break; if (_sp > XB_SPIN_CAP) { atomicAdd(&(bar)[XB_TMO], 1u); break; } } } } while (0)

struct XcdBarrier {
    unsigned* bar; unsigned x;
    volatile LAS unsigned* st;
};

__device__ __forceinline__ XcdBarrier xcd_barrier_post(unsigned* bar, volatile LAS unsigned* st) {
    XcdBarrier b; b.bar = bar; b.x = xb_xcc_id(); b.st = st;
    if (threadIdx.x == 0) (void)xb_add(&bar[XB_XCNT(b.x)], 1u);
    return b;
}
__device__ __forceinline__ void xcd_barrier_complete(unsigned* bar, unsigned x, unsigned& nloc, unsigned& nx) {
    const unsigned G = gridDim.x * gridDim.y * gridDim.z;
    unsigned sum, cnt, mine, sp = 0u;
    for (;;) {
        sum = 0u; cnt = 0u; mine = 0u;
#pragma unroll
        for (unsigned j = 0; j < 16; ++j) { const unsigned c = xb_ld(&bar[XB_XCNT(j)]); sum += c; cnt += (c > 0u) ? 1u : 0u; mine = (j == x) ? c : mine; }
        if (sum == G) break;
        __builtin_amdgcn_s_sleep(1);
        if ((++sp & 255u) == 0u) { if (xb_ld(&bar[XB_TMO])) break; if (sp > XB_SPIN_CAP) { atomicAdd(&bar[XB_TMO], 1u); break; } }
    }
    nloc = mine > 0u ? mine : 1u; nx = cnt > 0u ? cnt : 1u;
}

__device__ __forceinline__ void xcd_barrier(const XcdBarrier& b) {
    asm volatile("s_waitcnt vmcnt(0)" ::: "memory");
    __syncthreads();
    if (threadIdx.x == 0) {
        unsigned* bar = b.bar;
        __builtin_amdgcn_s_waitcnt(0);
        unsigned nloc = b.st[0], nx = b.st[1];
        if (nloc == 0u) { xcd_barrier_complete(bar, b.x, nloc, nx); b.st[0] = nloc; b.st[1] = nx; }
        const unsigned old = xb_add(&bar[XB_XSUB(b.x)], 1u);
        const unsigned gen = old / nloc;
        if (old + 1u == (gen + 1u) * nloc) {
            __builtin_amdgcn_fence(__ATOMIC_RELEASE, "agent");
            asm volatile("s_waitcnt vmcnt(0)" ::: "memory");
            const unsigned og = xb_add(&bar[XB_TOP], 1u);
            const unsigned tg = og / nx;
            if (og + 1u == (tg + 1u) * nx) xb_add(&bar[XB_TOPGEN], 1u);
            else XB_SPIN(xb_ld(&bar[XB_TOPGEN]) == tg, bar);
            __builtin_amdgcn_fence(__ATOMIC_ACQUIRE, "agent");
            xb_add(&bar[XB_XGEN(b.x)], 1u);
            asm volatile("s_waitcnt vmcnt(0)" ::: "memory");
        } else {
            XB_SPIN(xb_ld(&bar[XB_XGEN(b.x)]) == gen, bar);
            __builtin_amdgcn_fence(__ATOMIC_ACQUIRE, "agent");
            asm volatile("s_waitcnt vmcnt(0)" ::: "memory");
        }
    }
    __syncthreads();
}
constexpr int D = 1024, M_CTX = 8192, M = 16384, L_CTX = 256, L_LAT = 1024, NB_CTX = 32, NB_LAT = 8;
constexpr int DIN = 3584, DFF = 4096, DPOOL = 512, NGRP = 64, NST = 64, HG = 16;
constexpr float DN_ALPHA = 1.189207115002721f;
constexpr float LN_EPS = 1e-6f;
constexpr int NWAVES = 8;

constexpr size_t MiB = 1u << 20;
constexpr size_t WS_CTL = 0, CTL_ZERO_BYTES = 64 * 1024;
constexpr size_t WS_MODP = 1 * MiB;
constexpr size_t WS_MODF = 2 * MiB;
constexpr size_t WS_LAMB = 2 * MiB + 512 * 1024;
constexpr size_t WS_BB   = 3 * MiB;
constexpr size_t WS_CT   = 3 * MiB + 512 * 1024;
constexpr size_t WS_WIN = 4 * MiB, WS_WGLU = 11 * MiB, WS_WPA = 13 * MiB, WS_WPB = 15 * MiB, WS_WOUT = 17 * MiB, WS_W1 = 19 * MiB, WS_W2 = 27 * MiB, WS_WPOOL = 35 * MiB;
constexpr size_t WS_RA = 36 * MiB;
constexpr size_t WS_RB = 68 * MiB;
constexpr size_t WS_UB = 100 * MiB;
constexpr size_t WS_GA = 116 * MiB, WS_GB = 148 * MiB;
constexpr size_t WS_P  = 180 * MiB;
constexpr size_t WS_HM = 100 * MiB;
constexpr size_t WS_END = 228 * MiB;
constexpr int CW_BAR = 1024;

constexpr int RING_BYTES = 131072, LDSCTL_OFF = RING_BYTES, MISC_OFF = LDSCTL_OFF + 320, LDS_BYTES = 147456;

typedef unsigned u32x2 __attribute__((ext_vector_type(2)));
typedef float f32x16 __attribute__((ext_vector_type(16)));
__device__ __forceinline__ float bf_lo(unsigned w) { return __builtin_bit_cast(float, w << 16); }
__device__ __forceinline__ float bf_hi(unsigned w) { return __builtin_bit_cast(float, w & 0xffff0000u); }
__device__ __forceinline__ float fsigmoid(float x) { return __builtin_amdgcn_rcpf(1.0f + __builtin_amdgcn_exp2f(-1.4426950408889634f * x)); }
__device__ __forceinline__ float gelu_tanh(float x) { const float u = x * (1.5957691216057308f + 0.0713548162726f * x * x); return x * fsigmoid(u); }

namespace pg8 {
#define EPI_LOOP_BEGIN _Pragma("unroll") for (int ai = 0; ai < 2; ++ai) _Pragma("unroll") for (int m = 0; m < 4; ++m) { const int row = u.pm * BM + ai * HALF + wr * 64 + m * 16 + fr; _Pragma("unroll") for (int bj = 0; bj < 2; ++bj) { const int cl = bj * HALF + wc * 32 + 8 * fq;
#define EPI_LOOP_END } }
__device__ __forceinline__ u32x4 pack8(const f32x4& a, const f32x4& b) { u32x4 w; w.x = cvt_pk_bf16(a[0], a[1]); w.y = cvt_pk_bf16(a[2], a[3]); w.z = cvt_pk_bf16(b[0], b[1]); w.w = cvt_pk_bf16(b[2], b[3]); return w; }
__device__ __forceinline__ void unpack8(const u32x4& w, f32x4& a, f32x4& b) { a = (f32x4){bf_lo(w.x), bf_hi(w.x), bf_lo(w.y), bf_hi(w.y)}; b = (f32x4){bf_lo(w.z), bf_hi(w.z), bf_lo(w.w), bf_hi(w.w)}; }

struct EpiIn {
    static constexpr bool PERM = true, AFTER_DRAIN = false;
    bf16_t *ua, *ub, *ga, *gb; const float* bias;
    __device__ __forceinline__ bool keep(const Unit&) const { return false; }
    __device__ __forceinline__ void operator()(f32x4 (&acc)[2][2][4][2], const Unit& u, int wr, int wc, int fr, int fq) const {
        bf16_t* base; int ldc, c0; bool sg;
        if (u.pn < 4) { base = ua; ldc = D; c0 = u.pn * BM; sg = false; } else if (u.pn < 6) { base = ub; ldc = DPOOL; c0 = (u.pn - 4) * BM; sg = false; }
        else if (u.pn < 10) { base = ga; ldc = D; c0 = (u.pn - 6) * BM; sg = true; } else { base = gb; ldc = D; c0 = (u.pn - 10) * BM; sg = true; }
        EPI_LOOP_BEGIN
            const float* bp = bias + u.pn * BM + cl; f32x4 v0 = acc[ai][bj][m][0] + *(const f32x4*)bp, v1 = acc[ai][bj][m][1] + *(const f32x4*)(bp + 4);
            if (sg) {
#pragma unroll
                for (int j = 0; j < 4; ++j) { v0[j] = fsigmoid(v0[j]); v1[j] = fsigmoid(v1[j]); } }
            *(u32x4*)(base + (size_t)row * ldc + c0 + cl) = pack8(v0, v1);
        EPI_LOOP_END
    }
};
struct EpiGlu {
    static constexpr bool PERM = true, AFTER_DRAIN = false;
    const bf16_t* v; bf16_t* o; const float* bias;
    __device__ __forceinline__ bool keep(const Unit&) const { return false; }
    __device__ __forceinline__ void operator()(f32x4 (&acc)[2][2][4][2], const Unit& u, int wr, int wc, int fr, int fq) const {
        EPI_LOOP_BEGIN
            const int col = u.pn * BM + cl; const float* bp = bias + col; f32x4 t0 = acc[ai][bj][m][0] + *(const f32x4*)bp, t1 = acc[ai][bj][m][1] + *(const f32x4*)(bp + 4);
            f32x4 x0, x1; unpack8(*(const u32x4*)(v + (size_t)row * D + col), x0, x1);
#pragma unroll
            for (int j = 0; j < 4; ++j) { t0[j] = x0[j] * fsigmoid(t0[j]); t1[j] = x1[j] * fsigmoid(t1[j]); }
            *(u32x4*)(o + (size_t)row * D + col) = pack8(t0, t1);
        EPI_LOOP_END
    }
};
struct EpiMerge {
    static constexpr bool PERM = true, AFTER_DRAIN = false;
    const bf16_t *ga, *gb; bf16_t* o;
    __device__ __forceinline__ bool keep(const Unit& u) const { return u.part == 0; }
    __device__ __forceinline__ void operator()(f32x4 (&acc)[2][2][4][2], const Unit& u, int wr, int wc, int fr, int fq) const {
        EPI_LOOP_BEGIN
            const size_t off = (size_t)row * D + u.pn * BM + cl; f32x4 b0, b1; unpack8(*(const u32x4*)(gb + off), b0, b1);
            if (u.part == 0) { f32x4 a0, a1; unpack8(*(const u32x4*)(ga + off), a0, a1);
#pragma unroll
                for (int j = 0; j < 4; ++j) { acc[ai][bj][m][0][j] *= a0[j] * __builtin_amdgcn_rcpf(fmaxf(b0[j], 1e-30f)); acc[ai][bj][m][1][j] *= a1[j] * __builtin_amdgcn_rcpf(fmaxf(b1[j], 1e-30f)); } }
            else { *(u32x4*)(o + off) = pack8(acc[ai][bj][m][0] * b0, acc[ai][bj][m][1] * b1); }
        EPI_LOOP_END
    }
};
struct EpiRes {
    static constexpr bool PERM = true, AFTER_DRAIN = false;
    const float *base_ctx, *base_lat; float* out; const float* bias; const float* modf; int gate_idx;
    __device__ __forceinline__ bool keep(const Unit&) const { return false; }
    __device__ __forceinline__ void operator()(f32x4 (&acc)[2][2][4][2], const Unit& u, int wr, int wc, int fr, int fq) const {
        const int r0 = u.pm * BM; const int bidx = r0 < M_CTX ? 0 : 1 + (r0 - M_CTX) / L_LAT;
        const float* gate = modf + (size_t)bidx * 6 * D + gate_idx * D; const float* bs = r0 < M_CTX ? base_ctx : base_lat - (size_t)M_CTX * D;
        EPI_LOOP_BEGIN
            const int col = u.pn * BM + cl; const size_t off = (size_t)row * D + col;
            const f32x4 g0 = *(const f32x4*)(gate + col), g1 = *(const f32x4*)(gate + col + 4), c0 = *(const f32x4*)(bias + col), c1 = *(const f32x4*)(bias + col + 4);
            const f32x4 x0 = *(const f32x4*)(bs + off), x1 = *(const f32x4*)(bs + off + 4);
            *(f32x4*)(out + off) = x0 * DN_ALPHA + g0 * (acc[ai][bj][m][0] + c0); *(f32x4*)(out + off + 4) = x1 * DN_ALPHA + g1 * (acc[ai][bj][m][1] + c1);
        EPI_LOOP_END
    }
};
struct EpiRelu2 {
    static constexpr bool PERM = true, AFTER_DRAIN = false;
    bf16_t* o; const float* bias;
    __device__ __forceinline__ bool keep(const Unit&) const { return false; }
    __device__ __forceinline__ void operator()(f32x4 (&acc)[2][2][4][2], const Unit& u, int wr, int wc, int fr, int fq) const {
        EPI_LOOP_BEGIN
            const int col = u.pn * BM + cl; f32x4 t0 = acc[ai][bj][m][0] + *(const f32x4*)(bias + col), t1 = acc[ai][bj][m][1] + *(const f32x4*)(bias + col + 4);
#pragma unroll
            for (int j = 0; j < 4; ++j) { const float a = fmaxf(t0[j], 0.f), b = fmaxf(t1[j], 0.f); t0[j] = a * a; t1[j] = b * b; }
            *(u32x4*)(o + (size_t)row * DFF + col) = pack8(t0, t1);
        EPI_LOOP_END
    }
};
}
struct Frame {
    LAS unsigned char* lds;
    volatile LAS unsigned* MISC;
    gu32* ctl;
    int tid, lane, wave, G, bid;
    const float* in[33]; float* out; unsigned char* ws;
};
enum { I_XP = 0, I_XS, I_STATE, I_C, I_CCTX, I_WADA, I_BADA, I_WIN, I_BIN, I_LAMRE, I_LAMIM, I_LOGDT, I_BRE, I_BIM, I_CRE, I_CIM, I_S5D, I_WGLU, I_BGLU, I_WPA, I_WPOOL, I_PSCALE, I_WPB,
       I_WOUT, I_BOUT, I_LN1G, I_LN1B, I_W1, I_B1, I_W2, I_B2, I_LN2G, I_LN2B };

__device__ __forceinline__ float wave_sum(float v) {
#pragma unroll
    for (int o = 1; o < 64; o <<= 1) v += __shfl_xor(v, o);
    return v;
}
__device__ __forceinline__ void p0_transpose_item(const float* W, int N, bf16* WT, int ldt, LAS float* scr, int item, int lane) {
    const int nblk = N / 32, kb = item / nblk, nb = item % nblk, k0 = 64 * kb, n0 = 32 * nb;
#pragma unroll 8
    for (int i = 0; i < 32; ++i) { const int kk = 2 * i + (lane >> 5); scr[kk * 33 + (lane & 31)] = W[(size_t)(k0 + kk) * N + n0 + (lane & 31)]; }
    LDS_WAIT(); asm volatile("" ::: "memory");
    const int c = lane & 7;
#pragma unroll
    for (int j = 0; j < 4; ++j) { const int n = (lane >> 3) + 8 * j; const LAS float* s = scr + (8 * c) * 33 + n;
        v4u o; o.x = pk2(s[0 * 33], s[1 * 33]); o.y = pk2(s[2 * 33], s[3 * 33]); o.z = pk2(s[4 * 33], s[5 * 33]); o.w = pk2(s[6 * 33], s[7 * 33]);
        *(GAS v4u*)(WT + (size_t)(n0 + n) * ldt + k0 + 8 * c) = o; }
    LDS_WAIT(); asm volatile("" ::: "memory");
}

__device__ __forceinline__ void phase0(Frame& F) {
    unsigned char* ws = F.ws;
    if (F.bid < 96) {
        const int cc = F.bid % 24, kq = F.bid / 24, k0 = kq * 256 + F.wave * 32;
        LAS float* sv = (LAS float*)(F.lds) + F.wave * 288;
        LAS float* red = (LAS float*)(F.lds + 16384);
        if (F.lane < 32) {
#pragma unroll
            for (int r = 0; r < 9; ++r) { const float cv = r == 0 ? F.in[I_CCTX][k0 + F.lane] : F.in[I_C][(size_t)(r - 1) * D + k0 + F.lane]; sv[r * 32 + F.lane] = cv * fsigmoid(cv); }
        }
        LDS_WAIT(); asm volatile("" ::: "memory");
        f32x4 a[9];
#pragma unroll
        for (int r = 0; r < 9; ++r) a[r] = (f32x4){0.f, 0.f, 0.f, 0.f};
        const float* wp = F.in[I_WADA] + (size_t)k0 * 6144 + cc * 256 + F.lane * 4;
#pragma unroll 8
        for (int k = 0; k < 32; ++k) { const f32x4 w = *(const f32x4*)(wp + (size_t)k * 6144);
#pragma unroll
            for (int r = 0; r < 9; ++r) a[r] += w * sv[r * 32 + k]; }
#pragma unroll
        for (int r = 0; r < 9; ++r) *(LAS f32x4*)(red + (F.wave * 9 + r) * 256 + F.lane * 4) = a[r];
        __syncthreads();
        float* mp = (float*)(ws + WS_MODP) + (size_t)kq * 9 * 6144;
        for (int i = F.tid; i < 9 * 256; i += NWAVES * 64) { const int r = i >> 8, c = i & 255; float s = 0.f;
#pragma unroll
            for (int w = 0; w < 8; ++w) s += red[(w * 9 + r) * 256 + c];
            mp[(size_t)r * 6144 + cc * 256 + c] = s; }
        __syncthreads();
    }
    for (int it = F.bid * (NWAVES * 64) + F.tid; it < 2 * NGRP * NST; it += F.G * NWAVES * 64) {
        const int p = it & 63, g = (it >> 6) & 63, dir = it >> 12;
        const float lr = F.in[I_LAMRE][it], li = F.in[I_LAMIM][it], dt = expf(F.in[I_LOGDT][dir * 64 + g]);
        const float zr = lr * dt, zi = li * dt, e = expf(zr); float sn, cs; sincosf(zi, &sn, &cs);
        const float lbr = e * cs, lbi = e * sn;
        const float sh = sinf(0.5f * zi); const float nr = expm1f(zr) * cs - 2.f * sh * sh, ni = lbi;
        const float den = 1.f / (lr * lr + li * li); const float wr_ = (nr * lr + ni * li) * den, wi_ = (ni * lr - nr * li) * den;
        float* lamb = (float*)(ws + WS_LAMB) + (size_t)it * 2; lamb[0] = lbr; lamb[1] = lbi;
        bf16* bb = (bf16*)(ws + WS_BB); const float* bre = F.in[I_BRE] + (size_t)it * 16; const float* bim = F.in[I_BIM] + (size_t)it * 16;
        unsigned ore[8], oim[8];
#pragma unroll
        for (int h = 0; h < 8; ++h) { const float r0 = bre[2 * h], i0 = bim[2 * h], r1 = bre[2 * h + 1], i1 = bim[2 * h + 1];
            ore[h] = pk2(wr_ * r0 - wi_ * i0, wr_ * r1 - wi_ * i1); oim[h] = pk2(wr_ * i0 + wi_ * r0, wr_ * i1 + wi_ * r1); }
        v4u* dre = (v4u*)(bb + ((size_t)((dir * 64 + g) * 2 + 0) * 64 + p) * 16); v4u* dim_ = (v4u*)(bb + ((size_t)((dir * 64 + g) * 2 + 1) * 64 + p) * 16);
        dre[0] = (v4u){ore[0], ore[1], ore[2], ore[3]}; dre[1] = (v4u){ore[4], ore[5], ore[6], ore[7]};
        dim_[0] = (v4u){oim[0], oim[1], oim[2], oim[3]}; dim_[1] = (v4u){oim[4], oim[5], oim[6], oim[7]};
        bf16* ct = (bf16*)(ws + WS_CT) + (size_t)(dir * 64 + g) * 16 * 128;
#pragma unroll
        for (int h = 0; h < 16; ++h) { const size_t ci = ((size_t)(dir * 64 + g) * 16 + h) * 64 + p;
            *(unsigned*)(ct + h * 128 + 2 * p) = pk2(F.in[I_CRE][ci], -F.in[I_CIM][ci]); }
    }
    {
        LAS float* scr = (LAS float*)(F.lds + F.wave * 16384);
        const int gw = F.bid * NWAVES + F.wave, NGW = F.G * NWAVES;
        constexpr int I_IN = (D / 64) * (DIN / 32), I_SQ = (D / 64) * (D / 32), I_PB = (DPOOL / 64) * (D / 32), I_1 = (D / 64) * (DFF / 32), I_2 = (DFF / 64) * (D / 32), I_PL = 4 * 2 * 4;
        constexpr int NITEMS = I_IN + 3 * I_SQ + I_PB + I_1 + I_2 + I_PL;
        for (int it = gw; it < NITEMS; it += NGW) {
            int r = it;
            if (r < I_1) { p0_transpose_item(F.in[I_W1], DFF, (bf16*)(ws + WS_W1), D, scr, r, F.lane); continue; } r -= I_1;
            if (r < I_2) { p0_transpose_item(F.in[I_W2], D, (bf16*)(ws + WS_W2), DFF, scr, r, F.lane); continue; } r -= I_2;
            if (r < I_IN) { p0_transpose_item(F.in[I_WIN], DIN, (bf16*)(ws + WS_WIN), D, scr, r, F.lane); continue; } r -= I_IN;
            if (r < I_SQ) { p0_transpose_item(F.in[I_WGLU], D, (bf16*)(ws + WS_WGLU), D, scr, r, F.lane); continue; } r -= I_SQ;
            if (r < I_SQ) { p0_transpose_item(F.in[I_WPA], D, (bf16*)(ws + WS_WPA), D, scr, r, F.lane); continue; } r -= I_SQ;
            if (r < I_SQ) { p0_transpose_item(F.in[I_WOUT], D, (bf16*)(ws + WS_WOUT), D, scr, r, F.lane); continue; } r -= I_SQ;
            if (r < I_PB) { p0_transpose_item(F.in[I_WPB], D, (bf16*)(ws + WS_WPB), D, scr, r, F.lane); continue; } r -= I_PB;
            { const int gi = r >> 3; p0_transpose_item(F.in[I_WPOOL] + (size_t)gi * 128 * 128, 128, (bf16*)(ws + WS_WPOOL) + (size_t)gi * 128 * 128, 128, scr, r & 7, F.lane); }
        }
    }
}

__device__ __forceinline__ f32x4 mod4(Frame& F, int bidx, int idx) {
    const float* mp = (const float*)(F.ws + WS_MODP) + (size_t)bidx * 6144 + idx;
    f32x4 s = *(const f32x4*)(F.in[I_BADA] + idx);
#pragma unroll
    for (int q = 0; q < 4; ++q) s += *(const f32x4*)(mp + (size_t)q * 9 * 6144);
    return s;
}
__device__ __forceinline__ int batch_of_row(int r0) { return r0 < M_CTX ? 0 : 1 + (r0 - M_CTX) / L_LAT; }

__device__ __forceinline__ void phase1(Frame& F) {
    LAS f32x4* sc = (LAS f32x4*)(F.lds); LAS f32x4* sh = (LAS f32x4*)(F.lds + 4096);
    bf16* H = (bf16*)(F.ws + WS_RA);
    if (F.bid < 9) { float* mf = (float*)(F.ws + WS_MODF) + (size_t)F.bid * 6144; for (int i = F.tid; i < 6144 / 4; i += NWAVES * 64) *(f32x4*)(mf + 4 * i) = mod4(F, F.bid, 4 * i); }
    for (int rb = F.bid; rb < M / 64; rb += F.G) {
        const int r0 = rb * 64, bidx = batch_of_row(r0);
        __syncthreads();
        if (F.tid < 256) { sc[F.tid] = mod4(F, bidx, D + 4 * F.tid) + 1.0f; sh[F.tid] = mod4(F, bidx, 4 * F.tid); }
        __syncthreads();
        for (int j = 0; j < 8; ++j) {
            const int m = r0 + F.wave * 8 + j;
            const float* xrow = (m < M_CTX ? F.in[I_XP] + (size_t)m * D : F.in[I_XS] + (size_t)(m - M_CTX) * D);
            const GAS f32x4* xr = (const GAS f32x4*)xrow + F.lane;
            f32x4 v[4]; float s = 0.f;
#pragma unroll
            for (int q = 0; q < 4; ++q) { v[q] = xr[64 * q]; s += (v[q].x + v[q].y) + (v[q].z + v[q].w); }
            const float mean = wave_sum(s) * (1.f / D); float s2 = 0.f;
#pragma unroll
            for (int q = 0; q < 4; ++q) { v[q] = v[q] - mean; s2 += (v[q].x * v[q].x + v[q].y * v[q].y) + (v[q].z * v[q].z + v[q].w * v[q].w); }
            const float rstd = 1.f / sqrtf(wave_sum(s2) * (1.f / D) + LN_EPS);
            GAS u32x2* o8 = (GAS u32x2*)(H + (size_t)m * D) + F.lane;
#pragma unroll
            for (int q = 0; q < 4; ++q) { const f32x4 y = v[q] * rstd * sc[F.lane + 64 * q] + sh[F.lane + 64 * q]; u32x2 w; w.x = pg8::cvt_pk_bf16(y.x, y.y); w.y = pg8::cvt_pk_bf16(y.z, y.w); o8[64 * q] = w; }
        }
    }
}

template <bool SECOND> __device__ __forceinline__ void phase_ln(Frame& F, const float* lg, const float* lb, bf16* H2) {
    LAS f32x4* sc = (LAS f32x4*)(F.lds); LAS f32x4* sh = (LAS f32x4*)(F.lds + 4096);
    for (int rb = F.bid; rb < M / 64; rb += F.G) {
        const int r0 = rb * 64, bidx = batch_of_row(r0);
        if (SECOND) {
            __syncthreads();
            const float* mf = (const float*)(F.ws + WS_MODF) + (size_t)bidx * 6144;
            if (F.tid < 256) { sc[F.tid] = *(const f32x4*)(mf + 4 * D + 4 * F.tid) + 1.0f; sh[F.tid] = *(const f32x4*)(mf + 3 * D + 4 * F.tid); }
            __syncthreads();
        }
        f32x4 gg[4], bb[4];
#pragma unroll
        for (int q = 0; q < 4; ++q) { gg[q] = *(const f32x4*)(lg + 4 * (F.lane + 64 * q)); bb[q] = *(const f32x4*)(lb + 4 * (F.lane + 64 * q)); }
        for (int j = 0; j < 8; ++j) {
            const int m = r0 + F.wave * 8 + j;
            GAS f32x4* xr = (GAS f32x4*)(F.out + (size_t)m * D) + F.lane;
            f32x4 v[4]; float s = 0.f;
#pragma unroll
            for (int q = 0; q < 4; ++q) { v[q] = xr[64 * q]; s += (v[q].x + v[q].y) + (v[q].z + v[q].w); }
            float mean = wave_sum(s) * (1.f / D), s2 = 0.f;
#pragma unroll
            for (int q = 0; q < 4; ++q) { v[q] = v[q] - mean; s2 += (v[q].x * v[q].x + v[q].y * v[q].y) + (v[q].z * v[q].z + v[q].w * v[q].w); }
            float rstd = 1.f / sqrtf(wave_sum(s2) * (1.f / D) + LN_EPS);
            s = 0.f;
#pragma unroll
            for (int q = 0; q < 4; ++q) { v[q] = v[q] * rstd * gg[q] + bb[q]; xr[64 * q] = v[q]; s += (v[q].x + v[q].y) + (v[q].z + v[q].w); }
            if (SECOND) {
                mean = wave_sum(s) * (1.f / D); s2 = 0.f;
#pragma unroll
                for (int q = 0; q < 4; ++q) { v[q] = v[q] - mean; s2 += (v[q].x * v[q].x + v[q].y * v[q].y) + (v[q].z * v[q].z + v[q].w * v[q].w); }
                rstd = 1.f / sqrtf(wave_sum(s2) * (1.f / D) + LN_EPS);
                GAS u32x2* o8 = (GAS u32x2*)(H2 + (size_t)m * D) + F.lane;
#pragma unroll
                for (int q = 0; q < 4; ++q) { const f32x4 y = v[q] * rstd * sc[F.lane + 64 * q] + sh[F.lane + 64 * q]; u32x2 w; w.x = pg8::cvt_pk_bf16(y.x, y.y); w.y = pg8::cvt_pk_bf16(y.z, y.w); o8[64 * q] = w; }
            }
        }
    }
}
constexpr int S5_ROWB = 288, S5_WAVEB = 32 * S5_ROWB;
__device__ __forceinline__ void s5_task(Frame& F, bool lat, int seq, int gq) {
    const int lane = F.lane, n = lane & 31, hf = lane >> 5, g = gq * 4 + (F.wave >> 1), dir = F.wave & 1;
    const int L = lat ? L_LAT : L_CTX, tokbase = lat ? (M_CTX + seq * L_LAT) : seq * L_CTX, nch = L / 32;
    const bf16* UA = (const bf16*)(F.ws + WS_RB); bf16* V = (bf16*)(F.ws + WS_RA); float* PART = F.out;
    LAS unsigned char* sl = F.lds + F.wave * S5_WAVEB;
    bf16x8 Bf[2][2], Cf[4];
    { const bf16* bb = (const bf16*)(F.ws + WS_BB);
#pragma unroll
      for (int q = 0; q < 2; ++q)
#pragma unroll
        for (int part = 0; part < 2; ++part) Bf[q][part] = *(const bf16x8*)(bb + ((size_t)((dir * 64 + g) * 2 + part) * 64 + (n + 32 * q)) * 16 + 8 * hf);
      const bf16* ct = (const bf16*)(F.ws + WS_CT) + ((size_t)(dir * 64 + g) * 16 + (lane & 15)) * 128 + 8 * (lane >> 4);
#pragma unroll
      for (int ks = 0; ks < 4; ++ks) Cf[ks] = *(const bf16x8*)(ct + 32 * ks); }
    const int p = n + 32 * hf;
    const float lr = ((const float*)(F.ws + WS_LAMB))[((size_t)(dir * 64 + g) * 64 + p) * 2], li = ((const float*)(F.ws + WS_LAMB))[((size_t)(dir * 64 + g) * 64 + p) * 2 + 1];
    float sr = 0.f, si = 0.f;
    if (lat) { const float* st = F.in[I_STATE] + ((size_t)(seq * 2 + dir) * 2) * 4096 + g * 64 + p; sr = st[0]; si = st[4096]; }
    const int tauA = 16 * ((n >> 2) & 1) + (n & 3) + 4 * (n >> 3);
    const int tA = dir ? 31 - tauA : tauA;
    const bf16* ua_lane = UA + (size_t)tokbase * D + g * 16 + 8 * hf;
    const int h0 = 4 * (lane >> 4), colg = g * 16 + h0;
    const f32x4 dsum = *(const f32x4*)(F.in[I_S5D] + colg) + *(const f32x4*)(F.in[I_S5D] + D + colg);
    bf16x8 Acur = *(const bf16x8*)(ua_lane + (size_t)((dir ? L - 32 : 0) + tA) * D);
    for (int c = 0; c < nch; ++c) {
        const int t0 = dir ? L - 32 * (c + 1) : 32 * c;
        if (c == nch / 2) { asm volatile("s_waitcnt vmcnt(0)" ::: "memory"); __syncthreads(); }
        const f32x16 z16 = {0.f, 0.f, 0.f, 0.f, 0.f, 0.f, 0.f, 0.f, 0.f, 0.f, 0.f, 0.f, 0.f, 0.f, 0.f, 0.f};
        f32x16 x00 = __builtin_amdgcn_mfma_f32_32x32x16_bf16(Acur, Bf[0][0], z16, 0, 0, 0);
        f32x16 x01 = __builtin_amdgcn_mfma_f32_32x32x16_bf16(Acur, Bf[0][1], z16, 0, 0, 0);
        f32x16 x10 = __builtin_amdgcn_mfma_f32_32x32x16_bf16(Acur, Bf[1][0], z16, 0, 0, 0);
        f32x16 x11 = __builtin_amdgcn_mfma_f32_32x32x16_bf16(Acur, Bf[1][1], z16, 0, 0, 0);
        if (c + 1 < nch) { const int t1 = dir ? L - 32 * (c + 2) : 32 * (c + 1); Acur = *(const bf16x8*)(ua_lane + (size_t)(t1 + tA) * D); }
        float xr0[16], xi0[16], xr1[16], xi1[16];
#pragma unroll
        for (int i = 0; i < 16; ++i) {
            { auto r = __builtin_amdgcn_permlane32_swap(__float_as_uint(x00[i]), __float_as_uint(x10[i]), false, false); xr0[i] = __uint_as_float(r[0]); xr1[i] = __uint_as_float(r[1]); }
            { auto r = __builtin_amdgcn_permlane32_swap(__float_as_uint(x01[i]), __float_as_uint(x11[i]), false, false); xi0[i] = __uint_as_float(r[0]); xi1[i] = __uint_as_float(r[1]); }
        }
        LAS unsigned* srow = (LAS unsigned*)(sl + p * 4);
#pragma unroll
        for (int i = 0; i < 16; ++i) { const float nr = lr * sr - li * si + xr0[i], ni = lr * si + li * sr + xi0[i]; sr = nr; si = ni; srow[i * (S5_ROWB / 4)] = pg8::cvt_pk_bf16(sr, si); }
#pragma unroll
        for (int i = 0; i < 16; ++i) { const float nr = lr * sr - li * si + xr1[i], ni = lr * si + li * sr + xi1[i]; sr = nr; si = ni; srow[(16 + i) * (S5_ROWB / 4)] = pg8::cvt_pk_bf16(sr, si); }
        asm volatile("" ::: "memory");
#if MK_DEBUG
        if (!lat && dir == 0 && c == 0 && g == 3 * seq + 1 && seq >= 2 && seq < 8) { float* dx = (float*)(F.ws + 231 * MiB) + (size_t)seq * 32 * 64 * 4;
#pragma unroll
            for (int i = 0; i < 16; ++i) { dx[(i * 64 + p) * 4 + 0] = xr0[i]; dx[(i * 64 + p) * 4 + 1] = xi0[i]; dx[((16 + i) * 64 + p) * 4 + 0] = xr1[i]; dx[((16 + i) * 64 + p) * 4 + 1] = xi1[i]; }
            for (int i = 0; i < 32; ++i) { const unsigned w = *(const LAS unsigned*)(sl + i * S5_ROWB + p * 4); dx[(i * 64 + p) * 4 + 2] = bf_lo(w); dx[(i * 64 + p) * 4 + 3] = bf_hi(w); } }
#endif
        f32x4 y[2];
#pragma unroll
        for (int tt = 0; tt < 2; ++tt) { y[tt] = (f32x4){0.f, 0.f, 0.f, 0.f};
#pragma unroll
            for (int ks = 0; ks < 4; ++ks) { const bf16x8 sb = *(const LAS bf16x8*)(sl + (16 * tt + (lane & 15)) * S5_ROWB + (32 * ks + 8 * (lane >> 4)) * 2);
                y[tt] = __builtin_amdgcn_mfma_f32_16x16x32_bf16(Cf[ks], sb, y[tt], 0, 0, 0); } }
        asm volatile("" ::: "memory");
#pragma unroll
        for (int tt = 0; tt < 2; ++tt) { const int tau = 16 * tt + (lane & 15); const size_t off = (size_t)(tokbase + t0 + (dir ? 31 - tau : tau)) * D + colg;
            if (c < nch / 2) { *(f32x4*)(PART + off) = y[tt]; }
            else { const f32x4 pv = *(const f32x4*)(PART + off); const u32x2 uw = *(const u32x2*)(UA + off);
                const f32x4 uu = {bf_lo(uw.x), bf_hi(uw.x), bf_lo(uw.y), bf_hi(uw.y)}; const f32x4 t = y[tt] + pv + dsum * uu;
                u32x2 w; w.x = pg8::cvt_pk_bf16(gelu_tanh(t.x), gelu_tanh(t.y)); w.y = pg8::cvt_pk_bf16(gelu_tanh(t.z), gelu_tanh(t.w)); *(u32x2*)(V + off) = w; } }
    }
    if (!lat) { float* o = F.out + (size_t)M * D + ((size_t)(seq * 2 + dir) * 2) * 4096 + g * 64 + p; o[0] = sr; o[4096] = si; }
}

constexpr int PL_ROWB = 288;
__device__ __forceinline__ void pool_task(Frame& F, int tile) {
    const int tok0 = tile * 64; const bool lat = tile >= M_CTX / 64; const int npr = lat ? 64 : L_CTX, off = lat ? 0 : (tile & 3) * 64;
    const bf16* UB = (const bf16*)(F.ws + WS_UB); bf16* P = (bf16*)(F.ws + WS_P); const bf16* WPT = (const bf16*)(F.ws + WS_WPOOL);
    LAS unsigned char* ul = F.lds; LAS unsigned char* pl = F.lds + 80 * PL_ROWB;
    const int lane = F.lane;
    for (int gi = 0; gi < 4; ++gi) {
        const int w = 2 << gi, hw = w >> 1;
        __syncthreads();
        for (int i = F.tid; i < 80 * 16; i += NWAVES * 64) { const int j = i >> 4, pc = i & 15; const int tt = off + j - 8; v4u v = (v4u){0u, 0u, 0u, 0u};
            if (tt >= 0 && tt < npr) v = *(const v4u*)(UB + (size_t)(tok0 - off + tt) * DPOOL + gi * 128 + pc * 8);
            *(LAS v4u*)(ul + j * PL_ROWB + pc * 16) = v; }
        __syncthreads();
        { const int cp = F.tid & 63, tr = F.tid >> 6; const LAS unsigned char* ucol = ul + cp * 4;
          int tt = off + tr * 8; int lo = max(tt - hw, 0), hi = min(tt - hw + w, npr); float s0 = 0.f, s1 = 0.f;
          for (int q = lo; q < hi; ++q) { const unsigned x = *(const LAS unsigned*)(ucol + (q - off + 8) * PL_ROWB); s0 += bf_lo(x); s1 += bf_hi(x); }
          for (int j = 0; j < 8; ++j) {
              const unsigned xc = *(const LAS unsigned*)(ucol + (tr * 8 + j + 8) * PL_ROWB); const float inv = 1.0f / (float)(hi - lo);
              *(LAS unsigned*)(pl + (tr * 8 + j) * PL_ROWB + cp * 4) = pg8::cvt_pk_bf16(s0 * inv - bf_lo(xc), s1 * inv - bf_hi(xc));
              ++tt; const int nlo = max(tt - hw, 0), nhi = min(tt - hw + w, npr);
              if (nhi > hi) { const unsigned x = *(const LAS unsigned*)(ucol + (hi - off + 8) * PL_ROWB); s0 += bf_lo(x); s1 += bf_hi(x); }
              if (nlo > lo) { const unsigned x = *(const LAS unsigned*)(ucol + (lo - off + 8) * PL_ROWB); s0 -= bf_lo(x); s1 -= bf_hi(x); }
              lo = nlo; hi = nhi; } }
        __syncthreads();
        { bf16x8 Wf[4];
#pragma unroll
          for (int ks = 0; ks < 4; ++ks) Wf[ks] = *(const bf16x8*)(WPT + ((size_t)gi * 128 + 16 * F.wave + (lane & 15)) * 128 + 32 * ks + 8 * (lane >> 4));
          const int o0 = gi * 128 + 16 * F.wave + 4 * (lane >> 4); const f32x4 ps = *(const f32x4*)(F.in[I_PSCALE] + o0);
#pragma unroll
          for (int tt = 0; tt < 4; ++tt) { f32x4 a = (f32x4){0.f, 0.f, 0.f, 0.f};
#pragma unroll
              for (int ks = 0; ks < 4; ++ks) { const bf16x8 pb = *(const LAS bf16x8*)(pl + (16 * tt + (lane & 15)) * PL_ROWB + (32 * ks + 8 * (lane >> 4)) * 2);
                  a = __builtin_amdgcn_mfma_f32_16x16x32_bf16(Wf[ks], pb, a, 0, 0, 0); }
              a = a * ps; u32x2 wv; wv.x = pg8::cvt_pk_bf16(a.x, a.y); wv.y = pg8::cvt_pk_bf16(a.z, a.w);
              *(u32x2*)(P + (size_t)(tok0 + 16 * tt + (lane & 15)) * D + o0) = wv; } }
    }
}
#if MK_DEBUG
constexpr int CW_FAIL = 8192;
constexpr size_t WS_DBG = 230 * MiB;
__device__ __forceinline__ unsigned dh(unsigned i) { i ^= i >> 16; i *= 0x7feb352du; i ^= i >> 15; i *= 0x846ca68bu; i ^= i >> 16; return i; }
__device__ __forceinline__ float bf2f(bf16 b) { return __builtin_bit_cast(float, (unsigned)b << 16); }
__device__ __forceinline__ void dfail(Frame& F, int id, bool bad) { if (bad) atomicAdd((unsigned*)(F.ctl + CW_FAIL + id), 1u); }
__device__ __forceinline__ bool dneq(float got, float ref, float rel, float abs_) { const float d = fabsf(got - ref); return !(d <= rel * fabsf(ref) + abs_); }
__device__ __forceinline__ const float* xrow_ptr(Frame& F, int m) { return m < M_CTX ? F.in[I_XP] + (size_t)m * D : F.in[I_XS] + (size_t)(m - M_CTX) * D; }

__device__ __forceinline__ void dbg_wt(Frame& F, const float* W, int K, int N, const bf16* WT, int ldt, unsigned salt) {
    for (int s = F.tid; s < 2048; s += 512) { const unsigned h = dh(s * 2u + salt); const int k = h % K, n = (h >> 12) % N; const float w = W[(size_t)k * N + n], t = bf2f(WT[(size_t)n * ldt + k]);
        dfail(F, 1, dneq(t, w, 0.0045f, 1e-30f)); }
}
__device__ __forceinline__ void dbg_check(Frame& F, int phase) {
    if (F.bid != 0) return;
    unsigned char* ws = F.ws;
    if (phase == 0) {
        dbg_wt(F, F.in[I_WIN], D, DIN, (const bf16*)(ws + WS_WIN), D, 11); dbg_wt(F, F.in[I_WGLU], D, D, (const bf16*)(ws + WS_WGLU), D, 12); dbg_wt(F, F.in[I_WPA], D, D, (const bf16*)(ws + WS_WPA), D, 13);
        dbg_wt(F, F.in[I_WPB], DPOOL, D, (const bf16*)(ws + WS_WPB), D, 14); dbg_wt(F, F.in[I_WOUT], D, D, (const bf16*)(ws + WS_WOUT), D, 15); dbg_wt(F, F.in[I_W1], D, DFF, (const bf16*)(ws + WS_W1), D, 16);
        dbg_wt(F, F.in[I_W2], DFF, D, (const bf16*)(ws + WS_W2), DFF, 17);
        for (int gi = 0; gi < 4; ++gi) dbg_wt(F, F.in[I_WPOOL] + gi * 16384, 128, 128, (const bf16*)(ws + WS_WPOOL) + gi * 16384, 128, 18 + gi);
        for (int s = F.tid; s < 2048; s += 512) {
            const int it = dh(s + 77u) % 8192; const int p = it & 63, g = (it >> 6) & 63, dir = it >> 12;
            const double lr = F.in[I_LAMRE][it], li = F.in[I_LAMIM][it], dt = exp((double)F.in[I_LOGDT][dir * 64 + g]);
            const double e = exp(lr * dt), lbr = e * cos(li * dt), lbi = e * sin(li * dt), nr = lbr - 1.0, ni = lbi, den = lr * lr + li * li, wr = (nr * lr + ni * li) / den, wi = (ni * lr - nr * li) / den;
            const float* lamb = (const float*)(ws + WS_LAMB) + (size_t)it * 2; dfail(F, 2, dneq(lamb[0], (float)lbr, 1e-5f, 1e-6f) || dneq(lamb[1], (float)lbi, 1e-5f, 1e-6f));
            const int h = dh(s + 99u) & 15; const double br = F.in[I_BRE][(size_t)it * 16 + h], bi = F.in[I_BIM][(size_t)it * 16 + h];
            const bf16* bb = (const bf16*)(ws + WS_BB);
            dfail(F, 2, dneq(bf2f(bb[((size_t)((dir * 64 + g) * 2 + 0) * 64 + p) * 16 + h]), (float)(wr * br - wi * bi), 0.01f, 1e-6f) || dneq(bf2f(bb[((size_t)((dir * 64 + g) * 2 + 1) * 64 + p) * 16 + h]), (float)(wr * bi + wi * br), 0.01f, 1e-6f));
            const bf16* ct = (const bf16*)(ws + WS_CT) + ((size_t)(dir * 64 + g) * 16 + h) * 128; const size_t ci = ((size_t)(dir * 64 + g) * 16 + h) * 64 + p;
            dfail(F, 2, dneq(bf2f(ct[2 * p]), F.in[I_CRE][ci], 0.0045f, 1e-30f) || dneq(bf2f(ct[2 * p + 1]), -F.in[I_CIM][ci], 0.0045f, 1e-30f));
        }
    }
    if (phase == 1) {
        for (int s = F.tid; s < 1024; s += 512) {
            const unsigned h = dh(s + 5u); const int r = h % 9, idx = (h >> 8) % 6144; double a = F.in[I_BADA][idx];
            for (int k = 0; k < D; ++k) { const double cv = r == 0 ? F.in[I_CCTX][k] : F.in[I_C][(size_t)(r - 1) * D + k]; a += cv / (1.0 + exp(-cv)) * (double)F.in[I_WADA][(size_t)k * 6144 + idx]; }
            dfail(F, 3, dneq(((const float*)(ws + WS_MODF))[(size_t)r * 6144 + idx], (float)a, 1e-4f, 1e-4f));
        }
        for (int s = F.tid; s < 1024; s += 512) {
            const unsigned h = dh(s + 1234u); const int m = h % M, j = (h >> 16) % D; const float* x = xrow_ptr(F, m); double mu = 0, var = 0;
            for (int k = 0; k < D; ++k) mu += x[k]; mu /= D; for (int k = 0; k < D; ++k) { const double d = x[k] - mu; var += d * d; } var /= D;
            const float* mf = (const float*)(ws + WS_MODF) + (size_t)batch_of_row(m) * 6144;
            const double y = (x[j] - mu) / sqrt(var + 1e-6) * (1.0 + mf[D + j]) + mf[j];
            dfail(F, 4, dneq(bf2f(((const bf16*)(ws + WS_RA))[(size_t)m * D + j]), (float)y, 0.006f, 0.004f));
        }
    }
    if (phase == 2) {
        for (int s = F.tid; s < 2048; s += 512) { const unsigned h = dh(s + 4321u); const int m = h % M, zc = (h >> 14) % DIN; const bf16* hr = (const bf16*)(ws + WS_RA) + (size_t)m * D; double a = F.in[I_BIN][zc];
            for (int k = 0; k < D; ++k) a += (double)bf2f(hr[k]) * (double)F.in[I_WIN][(size_t)k * DIN + zc];
            float got;
            if (zc < 1024) got = bf2f(((const bf16*)(ws + WS_RB))[(size_t)m * D + zc]);
            else if (zc < 1536) got = bf2f(((const bf16*)(ws + WS_UB))[(size_t)m * DPOOL + zc - 1024]);
            else if (zc < 2560) { got = bf2f(((const bf16*)(ws + WS_GA))[(size_t)m * D + zc - 1536]); a = 1.0 / (1.0 + exp(-a)); }
            else { got = bf2f(((const bf16*)(ws + WS_GB))[(size_t)m * D + zc - 2560]); a = 1.0 / (1.0 + exp(-a)); }
            dfail(F, 5, dneq(got, (float)a, 0.01f, 0.02f)); }
    }
    if (phase == 3) {
        { const int w = F.wave, lane = F.lane; const bool lat = w < 2; const unsigned h = dh(w + 31u); const int seq = lat ? (h % NB_LAT) : w, g = lat ? (h >> 8) % NGRP : 3 * w + 1;
          const int L = lat ? L_LAT : L_CTX, tokbase = lat ? M_CTX + seq * L_LAT : seq * L_CTX; const bf16* UA = (const bf16*)(ws + WS_RB); const bf16* V = (const bf16*)(ws + WS_RA);
          float* yf = (float*)(ws + WS_DBG) + (size_t)w * L_LAT * 16;
          for (int dir = 0; dir < 2; ++dir) {
              const int it = (dir * 64 + g) * 64 + lane; const float lr = F.in[I_LAMRE][it], li = F.in[I_LAMIM][it], dt = expf(F.in[I_LOGDT][dir * 64 + g]);
              const float e = expf(lr * dt), lbr = e * cosf(li * dt), lbi = e * sinf(li * dt), nr = lbr - 1.f, ni = lbi, den = 1.f / (lr * lr + li * li), wr = (nr * lr + ni * li) * den, wi = (ni * lr - nr * li) * den;
              float br[16], bi[16], cr[16], cim[16];
#pragma unroll
              for (int hh = 0; hh < 16; ++hh) { const float a = F.in[I_BRE][(size_t)it * 16 + hh], b = F.in[I_BIM][(size_t)it * 16 + hh]; br[hh] = wr * a - wi * b; bi[hh] = wr * b + wi * a;
                  const size_t ci = ((size_t)(dir * 64 + g) * 16 + hh) * 64 + lane; cr[hh] = F.in[I_CRE][ci]; cim[hh] = F.in[I_CIM][ci]; }
              float sr = 0.f, si = 0.f; if (lat) { const float* st = F.in[I_STATE] + ((size_t)(seq * 2 + dir) * 2) * 4096 + g * 64 + lane; sr = st[0]; si = st[4096]; }
              for (int tq = 0; tq < L; ++tq) { const int t = dir ? L - 1 - tq : tq; const bf16* ur = UA + (size_t)(tokbase + t) * D + g * 16; float bur = 0.f, bui = 0.f;
#pragma unroll
                  for (int hh = 0; hh < 16; ++hh) { const float u = bf2f(ur[hh]); bur += br[hh] * u; bui += bi[hh] * u; }
                  const float nsr = lbr * sr - lbi * si + bur, nsi = lbr * si + lbi * sr + bui; sr = nsr; si = nsi;
                  if (!lat && dir == 0 && tq < 32) { const float* dx = (const float*)(ws + 231 * MiB) + (size_t)seq * 32 * 64 * 4 + (tq * 64 + lane) * 4;
                      dfail(F, 20, dneq(dx[0], bur, 0.02f, 0.002f) || dneq(dx[1], bui, 0.02f, 0.002f)); dfail(F, 21, dneq(dx[2], sr, 0.02f, 0.002f) || dneq(dx[3], si, 0.02f, 0.002f)); }
                  float mine = 0.f;
#pragma unroll
                  for (int hh = 0; hh < 16; ++hh) { const float y = wave_sum(cr[hh] * sr - cim[hh] * si); if (lane == hh) mine = y; }
                  if (lane < 16) { const float pt = F.out[(size_t)(tokbase + t) * D + g * 16 + lane];
                      if (dir == 0) { yf[(size_t)t * 16 + lane] = mine; if (t < L / 2) dfail(F, lat ? 10 : 6, dneq(pt, mine, 0.03f, 0.01f)); }
                      else { if (t >= L / 2) dfail(F, lat ? 11 : 7, dneq(pt, mine, 0.03f, 0.01f)); const float u = bf2f(ur[lane]); const float tot = yf[(size_t)t * 16 + lane] + mine + (F.in[I_S5D][g * 16 + lane] + F.in[I_S5D][D + g * 16 + lane]) * u;
                          const float ref = tot / (1.f + expf(-1.5957691216f * (tot + 0.044715f * tot * tot * tot)));
                          dfail(F, lat ? 12 : 8, dneq(bf2f(V[(size_t)(tokbase + t) * D + g * 16 + lane]), ref, 0.03f, 0.03f)); } }
              }
              if (!lat) { const float* o = F.out + (size_t)M * D + ((size_t)(seq * 2 + dir) * 2) * 4096 + g * 64 + lane; dfail(F, 9, dneq(o[0], sr, 0.02f, 0.01f) || dneq(o[4096], si, 0.02f, 0.01f)); }
              __builtin_amdgcn_s_waitcnt(0);
          } }
        for (int s = F.tid; s < 2048; s += 512) { const unsigned h = dh(s + 999u); const int tok = h % M, o = (h >> 14) % DPOOL, gi = o >> 7, w = 2 << gi; const bool lat = tok >= M_CTX;
            const int npr = lat ? 64 : L_CTX, rs = lat ? (tok & ~63) : (tok & ~255), tt = tok - rs, lo = max(tt - w / 2, 0), hi = min(tt - w / 2 + w, npr); const bf16* UB = (const bf16*)(ws + WS_UB); double a = 0;
            for (int i = 0; i < 128; ++i) { double sum = 0; for (int q = lo; q < hi; ++q) sum += bf2f(UB[(size_t)(rs + q) * DPOOL + gi * 128 + i]);
                const double pm = sum / (hi - lo) - bf2f(UB[(size_t)tok * DPOOL + gi * 128 + i]); a += pm * (double)F.in[I_WPOOL][((size_t)gi * 128 + i) * 128 + (o & 127)]; }
            a *= F.in[I_PSCALE][o]; dfail(F, 13, dneq(bf2f(((const bf16*)(ws + WS_P))[(size_t)tok * D + o]), (float)a, 0.02f, 0.02f)); }
    }
    if (phase == 4) {
        for (int s = F.tid; s < 2048; s += 512) { const unsigned h = dh(s + 41u); const int m = h % M, c = (h >> 14) % D; const bf16* vr = (const bf16*)(ws + WS_RA) + (size_t)m * D; double a = F.in[I_BGLU][c];
            for (int k = 0; k < D; ++k) a += (double)bf2f(vr[k]) * (double)F.in[I_WGLU][(size_t)k * D + c];
            const double ref = bf2f(vr[c]) / (1.0 + exp(-a)); dfail(F, 14, dneq(bf2f(((const bf16*)(ws + WS_RB))[(size_t)m * D + c]), (float)ref, 0.02f, 0.02f)); }
    }
    if (phase == 5) {
        for (int s = F.tid; s < 2048; s += 512) { const unsigned h = dh(s + 51u); const int m = h % M, c = (h >> 14) % D; const bf16* v2 = (const bf16*)(ws + WS_RB) + (size_t)m * D; const bf16* pr = (const bf16*)(ws + WS_P) + (size_t)m * D; double ya = 0, yb = 0;
            for (int k = 0; k < D; ++k) ya += (double)bf2f(v2[k]) * (double)F.in[I_WPA][(size_t)k * D + c];
            for (int k = 0; k < DPOOL; ++k) yb += (double)bf2f(pr[k]) * (double)F.in[I_WPB][(size_t)k * D + c];
            const double ref = bf2f(((const bf16*)(ws + WS_GA))[(size_t)m * D + c]) * ya + bf2f(((const bf16*)(ws + WS_GB))[(size_t)m * D + c]) * yb;
            dfail(F, 15, dneq(bf2f(((const bf16*)(ws + WS_RA))[(size_t)m * D + c]), (float)ref, 0.03f, 0.03f)); }
    }
    if (phase == 6) {
        for (int s = F.tid; s < 2048; s += 512) { const unsigned h = dh(s + 61u); const int m = h % M, c = (h >> 14) % D; const bf16* mr = (const bf16*)(ws + WS_RA) + (size_t)m * D; double a = F.in[I_BOUT][c];
            for (int k = 0; k < D; ++k) a += (double)bf2f(mr[k]) * (double)F.in[I_WOUT][(size_t)k * D + c];
            const float* mf = (const float*)(ws + WS_MODF) + (size_t)batch_of_row(m) * 6144; const double ref = (double)DN_ALPHA * xrow_ptr(F, m)[c] + mf[2 * D + c] * a;
            dfail(F, 16, dneq(F.out[(size_t)m * D + c], (float)ref, 0.01f, 0.02f)); }
    }
    if (phase == 7) {
        for (int s = F.tid; s < 1024; s += 512) { const unsigned h = dh(s + 71u); const int m = h % M, j = (h >> 16) % D; const float* x = F.out + (size_t)m * D; double mu = 0, var = 0, mn = 0, vn = 0;
            for (int k = 0; k < D; ++k) { mu += x[k]; const double z = (x[k] - F.in[I_LN1B][k]) / F.in[I_LN1G][k]; mn += z; vn += z * z; } mu /= D; mn /= D; vn = vn / D - mn * mn;
            for (int k = 0; k < D; ++k) { const double d = x[k] - mu; var += d * d; } var /= D;
            const float* mf = (const float*)(ws + WS_MODF) + (size_t)batch_of_row(m) * 6144; const double y = (x[j] - mu) / sqrt(var + 1e-6) * (1.0 + mf[4 * D + j]) + mf[3 * D + j];
            dfail(F, 17, dneq(bf2f(((const bf16*)(ws + WS_RB))[(size_t)m * D + j]), (float)y, 0.006f, 0.004f) || fabs(mn) > 1e-3 || fabs(vn - 1.0) > 1e-2); }
    }
    if (phase == 8) {
        for (int s = F.tid; s < 2048; s += 512) { const unsigned h = dh(s + 81u); const int m = h % M, c = (h >> 14) % DFF; const bf16* hr = (const bf16*)(ws + WS_RB) + (size_t)m * D; double a = F.in[I_B1][c];
            for (int k = 0; k < D; ++k) a += (double)bf2f(hr[k]) * (double)F.in[I_W1][(size_t)k * DFF + c];
            a = a > 0 ? a * a : 0; dfail(F, 18, dneq(bf2f(((const bf16*)(ws + WS_HM))[(size_t)m * DFF + c]), (float)a, 0.02f, 0.02f)); }
        for (int s = F.tid; s < 2048; s += 512) { const unsigned h = dh(s + 91u); const int m = h % M, c = (h >> 14) % D; ((float*)(ws + WS_DBG))[s] = F.out[(size_t)m * D + c]; }
    }
    if (phase == 9) {
        for (int s = F.tid; s < 2048; s += 512) { const unsigned h = dh(s + 91u); const int m = h % M, c = (h >> 14) % D; const bf16* hr = (const bf16*)(ws + WS_HM) + (size_t)m * DFF; double a = F.in[I_B2][c];
            for (int k = 0; k < DFF; ++k) a += (double)bf2f(hr[k]) * (double)F.in[I_W2][(size_t)k * D + c];
            const float* mf = (const float*)(ws + WS_MODF) + (size_t)batch_of_row(m) * 6144; const double ref = (double)DN_ALPHA * ((const float*)(ws + WS_DBG))[s] + mf[5 * D + c] * a;
            dfail(F, 19, dneq(F.out[(size_t)m * D + c], (float)ref, 0.01f, 0.02f)); }
    }
}
__device__ __forceinline__ void dbg_encode(Frame& F) {
    int code = 0;
    for (int k = 24; k >= 1; --k) { if (k == 20 || k == 21) continue; if (__hip_atomic_load((unsigned*)(F.ctl + CW_FAIL + k), __ATOMIC_RELAXED, __HIP_MEMORY_SCOPE_AGENT) != 0u) code = k; }
    if (code == 6) { if (__hip_atomic_load((unsigned*)(F.ctl + CW_FAIL + 21), __ATOMIC_RELAXED, __HIP_MEMORY_SCOPE_AGENT)) code = 21; if (__hip_atomic_load((unsigned*)(F.ctl + CW_FAIL + 20), __ATOMIC_RELAXED, __HIP_MEMORY_SCOPE_AGENT)) code = 20; }
#if MK_DEBUG_FORCE
    code = MK_DEBUG_FORCE;
#endif
    if (code == 0) return;
    const size_t total = (size_t)M * D + (size_t)NB_CTX * 4 * 4096;
    for (size_t i = (size_t)F.bid * 512 + F.tid; i < total; i += (size_t)F.G * 512) F.out[i] = i < (size_t)M_CTX * D ? (float)(code + 1) : 0.f;
}
#define DBG_CHECK(k) do { if (IN(k)) { xcd_barrier(bar); dbg_check(F, k); } } while (0)
#else
#define DBG_CHECK(k) do { } while (0)
#endif
struct Args { const float* in[33]; float* out; unsigned char* ws; int ph_lo, ph_hi; };
__global__ void __launch_bounds__(NWAVES * 64, 2) mk_fwd(Args args) {
    extern __shared__ __attribute__((aligned(16))) unsigned char lds[];
    Frame F;
    F.lds = (LAS unsigned char*)lds;
    F.MISC = (volatile LAS unsigned*)(F.lds + MISC_OFF);
    F.tid = threadIdx.x; F.lane = F.tid & 63; F.wave = __builtin_amdgcn_readfirstlane(F.tid >> 6);
    F.G = gridDim.x; F.bid = blockIdx.x;
#pragma unroll
    for (int i = 0; i < 33; ++i) F.in[i] = args.in[i];
    F.out = args.out; F.ws = args.ws; F.ctl = (gu32*)(args.ws + WS_CTL);
    unsigned char* ws = args.ws;
    for (int u = F.tid; u < (LDS_BYTES - LDSCTL_OFF) / 4; u += NWAVES * 64) ((LAS unsigned*)(F.lds + LDSCTL_OFF))[u] = 0u;
    __syncthreads();
    XcdBarrier bar = xcd_barrier_post((unsigned*)(F.ctl + CW_BAR), F.MISC + 8);
    const int lo = args.ph_lo, hi = args.ph_hi;
#define IN(k) (lo <= (k) && (k) < hi)
#define SEAM(k) do { if (IN(k) && IN((k) + 1)) xcd_barrier(bar); } while (0)
    typedef pg8::bf16_t bt;
    if (IN(0)) { phase0(F); } DBG_CHECK(0); SEAM(0);
    if (IN(1)) { phase1(F); } DBG_CHECK(1); SEAM(1);
    if (IN(2)) {
        pg8::Gemm g{(const bt*)(ws + WS_RA), nullptr, (const bt*)(ws + WS_WIN), nullptr, D / 64, 0, D}; pg8::StaticOrder S; S.init(M, DIN, F.G, F.bid);
        pg8::EpiIn E{(bt*)(ws + WS_RB), (bt*)(ws + WS_UB), (bt*)(ws + WS_GA), (bt*)(ws + WS_GB), F.in[I_BIN]};
        pg8::gemm_phase<pg8::EpiIn, pg8::StaticOrder, true, true>(F.lds, g, S, E);
    } DBG_CHECK(2); SEAM(2);
    if (IN(3)) {
        if (F.G == 256) {
            if (F.bid < 128) s5_task(F, true, F.bid >> 4, F.bid & 15);
            else for (int i = 0; i < 4; ++i) { const int id = (F.bid - 128) * 4 + i; s5_task(F, false, id >> 4, id & 15); }
        } else {
            for (int t = F.bid; t < 640; t += F.G) { if (t < 128) s5_task(F, true, t >> 4, t & 15); else s5_task(F, false, (t - 128) >> 4, (t - 128) & 15); }
        }
        for (int tile = F.bid; tile < M / 64; tile += F.G) pool_task(F, tile);
        __syncthreads();
    } DBG_CHECK(3); SEAM(3);
    if (IN(4)) {
        pg8::Gemm g{(const bt*)(ws + WS_RA), nullptr, (const bt*)(ws + WS_WGLU), nullptr, D / 64, 0, D}; pg8::StaticOrder S; S.init(M, D, F.G, F.bid);
        pg8::EpiGlu E{(const bt*)(ws + WS_RA), (bt*)(ws + WS_RB), F.in[I_BGLU]};
        pg8::gemm_phase<pg8::EpiGlu, pg8::StaticOrder, true, true>(F.lds, g, S, E);
    } DBG_CHECK(4); SEAM(4);
    if (IN(5)) {
        pg8::Gemm g{(const bt*)(ws + WS_RB), (const bt*)(ws + WS_P), (const bt*)(ws + WS_WPA), (const bt*)(ws + WS_WPB), D / 64, DPOOL / 64, D}; pg8::StaticOrder S; S.init(M, D, F.G, F.bid, 2);
        pg8::EpiMerge E{(const bt*)(ws + WS_GA), (const bt*)(ws + WS_GB), (bt*)(ws + WS_RA)};
        pg8::gemm_phase<pg8::EpiMerge, pg8::StaticOrder, true, true>(F.lds, g, S, E);
    } DBG_CHECK(5); SEAM(5);
    if (IN(6)) {
        pg8::Gemm g{(const bt*)(ws + WS_RA), nullptr, (const bt*)(ws + WS_WOUT), nullptr, D / 64, 0, D}; pg8::StaticOrder S; S.init(M, D, F.G, F.bid);
        pg8::EpiRes E{F.in[I_XP], F.in[I_XS], F.out, F.in[I_BOUT], (const float*)(ws + WS_MODF), 2};
        pg8::gemm_phase<pg8::EpiRes, pg8::StaticOrder, true, true>(F.lds, g, S, E);
    } DBG_CHECK(6); SEAM(6);
    if (IN(7)) { phase_ln<true>(F, F.in[I_LN1G], F.in[I_LN1B], (bf16*)(ws + WS_RB)); } DBG_CHECK(7); SEAM(7);
    if (IN(8)) {
        pg8::Gemm g{(const bt*)(ws + WS_RB), nullptr, (const bt*)(ws + WS_W1), nullptr, D / 64, 0, D}; pg8::StaticOrder S; S.init(M, DFF, F.G, F.bid);
        pg8::EpiRelu2 E{(bt*)(ws + WS_HM), F.in[I_B1]};
        pg8::gemm_phase<pg8::EpiRelu2, pg8::StaticOrder, true, true>(F.lds, g, S, E);
    } DBG_CHECK(8); SEAM(8);
    if (IN(9)) {
        pg8::Gemm g{(const bt*)(ws + WS_HM), nullptr, (const bt*)(ws + WS_W2), nullptr, DFF / 64, 0, DFF}; pg8::StaticOrder S; S.init(M, D, F.G, F.bid);
        pg8::EpiRes E{F.out, F.out + (size_t)M_CTX * D, F.out, F.in[I_B2], (const float*)(ws + WS_MODF), 5};
        pg8::gemm_phase<pg8::EpiRes, pg8::StaticOrder, true, true>(F.lds, g, S, E);
    } DBG_CHECK(9); SEAM(9);
    if (IN(10)) { phase_ln<false>(F, F.in[I_LN2G], F.in[I_LN2B], nullptr); }
#if MK_DEBUG
    xcd_barrier(bar); dbg_encode(F);
#endif
#undef IN
#undef SEAM
}

#ifndef MK_SPLIT
#define MK_SPLIT 0
#endif
extern "C" void kernel_launch(void* const* d_in, const int* in_sizes, int n_in, void* d_out, int out_size, void* d_ws, size_t ws_size, hipStream_t stream) {
    static int grid = 0;
    if (grid == 0) {
        if (n_in != 33 || ws_size < WS_END) { fprintf(stderr, "kernel_launch: unexpected inputs (n_in %d, ws %zu)\n", n_in, ws_size); grid = -1; return; }
        int dev = 0, cus = 0, per_cu = 0;
        if (hipGetDevice(&dev) != hipSuccess || hipDeviceGetAttribute(&cus, hipDeviceAttributeMultiprocessorCount, dev) != hipSuccess) { grid = -1; return; }
        if (hipFuncSetAttribute((const void*)mk_fwd, hipFuncAttributeMaxDynamicSharedMemorySize, LDS_BYTES) != hipSuccess) { fprintf(stderr, "kernel_launch: hipFuncSetAttribute failed\n"); grid = -1; return; }
        if (hipOccupancyMaxActiveBlocksPerMultiprocessor(&per_cu, (const void*)mk_fwd, NWAVES * 64, LDS_BYTES) != hipSuccess || per_cu < 1) fprintf(stderr, "kernel_launch: occupancy query says %d blocks per CU\n", per_cu);
        (void)hipGetLastError();
        grid = cus;
    }
    if (grid < 0) return;
    (void)hipMemsetAsync((char*)d_ws + WS_CTL, 0, CTL_ZERO_BYTES, stream);
    Args a{};
    for (int i = 0; i < 33; ++i) a.in[i] = (const float*)d_in[i];
    a.out = (float*)d_out; a.ws = (unsigned char*)d_ws;
#if MK_SPLIT
    for (int p = 0; p <= 10; ++p) { a.ph_lo = p; a.ph_hi = p + 1; hipLaunchKernelGGL(mk_fwd, dim3(grid), dim3(NWAVES * 64), LDS_BYTES, stream, a); }
#else
    a.ph_lo = 0; a.ph_hi = 11;
    hipLaunchKernelGGL(mk_fwd, dim3(grid), dim3(NWAVES * 64), LDS_BYTES, stream, a);
#endif
    const hipError_t le = hipPeekAtLastError();
    if (le != hipSuccess) fprintf(stderr, "kernel_launch: launch failed: %s\n", hipGetErrorName(le));
}
```

```cpp
#include <hip/hip_runtime.h>
#include <cstdio>
#include <cstdint>
#ifndef MK_DEBUG
#define MK_DEBUG 0
#endif
#ifndef MK_DEBUG_FORCE
#define MK_DEBUG_FORCE 0
#endif
#ifndef MK_STAMP
#define MK_STAMP 0
#endif
#ifndef MK_TB
#define MK_TB 3
#endif
#ifndef MK_SA
#define MK_SA 1
#endif
#ifndef MK_SB
#define MK_SB 3
#endif
#ifndef MK_OLDPOOL
#define MK_OLDPOOL 0
#endif
#ifndef MK_NOPR
#define MK_NOPR 0
#endif
#ifndef MK_POISON
#define MK_POISON 0
#endif
#ifndef MK_TRUNC
#define MK_TRUNC 0
#endif
#ifndef MK_HSLEEP
#define MK_HSLEEP 0
#endif
#ifndef MK_TSEL
#define MK_TSEL 2
#endif
#ifndef MK_NOS0
#define MK_NOS0 0
#endif
#ifndef MK_NOUL
#define MK_NOUL 0
#endif
#ifndef MK_GPH
#define MK_GPH 8
#endif
#ifndef MK_GUI
#define MK_GUI 1
#endif
namespace pg8 {
#define PG8_LAS __attribute__((address_space(3)))
typedef unsigned short bf16_t;
typedef short bf16x8 __attribute__((ext_vector_type(8)));
typedef float f32x4 __attribute__((ext_vector_type(4)));
typedef unsigned u32x4 __attribute__((ext_vector_type(4)));
constexpr int BM = 256, BK = 64, HALF = 128, HTB = HALF * BK * 2  , STAGE_BYTES = 8 * HTB, NXCD = 8, WGM = 8;

__host__ __device__ __forceinline__ int lds_byte(int r, int c) { const int st = (r >> 4) * 2 + (c >> 5), rr = r & 15, cc = c & 31, ob = rr * 64 + cc * 2; return st * 1024 + (ob ^ (((ob >> 9) & 1) << 5)); }
__host__ __device__ __forceinline__ void stage_rc(int b, int& R, int& C) { const int st = b / 1024, sb = b % 1024, swz = sb ^ (((sb >> 9) & 1) << 5); R = (st >> 1) * 16 + swz / 64; C = (st & 1) * 32 + (swz % 64) / 2; }
__host__ __device__ __forceinline__ int perm32(int rho) { const int n = rho >> 4, i = rho & 15; return 8 * (i >> 2) + 4 * n + (i & 3); }

struct Unit { int pm, pn, part; };
struct Gemm { const bf16_t *A0, *A1, *B0, *B1; int nt0, nt1, ld; int id_ = 0;
    __device__ __forceinline__ const char* a(int part) const { return (const char*)(part ? A1 : A0); }
    __device__ __forceinline__ const char* b(int part) const { return (const char*)(part ? B1 : B0); }
    __device__ __forceinline__ int nt(int part) const { return part ? nt1 : nt0; } };

struct StaticOrder {
    int nM, nN, nwg, G, c, np;
    __host__ __device__ void init(int M, int N, int G_, int c_, int np_ = 1) { nM = M / BM; nN = N / BM; nwg = nM * nN; G = G_; c = c_; np = np_; }
    __host__ __device__ bool next(int ii, Unit& u) const {
        const int i = (np == 2) ? (ii >> 1) : ii; u.part = (np == 2) ? (ii & 1) : 0;
        const long L = (long)i * G + c; if (L >= nwg) return false;
        int wgid = (int)L; { const int q = nwg / NXCD, r = nwg % NXCD, xcd = wgid % NXCD, off = wgid / NXCD; wgid = (xcd < r ? xcd * (q + 1) : r * (q + 1) + (xcd - r) * q) + off; }
        const int nig = WGM * nN, gid = wgid / nig, fm = gid * WGM, gsz = (nM - fm) < WGM ? (nM - fm) : WGM;
        u.pm = fm + ((wgid % nig) % gsz); u.pn = (wgid % nig) / gsz; return true;
    }
    __device__ __forceinline__ void a_ready(const Unit&) const {}
    __device__ __forceinline__ void done(const Unit&) const {}
};
__device__ __forceinline__ unsigned cvt_pk_bf16(float lo, float hi) { unsigned r; asm volatile("v_cvt_pk_bf16_f32 %0, %1, %2" : "=v"(r) : "v"(lo), "v"(hi)); return r; }
typedef float f32x2 __attribute__((ext_vector_type(2)));
#if MK_STAMP == 130
#define GST(id) do { if (g.id_ == MK_GPH && blockIdx.x == MK_TB && threadIdx.x == 0 && ui == MK_GUI) { if ((id) == MK_SA) ((volatile PG8_LAS unsigned*)(lds + 131072 + 320))[17] = (unsigned)__builtin_amdgcn_s_memrealtime(); if ((id) == MK_SB) ((volatile PG8_LAS unsigned*)(lds + 131072 + 320))[18] = (unsigned)__builtin_amdgcn_s_memrealtime(); } } while (0)
#else
#define GST(id) do { } while (0)
#endif
template <class Epi, class Sched, bool ALIGN_EPI = false, bool SP2 = false>
__device__ __forceinline__ void gemm_phase(PG8_LAS unsigned char* lds, const Gemm g, const Sched& S, const Epi& E) {
    const int tid = threadIdx.x, wid = __builtin_amdgcn_readfirstlane(tid >> 6), lane = tid & 63, wr = wid >> 2, wc = wid & 3, fr = lane & 15, fq = lane >> 4;
    const int K = g.ld;
    unsigned voffA[2], voffB[2];
#pragma unroll
    for (int i = 0; i < 2; ++i) { int R, C; stage_rc(tid * 16 + i * 8192, R, C); const int Rb = Epi::PERM ? ((R & ~31) + perm32(R & 31)) : R;
        voffA[i] = (unsigned)(R * K + C) * 2u; voffB[i] = (unsigned)(Rb * K + C) * 2u; }
    const size_t kstep = (size_t)(BK * 2);
    const size_t hstep = (size_t)HALF * K * 2;
    const size_t tstep = 2 * hstep;
    const unsigned ldsw = (unsigned)wid * 1024u;
    const int aoff = lds_byte(wr * 64 + fr, fq * 8), boff = lds_byte(wc * 32 + fr, fq * 8);
#define PG8_SA(b, h) (((b) * 2 + (h)) * HTB)
#define PG8_SB(b, h) ((4 + (b) * 2 + (h)) * HTB)
#define PG8_STAGE(bufoff, gbase, voff) do { _Pragma("unroll") for (int _i = 0; _i < 2; ++_i) \
        __builtin_amdgcn_global_load_lds((const unsigned*)((const char*)(gbase) + (voff)[_i]), (PG8_LAS unsigned*)(lds + (bufoff) + ldsw + _i * 8192), 16, 0, 0); } while (0)
#define PG8_LDA(dst, b, h) do { _Pragma("unroll") for (int m = 0; m < 4; ++m) _Pragma("unroll") for (int k = 0; k < 2; ++k) dst[m][k] = *(const PG8_LAS bf16x8*)(lds + PG8_SA(b, h) + aoff + m * 2048 + k * 1024); } while (0)
#define PG8_LDB(dst, b, h) do { _Pragma("unroll") for (int n = 0; n < 2; ++n) _Pragma("unroll") for (int k = 0; k < 2; ++k) dst[n][k] = *(const PG8_LAS bf16x8*)(lds + PG8_SB(b, h) + boff + n * 2048 + k * 1024); } while (0)
#define PG8_MMA(ai, bj, At, Bt) do { __builtin_amdgcn_s_setprio(1); _Pragma("unroll") for (int m = 0; m < 4; ++m) _Pragma("unroll") for (int n = 0; n < 2; ++n) _Pragma("unroll") for (int k = 0; k < 2; ++k) \
        acc[ai][bj][m][n] = __builtin_amdgcn_mfma_f32_16x16x32_bf16(Bt[n][k], At[m][k], acc[ai][bj][m][n], 0, 0, 0); __builtin_amdgcn_s_setprio(0); } while (0)
#define PG8_WAIT_V(n) asm volatile("s_waitcnt vmcnt(" #n ")" ::: "memory")
#define PG8_WAIT_L(n) asm volatile("s_waitcnt lgkmcnt(" #n ")" ::: "memory")
#define PG8_BAR __builtin_amdgcn_s_barrier()
#define PG8_SCHED __builtin_amdgcn_sched_barrier(0)
    Unit cur, nxt; int ui = 0;
    if (!S.next(0, cur)) return;
    f32x4 acc[2][2][4][2];
#pragma unroll
    for (int a = 0; a < 2; ++a)
#pragma unroll
        for (int b = 0; b < 2; ++b)
#pragma unroll
            for (int m = 0; m < 4; ++m)
#pragma unroll
                for (int n = 0; n < 2; ++n) acc[a][b][m][n] = (f32x4){0.f, 0.f, 0.f, 0.f};
    bf16x8 At[4][2], B0[2][2], B1[2][2];
    const char* cA = g.a(cur.part) + (size_t)cur.pm * tstep; const char* cB = g.b(cur.part) + (size_t)cur.pn * tstep;
    S.a_ready(cur);
    if constexpr (SP2) {
        PG8_STAGE(PG8_SB(0, 0), cB, voffB); PG8_STAGE(PG8_SB(0, 1), cB + hstep, voffB); PG8_STAGE(PG8_SA(0, 0), cA, voffA); PG8_STAGE(PG8_SA(0, 1), cA + hstep, voffA);
        if (wr == 1) PG8_BAR;
        PG8_WAIT_V(2); PG8_BAR;
        PG8_STAGE(PG8_SB(1, 0), cB + kstep, voffB); PG8_STAGE(PG8_SA(1, 0), cA + kstep, voffA); PG8_STAGE(PG8_SB(1, 1), cB + hstep + kstep, voffB);
        PG8_WAIT_V(6); PG8_BAR;
    } else {
        PG8_STAGE(PG8_SB(0, 0), cB, voffB); PG8_STAGE(PG8_SA(0, 0), cA, voffA); PG8_STAGE(PG8_SB(0, 1), cB + hstep, voffB); PG8_STAGE(PG8_SA(0, 1), cA + hstep, voffA);
        if (wr == 1) PG8_BAR;
        PG8_WAIT_V(4); PG8_BAR;
        PG8_STAGE(PG8_SB(1, 0), cB + kstep, voffB); PG8_STAGE(PG8_SA(1, 0), cA + kstep, voffA); PG8_STAGE(PG8_SB(1, 1), cB + hstep + kstep, voffB);
        PG8_WAIT_V(6); PG8_BAR;
    }
    for (;;) {
        const bool has_next = S.next(ui + 1, nxt);
        const char* nA = has_next ? g.a(nxt.part) + (size_t)nxt.pm * tstep : cA; const char* nB = has_next ? g.b(nxt.part) + (size_t)nxt.pn * tstep : cB;
        const int nt = g.nt(cur.part);
        GST(0);
        for (int t = 0; t < nt; t += 2) {
            const bool last = (t == nt - 2);
            const char* a1 = cA + (size_t)(t + 1) * kstep;
            const char* a2 = last ? nA : cA + (size_t)(t + 2) * kstep; const char* b2 = last ? nB : cB + (size_t)(t + 2) * kstep;
            const char* a3 = a2 + kstep; const char* b3 = b2 + kstep;
            if (last && has_next) S.a_ready(nxt);
            if constexpr (SP2) {
            PG8_LDB(B0, 0, 0); PG8_LDB(B1, 0, 1); PG8_SCHED; PG8_LDA(At, 0, 0); PG8_STAGE(PG8_SA(1, 1), a1 + hstep, voffA); PG8_WAIT_V(8); PG8_WAIT_L(0); PG8_BAR; PG8_MMA(0, 0, At, B0); PG8_MMA(0, 1, At, B1); PG8_BAR; PG8_SCHED;
            PG8_LDA(At, 0, 1); PG8_STAGE(PG8_SB(0, 0), b2, voffB); PG8_STAGE(PG8_SB(0, 1), b2 + hstep, voffB); PG8_STAGE(PG8_SA(0, 0), a2, voffA); PG8_WAIT_V(8); PG8_WAIT_L(0); PG8_BAR; PG8_MMA(1, 0, At, B0); PG8_MMA(1, 1, At, B1); PG8_BAR; PG8_SCHED;
            PG8_LDB(B0, 1, 0); PG8_LDB(B1, 1, 1); PG8_SCHED; PG8_LDA(At, 1, 0); PG8_STAGE(PG8_SA(0, 1), a2 + hstep, voffA); PG8_WAIT_V(8); PG8_WAIT_L(0); PG8_BAR; PG8_MMA(0, 0, At, B0); PG8_MMA(0, 1, At, B1); PG8_BAR; PG8_SCHED;
            PG8_LDA(At, 1, 1); PG8_STAGE(PG8_SB(1, 0), b3, voffB); PG8_STAGE(PG8_SB(1, 1), b3 + hstep, voffB); PG8_STAGE(PG8_SA(1, 0), a3, voffA); PG8_WAIT_V(8); PG8_WAIT_L(0); PG8_BAR; PG8_MMA(1, 0, At, B0); PG8_MMA(1, 1, At, B1); PG8_BAR; PG8_SCHED;
            } else {
            PG8_LDB(B0, 0, 0); PG8_SCHED; PG8_LDA(At, 0, 0); PG8_STAGE(PG8_SA(1, 1), a1 + hstep, voffA);
            PG8_WAIT_L(8); PG8_BAR; PG8_WAIT_L(0); PG8_MMA(0, 0, At, B0); PG8_BAR; PG8_SCHED;
            PG8_LDB(B1, 0, 1); PG8_STAGE(PG8_SB(0, 0), b2, voffB);
            PG8_BAR; PG8_WAIT_L(0); PG8_MMA(0, 1, At, B1); PG8_BAR;
            PG8_LDA(At, 0, 1); PG8_STAGE(PG8_SA(0, 0), a2, voffA);
            PG8_BAR; PG8_WAIT_L(0); PG8_MMA(1, 0, At, B0); PG8_BAR; PG8_SCHED;
            PG8_STAGE(PG8_SB(0, 1), b2 + hstep, voffB);
            PG8_WAIT_V(6); PG8_BAR; PG8_MMA(1, 1, At, B1); PG8_BAR;
            PG8_LDB(B0, 1, 0); PG8_SCHED; PG8_LDA(At, 1, 0); PG8_STAGE(PG8_SA(0, 1), a2 + hstep, voffA);
            PG8_WAIT_L(8); PG8_BAR; PG8_WAIT_L(0); PG8_MMA(0, 0, At, B0); PG8_BAR; PG8_SCHED;
            PG8_LDB(B1, 1, 1); PG8_STAGE(PG8_SB(1, 0), b3, voffB);
            PG8_BAR; PG8_WAIT_L(0); PG8_MMA(0, 1, At, B1); PG8_BAR;
            PG8_LDA(At, 1, 1); PG8_STAGE(PG8_SA(1, 0), a3, voffA);
            PG8_BAR; PG8_WAIT_L(0); PG8_MMA(1, 0, At, B0); PG8_BAR; PG8_SCHED;
            PG8_STAGE(PG8_SB(1, 1), b3 + hstep, voffB);
            PG8_WAIT_V(6); PG8_BAR; PG8_MMA(1, 1, At, B1); PG8_BAR;
            }
        }
        GST(1);
        if constexpr (ALIGN_EPI) { if (wr == 0) PG8_BAR; }
        GST(2);
        if constexpr (!Epi::AFTER_DRAIN) { E(acc, cur, wr, wc, fr, fq); S.done(cur); }
        GST(3);
        if (!has_next) break;
        if (!E.keep(cur)) {
#pragma unroll
        for (int a = 0; a < 2; ++a)
#pragma unroll
            for (int b = 0; b < 2; ++b)
#pragma unroll
                for (int m = 0; m < 4; ++m)
#pragma unroll
                    for (int n = 0; n < 2; ++n) acc[a][b][m][n] = (f32x4){0.f, 0.f, 0.f, 0.f};
        }
        cur = nxt; cA = nA; cB = nB; ++ui;
        if constexpr (ALIGN_EPI) { if (wr == 1) PG8_BAR; }
    }
    PG8_WAIT_V(0);
    if constexpr (!ALIGN_EPI) { if (wr == 0) PG8_BAR; }
    PG8_BAR;
    if constexpr (Epi::AFTER_DRAIN) { E.fused(acc, cur, wr, wc, fr, fq, lds, wid, lane); S.done(cur); }
#undef PG8_SA
#undef PG8_SB
#undef PG8_STAGE
#undef PG8_LDA
#undef PG8_LDB
#undef PG8_MMA
#undef PG8_WAIT_V
#undef PG8_WAIT_L
#undef PG8_BAR
#undef PG8_SCHED
}
}
#define GAS __attribute__((address_space(1)))
#define LAS __attribute__((address_space(3)))
typedef unsigned short bf16;
typedef unsigned v4u __attribute__((ext_vector_type(4)));
typedef float f32x4 __attribute__((ext_vector_type(4)));
typedef short bf16x8 __attribute__((ext_vector_type(8)));
typedef GAS unsigned gu32;
typedef GAS unsigned long long gu64;
#define RLX_AGENT __ATOMIC_RELAXED, __HIP_MEMORY_SCOPE_AGENT
#define LDS_WAIT() asm volatile("s_waitcnt lgkmcnt(0)" ::: "memory")
#define VM_WAIT() asm volatile("s_waitcnt vmcnt(0)" ::: "memory")
__device__ __forceinline__ unsigned long long rt() { return __builtin_amdgcn_s_memrealtime(); }
__device__ __forceinline__ unsigned f2bf(float f) { unsigned u = __builtin_bit_cast(unsigned, f); return (u + 0x7fffu + ((u >> 16) & 1u)) >> 16; }
__device__ __forceinline__ unsigned pk2(float lo, float hi) { return f2bf(lo) | (f2bf(hi) << 16); }

#define XB_TMO      128
#define XB_XCNT(j)  (256  + 64 * (j))
#define XB_XSUB(j)  (1280 + 64 * (j))
#define XB_XGEN(j)  (2304 + 64 * (j))
#define XB_TOP      3328
#define XB_TOPGEN   3392
#define XCD_BAR_WORDS 3456
#define XB_SPIN_CAP (1u << 18)

__device__ __forceinline__ unsigned xb_ld(unsigned* p)              { return __hip_atomic_load(p, __ATOMIC_RELAXED, __HIP_MEMORY_SCOPE_AGENT); }
__device__ __forceinline__ unsigned xb_add(unsigned* p, unsigned v) { return __hip_atomic_fetch_add(p, v, __ATOMIC_RELAXED, __HIP_MEMORY_SCOPE_AGENT); }
__device__ __forceinline__ unsigned xb_xcc_id() { return (unsigned)__builtin_amdgcn_s_getreg((3 << 11) | 20) & 0xFu; }
#define XB_SPIN(cond, bar) do { unsigned _sp = 0; while (cond) { __builtin_amdgcn_s_sleep(1); \
    if ((++_sp & 255u) == 0u) { if (xb_ld(&(bar)[XB_TMO])) break; if (_sp > XB_SPIN_CAP) { atomicAdd(&(bar)[XB_TMO], 1u); break; } } } } while (0)

struct XcdBarrier {
    unsigned* bar; unsigned x;
    volatile LAS unsigned* st;
};

__device__ __forceinline__ XcdBarrier xcd_barrier_post(unsigned* bar, volatile LAS unsigned* st) {
    XcdBarrier b; b.bar = bar; b.x = xb_xcc_id(); b.st = st;
    if (threadIdx.x == 0) (void)xb_add(&bar[XB_XCNT(b.x)], 1u);
    return b;
}
__device__ __forceinline__ void xcd_barrier_complete(unsigned* bar, unsigned x, unsigned& nloc, unsigned& nx) {
    const unsigned G = gridDim.x * gridDim.y * gridDim.z;
    unsigned sum, cnt, mine, sp = 0u;
    for (;;) {
        sum = 0u; cnt = 0u; mine = 0u;
#pragma unroll
        for (unsigned j = 0; j < 16; ++j) { const unsigned c = xb_ld(&bar[XB_XCNT(j)]); sum += c; cnt += (c > 0u) ? 1u : 0u; mine = (j == x) ? c : mine; }
        if (sum == G) break;
        __builtin_amdgcn_s_sleep(1);
        if ((++sp & 255u) == 0u) { if (xb_ld(&bar[XB_TMO])) break; if (sp > XB_SPIN_CAP) { atomicAdd(&bar[XB_TMO], 1u); break; } }
    }
    nloc = mine > 0u ? mine : 1u; nx = cnt > 0u ? cnt : 1u;
}

__device__ __forceinline__ void xcd_barrier(const XcdBarrier& b) {
    asm volatile("s_waitcnt vmcnt(0)" ::: "memory");
    __syncthreads();
    if (threadIdx.x == 0) {
        unsigned* bar = b.bar;
        __builtin_amdgcn_s_waitcnt(0);
        unsigned nloc = b.st[0], nx = b.st[1];
        if (nloc == 0u) { xcd_barrier_complete(bar, b.x, nloc, nx); b.st[0] = nloc; b.st[1] = nx; }
        const unsigned old = xb_add(&bar[XB_XSUB(b.x)], 1u);
        const unsigned gen = old / nloc;
        if (old + 1u == (gen + 1u) * nloc) {
            __builtin_amdgcn_fence(__ATOMIC_RELEASE, "agent");
            asm volatile("s_waitcnt vmcnt(0)" ::: "memory");
            const unsigned og = xb_add(&bar[XB_TOP], 1u);
            const unsigned tg = og / nx;
            if (og + 1u == (tg + 1u) * nx) xb_add(&bar[XB_TOPGEN], 1u);
            else XB_SPIN(xb_ld(&bar[XB_TOPGEN]) == tg, bar);
            __builtin_amdgcn_fence(__ATOMIC_ACQUIRE, "agent");
            xb_add(&bar[XB_XGEN(b.x)], 1u);
            asm volatile("s_waitcnt vmcnt(0)" ::: "memory");
        } else {
            XB_SPIN(xb_ld(&bar[XB_XGEN(b.x)]) == gen, bar);
            __builtin_amdgcn_fence(__ATOMIC_ACQUIRE, "agent");
            asm volatile("s_waitcnt vmcnt(0)" ::: "memory");
        }
    }
    __syncthreads();
}
constexpr int D = 1024, M_CTX = 8192, M = 16384, L_CTX = 256, L_LAT = 1024, NB_CTX = 32, NB_LAT = 8;
constexpr int DIN = 3584, DFF = 4096, DPOOL = 512, NGRP = 64, NST = 64, HG = 16;
constexpr float DN_ALPHA = 1.189207115002721f;
constexpr float LN_EPS = 1e-6f;
constexpr int NWAVES = 8;

constexpr size_t MiB = 1u << 20;
constexpr size_t WS_CTL = 0, CTL_ZERO_BYTES = 64 * 1024;
constexpr size_t WS_MODP = 1 * MiB;
constexpr size_t WS_MODF = 2 * MiB;
constexpr size_t WS_STATS = 2 * MiB + 256 * 1024;
constexpr size_t WS_LAMB = 2 * MiB + 512 * 1024;
constexpr size_t WS_BB   = 3 * MiB;
constexpr size_t WS_CT   = 3 * MiB + 512 * 1024;
constexpr size_t WS_WIN = 4 * MiB, WS_WGLU = 11 * MiB, WS_WPA = 13 * MiB, WS_WPB = 15 * MiB, WS_WOUT = 17 * MiB, WS_W1 = 19 * MiB, WS_W2 = 27 * MiB, WS_WPOOL = 35 * MiB;
constexpr size_t WS_RA = 36 * MiB;
constexpr size_t WS_RB = 68 * MiB;
constexpr size_t WS_UB = 100 * MiB;
constexpr size_t WS_GA = 116 * MiB, WS_GB = 148 * MiB;
constexpr size_t WS_P  = 180 * MiB;
constexpr size_t WS_HM = 100 * MiB;
constexpr size_t WS_V  = 212 * MiB;
constexpr size_t WS_END = 244 * MiB;
constexpr int CW_BAR = 1024;

constexpr int RING_BYTES = 131072, LDSCTL_OFF = RING_BYTES, MISC_OFF = LDSCTL_OFF + 320, LDS_BYTES = 147456;

typedef unsigned u32x2 __attribute__((ext_vector_type(2)));
typedef float f32x16 __attribute__((ext_vector_type(16)));
__device__ __forceinline__ float bf_lo(unsigned w) { return __builtin_bit_cast(float, w << 16); }
__device__ __forceinline__ float bf_hi(unsigned w) { return __builtin_bit_cast(float, w & 0xffff0000u); }
__device__ __forceinline__ float fsigmoid(float x) { return __builtin_amdgcn_rcpf(1.0f + __builtin_amdgcn_exp2f(-1.4426950408889634f * x)); }
__device__ __forceinline__ float gelu_tanh(float x) { const float u = x * (1.5957691216057308f + 0.0713548162726f * x * x); return x * fsigmoid(u); }

namespace pg8 {
#define EPI_LOOP_BEGIN _Pragma("unroll") for (int ai = 0; ai < 2; ++ai) _Pragma("unroll") for (int m = 0; m < 4; ++m) { const int row = u.pm * BM + ai * HALF + wr * 64 + m * 16 + fr; _Pragma("unroll") for (int bj = 0; bj < 2; ++bj) { const int cl = bj * HALF + wc * 32 + 8 * fq;
#define EPI_LOOP_END } }
__device__ __forceinline__ u32x4 pack8(const f32x4& a, const f32x4& b) { u32x4 w; w.x = cvt_pk_bf16(a[0], a[1]); w.y = cvt_pk_bf16(a[2], a[3]); w.z = cvt_pk_bf16(b[0], b[1]); w.w = cvt_pk_bf16(b[2], b[3]); return w; }
__device__ __forceinline__ void unpack8(const u32x4& w, f32x4& a, f32x4& b) { a = (f32x4){bf_lo(w.x), bf_hi(w.x), bf_lo(w.y), bf_hi(w.y)}; b = (f32x4){bf_lo(w.z), bf_hi(w.z), bf_lo(w.w), bf_hi(w.w)}; }

struct EpiIn {
    static constexpr bool PERM = true, AFTER_DRAIN = false;
    bf16_t *ua, *ub, *ga, *gb; const float* bias;
    __device__ __forceinline__ bool keep(const Unit&) const { return false; }
    __device__ __forceinline__ int nstores(const Unit&) const { return 16; }
    __device__ __forceinline__ void operator()(f32x4 (&acc)[2][2][4][2], const Unit& u, int wr, int wc, int fr, int fq) const {
        bf16_t* base; int ldc, c0; bool sg;
        if (u.pn < 4) { base = ua; ldc = D; c0 = u.pn * BM; sg = false; } else if (u.pn < 6) { base = ub; ldc = DPOOL; c0 = (u.pn - 4) * BM; sg = false; }
        else if (u.pn < 10) { base = ga; ldc = D; c0 = (u.pn - 6) * BM; sg = true; } else { base = gb; ldc = D; c0 = (u.pn - 10) * BM; sg = true; }
        EPI_LOOP_BEGIN
            const float* bp = bias + u.pn * BM + cl; f32x4 v0 = acc[ai][bj][m][0] + *(const f32x4*)bp, v1 = acc[ai][bj][m][1] + *(const f32x4*)(bp + 4);
            if (sg) {
#pragma unroll
                for (int j = 0; j < 4; ++j) { v0[j] = fsigmoid(v0[j]); v1[j] = fsigmoid(v1[j]); } }
            *(u32x4*)(base + (size_t)row * ldc + c0 + cl) = pack8(v0, v1);
        EPI_LOOP_END
    }
};
struct EpiGlu {
    static constexpr bool PERM = true, AFTER_DRAIN = false;
    const bf16_t* v; bf16_t* o; const float* bias;
    __device__ __forceinline__ bool keep(const Unit&) const { return false; }
    __device__ __forceinline__ int nstores(const Unit&) const { return 16; }
    __device__ __forceinline__ void operator()(f32x4 (&acc)[2][2][4][2], const Unit& u, int wr, int wc, int fr, int fq) const {
        EPI_LOOP_BEGIN
            const int col = u.pn * BM + cl; const float* bp = bias + col; f32x4 t0 = acc[ai][bj][m][0] + *(const f32x4*)bp, t1 = acc[ai][bj][m][1] + *(const f32x4*)(bp + 4);
            f32x4 x0, x1; unpack8(*(const u32x4*)(v + (size_t)row * D + col), x0, x1);
#pragma unroll
            for (int j = 0; j < 4; ++j) { t0[j] = x0[j] * fsigmoid(t0[j]); t1[j] = x1[j] * fsigmoid(t1[j]); }
            *(u32x4*)(o + (size_t)row * D + col) = pack8(t0, t1);
        EPI_LOOP_END
    }
};
struct EpiMerge {
    static constexpr bool PERM = true, AFTER_DRAIN = false;
    const bf16_t *ga, *gb; bf16_t* o;
    __device__ __forceinline__ bool keep(const Unit& u) const { return u.part == 0; }
    __device__ __forceinline__ int nstores(const Unit& u) const { return u.part == 0 ? 0 : 16; }
    __device__ __forceinline__ void operator()(f32x4 (&acc)[2][2][4][2], const Unit& u, int wr, int wc, int fr, int fq) const {
        EPI_LOOP_BEGIN
            const size_t off = (size_t)row * D + u.pn * BM + cl; f32x4 b0, b1; unpack8(*(const u32x4*)(gb + off), b0, b1);
            if (u.part == 0) { f32x4 a0, a1; unpack8(*(const u32x4*)(ga + off), a0, a1);
#pragma unroll
                for (int j = 0; j < 4; ++j) { acc[ai][bj][m][0][j] *= a0[j] * __builtin_amdgcn_rcpf(fmaxf(b0[j], 1e-30f)); acc[ai][bj][m][1][j] *= a1[j] * __builtin_amdgcn_rcpf(fmaxf(b1[j], 1e-30f)); } }
            else { *(u32x4*)(o + off) = pack8(acc[ai][bj][m][0] * b0, acc[ai][bj][m][1] * b1); }
        EPI_LOOP_END
    }
};
struct EpiRes1 {
    static constexpr bool PERM = true, AFTER_DRAIN = false;
    const float *x_ctx, *x_lat; bf16_t* out; const float* bias; const float* modf;
    __device__ __forceinline__ bool keep(const Unit&) const { return false; }
    __device__ __forceinline__ int nstores(const Unit&) const { return 16; }
    __device__ __forceinline__ void operator()(f32x4 (&acc)[2][2][4][2], const Unit& u, int wr, int wc, int fr, int fq) const {
        const int r0 = u.pm * BM; const int bidx = r0 < M_CTX ? 0 : 1 + (r0 - M_CTX) / L_LAT;
        const float* gate = modf + (size_t)bidx * 6 * D + 2 * D; const float* bs = r0 < M_CTX ? x_ctx : x_lat - (size_t)M_CTX * D;
        EPI_LOOP_BEGIN
            const int col = u.pn * BM + cl; const size_t off = (size_t)row * D + col;
            const f32x4 g0 = *(const f32x4*)(gate + col), g1 = *(const f32x4*)(gate + col + 4), c0 = *(const f32x4*)(bias + col), c1 = *(const f32x4*)(bias + col + 4);
            const f32x4 x0 = *(const f32x4*)(bs + off), x1 = *(const f32x4*)(bs + off + 4);
            *(u32x4*)(out + off) = pack8(x0 * DN_ALPHA + g0 * (acc[ai][bj][m][0] + c0), x1 * DN_ALPHA + g1 * (acc[ai][bj][m][1] + c1));
        EPI_LOOP_END
    }
};
struct EpiRes2 {
    static constexpr bool PERM = true, AFTER_DRAIN = false;
    const bf16_t* r1; const float* stats; const float *lg, *lb; bf16_t* out; const float* bias; const float* modf;
    __device__ __forceinline__ bool keep(const Unit&) const { return false; }
    __device__ __forceinline__ int nstores(const Unit&) const { return 16; }
    __device__ __forceinline__ void operator()(f32x4 (&acc)[2][2][4][2], const Unit& u, int wr, int wc, int fr, int fq) const {
        const int r0 = u.pm * BM; const int bidx = r0 < M_CTX ? 0 : 1 + (r0 - M_CTX) / L_LAT;
        const float* gate = modf + (size_t)bidx * 6 * D + 5 * D;
        EPI_LOOP_BEGIN
            const int col = u.pn * BM + cl; const size_t off = (size_t)row * D + col;
            const f32x4 g0 = *(const f32x4*)(gate + col), g1 = *(const f32x4*)(gate + col + 4), c0 = *(const f32x4*)(bias + col), c1 = *(const f32x4*)(bias + col + 4);
            const f32x4 lg0 = *(const f32x4*)(lg + col), lg1 = *(const f32x4*)(lg + col + 4), lb0 = *(const f32x4*)(lb + col), lb1 = *(const f32x4*)(lb + col + 4);
            const float mu = stats[2 * row], rs = stats[2 * row + 1];
            f32x4 x0, x1; unpack8(*(const u32x4*)(r1 + off), x0, x1);
            x0 = (x0 - mu) * rs * lg0 + lb0; x1 = (x1 - mu) * rs * lg1 + lb1;
            *(u32x4*)(out + off) = pack8(x0 * DN_ALPHA + g0 * (acc[ai][bj][m][0] + c0), x1 * DN_ALPHA + g1 * (acc[ai][bj][m][1] + c1));
        EPI_LOOP_END
    }
};
struct EpiRelu2 {
    static constexpr bool PERM = true, AFTER_DRAIN = false;
    bf16_t* o; const float* bias;
    __device__ __forceinline__ bool keep(const Unit&) const { return false; }
    __device__ __forceinline__ int nstores(const Unit&) const { return 16; }
    __device__ __forceinline__ void operator()(f32x4 (&acc)[2][2][4][2], const Unit& u, int wr, int wc, int fr, int fq) const {
        EPI_LOOP_BEGIN
            const int col = u.pn * BM + cl; f32x4 t0 = acc[ai][bj][m][0] + *(const f32x4*)(bias + col), t1 = acc[ai][bj][m][1] + *(const f32x4*)(bias + col + 4);
#pragma unroll
            for (int j = 0; j < 4; ++j) { const float a = fmaxf(t0[j], 0.f), b = fmaxf(t1[j], 0.f); t0[j] = a * a; t1[j] = b * b; }
            *(u32x4*)(o + (size_t)row * DFF + col) = pack8(t0, t1);
        EPI_LOOP_END
    }
};
}
struct Frame {
    LAS unsigned char* lds;
    volatile LAS unsigned* MISC;
    gu32* ctl;
    int tid, lane, wave, G, bid;
    const float* in[33]; float* out; unsigned char* ws;
};
enum { I_XP = 0, I_XS, I_STATE, I_C, I_CCTX, I_WADA, I_BADA, I_WIN, I_BIN, I_LAMRE, I_LAMIM, I_LOGDT, I_BRE, I_BIM, I_CRE, I_CIM, I_S5D, I_WGLU, I_BGLU, I_WPA, I_WPOOL, I_PSCALE, I_WPB,
       I_WOUT, I_BOUT, I_LN1G, I_LN1B, I_W1, I_B1, I_W2, I_B2, I_LN2G, I_LN2B };

__device__ __forceinline__ float wave_sum(float v) {
#pragma unroll
    for (int o = 1; o < 64; o <<= 1) v += __shfl_xor(v, o);
    return v;
}
__device__ __forceinline__ void p0_transpose_item(const float* W, int N, bf16* WT, int ldt, LAS unsigned* scr, int item, int lane) {
    const int nblk = N / 64, kb = item / nblk, nb = item % nblk, k0 = 64 * kb, n0 = 64 * nb, q = lane & 15, kp = lane >> 4;
    f32x4 v0[8], v1[8];
#pragma unroll
    for (int i = 0; i < 8; ++i) { const float* p = W + (size_t)(k0 + 8 * i + 2 * kp) * N + n0 + 4 * q; v0[i] = *(const f32x4*)p; v1[i] = *(const f32x4*)(p + N); }
#pragma unroll
    for (int i = 0; i < 8; ++i)
#pragma unroll
        for (int j = 0; j < 4; ++j) scr[(4 * q + j) * 33 + 4 * i + kp] = pk2(v0[i][j], v1[i][j]);
    LDS_WAIT(); asm volatile("" ::: "memory");
    const int kc = lane & 7;
#pragma unroll
    for (int jj = 0; jj < 8; ++jj) { const int n = 8 * jj + (lane >> 3); const LAS unsigned* s = scr + n * 33 + 4 * kc;
        v4u o; o.x = s[0]; o.y = s[1]; o.z = s[2]; o.w = s[3];
        *(GAS v4u*)(WT + (size_t)(n0 + n) * ldt + k0 + 8 * kc) = o; }
    LDS_WAIT(); asm volatile("" ::: "memory");
}

__device__ __forceinline__ void phase0(Frame& F) {
    unsigned char* ws = F.ws;
    if (F.bid < 96) {
        const int cc = F.bid % 24, kq = F.bid / 24, k0 = kq * 256 + F.wave * 32;
        LAS float* sv = (LAS float*)(F.lds) + F.wave * 288;
        LAS float* red = (LAS float*)(F.lds + 16384);
        if (F.lane < 32) {
#pragma unroll
            for (int r = 0; r < 9; ++r) { const float cv = r == 0 ? F.in[I_CCTX][k0 + F.lane] : F.in[I_C][(size_t)(r - 1) * D + k0 + F.lane]; sv[r * 32 + F.lane] = cv * fsigmoid(cv); }
        }
        LDS_WAIT(); asm volatile("" ::: "memory");
        f32x4 a[9];
#pragma unroll
        for (int r = 0; r < 9; ++r) a[r] = (f32x4){0.f, 0.f, 0.f, 0.f};
        const float* wp = F.in[I_WADA] + (size_t)k0 * 6144 + cc * 256 + F.lane * 4;
#pragma unroll 8
        for (int k = 0; k < 32; ++k) { const f32x4 w = *(const f32x4*)(wp + (size_t)k * 6144);
#pragma unroll
            for (int r = 0; r < 9; ++r) a[r] += w * sv[r * 32 + k]; }
#pragma unroll
        for (int r = 0; r < 9; ++r) *(LAS f32x4*)(red + (F.wave * 9 + r) * 256 + F.lane * 4) = a[r];
        __syncthreads();
        float* mp = (float*)(ws + WS_MODP) + (size_t)kq * 9 * 6144;
        for (int i = F.tid; i < 9 * 256; i += NWAVES * 64) { const int r = i >> 8, c = i & 255; float s = 0.f;
#pragma unroll
            for (int w = 0; w < 8; ++w) s += red[(w * 9 + r) * 256 + c];
            mp[(size_t)r * 6144 + cc * 256 + c] = s; }
        __syncthreads();
    }
    for (int it = F.bid * (NWAVES * 64) + F.tid; it < 2 * NGRP * NST; it += F.G * NWAVES * 64) {
        const int p = it & 63, g = (it >> 6) & 63, dir = it >> 12;
        const float lr = F.in[I_LAMRE][it], li = F.in[I_LAMIM][it], dt = expf(F.in[I_LOGDT][dir * 64 + g]);
        const float zr = lr * dt, zi = li * dt, e = expf(zr); float sn, cs; sincosf(zi, &sn, &cs);
        const float lbr = e * cs, lbi = e * sn;
        const float sh = sinf(0.5f * zi); const float nr = expm1f(zr) * cs - 2.f * sh * sh, ni = lbi;
        const float den = 1.f / (lr * lr + li * li); const float wr_ = (nr * lr + ni * li) * den, wi_ = (ni * lr - nr * li) * den;
        float* lamb = (float*)(ws + WS_LAMB) + (size_t)it * 2; lamb[0] = lbr; lamb[1] = lbi;
        bf16* bb = (bf16*)(ws + WS_BB); const float* bre = F.in[I_BRE] + (size_t)it * 16; const float* bim = F.in[I_BIM] + (size_t)it * 16;
        unsigned ore[8], oim[8];
#pragma unroll
        for (int h = 0; h < 8; ++h) { const float r0 = bre[2 * h], i0 = bim[2 * h], r1 = bre[2 * h + 1], i1 = bim[2 * h + 1];
            ore[h] = pk2(wr_ * r0 - wi_ * i0, wr_ * r1 - wi_ * i1); oim[h] = pk2(wr_ * i0 + wi_ * r0, wr_ * i1 + wi_ * r1); }
        v4u* dre = (v4u*)(bb + ((size_t)((dir * 64 + g) * 2 + 0) * 64 + p) * 16); v4u* dim_ = (v4u*)(bb + ((size_t)((dir * 64 + g) * 2 + 1) * 64 + p) * 16);
        dre[0] = (v4u){ore[0], ore[1], ore[2], ore[3]}; dre[1] = (v4u){ore[4], ore[5], ore[6], ore[7]};
        dim_[0] = (v4u){oim[0], oim[1], oim[2], oim[3]}; dim_[1] = (v4u){oim[4], oim[5], oim[6], oim[7]};
        bf16* ct = (bf16*)(ws + WS_CT) + (size_t)(dir * 64 + g) * 16 * 128;
#pragma unroll
        for (int h = 0; h < 16; ++h) { const size_t ci = ((size_t)(dir * 64 + g) * 16 + h) * 64 + p;
            *(unsigned*)(ct + h * 128 + 2 * p) = pk2(F.in[I_CRE][ci], -F.in[I_CIM][ci]); }
    }
    {
        LAS unsigned* scr = (LAS unsigned*)(F.lds + F.wave * 16384);
        const int gw = ((F.bid + F.G - (F.G > 96 ? 96 : 0)) % F.G) * NWAVES + F.wave, NGW = F.G * NWAVES;
        constexpr int I_IN = (D / 64) * (DIN / 64), I_SQ = (D / 64) * (D / 64), I_PB = (DPOOL / 64) * (D / 64), I_1 = (D / 64) * (DFF / 64), I_2 = (DFF / 64) * (D / 64), I_PL = 4 * 2 * 2;
        constexpr int NITEMS = I_IN + 3 * I_SQ + I_PB + I_1 + I_2 + I_PL;
        for (int it = gw; it < NITEMS; it += NGW) {
            int r = it;
            if (r < I_1) { p0_transpose_item(F.in[I_W1], DFF, (bf16*)(ws + WS_W1), D, scr, r, F.lane); continue; } r -= I_1;
            if (r < I_2) { p0_transpose_item(F.in[I_W2], D, (bf16*)(ws + WS_W2), DFF, scr, r, F.lane); continue; } r -= I_2;
            if (r < I_IN) { p0_transpose_item(F.in[I_WIN], DIN, (bf16*)(ws + WS_WIN), D, scr, r, F.lane); continue; } r -= I_IN;
            if (r < I_SQ) { p0_transpose_item(F.in[I_WGLU], D, (bf16*)(ws + WS_WGLU), D, scr, r, F.lane); continue; } r -= I_SQ;
            if (r < I_SQ) { p0_transpose_item(F.in[I_WPA], D, (bf16*)(ws + WS_WPA), D, scr, r, F.lane); continue; } r -= I_SQ;
            if (r < I_SQ) { p0_transpose_item(F.in[I_WOUT], D, (bf16*)(ws + WS_WOUT), D, scr, r, F.lane); continue; } r -= I_SQ;
            if (r < I_PB) { p0_transpose_item(F.in[I_WPB], D, (bf16*)(ws + WS_WPB), D, scr, r, F.lane); continue; } r -= I_PB;
            { const int gi = r >> 2; p0_transpose_item(F.in[I_WPOOL] + (size_t)gi * 128 * 128, 128, (bf16*)(ws + WS_WPOOL) + (size_t)gi * 128 * 128, 128, scr, r & 3, F.lane); }
        }
    }
}

__device__ __forceinline__ f32x4 mod4(Frame& F, int bidx, int idx) {
    const float* mp = (const float*)(F.ws + WS_MODP) + (size_t)bidx * 6144 + idx;
    f32x4 s = *(const f32x4*)(F.in[I_BADA] + idx);
#pragma unroll
    for (int q = 0; q < 4; ++q) s += *(const f32x4*)(mp + (size_t)q * 9 * 6144);
    return s;
}
__device__ __forceinline__ int batch_of_row(int r0) { return r0 < M_CTX ? 0 : 1 + (r0 - M_CTX) / L_LAT; }

__device__ __forceinline__ void phase1(Frame& F) {
    LAS f32x4* sc = (LAS f32x4*)(F.lds); LAS f32x4* sh = (LAS f32x4*)(F.lds + 4096);
    bf16* H = (bf16*)(F.ws + WS_RA);
    if (F.bid < 9) { float* mf = (float*)(F.ws + WS_MODF) + (size_t)F.bid * 6144; for (int i = F.tid; i < 6144 / 4; i += NWAVES * 64) *(f32x4*)(mf + 4 * i) = mod4(F, F.bid, 4 * i); }
    for (int rb = F.bid; rb < M / 64; rb += F.G) {
        const int r0 = rb * 64, bidx = batch_of_row(r0);
        __syncthreads();
        if (F.tid < 256) { sc[F.tid] = mod4(F, bidx, D + 4 * F.tid) + 1.0f; sh[F.tid] = mod4(F, bidx, 4 * F.tid); }
        __syncthreads();
        f32x4 xv[8][4];
#pragma unroll
        for (int j = 0; j < 8; ++j) { const int m = r0 + F.wave * 8 + j;
            const float* xrow = (m < M_CTX ? F.in[I_XP] + (size_t)m * D : F.in[I_XS] + (size_t)(m - M_CTX) * D); const GAS f32x4* xr = (const GAS f32x4*)xrow + F.lane;
#pragma unroll
            for (int q = 0; q < 4; ++q) xv[j][q] = xr[64 * q]; }
#pragma unroll
        for (int j = 0; j < 8; ++j) {
            const int m = r0 + F.wave * 8 + j;
            f32x4 v[4]; float s = 0.f;
#pragma unroll
            for (int q = 0; q < 4; ++q) { v[q] = xv[j][q]; s += (v[q].x + v[q].y) + (v[q].z + v[q].w); }
            const float mean = wave_sum(s) * (1.f / D); float s2 = 0.f;
#pragma unroll
            for (int q = 0; q < 4; ++q) { v[q] = v[q] - mean; s2 += (v[q].x * v[q].x + v[q].y * v[q].y) + (v[q].z * v[q].z + v[q].w * v[q].w); }
            const float rstd = 1.f / sqrtf(wave_sum(s2) * (1.f / D) + LN_EPS);
            GAS u32x2* o8 = (GAS u32x2*)(H + (size_t)m * D) + F.lane;
#pragma unroll
            for (int q = 0; q < 4; ++q) { const f32x4 y = v[q] * rstd * sc[F.lane + 64 * q] + sh[F.lane + 64 * q]; u32x2 w; w.x = pg8::cvt_pk_bf16(y.x, y.y); w.y = pg8::cvt_pk_bf16(y.z, y.w); o8[64 * q] = w; }
        }
    }
}

__device__ __forceinline__ void unpack4(const u32x2 w, f32x4& v) { v = (f32x4){bf_lo(w.x), bf_hi(w.x), bf_lo(w.y), bf_hi(w.y)}; }
__device__ __forceinline__ void phase_ln1(Frame& F, const bf16* R1, float* stats, bf16* H2) {
    LAS f32x4* sc = (LAS f32x4*)(F.lds); LAS f32x4* sh = (LAS f32x4*)(F.lds + 4096);
    const float* lg = F.in[I_LN1G]; const float* lb = F.in[I_LN1B];
    for (int rb = F.bid; rb < M / 64; rb += F.G) {
        const int r0 = rb * 64, bidx = batch_of_row(r0);
        __syncthreads();
        const float* mf = (const float*)(F.ws + WS_MODF) + (size_t)bidx * 6144;
        if (F.tid < 256) { sc[F.tid] = *(const f32x4*)(mf + 4 * D + 4 * F.tid) + 1.0f; sh[F.tid] = *(const f32x4*)(mf + 3 * D + 4 * F.tid); }
        __syncthreads();
        f32x4 gg[4], bb[4];
#pragma unroll
        for (int q = 0; q < 4; ++q) { gg[q] = *(const f32x4*)(lg + 4 * (F.lane + 64 * q)); bb[q] = *(const f32x4*)(lb + 4 * (F.lane + 64 * q)); }
        u32x2 raw[8][4];
#pragma unroll
        for (int j = 0; j < 8; ++j)
#pragma unroll
            for (int q = 0; q < 4; ++q) raw[j][q] = ((const GAS u32x2*)(R1 + (size_t)(r0 + F.wave * 8 + j) * D))[F.lane + 64 * q];
#pragma unroll
        for (int j = 0; j < 8; ++j) {
            const int m = r0 + F.wave * 8 + j;
            f32x4 v[4]; float s = 0.f;
#pragma unroll
            for (int q = 0; q < 4; ++q) { unpack4(raw[j][q], v[q]); s += (v[q].x + v[q].y) + (v[q].z + v[q].w); }
            float mean = wave_sum(s) * (1.f / D), s2 = 0.f;
#pragma unroll
            for (int q = 0; q < 4; ++q) { v[q] = v[q] - mean; s2 += (v[q].x * v[q].x + v[q].y * v[q].y) + (v[q].z * v[q].z + v[q].w * v[q].w); }
            float rstd = 1.f / sqrtf(wave_sum(s2) * (1.f / D) + LN_EPS);
            if (F.lane == 0) { stats[2 * m] = mean; stats[2 * m + 1] = rstd; }
            s = 0.f;
#pragma unroll
            for (int q = 0; q < 4; ++q) { v[q] = v[q] * rstd * gg[q] + bb[q]; s += (v[q].x + v[q].y) + (v[q].z + v[q].w); }
            mean = wave_sum(s) * (1.f / D); s2 = 0.f;
#pragma unroll
            for (int q = 0; q < 4; ++q) { v[q] = v[q] - mean; s2 += (v[q].x * v[q].x + v[q].y * v[q].y) + (v[q].z * v[q].z + v[q].w * v[q].w); }
            rstd = 1.f / sqrtf(wave_sum(s2) * (1.f / D) + LN_EPS);
            GAS u32x2* o8 = (GAS u32x2*)(H2 + (size_t)m * D) + F.lane;
#pragma unroll
            for (int q = 0; q < 4; ++q) { const f32x4 y = v[q] * rstd * sc[F.lane + 64 * q] + sh[F.lane + 64 * q]; u32x2 w; w.x = pg8::cvt_pk_bf16(y.x, y.y); w.y = pg8::cvt_pk_bf16(y.z, y.w); o8[64 * q] = w; }
        }
    }
}
__device__ __forceinline__ void phase_ln2(Frame& F, const bf16* R2) {
    const float* lg = F.in[I_LN2G]; const float* lb = F.in[I_LN2B];
    f32x4 gg[4], bb[4];
#pragma unroll
    for (int q = 0; q < 4; ++q) { gg[q] = *(const f32x4*)(lg + 4 * (F.lane + 64 * q)); bb[q] = *(const f32x4*)(lb + 4 * (F.lane + 64 * q)); }
    for (int rb = F.bid; rb < M / 64; rb += F.G) {
        const int r0 = rb * 64;
        u32x2 raw[8][4];
#pragma unroll
        for (int j = 0; j < 8; ++j)
#pragma unroll
            for (int q = 0; q < 4; ++q) raw[j][q] = ((const GAS u32x2*)(R2 + (size_t)(r0 + F.wave * 8 + j) * D))[F.lane + 64 * q];
#pragma unroll
        for (int j = 0; j < 8; ++j) {
            const int m = r0 + F.wave * 8 + j;
            f32x4 v[4]; float s = 0.f;
#pragma unroll
            for (int q = 0; q < 4; ++q) { unpack4(raw[j][q], v[q]); s += (v[q].x + v[q].y) + (v[q].z + v[q].w); }
            const float mean = wave_sum(s) * (1.f / D); float s2 = 0.f;
#pragma unroll
            for (int q = 0; q < 4; ++q) { v[q] = v[q] - mean; s2 += (v[q].x * v[q].x + v[q].y * v[q].y) + (v[q].z * v[q].z + v[q].w * v[q].w); }
            const float rstd = 1.f / sqrtf(wave_sum(s2) * (1.f / D) + LN_EPS);
            GAS f32x4* xr = (GAS f32x4*)(F.out + (size_t)m * D) + F.lane;
#pragma unroll
            for (int q = 0; q < 4; ++q) xr[64 * q] = v[q] * rstd * gg[q] + bb[q];
        }
    }
}
constexpr int S5_ROWB = 288, S5_WAVEB = 32 * S5_ROWB;
__device__ __forceinline__ void s5_task(Frame& F, bool lat, int seq, int gq) {
    const int lane = F.lane, n = lane & 31, hf = lane >> 5, g = gq * 4 + (F.wave >> 1), dir = F.wave & 1;
    const int L = lat ? L_LAT : L_CTX, tokbase = lat ? (M_CTX + seq * L_LAT) : seq * L_CTX, nch = L / 32;
    const bf16* UA = (const bf16*)(F.ws + WS_RB); bf16* V = (bf16*)(F.ws + WS_RA); float* PART = F.out;
    LAS unsigned char* sl = F.lds + F.wave * S5_WAVEB;
    bf16x8 Bf[2][2], Cf[4];
    { const bf16* bb = (const bf16*)(F.ws + WS_BB);
#pragma unroll
      for (int q = 0; q < 2; ++q)
#pragma unroll
        for (int part = 0; part < 2; ++part) Bf[q][part] = *(const bf16x8*)(bb + ((size_t)((dir * 64 + g) * 2 + part) * 64 + (n + 32 * q)) * 16 + 8 * hf);
      const bf16* ct = (const bf16*)(F.ws + WS_CT) + ((size_t)(dir * 64 + g) * 16 + (lane & 15)) * 128 + 8 * (lane >> 4);
#pragma unroll
      for (int ks = 0; ks < 4; ++ks) Cf[ks] = *(const bf16x8*)(ct + 32 * ks); }
    const int p = n + 32 * hf;
    const float lr = ((const float*)(F.ws + WS_LAMB))[((size_t)(dir * 64 + g) * 64 + p) * 2], li = ((const float*)(F.ws + WS_LAMB))[((size_t)(dir * 64 + g) * 64 + p) * 2 + 1];
    float sr = 0.f, si = 0.f;
    if (lat) { const float* st = F.in[I_STATE] + ((size_t)(seq * 2 + dir) * 2) * 4096 + g * 64 + p; sr = st[0]; si = st[4096]; }
    const int tauA = 16 * ((n >> 2) & 1) + (n & 3) + 4 * (n >> 3);
    const int tA = dir ? 31 - tauA : tauA;
    const bf16* ua_lane = UA + (size_t)tokbase * D + g * 16 + 8 * hf;
    const int h0 = 4 * (lane >> 4), colg = g * 16 + h0;
    const f32x4 dsum = *(const f32x4*)(F.in[I_S5D] + colg) + *(const f32x4*)(F.in[I_S5D] + D + colg);
    bf16x8 Acur = *(const bf16x8*)(ua_lane + (size_t)((dir ? L - 32 : 0) + tA) * D);
    for (int c = 0; c < nch; ++c) {
        const int t0 = dir ? L - 32 * (c + 1) : 32 * c;
        if (c == nch / 2) { asm volatile("s_waitcnt vmcnt(0)" ::: "memory"); __syncthreads(); }
        const f32x16 z16 = {0.f, 0.f, 0.f, 0.f, 0.f, 0.f, 0.f, 0.f, 0.f, 0.f, 0.f, 0.f, 0.f, 0.f, 0.f, 0.f};
        f32x16 x00 = __builtin_amdgcn_mfma_f32_32x32x16_bf16(Acur, Bf[0][0], z16, 0, 0, 0);
        f32x16 x01 = __builtin_amdgcn_mfma_f32_32x32x16_bf16(Acur, Bf[0][1], z16, 0, 0, 0);
        f32x16 x10 = __builtin_amdgcn_mfma_f32_32x32x16_bf16(Acur, Bf[1][0], z16, 0, 0, 0);
        f32x16 x11 = __builtin_amdgcn_mfma_f32_32x32x16_bf16(Acur, Bf[1][1], z16, 0, 0, 0);
        if (c + 1 < nch) { const int t1 = dir ? L - 32 * (c + 2) : 32 * (c + 1); Acur = *(const bf16x8*)(ua_lane + (size_t)(t1 + tA) * D); }
        float xr0[16], xi0[16], xr1[16], xi1[16];
#pragma unroll
        for (int i = 0; i < 16; ++i) {
            { auto r = __builtin_amdgcn_permlane32_swap(__float_as_uint(x00[i]), __float_as_uint(x10[i]), false, false); xr0[i] = __uint_as_float(r[0]); xr1[i] = __uint_as_float(r[1]); }
            { auto r = __builtin_amdgcn_permlane32_swap(__float_as_uint(x01[i]), __float_as_uint(x11[i]), false, false); xi0[i] = __uint_as_float(r[0]); xi1[i] = __uint_as_float(r[1]); }
        }
        LAS unsigned* srow = (LAS unsigned*)(sl + p * 4);
#pragma unroll
        for (int i = 0; i < 16; ++i) { const float nr = lr * sr - li * si + xr0[i], ni = lr * si + li * sr + xi0[i]; sr = nr; si = ni; srow[i * (S5_ROWB / 4)] = pg8::cvt_pk_bf16(sr, si); }
#pragma unroll
        for (int i = 0; i < 16; ++i) { const float nr = lr * sr - li * si + xr1[i], ni = lr * si + li * sr + xi1[i]; sr = nr; si = ni; srow[(16 + i) * (S5_ROWB / 4)] = pg8::cvt_pk_bf16(sr, si); }
        asm volatile("" ::: "memory");
#if MK_DEBUG
        if (!lat && dir == 0 && c == 0 && g == 3 * seq + 1 && seq >= 2 && seq < 8) { float* dx = (float*)(F.ws + 231 * MiB) + (size_t)seq * 32 * 64 * 4;
#pragma unroll
            for (int i = 0; i < 16; ++i) { dx[(i * 64 + p) * 4 + 0] = xr0[i]; dx[(i * 64 + p) * 4 + 1] = xi0[i]; dx[((16 + i) * 64 + p) * 4 + 0] = xr1[i]; dx[((16 + i) * 64 + p) * 4 + 1] = xi1[i]; }
            for (int i = 0; i < 32; ++i) { const unsigned w = *(const LAS unsigned*)(sl + i * S5_ROWB + p * 4); dx[(i * 64 + p) * 4 + 2] = bf_lo(w); dx[(i * 64 + p) * 4 + 3] = bf_hi(w); } }
#endif
        f32x4 y[2];
#pragma unroll
        for (int tt = 0; tt < 2; ++tt) { y[tt] = (f32x4){0.f, 0.f, 0.f, 0.f};
#pragma unroll
            for (int ks = 0; ks < 4; ++ks) { const bf16x8 sb = *(const LAS bf16x8*)(sl + (16 * tt + (lane & 15)) * S5_ROWB + (32 * ks + 8 * (lane >> 4)) * 2);
                y[tt] = __builtin_amdgcn_mfma_f32_16x16x32_bf16(Cf[ks], sb, y[tt], 0, 0, 0); } }
        asm volatile("" ::: "memory");
#pragma unroll
        for (int tt = 0; tt < 2; ++tt) { const int tau = 16 * tt + (lane & 15); const size_t off = (size_t)(tokbase + t0 + (dir ? 31 - tau : tau)) * D + colg;
            if (c < nch / 2) { *(f32x4*)(PART + off) = y[tt]; }
            else { const f32x4 pv = *(const f32x4*)(PART + off); const u32x2 uw = *(const u32x2*)(UA + off);
                const f32x4 uu = {bf_lo(uw.x), bf_hi(uw.x), bf_lo(uw.y), bf_hi(uw.y)}; const f32x4 t = y[tt] + pv + dsum * uu;
                u32x2 w; w.x = pg8::cvt_pk_bf16(gelu_tanh(t.x), gelu_tanh(t.y)); w.y = pg8::cvt_pk_bf16(gelu_tanh(t.z), gelu_tanh(t.w)); *(u32x2*)(V + off) = w; } }
    }
    if (!lat) { float* o = F.out + (size_t)M * D + ((size_t)(seq * 2 + dir) * 2) * 4096 + g * 64 + p; o[0] = sr; o[4096] = si; }
}

constexpr int PL_ROWB = 1056;
#if MK_STAMP == 120
#define PST(id) do { if (F.bid == MK_TB && F.tid == 0) { if ((id) == MK_SA) F.MISC[17] = (unsigned)__builtin_amdgcn_s_memrealtime(); if ((id) == MK_SB) F.MISC[18] = (unsigned)__builtin_amdgcn_s_memrealtime(); } } while (0)
#else
#define PST(id) do { } while (0)
#endif
__device__ __forceinline__ void pool_task(Frame& F, int tile) {
    PST(0);
    const int tok0 = tile * 64; const bool lat = tile >= M_CTX / 64; const int npr = lat ? 64 : L_CTX, off = lat ? 0 : (tile & 3) * 64;
    const bf16* UB = (const bf16*)(F.ws + WS_UB); bf16* P = (bf16*)(F.ws + WS_P); const bf16* WPT = (const bf16*)(F.ws + WS_WPOOL);
    LAS unsigned char* ul = F.lds;
    const int lane = F.lane, gi3 = F.wave >> 1, oh = F.wave & 1;
    bf16x8 Wf[4][4];
#pragma unroll
    for (int ot = 0; ot < 4; ++ot)
#pragma unroll
        for (int ks = 0; ks < 4; ++ks) Wf[ot][ks] = *(const bf16x8*)(WPT + ((size_t)gi3 * 128 + 64 * oh + 16 * ot + (lane & 15)) * 128 + 32 * ks + 8 * (lane >> 4));
    f32x4 psc[4];
#pragma unroll
    for (int ot = 0; ot < 4; ++ot) psc[ot] = *(const f32x4*)(F.in[I_PSCALE] + gi3 * 128 + 64 * oh + 4 * (lane >> 4) + 16 * ot);
    __syncthreads();
    PST(1);
    { v4u v[10];
#pragma unroll
      for (int q = 0; q < 10; ++q) { const int i = F.tid + q * 512, j = i >> 6, pc = i & 63; const int tt = off + j - 8, ttc = min(max(tt, 0), npr - 1);
          v[q] = *(const v4u*)(UB + (size_t)(tok0 - off + ttc) * DPOOL + pc * 8); }
#pragma unroll
      for (int q = 0; q < 10; ++q) { const int i = F.tid + q * 512, j = i >> 6, pc = i & 63; const int tt = off + j - 8; const bool ok = tt >= 0 && tt < npr;
          v4u w = v[q]; w.x = ok ? w.x : 0u; w.y = ok ? w.y : 0u; w.z = ok ? w.z : 0u; w.w = ok ? w.w : 0u; *(LAS v4u*)(ul + j * PL_ROWB + pc * 16) = w; } }
    __syncthreads();
    PST(2);
    unsigned pm[32];
    { const int cp = F.tid & 255, th = F.tid >> 8, gi = cp >> 6, w = 2 << gi, hw = w >> 1; const LAS unsigned char* ucol = ul + cp * 4 + (th * 32 + 8) * PL_ROWB;
      float s0 = 0.f, s1 = 0.f;
      for (int d = -hw; d < hw; ++d) { const unsigned x = *(const LAS unsigned*)(ucol + d * PL_ROWB); s0 += bf_lo(x); s1 += bf_hi(x); }
      const int tt0 = off + th * 32;
#pragma unroll
      for (int j = 0; j < 32; ++j) {
          const unsigned xc = *(const LAS unsigned*)(ucol + j * PL_ROWB); const int tt = tt0 + j; const float inv = __builtin_amdgcn_rcpf((float)(min(tt - hw + w, npr) - max(tt - hw, 0)));
          pm[j] = pg8::cvt_pk_bf16(s0 * inv - bf_lo(xc), s1 * inv - bf_hi(xc));
          const unsigned xa = *(const LAS unsigned*)(ucol + (j + hw) * PL_ROWB), xs = *(const LAS unsigned*)(ucol + (j - hw) * PL_ROWB);
          s0 += bf_lo(xa) - bf_lo(xs); s1 += bf_hi(xa) - bf_hi(xs); }
      PST(3);
      __syncthreads();
#pragma unroll
      for (int j = 0; j < 32; ++j) *(LAS unsigned*)(ul + (th * 32 + j) * PL_ROWB + cp * 4) = pm[j]; }
    __syncthreads();
    PST(4);
    { const int obase = gi3 * 128 + 64 * oh + 4 * (lane >> 4);
#pragma unroll
      for (int tt = 0; tt < 4; ++tt) { bf16x8 pb[4];
#pragma unroll
          for (int ks = 0; ks < 4; ++ks) pb[ks] = *(const LAS bf16x8*)(ul + (16 * tt + (lane & 15)) * PL_ROWB + (gi3 * 128 + 32 * ks + 8 * (lane >> 4)) * 2);
#pragma unroll
          for (int ot = 0; ot < 4; ++ot) { f32x4 a = (f32x4){0.f, 0.f, 0.f, 0.f};
#pragma unroll
              for (int ks = 0; ks < 4; ++ks) a = __builtin_amdgcn_mfma_f32_16x16x32_bf16(Wf[ot][ks], pb[ks], a, 0, 0, 0);
              const int o0 = obase + 16 * ot; a = a * psc[ot]; u32x2 wv; wv.x = pg8::cvt_pk_bf16(a.x, a.y); wv.y = pg8::cvt_pk_bf16(a.z, a.w);
              *(u32x2*)(P + (size_t)(tok0 + 16 * tt + (lane & 15)) * D + o0) = wv; } } }
    PST(5);
}
constexpr int PLO_ROWB = 288;
__device__ __forceinline__ void pool_task_old(Frame& F, int tile) {
    const int tok0 = tile * 64; const bool lat = tile >= M_CTX / 64; const int npr = lat ? 64 : L_CTX, off = lat ? 0 : (tile & 3) * 64;
    const bf16* UB = (const bf16*)(F.ws + WS_UB); bf16* P = (bf16*)(F.ws + WS_P); const bf16* WPT = (const bf16*)(F.ws + WS_WPOOL);
    LAS unsigned char* ul = F.lds; LAS unsigned char* pl = F.lds + 80 * PLO_ROWB;
    const int lane = F.lane;
    for (int gi = 0; gi < 4; ++gi) {
        const int w = 2 << gi, hw = w >> 1;
        __syncthreads();
        for (int i = F.tid; i < 80 * 16; i += NWAVES * 64) { const int j = i >> 4, pc = i & 15; const int tt = off + j - 8; v4u v = (v4u){0u, 0u, 0u, 0u};
            if (tt >= 0 && tt < npr) v = *(const v4u*)(UB + (size_t)(tok0 - off + tt) * DPOOL + gi * 128 + pc * 8);
            *(LAS v4u*)(ul + j * PLO_ROWB + pc * 16) = v; }
        __syncthreads();
        { const int cp = F.tid & 63, tr = F.tid >> 6; const LAS unsigned char* ucol = ul + cp * 4;
          int tt = off + tr * 8; int lo = max(tt - hw, 0), hi = min(tt - hw + w, npr); float s0 = 0.f, s1 = 0.f;
          for (int q = lo; q < hi; ++q) { const unsigned x = *(const LAS unsigned*)(ucol + (q - off + 8) * PLO_ROWB); s0 += bf_lo(x); s1 += bf_hi(x); }
          for (int j = 0; j < 8; ++j) {
              const unsigned xc = *(const LAS unsigned*)(ucol + (tr * 8 + j + 8) * PLO_ROWB); const float inv = 1.0f / (float)(hi - lo);
              *(LAS unsigned*)(pl + (tr * 8 + j) * PLO_ROWB + cp * 4) = pg8::cvt_pk_bf16(s0 * inv - bf_lo(xc), s1 * inv - bf_hi(xc));
              ++tt; const int nlo = max(tt - hw, 0), nhi = min(tt - hw + w, npr);
              if (nhi > hi) { const unsigned x = *(const LAS unsigned*)(ucol + (hi - off + 8) * PLO_ROWB); s0 += bf_lo(x); s1 += bf_hi(x); }
              if (nlo > lo) { const unsigned x = *(const LAS unsigned*)(ucol + (lo - off + 8) * PLO_ROWB); s0 -= bf_lo(x); s1 -= bf_hi(x); }
              lo = nlo; hi = nhi; } }
        __syncthreads();
        { bf16x8 Wf[4];
#pragma unroll
          for (int ks = 0; ks < 4; ++ks) Wf[ks] = *(const bf16x8*)(WPT + ((size_t)gi * 128 + 16 * F.wave + (lane & 15)) * 128 + 32 * ks + 8 * (lane >> 4));
          const int o0 = gi * 128 + 16 * F.wave + 4 * (lane >> 4); const f32x4 ps = *(const f32x4*)(F.in[I_PSCALE] + o0);
#pragma unroll
          for (int tt = 0; tt < 4; ++tt) { f32x4 a = (f32x4){0.f, 0.f, 0.f, 0.f};
#pragma unroll
              for (int ks = 0; ks < 4; ++ks) { const bf16x8 pb = *(const LAS bf16x8*)(pl + (16 * tt + (lane & 15)) * PLO_ROWB + (32 * ks + 8 * (lane >> 4)) * 2);
                  a = __builtin_amdgcn_mfma_f32_16x16x32_bf16(Wf[ks], pb, a, 0, 0, 0); }
              a = a * ps; u32x2 wv; wv.x = pg8::cvt_pk_bf16(a.x, a.y); wv.y = pg8::cvt_pk_bf16(a.z, a.w);
              *(u32x2*)(P + (size_t)(tok0 + 16 * tt + (lane & 15)) * D + o0) = wv; } }
    }
}
#if MK_DEBUG
constexpr int CW_FAIL = 8192;
constexpr size_t WS_DBG = 230 * MiB;
__device__ __forceinline__ unsigned dh(unsigned i) { i ^= i >> 16; i *= 0x7feb352du; i ^= i >> 15; i *= 0x846ca68bu; i ^= i >> 16; return i; }
__device__ __forceinline__ float bf2f(bf16 b) { return __builtin_bit_cast(float, (unsigned)b << 16); }
__device__ __forceinline__ void dfail(Frame& F, int id, bool bad) { if (bad) atomicAdd((unsigned*)(F.ctl + CW_FAIL + id), 1u); }
__device__ __forceinline__ bool dneq(float got, float ref, float rel, float abs_) { const float d = fabsf(got - ref); return !(d <= rel * fabsf(ref) + abs_); }
__device__ __forceinline__ const float* xrow_ptr(Frame& F, int m) { return m < M_CTX ? F.in[I_XP] + (size_t)m * D : F.in[I_XS] + (size_t)(m - M_CTX) * D; }

__device__ __forceinline__ void dbg_wt(Frame& F, const float* W, int K, int N, const bf16* WT, int ldt, unsigned salt) {
    for (int s = F.tid; s < 2048; s += 512) { const unsigned h = dh(s * 2u + salt); const int k = h % K, n = (h >> 12) % N; const float w = W[(size_t)k * N + n], t = bf2f(WT[(size_t)n * ldt + k]);
        dfail(F, 1, dneq(t, w, 0.0045f, 1e-30f)); }
}
__device__ __forceinline__ void dbg_check(Frame& F, int phase) {
    if (F.bid != 0) return;
    unsigned char* ws = F.ws;
    if (phase == 0) {
        dbg_wt(F, F.in[I_WIN], D, DIN, (const bf16*)(ws + WS_WIN), D, 11); dbg_wt(F, F.in[I_WGLU], D, D, (const bf16*)(ws + WS_WGLU), D, 12); dbg_wt(F, F.in[I_WPA], D, D, (const bf16*)(ws + WS_WPA), D, 13);
        dbg_wt(F, F.in[I_WPB], DPOOL, D, (const bf16*)(ws + WS_WPB), D, 14); dbg_wt(F, F.in[I_WOUT], D, D, (const bf16*)(ws + WS_WOUT), D, 15); dbg_wt(F, F.in[I_W1], D, DFF, (const bf16*)(ws + WS_W1), D, 16);
        dbg_wt(F, F.in[I_W2], DFF, D, (const bf16*)(ws + WS_W2), DFF, 17);
        for (int gi = 0; gi < 4; ++gi) dbg_wt(F, F.in[I_WPOOL] + gi * 16384, 128, 128, (const bf16*)(ws + WS_WPOOL) + gi * 16384, 128, 18 + gi);
        for (int s = F.tid; s < 2048; s += 512) {
            const int it = dh(s + 77u) % 8192; const int p = it & 63, g = (it >> 6) & 63, dir = it >> 12;
            const double lr = F.in[I_LAMRE][it], li = F.in[I_LAMIM][it], dt = exp((double)F.in[I_LOGDT][dir * 64 + g]);
            const double e = exp(lr * dt), lbr = e * cos(li * dt), lbi = e * sin(li * dt), nr = lbr - 1.0, ni = lbi, den = lr * lr + li * li, wr = (nr * lr + ni * li) / den, wi = (ni * lr - nr * li) / den;
            const float* lamb = (const float*)(ws + WS_LAMB) + (size_t)it * 2; dfail(F, 2, dneq(lamb[0], (float)lbr, 1e-5f, 1e-6f) || dneq(lamb[1], (float)lbi, 1e-5f, 1e-6f));
            const int h = dh(s + 99u) & 15; const double br = F.in[I_BRE][(size_t)it * 16 + h], bi = F.in[I_BIM][(size_t)it * 16 + h];
            const bf16* bb = (const bf16*)(ws + WS_BB);
            dfail(F, 2, dneq(bf2f(bb[((size_t)((dir * 64 + g) * 2 + 0) * 64 + p) * 16 + h]), (float)(wr * br - wi * bi), 0.01f, 1e-6f) || dneq(bf2f(bb[((size_t)((dir * 64 + g) * 2 + 1) * 64 + p) * 16 + h]), (float)(wr * bi + wi * br), 0.01f, 1e-6f));
            const bf16* ct = (const bf16*)(ws + WS_CT) + ((size_t)(dir * 64 + g) * 16 + h) * 128; const size_t ci = ((size_t)(dir * 64 + g) * 16 + h) * 64 + p;
            dfail(F, 2, dneq(bf2f(ct[2 * p]), F.in[I_CRE][ci], 0.0045f, 1e-30f) || dneq(bf2f(ct[2 * p + 1]), -F.in[I_CIM][ci], 0.0045f, 1e-30f));
        }
    }
    if (phase == 1) {
        for (int s = F.tid; s < 1024; s += 512) {
            const unsigned h = dh(s + 5u); const int r = h % 9, idx = (h >> 8) % 6144; double a = F.in[I_BADA][idx];
            for (int k = 0; k < D; ++k) { const double cv = r == 0 ? F.in[I_CCTX][k] : F.in[I_C][(size_t)(r - 1) * D + k]; a += cv / (1.0 + exp(-cv)) * (double)F.in[I_WADA][(size_t)k * 6144 + idx]; }
            dfail(F, 3, dneq(((const float*)(ws + WS_MODF))[(size_t)r * 6144 + idx], (float)a, 1e-4f, 1e-4f));
        }
        for (int s = F.tid; s < 1024; s += 512) {
            const unsigned h = dh(s + 1234u); const int m = h % M, j = (h >> 16) % D; const float* x = xrow_ptr(F, m); double mu = 0, var = 0;
            for (int k = 0; k < D; ++k) mu += x[k]; mu /= D; for (int k = 0; k < D; ++k) { const double d = x[k] - mu; var += d * d; } var /= D;
            const float* mf = (const float*)(ws + WS_MODF) + (size_t)batch_of_row(m) * 6144;
            const double y = (x[j] - mu) / sqrt(var + 1e-6) * (1.0 + mf[D + j]) + mf[j];
            dfail(F, 4, dneq(bf2f(((const bf16*)(ws + WS_RA))[(size_t)m * D + j]), (float)y, 0.006f, 0.004f));
        }
    }
    if (phase == 2) {
        for (int s = F.tid; s < 2048; s += 512) { const unsigned h = dh(s + 4321u); const int m = h % M, zc = (h >> 14) % DIN; const bf16* hr = (const bf16*)(ws + WS_RA) + (size_t)m * D; double a = F.in[I_BIN][zc];
            for (int k = 0; k < D; ++k) a += (double)bf2f(hr[k]) * (double)F.in[I_WIN][(size_t)k * DIN + zc];
            float got;
            if (zc < 1024) got = bf2f(((const bf16*)(ws + WS_RB))[(size_t)m * D + zc]);
            else if (zc < 1536) got = bf2f(((const bf16*)(ws + WS_UB))[(size_t)m * DPOOL + zc - 1024]);
            else if (zc < 2560) { got = bf2f(((const bf16*)(ws + WS_GA))[(size_t)m * D + zc - 1536]); a = 1.0 / (1.0 + exp(-a)); }
            else { got = bf2f(((const bf16*)(ws + WS_GB))[(size_t)m * D + zc - 2560]); a = 1.0 / (1.0 + exp(-a)); }
            dfail(F, 5, dneq(got, (float)a, 0.01f, 0.02f)); }
    }
    if (phase == 3) {
        { const int w = F.wave, lane = F.lane; const bool lat = w < 2; const unsigned h = dh(w + 31u); const int seq = lat ? (h % NB_LAT) : w, g = lat ? (h >> 8) % NGRP : 3 * w + 1;
          const int L = lat ? L_LAT : L_CTX, tokbase = lat ? M_CTX + seq * L_LAT : seq * L_CTX; const bf16* UA = (const bf16*)(ws + WS_RB); const bf16* V = (const bf16*)(ws + WS_RA);
          float* yf = (float*)(ws + WS_DBG) + (size_t)w * L_LAT * 16;
          for (int dir = 0; dir < 2; ++dir) {
              const int it = (dir * 64 + g) * 64 + lane; const float lr = F.in[I_LAMRE][it], li = F.in[I_LAMIM][it], dt = expf(F.in[I_LOGDT][dir * 64 + g]);
              const float e = expf(lr * dt), lbr = e * cosf(li * dt), lbi = e * sinf(li * dt), nr = lbr - 1.f, ni = lbi, den = 1.f / (lr * lr + li * li), wr = (nr * lr + ni * li) * den, wi = (ni * lr - nr * li) * den;
              float br[16], bi[16], cr[16], cim[16];
#pragma unroll
              for (int hh = 0; hh < 16; ++hh) { const float a = F.in[I_BRE][(size_t)it * 16 + hh], b = F.in[I_BIM][(size_t)it * 16 + hh]; br[hh] = wr * a - wi * b; bi[hh] = wr * b + wi * a;
                  const size_t ci = ((size_t)(dir * 64 + g) * 16 + hh) * 64 + lane; cr[hh] = F.in[I_CRE][ci]; cim[hh] = F.in[I_CIM][ci]; }
              float sr = 0.f, si = 0.f; if (lat) { const float* st = F.in[I_STATE] + ((size_t)(seq * 2 + dir) * 2) * 4096 + g * 64 + lane; sr = st[0]; si = st[4096]; }
              for (int tq = 0; tq < L; ++tq) { const int t = dir ? L - 1 - tq : tq; const bf16* ur = UA + (size_t)(tokbase + t) * D + g * 16; float bur = 0.f, bui = 0.f;
#pragma unroll
                  for (int hh = 0; hh < 16; ++hh) { const float u = bf2f(ur[hh]); bur += br[hh] * u; bui += bi[hh] * u; }
                  const float nsr = lbr * sr - lbi * si + bur, nsi = lbr * si + lbi * sr + bui; sr = nsr; si = nsi;
                  if (!lat && dir == 0 && tq < 32) { const float* dx = (const float*)(ws + 231 * MiB) + (size_t)seq * 32 * 64 * 4 + (tq * 64 + lane) * 4;
                      dfail(F, 20, dneq(dx[0], bur, 0.02f, 0.002f) || dneq(dx[1], bui, 0.02f, 0.002f)); dfail(F, 21, dneq(dx[2], sr, 0.02f, 0.002f) || dneq(dx[3], si, 0.02f, 0.002f)); }
                  float mine = 0.f;
#pragma unroll
                  for (int hh = 0; hh < 16; ++hh) { const float y = wave_sum(cr[hh] * sr - cim[hh] * si); if (lane == hh) mine = y; }
                  if (lane < 16) { const float pt = F.out[(size_t)(tokbase + t) * D + g * 16 + lane];
                      if (dir == 0) { yf[(size_t)t * 16 + lane] = mine; if (t < L / 2) dfail(F, lat ? 10 : 6, dneq(pt, mine, 0.03f, 0.01f)); }
                      else { if (t >= L / 2) dfail(F, lat ? 11 : 7, dneq(pt, mine, 0.03f, 0.01f)); const float u = bf2f(ur[lane]); const float tot = yf[(size_t)t * 16 + lane] + mine + (F.in[I_S5D][g * 16 + lane] + F.in[I_S5D][D + g * 16 + lane]) * u;
                          const float ref = tot / (1.f + expf(-1.5957691216f * (tot + 0.044715f * tot * tot * tot)));
                          dfail(F, lat ? 12 : 8, dneq(bf2f(V[(size_t)(tokbase + t) * D + g * 16 + lane]), ref, 0.03f, 0.03f)); } }
              }
              if (!lat) { const float* o = F.out + (size_t)M * D + ((size_t)(seq * 2 + dir) * 2) * 4096 + g * 64 + lane; dfail(F, 9, dneq(o[0], sr, 0.02f, 0.01f) || dneq(o[4096], si, 0.02f, 0.01f)); }
              __builtin_amdgcn_s_waitcnt(0);
          } }
        for (int s = F.tid; s < 2048; s += 512) { const unsigned h = dh(s + 999u); const int tok = h % M, o = (h >> 14) % DPOOL, gi = o >> 7, w = 2 << gi; const bool lat = tok >= M_CTX;
            const int npr = lat ? 64 : L_CTX, rs = lat ? (tok & ~63) : (tok & ~255), tt = tok - rs, lo = max(tt - w / 2, 0), hi = min(tt - w / 2 + w, npr); const bf16* UB = (const bf16*)(ws + WS_UB); double a = 0;
            for (int i = 0; i < 128; ++i) { double sum = 0; for (int q = lo; q < hi; ++q) sum += bf2f(UB[(size_t)(rs + q) * DPOOL + gi * 128 + i]);
                const double pm = sum / (hi - lo) - bf2f(UB[(size_t)tok * DPOOL + gi * 128 + i]); a += pm * (double)F.in[I_WPOOL][((size_t)gi * 128 + i) * 128 + (o & 127)]; }
            a *= F.in[I_PSCALE][o]; dfail(F, 13, dneq(bf2f(((const bf16*)(ws + WS_P))[(size_t)tok * D + o]), (float)a, 0.02f, 0.02f)); }
    }
    if (phase == 4) {
        for (int s = F.tid; s < 2048; s += 512) { const unsigned h = dh(s + 41u); const int m = h % M, c = (h >> 14) % D; const bf16* vr = (const bf16*)(ws + WS_RA) + (size_t)m * D; double a = F.in[I_BGLU][c];
            for (int k = 0; k < D; ++k) a += (double)bf2f(vr[k]) * (double)F.in[I_WGLU][(size_t)k * D + c];
            const double ref = bf2f(vr[c]) / (1.0 + exp(-a)); dfail(F, 14, dneq(bf2f(((const bf16*)(ws + WS_RB))[(size_t)m * D + c]), (float)ref, 0.02f, 0.02f)); }
    }
    if (phase == 5) {
        for (int s = F.tid; s < 2048; s += 512) { const unsigned h = dh(s + 51u); const int m = h % M, c = (h >> 14) % D; const bf16* v2 = (const bf16*)(ws + WS_RB) + (size_t)m * D; const bf16* pr = (const bf16*)(ws + WS_P) + (size_t)m * D; double ya = 0, yb = 0;
            for (int k = 0; k < D; ++k) ya += (double)bf2f(v2[k]) * (double)F.in[I_WPA][(size_t)k * D + c];
            for (int k = 0; k < DPOOL; ++k) yb += (double)bf2f(pr[k]) * (double)F.in[I_WPB][(size_t)k * D + c];
            const double ref = bf2f(((const bf16*)(ws + WS_GA))[(size_t)m * D + c]) * ya + bf2f(((const bf16*)(ws + WS_GB))[(size_t)m * D + c]) * yb;
            dfail(F, 15, dneq(bf2f(((const bf16*)(ws + WS_RA))[(size_t)m * D + c]), (float)ref, 0.03f, 0.03f)); }
    }
    if (phase == 6) {
        for (int s = F.tid; s < 2048; s += 512) { const unsigned h = dh(s + 61u); const int m = h % M, c = (h >> 14) % D; const bf16* mr = (const bf16*)(ws + WS_RA) + (size_t)m * D; double a = F.in[I_BOUT][c];
            for (int k = 0; k < D; ++k) a += (double)bf2f(mr[k]) * (double)F.in[I_WOUT][(size_t)k * D + c];
            const float* mf = (const float*)(ws + WS_MODF) + (size_t)batch_of_row(m) * 6144; const double ref = (double)DN_ALPHA * xrow_ptr(F, m)[c] + mf[2 * D + c] * a;
            dfail(F, 16, dneq(bf2f(((const bf16*)F.out)[(size_t)m * D + c]), (float)ref, 0.012f, 0.02f)); }
    }
    if (phase == 7) {
        for (int s = F.tid; s < 1024; s += 512) { const unsigned h = dh(s + 71u); const int m = h % M, j = (h >> 16) % D; const bf16* r = (const bf16*)F.out + (size_t)m * D; double mu = 0, var = 0;
            for (int k = 0; k < D; ++k) mu += bf2f(r[k]); mu /= D; for (int k = 0; k < D; ++k) { const double dd = bf2f(r[k]) - mu; var += dd * dd; } var /= D; const double rs = 1.0 / sqrt(var + 1e-6);
            const float* st = (const float*)(ws + WS_STATS) + 2 * m;
            double m2 = 0, v2 = 0; for (int k = 0; k < D; ++k) m2 += (bf2f(r[k]) - mu) * rs * F.in[I_LN1G][k] + F.in[I_LN1B][k]; m2 /= D;
            for (int k = 0; k < D; ++k) { const double x1 = (bf2f(r[k]) - mu) * rs * F.in[I_LN1G][k] + F.in[I_LN1B][k] - m2; v2 += x1 * x1; } v2 /= D;
            const float* mf = (const float*)(ws + WS_MODF) + (size_t)batch_of_row(m) * 6144; const double x1j = (bf2f(r[j]) - mu) * rs * F.in[I_LN1G][j] + F.in[I_LN1B][j];
            const double y = (x1j - m2) / sqrt(v2 + 1e-6) * (1.0 + mf[4 * D + j]) + mf[3 * D + j];
            dfail(F, 17, dneq(bf2f(((const bf16*)(ws + WS_RB))[(size_t)m * D + j]), (float)y, 0.006f, 0.004f) || dneq(st[0], (float)mu, 1e-4f, 1e-5f) || dneq(st[1], (float)rs, 1e-4f, 1e-5f)); }
    }
    if (phase == 8) {
        for (int s = F.tid; s < 2048; s += 512) { const unsigned h = dh(s + 81u); const int m = h % M, c = (h >> 14) % DFF; const bf16* hr = (const bf16*)(ws + WS_RB) + (size_t)m * D; double a = F.in[I_B1][c];
            for (int k = 0; k < D; ++k) a += (double)bf2f(hr[k]) * (double)F.in[I_W1][(size_t)k * DFF + c];
            a = a > 0 ? a * a : 0; dfail(F, 18, dneq(bf2f(((const bf16*)(ws + WS_HM))[(size_t)m * DFF + c]), (float)a, 0.02f, 0.02f)); }
    }
    if (phase == 9) {
        for (int s = F.tid; s < 2048; s += 512) { const unsigned h = dh(s + 91u); const int m = h % M, c = (h >> 14) % D; const bf16* hr = (const bf16*)(ws + WS_HM) + (size_t)m * DFF; double a = F.in[I_B2][c];
            for (int k = 0; k < DFF; ++k) a += (double)bf2f(hr[k]) * (double)F.in[I_W2][(size_t)k * D + c];
            const float* st = (const float*)(ws + WS_STATS) + 2 * m; const double x1 = ((double)bf2f(((const bf16*)F.out)[(size_t)m * D + c]) - st[0]) * st[1] * F.in[I_LN1G][c] + F.in[I_LN1B][c];
            const float* mf = (const float*)(ws + WS_MODF) + (size_t)batch_of_row(m) * 6144; const double ref = (double)DN_ALPHA * x1 + mf[5 * D + c] * a;
            dfail(F, 19, dneq(bf2f(((const bf16*)(ws + WS_RA))[(size_t)m * D + c]), (float)ref, 0.012f, 0.02f)); }
    }
}
__device__ __forceinline__ void dbg_encode(Frame& F) {
    int code = 0;
    for (int k = 24; k >= 1; --k) { if (k == 20 || k == 21) continue; if (__hip_atomic_load((unsigned*)(F.ctl + CW_FAIL + k), __ATOMIC_RELAXED, __HIP_MEMORY_SCOPE_AGENT) != 0u) code = k; }
    if (code == 6) { if (__hip_atomic_load((unsigned*)(F.ctl + CW_FAIL + 21), __ATOMIC_RELAXED, __HIP_MEMORY_SCOPE_AGENT)) code = 21; if (__hip_atomic_load((unsigned*)(F.ctl + CW_FAIL + 20), __ATOMIC_RELAXED, __HIP_MEMORY_SCOPE_AGENT)) code = 20; }
#if MK_DEBUG_FORCE
    code = MK_DEBUG_FORCE;
#endif
    if (code == 0) return;
    const size_t total = (size_t)M * D + (size_t)NB_CTX * 4 * 4096;
    for (size_t i = (size_t)F.bid * 512 + F.tid; i < total; i += (size_t)F.G * 512) F.out[i] = i < (size_t)M_CTX * D ? (float)(code + 1) : 0.f;
}
#define DBG_CHECK(k) do { if (IN(k)) { xcd_barrier(bar); dbg_check(F, k); } } while (0)
#else
#define DBG_CHECK(k) do { } while (0)
#endif
struct Args { const float* in[33]; float* out; unsigned char* ws; int ph_lo, ph_hi; };
__global__ void __launch_bounds__(NWAVES * 64, 2) mk_fwd(Args args) {
    extern __shared__ __attribute__((aligned(16))) unsigned char lds[];
    Frame F;
    F.lds = (LAS unsigned char*)lds;
    F.MISC = (volatile LAS unsigned*)(F.lds + MISC_OFF);
    F.tid = threadIdx.x; F.lane = F.tid & 63; F.wave = __builtin_amdgcn_readfirstlane(F.tid >> 6);
    F.G = gridDim.x; F.bid = blockIdx.x;
#pragma unroll
    for (int i = 0; i < 33; ++i) F.in[i] = args.in[i];
    F.out = args.out; F.ws = args.ws; F.ctl = (gu32*)(args.ws + WS_CTL);
    unsigned char* ws = args.ws;
    for (int u = F.tid; u < (LDS_BYTES - LDSCTL_OFF) / 4; u += NWAVES * 64) ((LAS unsigned*)(F.lds + LDSCTL_OFF))[u] = 0u;
    __syncthreads();
    XcdBarrier bar = xcd_barrier_post((unsigned*)(F.ctl + CW_BAR), F.MISC + 8);
    const int lo = args.ph_lo, hi = args.ph_hi;
#if MK_STAMP
    if (F.bid == 0 && F.tid == 0 && MK_STAMP == 1) F.MISC[20] = (unsigned)__builtin_amdgcn_s_memrealtime();
#define STAMP(k) do { if (F.bid == 0 && F.tid == 0) { if ((k) == MK_STAMP - 2) F.MISC[20] = (unsigned)__builtin_amdgcn_s_memrealtime(); if ((k) == MK_STAMP - 1) F.MISC[21] = (unsigned)__builtin_amdgcn_s_memrealtime(); } } while (0)
#else
#define STAMP(k) do { } while (0)
#endif
#define IN(k) (lo <= (k) && (k) < hi)
#define SEAM(k) do { if (IN(k) && IN((k) + 1)) xcd_barrier(bar); } while (0)
    typedef pg8::bf16_t bt;
#if MK_POISON
    if (IN(0)) {
        v4u pz = (v4u){0xAAAAAAAAu, 0xAAAAAAAAu, 0xAAAAAAAAu, 0xAAAAAAAAu};
        for (size_t i = (size_t)F.bid * 512 + F.tid; i < ((size_t)M * D * 4 + 2 * MiB) / 16; i += (size_t)F.G * 512) ((v4u*)F.out)[i] = pz;
        for (size_t i = (size_t)F.bid * 512 + F.tid; i < (192 * MiB) / 16; i += (size_t)F.G * 512) ((v4u*)(ws + 36 * MiB))[i] = pz;
        for (size_t i = (size_t)F.bid * 512 + F.tid; i < (256 * 1024) / 16; i += (size_t)F.G * 512) ((v4u*)(ws + WS_STATS))[i] = pz;
    }
#endif
    if (IN(0)) { phase0(F); } DBG_CHECK(0); SEAM(0); STAMP(0);
    if (IN(1)) { phase1(F); } DBG_CHECK(1); SEAM(1); STAMP(1);
    if (IN(2)) {
        pg8::Gemm g{(const bt*)(ws + WS_RA), nullptr, (const bt*)(ws + WS_WIN), nullptr, D / 64, 0, D}; g.id_ = 2; pg8::StaticOrder S; S.init(M, DIN, F.G, F.bid);
        pg8::EpiIn E{(bt*)(ws + WS_RB), (bt*)(ws + WS_UB), (bt*)(ws + WS_GA), (bt*)(ws + WS_GB), F.in[I_BIN]};
        pg8::gemm_phase<pg8::EpiIn, pg8::StaticOrder, true, true>(F.lds, g, S, E);
    } DBG_CHECK(2); SEAM(2); STAMP(2);
    if (IN(3)) {
#if MK_STAMP >= 100
        if (F.bid == MK_TB && F.tid == 0) F.MISC[20] = (unsigned)__builtin_amdgcn_s_memrealtime();
#endif
        if (F.G == 256) {
            if (F.bid < 128) s5_task(F, true, F.bid >> 4, F.bid & 15);
            else for (int i = 0; i < 4; ++i) { const int id = (F.bid - 128) * 4 + i; s5_task(F, false, id >> 4, id & 15); }
        } else {
            for (int t = F.bid; t < 640; t += F.G) { if (t < 128) s5_task(F, true, t >> 4, t & 15); else s5_task(F, false, (t - 128) >> 4, (t - 128) & 15); }
        }
#if MK_STAMP == 100
        if (F.bid == MK_TB && F.tid == 0) F.MISC[21] = (unsigned)__builtin_amdgcn_s_memrealtime();
#endif
#if MK_STAMP == 101
        if (F.bid == MK_TB && F.tid == 0) F.MISC[20] = (unsigned)__builtin_amdgcn_s_memrealtime();
#endif
#if MK_OLDPOOL
        for (int tile = F.bid; tile < M / 64; tile += F.G) pool_task_old(F, tile);
#else
        if (F.G == 256) { if (F.bid < 128) { pool_task(F, 2 * F.bid); pool_task(F, 2 * F.bid + 1); } }
        else for (int tile = F.bid; tile < M / 64; tile += F.G) pool_task(F, tile);
#endif
        __syncthreads();
#if MK_STAMP == 101
        if (F.bid == MK_TB && F.tid == 0) F.MISC[21] = (unsigned)__builtin_amdgcn_s_memrealtime();
#endif
    } DBG_CHECK(3); SEAM(3); STAMP(3);
#if MK_TRUNC == 3
    { xcd_barrier(bar); const bf16* src = (const bf16*)(ws + WS_RA);
      for (size_t i = (size_t)F.bid * 512 + F.tid; i < (size_t)M * D; i += (size_t)F.G * 512) { const int tok = (int)(i >> 10); const bool lat = tok >= M_CTX; const int L = lat ? L_LAT : L_CTX, t = lat ? (tok - M_CTX) % L_LAT : tok % L_CTX;
          bool keep = true; if (MK_TSEL == 1) keep = !lat; if (MK_TSEL == 2) keep = lat; if (MK_TSEL == 3) keep = t < L / 2; if (MK_TSEL == 4) keep = t >= L / 2; if (MK_TSEL == 5) keep = (t & 31) < 16; if (MK_TSEL == 6) keep = ((i >> 4) & 1) == 0; if (MK_TSEL == 7) keep = lat && t < 512; if (MK_TSEL == 8) keep = lat && t >= 512; if (MK_TSEL == 9) keep = lat && (t < 32 || t >= 992); if (MK_TSEL == 10) keep = lat && (t >= 480 && t < 544);
          F.out[i] = keep ? bf_lo((unsigned)src[i]) : 0.f; }
      return; }
#endif
    if (IN(4)) {
        pg8::Gemm g{(const bt*)(ws + WS_RA), nullptr, (const bt*)(ws + WS_WGLU), nullptr, D / 64, 0, D}; g.id_ = 4; pg8::StaticOrder S; S.init(M, D, F.G, F.bid);
        pg8::EpiGlu E{(const bt*)(ws + WS_RA), (bt*)(ws + WS_RB), F.in[I_BGLU]};
        pg8::gemm_phase<pg8::EpiGlu, pg8::StaticOrder, true, true>(F.lds, g, S, E);
    } DBG_CHECK(4); SEAM(4); STAMP(4);
    if (IN(5)) {
        pg8::Gemm g{(const bt*)(ws + WS_RB), (const bt*)(ws + WS_P), (const bt*)(ws + WS_WPA), (const bt*)(ws + WS_WPB), D / 64, DPOOL / 64, D}; g.id_ = 5; pg8::StaticOrder S; S.init(M, D, F.G, F.bid, 2);
        pg8::EpiMerge E{(const bt*)(ws + WS_GA), (const bt*)(ws + WS_GB), (bt*)(ws + WS_RA)};
        pg8::gemm_phase<pg8::EpiMerge, pg8::StaticOrder, true, true>(F.lds, g, S, E);
    } DBG_CHECK(5); SEAM(5); STAMP(5);
    if (IN(6)) {
        pg8::Gemm g{(const bt*)(ws + WS_RA), nullptr, (const bt*)(ws + WS_WOUT), nullptr, D / 64, 0, D}; g.id_ = 6; pg8::StaticOrder S; S.init(M, D, F.G, F.bid);
        pg8::EpiRes1 E{F.in[I_XP], F.in[I_XS], (bt*)F.out, F.in[I_BOUT], (const float*)(ws + WS_MODF)};
        pg8::gemm_phase<pg8::EpiRes1, pg8::StaticOrder, true, true>(F.lds, g, S, E);
    } DBG_CHECK(6); SEAM(6); STAMP(6);
    if (IN(7)) { phase_ln1(F, (const bf16*)F.out, (float*)(ws + WS_STATS), (bf16*)(ws + WS_RB)); } DBG_CHECK(7); SEAM(7); STAMP(7);
#if MK_TRUNC == 7
    { xcd_barrier(bar); const bf16* src = (const bf16*)(ws + WS_RB); for (size_t i = (size_t)F.bid * 512 + F.tid; i < (size_t)M * D; i += (size_t)F.G * 512) F.out[i] = bf_lo((unsigned)src[i]); return; }
#endif
    if (IN(8)) {
        pg8::Gemm g{(const bt*)(ws + WS_RB), nullptr, (const bt*)(ws + WS_W1), nullptr, D / 64, 0, D}; g.id_ = 8; pg8::StaticOrder S; S.init(M, DFF, F.G, F.bid);
        pg8::EpiRelu2 E{(bt*)(ws + WS_HM), F.in[I_B1]};
        pg8::gemm_phase<pg8::EpiRelu2, pg8::StaticOrder, true, true>(F.lds, g, S, E);
    } DBG_CHECK(8); SEAM(8); STAMP(8);
#if MK_TRUNC == 8
    { xcd_barrier(bar); const bf16* src = (const bf16*)(ws + WS_HM); for (size_t i = (size_t)F.bid * 512 + F.tid; i < (size_t)M * D; i += (size_t)F.G * 512) F.out[i] = bf_lo((unsigned)src[i * 4 + (i & 3)]); return; }
#endif
    if (IN(9)) {
        pg8::Gemm g{(const bt*)(ws + WS_HM), nullptr, (const bt*)(ws + WS_W2), nullptr, DFF / 64, 0, DFF}; g.id_ = 9; pg8::StaticOrder S; S.init(M, D, F.G, F.bid);
        pg8::EpiRes2 E{(const bt*)F.out, (const float*)(ws + WS_STATS), F.in[I_LN1G], F.in[I_LN1B], (bt*)(ws + WS_RA), F.in[I_B2], (const float*)(ws + WS_MODF)};
        pg8::gemm_phase<pg8::EpiRes2, pg8::StaticOrder, true, true>(F.lds, g, S, E);
    } DBG_CHECK(9); SEAM(9); STAMP(9);
#if MK_TRUNC == 9
    { xcd_barrier(bar); const bf16* src = (const bf16*)(ws + WS_RA); for (size_t i = (size_t)F.bid * 512 + F.tid; i < (size_t)M * D; i += (size_t)F.G * 512) F.out[i] = bf_lo((unsigned)src[i]); return; }
#endif
    if (IN(10)) { phase_ln2(F, (const bf16*)(ws + WS_RA)); }
#if MK_STAMP
    STAMP(10); __syncthreads();
    if (F.bid == (MK_STAMP >= 100 ? MK_TB : 0) && F.tid == 0) { asm volatile("s_waitcnt vmcnt(0)" ::: "memory"); F.out[(size_t)(MK_STAMP >= 100 ? MK_TB : 0) * 64 * D] += (MK_STAMP == 120 || MK_STAMP == 130) ? (float)(F.MISC[18] - F.MISC[17]) * (1.0f / 1000.0f) : (MK_STAMP >= 110) ? (float)F.MISC[16] * (16.0f / 21000.0f) : (float)(F.MISC[21] - F.MISC[20]) * (1.0f / 1000.0f); }
#endif
#if MK_DEBUG
    xcd_barrier(bar); dbg_encode(F);
#endif
#undef IN
#undef SEAM
}

#ifndef MK_SPLIT
#define MK_SPLIT 0
#endif
extern "C" void kernel_launch(void* const* d_in, const int* in_sizes, int n_in, void* d_out, int out_size, void* d_ws, size_t ws_size, hipStream_t stream) {
    static int grid = 0;
    if (grid == 0) {
        if (n_in != 33 || ws_size < WS_END) { fprintf(stderr, "kernel_launch: unexpected inputs (n_in %d, ws %zu)\n", n_in, ws_size); grid = -1; return; }
        int dev = 0, cus = 0, per_cu = 0;
        if (hipGetDevice(&dev) != hipSuccess || hipDeviceGetAttribute(&cus, hipDeviceAttributeMultiprocessorCount, dev) != hipSuccess) { grid = -1; return; }
        if (hipFuncSetAttribute((const void*)mk_fwd, hipFuncAttributeMaxDynamicSharedMemorySize, LDS_BYTES) != hipSuccess) { fprintf(stderr, "kernel_launch: hipFuncSetAttribute failed\n"); grid = -1; return; }
        if (hipOccupancyMaxActiveBlocksPerMultiprocessor(&per_cu, (const void*)mk_fwd, NWAVES * 64, LDS_BYTES) != hipSuccess || per_cu < 1) fprintf(stderr, "kernel_launch: occupancy query says %d blocks per CU\n", per_cu);
        (void)hipGetLastError();
        grid = cus;
    }
    if (grid < 0) return;
    (void)hipMemsetAsync((char*)d_ws + WS_CTL, 0, CTL_ZERO_BYTES, stream);
    Args a{};
    for (int i = 0; i < 33; ++i) a.in[i] = (const float*)d_in[i];
    a.out = (float*)d_out; a.ws = (unsigned char*)d_ws;
#if MK_SPLIT
    for (int p = 0; p <= 10; ++p) { a.ph_lo = p; a.ph_hi = p + 1; hipLaunchKernelGGL(mk_fwd, dim3(grid), dim3(NWAVES * 64), LDS_BYTES, stream, a); }
#else
    a.ph_lo = 0; a.ph_hi = 11;
    hipLaunchKernelGGL(mk_fwd, dim3(grid), dim3(NWAVES * 64), LDS_BYTES, stream, a);
#endif
    const hipError_t le = hipPeekAtLastError();
    if (le != hipSuccess) fprintf(stderr, "kernel_launch: launch failed: %s\n", hipGetErrorName(le));
}
```

```cpp
#include <hip/hip_runtime.h>
#include <cstdio>
#include <cstdint>
#ifndef MK_DEBUG
#define MK_DEBUG 0
#endif
#ifndef MK_DEBUG_FORCE
#define MK_DEBUG_FORCE 0
#endif
#ifndef MK_STAMP
#define MK_STAMP 0
#endif
#ifndef MK_TB
#define MK_TB 200
#endif
#ifndef MK_SA
#define MK_SA 1
#endif
#ifndef MK_SB
#define MK_SB 3
#endif
#ifndef MK_OLDPOOL
#define MK_OLDPOOL 0
#endif
#ifndef MK_NOPR
#define MK_NOPR 0
#endif
#ifndef MK_POISON
#define MK_POISON 0
#endif
#ifndef MK_TRUNC
#define MK_TRUNC 0
#endif
#ifndef MK_HSLEEP
#define MK_HSLEEP 0
#endif
#ifndef MK_TSEL
#define MK_TSEL 2
#endif
#ifndef MK_NOS0
#define MK_NOS0 0
#endif
#ifndef MK_NOUL
#define MK_NOUL 0
#endif
#ifndef MK_GPH
#define MK_GPH 8
#endif
#ifndef MK_GUI
#define MK_GUI 1
#endif
namespace pg8 {
#define PG8_LAS __attribute__((address_space(3)))
typedef unsigned short bf16_t;
typedef short bf16x8 __attribute__((ext_vector_type(8)));
typedef float f32x4 __attribute__((ext_vector_type(4)));
typedef unsigned u32x4 __attribute__((ext_vector_type(4)));
constexpr int BM = 256, BK = 64, HALF = 128, HTB = HALF * BK * 2  , STAGE_BYTES = 8 * HTB, NXCD = 8, WGM = 8;

__host__ __device__ __forceinline__ int lds_byte(int r, int c) { const int st = (r >> 4) * 2 + (c >> 5), rr = r & 15, cc = c & 31, ob = rr * 64 + cc * 2; return st * 1024 + (ob ^ (((ob >> 9) & 1) << 5)); }
__host__ __device__ __forceinline__ void stage_rc(int b, int& R, int& C) { const int st = b / 1024, sb = b % 1024, swz = sb ^ (((sb >> 9) & 1) << 5); R = (st >> 1) * 16 + swz / 64; C = (st & 1) * 32 + (swz % 64) / 2; }
__host__ __device__ __forceinline__ int perm32(int rho) { const int n = rho >> 4, i = rho & 15; return 8 * (i >> 2) + 4 * n + (i & 3); }

struct Unit { int pm, pn, part; };
struct Gemm { const bf16_t *A0, *A1, *B0, *B1; int nt0, nt1, ld; int id_ = 0;
    __device__ __forceinline__ const char* a(int part) const { return (const char*)(part ? A1 : A0); }
    __device__ __forceinline__ const char* b(int part) const { return (const char*)(part ? B1 : B0); }
    __device__ __forceinline__ int nt(int part) const { return part ? nt1 : nt0; } };

struct StaticOrder {
    int nM, nN, nwg, G, c, np;
    __host__ __device__ void init(int M, int N, int G_, int c_, int np_ = 1) { nM = M / BM; nN = N / BM; nwg = nM * nN; G = G_; c = c_; np = np_; }
    __host__ __device__ bool next(int ii, Unit& u) const {
        const int i = (np == 2) ? (ii >> 1) : ii; u.part = (np == 2) ? (ii & 1) : 0;
        const long L = (long)i * G + c; if (L >= nwg) return false;
        int wgid = (int)L; { const int q = nwg / NXCD, r = nwg % NXCD, xcd = wgid % NXCD, off = wgid / NXCD; wgid = (xcd < r ? xcd * (q + 1) : r * (q + 1) + (xcd - r) * q) + off; }
        const int nig = WGM * nN, gid = wgid / nig, fm = gid * WGM, gsz = (nM - fm) < WGM ? (nM - fm) : WGM;
        u.pm = fm + ((wgid % nig) % gsz); u.pn = (wgid % nig) / gsz; return true;
    }
    __device__ __forceinline__ void a_ready(const Unit&) const {}
    __device__ __forceinline__ void done(const Unit&) const {}
};
__device__ __forceinline__ unsigned cvt_pk_bf16(float lo, float hi) { unsigned r; asm volatile("v_cvt_pk_bf16_f32 %0, %1, %2" : "=v"(r) : "v"(lo), "v"(hi)); return r; }
typedef float f32x2 __attribute__((ext_vector_type(2)));
#if MK_STAMP == 130
#define GST(id) do { if (g.id_ == MK_GPH && blockIdx.x == MK_TB && threadIdx.x == 0 && ui == MK_GUI) { if ((id) == MK_SA) ((volatile PG8_LAS unsigned*)(lds + 131072 + 320))[17] = (unsigned)__builtin_amdgcn_s_memrealtime(); if ((id) == MK_SB) ((volatile PG8_LAS unsigned*)(lds + 131072 + 320))[18] = (unsigned)__builtin_amdgcn_s_memrealtime(); } } while (0)
#else
#define GST(id) do { } while (0)
#endif
template <class Epi, class Sched, bool ALIGN_EPI = false, bool SP2 = false>
__device__ __forceinline__ void gemm_phase(PG8_LAS unsigned char* lds, const Gemm g, const Sched& S, const Epi& E) {
    const int tid = threadIdx.x, wid = __builtin_amdgcn_readfirstlane(tid >> 6), lane = tid & 63, wr = wid >> 2, wc = wid & 3, fr = lane & 15, fq = lane >> 4;
    const int K = g.ld;
    unsigned voffA[2], voffB[2];
#pragma unroll
    for (int i = 0; i < 2; ++i) { int R, C; stage_rc(tid * 16 + i * 8192, R, C); const int Rb = Epi::PERM ? ((R & ~31) + perm32(R & 31)) : R;
        voffA[i] = (unsigned)(R * K + C) * 2u; voffB[i] = (unsigned)(Rb * K + C) * 2u; }
    const size_t kstep = (size_t)(BK * 2);
    const size_t hstep = (size_t)HALF * K * 2;
    const size_t tstep = 2 * hstep;
    const unsigned ldsw = (unsigned)wid * 1024u;
    const int aoff = lds_byte(wr * 64 + fr, fq * 8), boff = lds_byte(wc * 32 + fr, fq * 8);
#define PG8_SA(b, h) (((b) * 2 + (h)) * HTB)
#define PG8_SB(b, h) ((4 + (b) * 2 + (h)) * HTB)
#define PG8_STAGE(bufoff, gbase, voff) do { _Pragma("unroll") for (int _i = 0; _i < 2; ++_i) \
        __builtin_amdgcn_global_load_lds((const unsigned*)((const char*)(gbase) + (voff)[_i]), (PG8_LAS unsigned*)(lds + (bufoff) + ldsw + _i * 8192), 16, 0, 0); } while (0)
#define PG8_LDA(dst, b, h) do { _Pragma("unroll") for (int m = 0; m < 4; ++m) _Pragma("unroll") for (int k = 0; k < 2; ++k) dst[m][k] = *(const PG8_LAS bf16x8*)(lds + PG8_SA(b, h) + aoff + m * 2048 + k * 1024); } while (0)
#define PG8_LDB(dst, b, h) do { _Pragma("unroll") for (int n = 0; n < 2; ++n) _Pragma("unroll") for (int k = 0; k < 2; ++k) dst[n][k] = *(const PG8_LAS bf16x8*)(lds + PG8_SB(b, h) + boff + n * 2048 + k * 1024); } while (0)
#define PG8_MMA(ai, bj, At, Bt) do { __builtin_amdgcn_s_setprio(1); _Pragma("unroll") for (int m = 0; m < 4; ++m) _Pragma("unroll") for (int n = 0; n < 2; ++n) _Pragma("unroll") for (int k = 0; k < 2; ++k) \
        acc[ai][bj][m][n] = __builtin_amdgcn_mfma_f32_16x16x32_bf16(Bt[n][k], At[m][k], acc[ai][bj][m][n], 0, 0, 0); __builtin_amdgcn_s_setprio(0); } while (0)
#define PG8_WAIT_V(n) asm volatile("s_waitcnt vmcnt(" #n ")" ::: "memory")
#define PG8_WAIT_L(n) asm volatile("s_waitcnt lgkmcnt(" #n ")" ::: "memory")
#define PG8_BAR __builtin_amdgcn_s_barrier()
#define PG8_SCHED __builtin_amdgcn_sched_barrier(0)
    Unit cur, nxt; int ui = 0;
    if (!S.next(0, cur)) return;
    f32x4 acc[2][2][4][2];
#pragma unroll
    for (int a = 0; a < 2; ++a)
#pragma unroll
        for (int b = 0; b < 2; ++b)
#pragma unroll
            for (int m = 0; m < 4; ++m)
#pragma unroll
                for (int n = 0; n < 2; ++n) acc[a][b][m][n] = (f32x4){0.f, 0.f, 0.f, 0.f};
    bf16x8 At[4][2], B0[2][2], B1[2][2];
    const char* cA = g.a(cur.part) + (size_t)cur.pm * tstep; const char* cB = g.b(cur.part) + (size_t)cur.pn * tstep;
    S.a_ready(cur);
    if constexpr (SP2) {
        PG8_STAGE(PG8_SB(0, 0), cB, voffB); PG8_STAGE(PG8_SB(0, 1), cB + hstep, voffB); PG8_STAGE(PG8_SA(0, 0), cA, voffA); PG8_STAGE(PG8_SA(0, 1), cA + hstep, voffA);
        if (wr == 1) PG8_BAR;
        PG8_WAIT_V(2); PG8_BAR;
        PG8_STAGE(PG8_SB(1, 0), cB + kstep, voffB); PG8_STAGE(PG8_SA(1, 0), cA + kstep, voffA); PG8_STAGE(PG8_SB(1, 1), cB + hstep + kstep, voffB);
        PG8_WAIT_V(6); PG8_BAR;
    } else {
        PG8_STAGE(PG8_SB(0, 0), cB, voffB); PG8_STAGE(PG8_SA(0, 0), cA, voffA); PG8_STAGE(PG8_SB(0, 1), cB + hstep, voffB); PG8_STAGE(PG8_SA(0, 1), cA + hstep, voffA);
        if (wr == 1) PG8_BAR;
        PG8_WAIT_V(4); PG8_BAR;
        PG8_STAGE(PG8_SB(1, 0), cB + kstep, voffB); PG8_STAGE(PG8_SA(1, 0), cA + kstep, voffA); PG8_STAGE(PG8_SB(1, 1), cB + hstep + kstep, voffB);
        PG8_WAIT_V(6); PG8_BAR;
    }
    for (;;) {
        const bool has_next = S.next(ui + 1, nxt);
        const char* nA = has_next ? g.a(nxt.part) + (size_t)nxt.pm * tstep : cA; const char* nB = has_next ? g.b(nxt.part) + (size_t)nxt.pn * tstep : cB;
        const int nt = g.nt(cur.part);
        GST(0);
        for (int t = 0; t < nt; t += 2) {
            const bool last = (t == nt - 2);
            const char* a1 = cA + (size_t)(t + 1) * kstep;
            const char* a2 = last ? nA : cA + (size_t)(t + 2) * kstep; const char* b2 = last ? nB : cB + (size_t)(t + 2) * kstep;
            const char* a3 = a2 + kstep; const char* b3 = b2 + kstep;
            if (last && has_next) S.a_ready(nxt);
            if constexpr (SP2) {
            PG8_LDB(B0, 0, 0); PG8_LDB(B1, 0, 1); PG8_SCHED; PG8_LDA(At, 0, 0); PG8_STAGE(PG8_SA(1, 1), a1 + hstep, voffA); PG8_WAIT_V(8); PG8_WAIT_L(0); PG8_BAR; PG8_MMA(0, 0, At, B0); PG8_MMA(0, 1, At, B1); PG8_BAR; PG8_SCHED;
            PG8_LDA(At, 0, 1); PG8_STAGE(PG8_SB(0, 0), b2, voffB); PG8_STAGE(PG8_SB(0, 1), b2 + hstep, voffB); PG8_STAGE(PG8_SA(0, 0), a2, voffA); PG8_WAIT_V(8); PG8_WAIT_L(0); PG8_BAR; PG8_MMA(1, 0, At, B0); PG8_MMA(1, 1, At, B1); PG8_BAR; PG8_SCHED;
            PG8_LDB(B0, 1, 0); PG8_LDB(B1, 1, 1); PG8_SCHED; PG8_LDA(At, 1, 0); PG8_STAGE(PG8_SA(0, 1), a2 + hstep, voffA); PG8_WAIT_V(8); PG8_WAIT_L(0); PG8_BAR; PG8_MMA(0, 0, At, B0); PG8_MMA(0, 1, At, B1); PG8_BAR; PG8_SCHED;
            PG8_LDA(At, 1, 1); PG8_STAGE(PG8_SB(1, 0), b3, voffB); PG8_STAGE(PG8_SB(1, 1), b3 + hstep, voffB); PG8_STAGE(PG8_SA(1, 0), a3, voffA); PG8_WAIT_V(8); PG8_WAIT_L(0); PG8_BAR; PG8_MMA(1, 0, At, B0); PG8_MMA(1, 1, At, B1); PG8_BAR; PG8_SCHED;
            } else {
            PG8_LDB(B0, 0, 0); PG8_SCHED; PG8_LDA(At, 0, 0); PG8_STAGE(PG8_SA(1, 1), a1 + hstep, voffA);
            PG8_WAIT_L(8); PG8_BAR; PG8_WAIT_L(0); PG8_MMA(0, 0, At, B0); PG8_BAR; PG8_SCHED;
            PG8_LDB(B1, 0, 1); PG8_STAGE(PG8_SB(0, 0), b2, voffB);
            PG8_BAR; PG8_WAIT_L(0); PG8_MMA(0, 1, At, B1); PG8_BAR;
            PG8_LDA(At, 0, 1); PG8_STAGE(PG8_SA(0, 0), a2, voffA);
            PG8_BAR; PG8_WAIT_L(0); PG8_MMA(1, 0, At, B0); PG8_BAR; PG8_SCHED;
            PG8_STAGE(PG8_SB(0, 1), b2 + hstep, voffB);
            PG8_WAIT_V(6); PG8_BAR; PG8_MMA(1, 1, At, B1); PG8_BAR;
            PG8_LDB(B0, 1, 0); PG8_SCHED; PG8_LDA(At, 1, 0); PG8_STAGE(PG8_SA(0, 1), a2 + hstep, voffA);
            PG8_WAIT_L(8); PG8_BAR; PG8_WAIT_L(0); PG8_MMA(0, 0, At, B0); PG8_BAR; PG8_SCHED;
            PG8_LDB(B1, 1, 1); PG8_STAGE(PG8_SB(1, 0), b3, voffB);
            PG8_BAR; PG8_WAIT_L(0); PG8_MMA(0, 1, At, B1); PG8_BAR;
            PG8_LDA(At, 1, 1); PG8_STAGE(PG8_SA(1, 0), a3, voffA);
            PG8_BAR; PG8_WAIT_L(0); PG8_MMA(1, 0, At, B0); PG8_BAR; PG8_SCHED;
            PG8_STAGE(PG8_SB(1, 1), b3 + hstep, voffB);
            PG8_WAIT_V(6); PG8_BAR; PG8_MMA(1, 1, At, B1); PG8_BAR;
            }
        }
        GST(1);
        if constexpr (ALIGN_EPI) { if (wr == 0) PG8_BAR; }
        GST(2);
        if constexpr (!Epi::AFTER_DRAIN) { E(acc, cur, wr, wc, fr, fq); S.done(cur); }
        GST(3);
        if (!has_next) break;
        if (!E.keep(cur)) {
#pragma unroll
        for (int a = 0; a < 2; ++a)
#pragma unroll
            for (int b = 0; b < 2; ++b)
#pragma unroll
                for (int m = 0; m < 4; ++m)
#pragma unroll
                    for (int n = 0; n < 2; ++n) acc[a][b][m][n] = (f32x4){0.f, 0.f, 0.f, 0.f};
        }
        cur = nxt; cA = nA; cB = nB; ++ui;
        if constexpr (ALIGN_EPI) { if (wr == 1) PG8_BAR; }
    }
    PG8_WAIT_V(0);
    if constexpr (!ALIGN_EPI) { if (wr == 0) PG8_BAR; }
    PG8_BAR;
    if constexpr (Epi::AFTER_DRAIN) { E.fused(acc, cur, wr, wc, fr, fq, lds, wid, lane); S.done(cur); }
#undef PG8_SA
#undef PG8_SB
#undef PG8_STAGE
#undef PG8_LDA
#undef PG8_LDB
#undef PG8_MMA
#undef PG8_WAIT_V
#undef PG8_WAIT_L
#undef PG8_BAR
#undef PG8_SCHED
}
}
#define GAS __attribute__((address_space(1)))
#define LAS __attribute__((address_space(3)))
typedef unsigned short bf16;
typedef unsigned v4u __attribute__((ext_vector_type(4)));
typedef float f32x4 __attribute__((ext_vector_type(4)));
typedef short bf16x8 __attribute__((ext_vector_type(8)));
typedef GAS unsigned gu32;
typedef GAS unsigned long long gu64;
#define RLX_AGENT __ATOMIC_RELAXED, __HIP_MEMORY_SCOPE_AGENT
#define LDS_WAIT() asm volatile("s_waitcnt lgkmcnt(0)" ::: "memory")
#define VM_WAIT() asm volatile("s_waitcnt vmcnt(0)" ::: "memory")
__device__ __forceinline__ unsigned long long rt() { return __builtin_amdgcn_s_memrealtime(); }
__device__ __forceinline__ unsigned f2bf(float f) { unsigned u = __builtin_bit_cast(unsigned, f); return (u + 0x7fffu + ((u >> 16) & 1u)) >> 16; }
__device__ __forceinline__ unsigned pk2(float lo, float hi) { return f2bf(lo) | (f2bf(hi) << 16); }

#define XB_TMO      128
#define XB_XCNT(j)  (256  + 64 * (j))
#define XB_XSUB(j)  (1280 + 64 * (j))
#define XB_XGEN(j)  (2304 + 64 * (j))
#define XB_TOP      3328
#define XB_TOPGEN   3392
#define XCD_BAR_WORDS 3456
#define XB_SPIN_CAP (1u << 18)

__device__ __forceinline__ unsigned xb_ld(unsigned* p)              { return __hip_atomic_load(p, __ATOMIC_RELAXED, __HIP_MEMORY_SCOPE_AGENT); }
__device__ __forceinline__ unsigned xb_add(unsigned* p, unsigned v) { return __hip_atomic_fetch_add(p, v, __ATOMIC_RELAXED, __HIP_MEMORY_SCOPE_AGENT); }
__device__ __forceinline__ unsigned xb_xcc_id() { return (unsigned)__builtin_amdgcn_s_getreg((3 << 11) | 20) & 0xFu; }
#define XB_SPIN(cond, bar) do { unsigned _sp = 0; while (cond) { __builtin_amdgcn_s_sleep(1); \
    if ((++_sp & 255u) == 0u) { if (xb_ld(&(bar)[XB_TMO])) break; if (_sp > XB_SPIN_CAP) { atomicAdd(&(bar)[XB_TMO], 1u); break; } } } } while (0)

struct XcdBarrier {
    unsigned* bar; unsigned x;
    volatile LAS unsigned* st;
};

__device__ __forceinline__ XcdBarrier xcd_barrier_post(unsigned* bar, volatile LAS unsigned* st) {
    XcdBarrier b; b.bar = bar; b.x = xb_xcc_id(); b.st = st;
    if (threadIdx.x == 0) (void)xb_add(&bar[XB_XCNT(b.x)], 1u);
    return b;
}
__device__ __forceinline__ void xcd_barrier_complete(unsigned* bar, unsigned x, unsigned& nloc, unsigned& nx) {
    const unsigned G = gridDim.x * gridDim.y * gridDim.z;
    unsigned sum, cnt, mine, sp = 0u;
    for (;;) {
        sum = 0u; cnt = 0u; mine = 0u;
#pragma unroll
        for (unsigned j = 0; j < 16; ++j) { const unsigned c = xb_ld(&bar[XB_XCNT(j)]); sum += c; cnt += (c > 0u) ? 1u : 0u; mine = (j == x) ? c : mine; }
        if (sum == G) break;
        __builtin_amdgcn_s_sleep(1);
        if ((++sp & 255u) == 0u) { if (xb_ld(&bar[XB_TMO])) break; if (sp > XB_SPIN_CAP) { atomicAdd(&bar[XB_TMO], 1u); break; } }
    }
    nloc = mine > 0u ? mine : 1u; nx = cnt > 0u ? cnt : 1u;
}

__device__ __forceinline__ void xcd_barrier(const XcdBarrier& b) {
    asm volatile("s_waitcnt vmcnt(0)" ::: "memory");
    __syncthreads();
    if (threadIdx.x == 0) {
        unsigned* bar = b.bar;
        __builtin_amdgcn_s_waitcnt(0);
        unsigned nloc = b.st[0], nx = b.st[1];
        if (nloc == 0u) { xcd_barrier_complete(bar, b.x, nloc, nx); b.st[0] = nloc; b.st[1] = nx; }
        const unsigned old = xb_add(&bar[XB_XSUB(b.x)], 1u);
        const unsigned gen = old / nloc;
        if (old + 1u == (gen + 1u) * nloc) {
            __builtin_amdgcn_fence(__ATOMIC_RELEASE, "agent");
            asm volatile("s_waitcnt vmcnt(0)" ::: "memory");
            const unsigned og = xb_add(&bar[XB_TOP], 1u);
            const unsigned tg = og / nx;
            if (og + 1u == (tg + 1u) * nx) xb_add(&bar[XB_TOPGEN], 1u);
            else XB_SPIN(xb_ld(&bar[XB_TOPGEN]) == tg, bar);
            __builtin_amdgcn_fence(__ATOMIC_ACQUIRE, "agent");
            xb_add(&bar[XB_XGEN(b.x)], 1u);
            asm volatile("s_waitcnt vmcnt(0)" ::: "memory");
        } else {
            XB_SPIN(xb_ld(&bar[XB_XGEN(b.x)]) == gen, bar);
            __builtin_amdgcn_fence(__ATOMIC_ACQUIRE, "agent");
            asm volatile("s_waitcnt vmcnt(0)" ::: "memory");
        }
    }
    __syncthreads();
}
constexpr int D = 1024, M_CTX = 8192, M = 16384, L_CTX = 256, L_LAT = 1024, NB_CTX = 32, NB_LAT = 8;
constexpr int DIN = 3584, DFF = 4096, DPOOL = 512, NGRP = 64, NST = 64, HG = 16;
constexpr float DN_ALPHA = 1.189207115002721f;
constexpr float LN_EPS = 1e-6f;
constexpr int NWAVES = 8;

constexpr size_t MiB = 1u << 20;
constexpr size_t WS_CTL = 0, CTL_ZERO_BYTES = 64 * 1024;
constexpr size_t WS_MODP = 1 * MiB;
constexpr size_t WS_MODF = 2 * MiB;
constexpr size_t WS_STATS = 2 * MiB + 256 * 1024;
constexpr size_t WS_LAMB = 244 * MiB;
constexpr size_t WS_BB2 = 244 * MiB + 256 * 1024;
constexpr size_t WS_V2 = 245 * MiB + 512 * 1024;
constexpr size_t WS_G2 = 246 * MiB + 768 * 1024;
constexpr size_t WS_BB   = 3 * MiB;
constexpr size_t WS_CT   = 3 * MiB + 512 * 1024;
constexpr size_t WS_WIN = 4 * MiB, WS_WGLU = 11 * MiB, WS_WPA = 13 * MiB, WS_WPB = 15 * MiB, WS_WOUT = 17 * MiB, WS_W1 = 19 * MiB, WS_W2 = 27 * MiB, WS_WPOOL = 35 * MiB;
constexpr size_t WS_RA = 36 * MiB;
constexpr size_t WS_RB = 68 * MiB;
constexpr size_t WS_UB = 100 * MiB;
constexpr size_t WS_GA = 116 * MiB, WS_GB = 148 * MiB;
constexpr size_t WS_P  = 180 * MiB;
constexpr size_t WS_HM = 100 * MiB;
constexpr size_t WS_V  = 212 * MiB;
constexpr size_t WS_END = 248 * MiB;
constexpr int CW_BAR = 1024;

constexpr int RING_BYTES = 131072, LDSCTL_OFF = RING_BYTES, MISC_OFF = LDSCTL_OFF + 320, LDS_BYTES = 147456;

typedef unsigned u32x2 __attribute__((ext_vector_type(2)));
typedef float f32x16 __attribute__((ext_vector_type(16)));
__device__ __forceinline__ float bf_lo(unsigned w) { return __builtin_bit_cast(float, w << 16); }
__device__ __forceinline__ float bf_hi(unsigned w) { return __builtin_bit_cast(float, w & 0xffff0000u); }
__device__ __forceinline__ float fsigmoid(float x) { return __builtin_amdgcn_rcpf(1.0f + __builtin_amdgcn_exp2f(-1.4426950408889634f * x)); }
__device__ __forceinline__ float gelu_tanh(float x) { const float u = x * (1.5957691216057308f + 0.0713548162726f * x * x); return x * fsigmoid(u); }

namespace pg8 {
#define EPI_LOOP_BEGIN _Pragma("unroll") for (int ai = 0; ai < 2; ++ai) _Pragma("unroll") for (int m = 0; m < 4; ++m) { const int row = u.pm * BM + ai * HALF + wr * 64 + m * 16 + fr; _Pragma("unroll") for (int bj = 0; bj < 2; ++bj) { const int cl = bj * HALF + wc * 32 + 8 * fq;
#define EPI_LOOP_END } }
__device__ __forceinline__ u32x4 pack8(const f32x4& a, const f32x4& b) { u32x4 w; w.x = cvt_pk_bf16(a[0], a[1]); w.y = cvt_pk_bf16(a[2], a[3]); w.z = cvt_pk_bf16(b[0], b[1]); w.w = cvt_pk_bf16(b[2], b[3]); return w; }
__device__ __forceinline__ void unpack8(const u32x4& w, f32x4& a, f32x4& b) { a = (f32x4){bf_lo(w.x), bf_hi(w.x), bf_lo(w.y), bf_hi(w.y)}; b = (f32x4){bf_lo(w.z), bf_hi(w.z), bf_lo(w.w), bf_hi(w.w)}; }

struct EpiIn {
    static constexpr bool PERM = true, AFTER_DRAIN = false;
    bf16_t *ua, *ub, *ga, *gb; const float* bias;
    __device__ __forceinline__ bool keep(const Unit&) const { return false; }
    __device__ __forceinline__ int nstores(const Unit&) const { return 16; }
    __device__ __forceinline__ void operator()(f32x4 (&acc)[2][2][4][2], const Unit& u, int wr, int wc, int fr, int fq) const {
        bf16_t* base; int ldc, c0; bool sg;
        if (u.pn < 4) { base = ua; ldc = D; c0 = u.pn * BM; sg = false; } else if (u.pn < 6) { base = ub; ldc = DPOOL; c0 = (u.pn - 4) * BM; sg = false; }
        else if (u.pn < 10) { base = ga; ldc = D; c0 = (u.pn - 6) * BM; sg = true; } else { base = gb; ldc = D; c0 = (u.pn - 10) * BM; sg = true; }
        EPI_LOOP_BEGIN
            const float* bp = bias + u.pn * BM + cl; f32x4 v0 = acc[ai][bj][m][0] + *(const f32x4*)bp, v1 = acc[ai][bj][m][1] + *(const f32x4*)(bp + 4);
            if (sg) {
#pragma unroll
                for (int j = 0; j < 4; ++j) { v0[j] = fsigmoid(v0[j]); v1[j] = fsigmoid(v1[j]); } }
            *(u32x4*)(base + (size_t)row * ldc + c0 + cl) = pack8(v0, v1);
        EPI_LOOP_END
    }
};
struct EpiGlu {
    static constexpr bool PERM = true, AFTER_DRAIN = false;
    const bf16_t* v; bf16_t* o; const float* bias;
    __device__ __forceinline__ bool keep(const Unit&) const { return false; }
    __device__ __forceinline__ int nstores(const Unit&) const { return 16; }
    __device__ __forceinline__ void operator()(f32x4 (&acc)[2][2][4][2], const Unit& u, int wr, int wc, int fr, int fq) const {
        EPI_LOOP_BEGIN
            const int col = u.pn * BM + cl; const float* bp = bias + col; f32x4 t0 = acc[ai][bj][m][0] + *(const f32x4*)bp, t1 = acc[ai][bj][m][1] + *(const f32x4*)(bp + 4);
            f32x4 x0, x1; unpack8(*(const u32x4*)(v + (size_t)row * D + col), x0, x1);
#pragma unroll
            for (int j = 0; j < 4; ++j) { t0[j] = x0[j] * fsigmoid(t0[j]); t1[j] = x1[j] * fsigmoid(t1[j]); }
            *(u32x4*)(o + (size_t)row * D + col) = pack8(t0, t1);
        EPI_LOOP_END
    }
};
struct EpiMerge {
    static constexpr bool PERM = true, AFTER_DRAIN = false;
    const bf16_t *ga, *gb; bf16_t* o;
    __device__ __forceinline__ bool keep(const Unit& u) const { return u.part == 0; }
    __device__ __forceinline__ int nstores(const Unit& u) const { return u.part == 0 ? 0 : 16; }
    __device__ __forceinline__ void operator()(f32x4 (&acc)[2][2][4][2], const Unit& u, int wr, int wc, int fr, int fq) const {
        EPI_LOOP_BEGIN
            const size_t off = (size_t)row * D + u.pn * BM + cl; f32x4 b0, b1; unpack8(*(const u32x4*)(gb + off), b0, b1);
            if (u.part == 0) { f32x4 a0, a1; unpack8(*(const u32x4*)(ga + off), a0, a1);
#pragma unroll
                for (int j = 0; j < 4; ++j) { acc[ai][bj][m][0][j] *= a0[j] * __builtin_amdgcn_rcpf(fmaxf(b0[j], 1e-30f)); acc[ai][bj][m][1][j] *= a1[j] * __builtin_amdgcn_rcpf(fmaxf(b1[j], 1e-30f)); } }
            else { *(u32x4*)(o + off) = pack8(acc[ai][bj][m][0] * b0, acc[ai][bj][m][1] * b1); }
        EPI_LOOP_END
    }
};
struct EpiRes1 {
    static constexpr bool PERM = true, AFTER_DRAIN = false;
    const float *x_ctx, *x_lat; bf16_t* out; const float* bias; const float* modf;
    __device__ __forceinline__ bool keep(const Unit&) const { return false; }
    __device__ __forceinline__ int nstores(const Unit&) const { return 16; }
    __device__ __forceinline__ void operator()(f32x4 (&acc)[2][2][4][2], const Unit& u, int wr, int wc, int fr, int fq) const {
        const int r0 = u.pm * BM; const int bidx = r0 < M_CTX ? 0 : 1 + (r0 - M_CTX) / L_LAT;
        const float* gate = modf + (size_t)bidx * 6 * D + 2 * D; const float* bs = r0 < M_CTX ? x_ctx : x_lat - (size_t)M_CTX * D;
        EPI_LOOP_BEGIN
            const int col = u.pn * BM + cl; const size_t off = (size_t)row * D + col;
            const f32x4 g0 = *(const f32x4*)(gate + col), g1 = *(const f32x4*)(gate + col + 4), c0 = *(const f32x4*)(bias + col), c1 = *(const f32x4*)(bias + col + 4);
            const f32x4 x0 = *(const f32x4*)(bs + off), x1 = *(const f32x4*)(bs + off + 4);
            *(u32x4*)(out + off) = pack8(x0 * DN_ALPHA + g0 * (acc[ai][bj][m][0] + c0), x1 * DN_ALPHA + g1 * (acc[ai][bj][m][1] + c1));
        EPI_LOOP_END
    }
};
struct EpiRes2 {
    static constexpr bool PERM = true, AFTER_DRAIN = false;
    const bf16_t* r1; const float* stats; const float *lg, *lb; bf16_t* out; const float* bias; const float* modf;
    __device__ __forceinline__ bool keep(const Unit&) const { return false; }
    __device__ __forceinline__ int nstores(const Unit&) const { return 16; }
    __device__ __forceinline__ void operator()(f32x4 (&acc)[2][2][4][2], const Unit& u, int wr, int wc, int fr, int fq) const {
        const int r0 = u.pm * BM; const int bidx = r0 < M_CTX ? 0 : 1 + (r0 - M_CTX) / L_LAT;
        const float* gate = modf + (size_t)bidx * 6 * D + 5 * D;
        EPI_LOOP_BEGIN
            const int col = u.pn * BM + cl; const size_t off = (size_t)row * D + col;
            const f32x4 g0 = *(const f32x4*)(gate + col), g1 = *(const f32x4*)(gate + col + 4), c0 = *(const f32x4*)(bias + col), c1 = *(const f32x4*)(bias + col + 4);
            const f32x4 lg0 = *(const f32x4*)(lg + col), lg1 = *(const f32x4*)(lg + col + 4), lb0 = *(const f32x4*)(lb + col), lb1 = *(const f32x4*)(lb + col + 4);
            const float mu = stats[2 * row], rs = stats[2 * row + 1];
            f32x4 x0, x1; unpack8(*(const u32x4*)(r1 + off), x0, x1);
            x0 = (x0 - mu) * rs * lg0 + lb0; x1 = (x1 - mu) * rs * lg1 + lb1;
            *(u32x4*)(out + off) = pack8(x0 * DN_ALPHA + g0 * (acc[ai][bj][m][0] + c0), x1 * DN_ALPHA + g1 * (acc[ai][bj][m][1] + c1));
        EPI_LOOP_END
    }
};
struct EpiRelu2 {
    static constexpr bool PERM = true, AFTER_DRAIN = false;
    bf16_t* o; const float* bias;
    __device__ __forceinline__ bool keep(const Unit&) const { return false; }
    __device__ __forceinline__ int nstores(const Unit&) const { return 16; }
    __device__ __forceinline__ void operator()(f32x4 (&acc)[2][2][4][2], const Unit& u, int wr, int wc, int fr, int fq) const {
        EPI_LOOP_BEGIN
            const int col = u.pn * BM + cl; f32x4 t0 = acc[ai][bj][m][0] + *(const f32x4*)(bias + col), t1 = acc[ai][bj][m][1] + *(const f32x4*)(bias + col + 4);
#pragma unroll
            for (int j = 0; j < 4; ++j) { const float a = fmaxf(t0[j], 0.f), b = fmaxf(t1[j], 0.f); t0[j] = a * a; t1[j] = b * b; }
            *(u32x4*)(o + (size_t)row * DFF + col) = pack8(t0, t1);
        EPI_LOOP_END
    }
};
}
struct Frame {
    LAS unsigned char* lds;
    volatile LAS unsigned* MISC;
    gu32* ctl;
    int tid, lane, wave, G, bid;
    const float* in[33]; float* out; unsigned char* ws;
};
enum { I_XP = 0, I_XS, I_STATE, I_C, I_CCTX, I_WADA, I_BADA, I_WIN, I_BIN, I_LAMRE, I_LAMIM, I_LOGDT, I_BRE, I_BIM, I_CRE, I_CIM, I_S5D, I_WGLU, I_BGLU, I_WPA, I_WPOOL, I_PSCALE, I_WPB,
       I_WOUT, I_BOUT, I_LN1G, I_LN1B, I_W1, I_B1, I_W2, I_B2, I_LN2G, I_LN2B };

__device__ __forceinline__ float wave_sum(float v) {
#pragma unroll
    for (int o = 1; o < 64; o <<= 1) v += __shfl_xor(v, o);
    return v;
}
__device__ __forceinline__ void p0_transpose_item(const float* W, int N, bf16* WT, int ldt, LAS unsigned* scr, int item, int lane) {
    const int nblk = N / 64, kb = item / nblk, nb = item % nblk, k0 = 64 * kb, n0 = 64 * nb, q = lane & 15, kp = lane >> 4;
    f32x4 v0[8], v1[8];
#pragma unroll
    for (int i = 0; i < 8; ++i) { const float* p = W + (size_t)(k0 + 8 * i + 2 * kp) * N + n0 + 4 * q; v0[i] = *(const f32x4*)p; v1[i] = *(const f32x4*)(p + N); }
#pragma unroll
    for (int i = 0; i < 8; ++i)
#pragma unroll
        for (int j = 0; j < 4; ++j) scr[(4 * q + j) * 33 + 4 * i + kp] = pk2(v0[i][j], v1[i][j]);
    LDS_WAIT(); asm volatile("" ::: "memory");
    const int kc = lane & 7;
#pragma unroll
    for (int jj = 0; jj < 8; ++jj) { const int n = 8 * jj + (lane >> 3); const LAS unsigned* s = scr + n * 33 + 4 * kc;
        v4u o; o.x = s[0]; o.y = s[1]; o.z = s[2]; o.w = s[3];
        *(GAS v4u*)(WT + (size_t)(n0 + n) * ldt + k0 + 8 * kc) = o; }
    LDS_WAIT(); asm volatile("" ::: "memory");
}

__device__ __forceinline__ void phase0(Frame& F) {
    unsigned char* ws = F.ws;
    if (F.bid < 96) {
        const int cc = F.bid % 24, kq = F.bid / 24, k0 = kq * 256 + F.wave * 32;
        LAS float* sv = (LAS float*)(F.lds) + F.wave * 288;
        LAS float* red = (LAS float*)(F.lds + 16384);
        if (F.lane < 32) {
#pragma unroll
            for (int r = 0; r < 9; ++r) { const float cv = r == 0 ? F.in[I_CCTX][k0 + F.lane] : F.in[I_C][(size_t)(r - 1) * D + k0 + F.lane]; sv[r * 32 + F.lane] = cv * fsigmoid(cv); }
        }
        LDS_WAIT(); asm volatile("" ::: "memory");
        f32x4 a[9];
#pragma unroll
        for (int r = 0; r < 9; ++r) a[r] = (f32x4){0.f, 0.f, 0.f, 0.f};
        const float* wp = F.in[I_WADA] + (size_t)k0 * 6144 + cc * 256 + F.lane * 4;
#pragma unroll 8
        for (int k = 0; k < 32; ++k) { const f32x4 w = *(const f32x4*)(wp + (size_t)k * 6144);
#pragma unroll
            for (int r = 0; r < 9; ++r) a[r] += w * sv[r * 32 + k]; }
#pragma unroll
        for (int r = 0; r < 9; ++r) *(LAS f32x4*)(red + (F.wave * 9 + r) * 256 + F.lane * 4) = a[r];
        __syncthreads();
        float* mp = (float*)(ws + WS_MODP) + (size_t)kq * 9 * 6144;
        for (int i = F.tid; i < 9 * 256; i += NWAVES * 64) { const int r = i >> 8, c = i & 255; float s = 0.f;
#pragma unroll
            for (int w = 0; w < 8; ++w) s += red[(w * 9 + r) * 256 + c];
            mp[(size_t)r * 6144 + cc * 256 + c] = s; }
        __syncthreads();
    }
    for (int wt = F.bid * NWAVES + F.wave; wt < 2 * NGRP; wt += F.G * NWAVES) {
        const int dir = wt >> 6, g = wt & 63, p = F.lane, it = wt * 64 + p;
        const float lr = F.in[I_LAMRE][it], li = F.in[I_LAMIM][it], dt = expf(F.in[I_LOGDT][wt]);
        const float zr = lr * dt, zi = li * dt, e = expf(zr); float sn, cs; sincosf(zi, &sn, &cs);
        const float lbr = e * cs, lbi = e * sn, l2r = lbr * lbr - lbi * lbi, l2i = 2.f * lbr * lbi;
        const float sh = sinf(0.5f * zi); const float nr = expm1f(zr) * cs - 2.f * sh * sh, ni = lbi;
        const float den = 1.f / (lr * lr + li * li); const float wr_ = (nr * lr + ni * li) * den, wi_ = (ni * lr - nr * li) * den;
        *(f32x4*)((float*)(ws + WS_LAMB) + (size_t)it * 4) = (f32x4){lbr, lbi, l2r, l2i};
        float br[16], bi[16], ar[16], ai[16], cr[16], ci[16];
#pragma unroll
        for (int h = 0; h < 16; ++h) { const float r0 = F.in[I_BRE][(size_t)it * 16 + h], i0 = F.in[I_BIM][(size_t)it * 16 + h];
            br[h] = wr_ * r0 - wi_ * i0; bi[h] = wr_ * i0 + wi_ * r0; ar[h] = lbr * br[h] - lbi * bi[h]; ai[h] = lbr * bi[h] + lbi * br[h];
            const size_t cix = ((size_t)wt * 16 + h) * 64 + p; cr[h] = F.in[I_CRE][cix]; ci[h] = F.in[I_CIM][cix]; }
        { bf16* bb = (bf16*)(ws + WS_BB2);
#pragma unroll
          for (int i = 0; i < 2; ++i)
#pragma unroll
            for (int part = 0; part < 2; ++part) { unsigned o[8];
#pragma unroll
              for (int h = 0; h < 8; ++h) { const float v0 = i == 0 ? (part == 0 ? ar[2 * h] : ai[2 * h]) : (part == 0 ? br[2 * h] : bi[2 * h]), v1 = i == 0 ? (part == 0 ? ar[2 * h + 1] : ai[2 * h + 1]) : (part == 0 ? br[2 * h + 1] : bi[2 * h + 1]); o[h] = pk2(v0, v1); }
              v4u* d = (v4u*)(bb + ((size_t)((i * 128 + wt) * 2 + part) * 64 + p) * 16); d[0] = (v4u){o[0], o[1], o[2], o[3]}; d[1] = (v4u){o[4], o[5], o[6], o[7]}; } }
        { bf16* v2 = (bf16*)(ws + WS_V2) + (size_t)wt * 2 * 16 * 128;
#pragma unroll
          for (int h = 0; h < 16; ++h) { const float c1r = cr[h] * lbr - ci[h] * lbi, c1i = cr[h] * lbi + ci[h] * lbr, c2r = cr[h] * l2r - ci[h] * l2i, c2i = cr[h] * l2i + ci[h] * l2r;
              *(unsigned*)(v2 + (0 * 16 + h) * 128 + 2 * p) = pk2(c1r, -c1i); *(unsigned*)(v2 + (1 * 16 + h) * 128 + 2 * p) = pk2(c2r, -c2i); } }
        { LAS unsigned* sc = (LAS unsigned*)(F.lds + F.wave * 16384);
#pragma unroll
          for (int h = 0; h < 16; ++h) { sc[h * 64 + p] = pk2(cr[h], -ci[h]); sc[1024 + h * 64 + p] = pk2(br[h], bi[h]); sc[2048 + h * 64 + p] = pk2(ar[h], ai[h]); }
          LDS_WAIT(); asm volatile("" ::: "memory");
          f32x4 k0 = (f32x4){0.f, 0.f, 0.f, 0.f}, k1 = (f32x4){0.f, 0.f, 0.f, 0.f};
#pragma unroll
          for (int ks = 0; ks < 4; ++ks) { const int o = (F.lane & 15) * 64 + 16 * ks + 4 * (F.lane >> 4);
              const bf16x8 af = *(const LAS bf16x8*)(sc + o), b0 = *(const LAS bf16x8*)(sc + 1024 + o), b1 = *(const LAS bf16x8*)(sc + 2048 + o);
              k0 = __builtin_amdgcn_mfma_f32_16x16x32_bf16(af, b0, k0, 0, 0, 0); k1 = __builtin_amdgcn_mfma_f32_16x16x32_bf16(af, b1, k1, 0, 0, 0); }
          bf16* g2 = (bf16*)(ws + WS_G2) + (size_t)wt * 2 * 16 * 32; const int hp = F.lane & 15;
#pragma unroll
          for (int r = 0; r < 4; ++r) { const int h = 4 * (F.lane >> 4) + r; const float kd = k0[r] + (h == hp ? F.in[I_S5D][dir * D + g * 16 + h] : 0.f);
              g2[(0 * 16 + h) * 32 + hp] = (bf16)f2bf(kd); g2[(0 * 16 + h) * 32 + 16 + hp] = (bf16)0; g2[(1 * 16 + h) * 32 + hp] = (bf16)f2bf(k1[r]); g2[(1 * 16 + h) * 32 + 16 + hp] = (bf16)f2bf(kd); }
          LDS_WAIT(); asm volatile("" ::: "memory"); }
    }
    {
        LAS unsigned* scr = (LAS unsigned*)(F.lds + F.wave * 16384);
        const int gw = F.bid * NWAVES + F.wave, NGW = F.G * NWAVES;
        constexpr int I_IN = (D / 64) * (DIN / 64), I_SQ = (D / 64) * (D / 64), I_PB = (DPOOL / 64) * (D / 64), I_1 = (D / 64) * (DFF / 64), I_2 = (DFF / 64) * (D / 64), I_PL = 4 * 2 * 2;
        constexpr int NITEMS = I_IN + 3 * I_SQ + I_PB + I_1 + I_2 + I_PL;
        for (int it = gw; it < NITEMS; it += NGW) {
            int r = it;
            if (r < I_1) { p0_transpose_item(F.in[I_W1], DFF, (bf16*)(ws + WS_W1), D, scr, r, F.lane); continue; } r -= I_1;
            if (r < I_2) { p0_transpose_item(F.in[I_W2], D, (bf16*)(ws + WS_W2), DFF, scr, r, F.lane); continue; } r -= I_2;
            if (r < I_IN) { p0_transpose_item(F.in[I_WIN], DIN, (bf16*)(ws + WS_WIN), D, scr, r, F.lane); continue; } r -= I_IN;
            if (r < I_SQ) { p0_transpose_item(F.in[I_WGLU], D, (bf16*)(ws + WS_WGLU), D, scr, r, F.lane); continue; } r -= I_SQ;
            if (r < I_SQ) { p0_transpose_item(F.in[I_WPA], D, (bf16*)(ws + WS_WPA), D, scr, r, F.lane); continue; } r -= I_SQ;
            if (r < I_SQ) { p0_transpose_item(F.in[I_WOUT], D, (bf16*)(ws + WS_WOUT), D, scr, r, F.lane); continue; } r -= I_SQ;
            if (r < I_PB) { p0_transpose_item(F.in[I_WPB], D, (bf16*)(ws + WS_WPB), D, scr, r, F.lane); continue; } r -= I_PB;
            { const int gi = r >> 2; p0_transpose_item(F.in[I_WPOOL] + (size_t)gi * 128 * 128, 128, (bf16*)(ws + WS_WPOOL) + (size_t)gi * 128 * 128, 128, scr, r & 3, F.lane); }
        }
    }
}

__device__ __forceinline__ f32x4 mod4(Frame& F, int bidx, int idx) {
    const float* mp = (const float*)(F.ws + WS_MODP) + (size_t)bidx * 6144 + idx;
    f32x4 s = *(const f32x4*)(F.in[I_BADA] + idx);
#pragma unroll
    for (int q = 0; q < 4; ++q) s += *(const f32x4*)(mp + (size_t)q * 9 * 6144);
    return s;
}
__device__ __forceinline__ int batch_of_row(int r0) { return r0 < M_CTX ? 0 : 1 + (r0 - M_CTX) / L_LAT; }

__device__ __forceinline__ void phase1(Frame& F) {
    LAS f32x4* sc = (LAS f32x4*)(F.lds); LAS f32x4* sh = (LAS f32x4*)(F.lds + 4096);
    bf16* H = (bf16*)(F.ws + WS_RA);
    if (F.bid < 9) { float* mf = (float*)(F.ws + WS_MODF) + (size_t)F.bid * 6144; for (int i = F.tid; i < 6144 / 4; i += NWAVES * 64) *(f32x4*)(mf + 4 * i) = mod4(F, F.bid, 4 * i); }
    for (int rb = F.bid; rb < M / 64; rb += F.G) {
        const int r0 = rb * 64, bidx = batch_of_row(r0);
        __syncthreads();
        if (F.tid < 256) { sc[F.tid] = mod4(F, bidx, D + 4 * F.tid) + 1.0f; sh[F.tid] = mod4(F, bidx, 4 * F.tid); }
        __syncthreads();
        f32x4 xv[8][4];
#pragma unroll
        for (int j = 0; j < 8; ++j) { const int m = r0 + F.wave * 8 + j;
            const float* xrow = (m < M_CTX ? F.in[I_XP] + (size_t)m * D : F.in[I_XS] + (size_t)(m - M_CTX) * D); const GAS f32x4* xr = (const GAS f32x4*)xrow + F.lane;
#pragma unroll
            for (int q = 0; q < 4; ++q) xv[j][q] = xr[64 * q]; }
#pragma unroll
        for (int j = 0; j < 8; ++j) {
            const int m = r0 + F.wave * 8 + j;
            f32x4 v[4]; float s = 0.f;
#pragma unroll
            for (int q = 0; q < 4; ++q) { v[q] = xv[j][q]; s += (v[q].x + v[q].y) + (v[q].z + v[q].w); }
            const float mean = wave_sum(s) * (1.f / D); float s2 = 0.f;
#pragma unroll
            for (int q = 0; q < 4; ++q) { v[q] = v[q] - mean; s2 += (v[q].x * v[q].x + v[q].y * v[q].y) + (v[q].z * v[q].z + v[q].w * v[q].w); }
            const float rstd = 1.f / sqrtf(wave_sum(s2) * (1.f / D) + LN_EPS);
            GAS u32x2* o8 = (GAS u32x2*)(H + (size_t)m * D) + F.lane;
#pragma unroll
            for (int q = 0; q < 4; ++q) { const f32x4 y = v[q] * rstd * sc[F.lane + 64 * q] + sh[F.lane + 64 * q]; u32x2 w; w.x = pg8::cvt_pk_bf16(y.x, y.y); w.y = pg8::cvt_pk_bf16(y.z, y.w); o8[64 * q] = w; }
        }
    }
}

__device__ __forceinline__ void unpack4(const u32x2 w, f32x4& v) { v = (f32x4){bf_lo(w.x), bf_hi(w.x), bf_lo(w.y), bf_hi(w.y)}; }
__device__ __forceinline__ void phase_ln1(Frame& F, const bf16* R1, float* stats, bf16* H2) {
    LAS f32x4* sc = (LAS f32x4*)(F.lds); LAS f32x4* sh = (LAS f32x4*)(F.lds + 4096);
    const float* lg = F.in[I_LN1G]; const float* lb = F.in[I_LN1B];
    for (int rb = F.bid; rb < M / 64; rb += F.G) {
        const int r0 = rb * 64, bidx = batch_of_row(r0);
        __syncthreads();
        const float* mf = (const float*)(F.ws + WS_MODF) + (size_t)bidx * 6144;
        if (F.tid < 256) { sc[F.tid] = *(const f32x4*)(mf + 4 * D + 4 * F.tid) + 1.0f; sh[F.tid] = *(const f32x4*)(mf + 3 * D + 4 * F.tid); }
        __syncthreads();
        f32x4 gg[4], bb[4];
#pragma unroll
        for (int q = 0; q < 4; ++q) { gg[q] = *(const f32x4*)(lg + 4 * (F.lane + 64 * q)); bb[q] = *(const f32x4*)(lb + 4 * (F.lane + 64 * q)); }
        u32x2 raw[8][4];
#pragma unroll
        for (int j = 0; j < 8; ++j)
#pragma unroll
            for (int q = 0; q < 4; ++q) raw[j][q] = ((const GAS u32x2*)(R1 + (size_t)(r0 + F.wave * 8 + j) * D))[F.lane + 64 * q];
#pragma unroll
        for (int j = 0; j < 8; ++j) {
            const int m = r0 + F.wave * 8 + j;
            f32x4 v[4]; float s = 0.f;
#pragma unroll
            for (int q = 0; q < 4; ++q) { unpack4(raw[j][q], v[q]); s += (v[q].x + v[q].y) + (v[q].z + v[q].w); }
            float mean = wave_sum(s) * (1.f / D), s2 = 0.f;
#pragma unroll
            for (int q = 0; q < 4; ++q) { v[q] = v[q] - mean; s2 += (v[q].x * v[q].x + v[q].y * v[q].y) + (v[q].z * v[q].z + v[q].w * v[q].w); }
            float rstd = 1.f / sqrtf(wave_sum(s2) * (1.f / D) + LN_EPS);
            if (F.lane == 0) { stats[2 * m] = mean; stats[2 * m + 1] = rstd; }
            s = 0.f;
#pragma unroll
            for (int q = 0; q < 4; ++q) { v[q] = v[q] * rstd * gg[q] + bb[q]; s += (v[q].x + v[q].y) + (v[q].z + v[q].w); }
            mean = wave_sum(s) * (1.f / D); s2 = 0.f;
#pragma unroll
            for (int q = 0; q < 4; ++q) { v[q] = v[q] - mean; s2 += (v[q].x * v[q].x + v[q].y * v[q].y) + (v[q].z * v[q].z + v[q].w * v[q].w); }
            rstd = 1.f / sqrtf(wave_sum(s2) * (1.f / D) + LN_EPS);
            GAS u32x2* o8 = (GAS u32x2*)(H2 + (size_t)m * D) + F.lane;
#pragma unroll
            for (int q = 0; q < 4; ++q) { const f32x4 y = v[q] * rstd * sc[F.lane + 64 * q] + sh[F.lane + 64 * q]; u32x2 w; w.x = pg8::cvt_pk_bf16(y.x, y.y); w.y = pg8::cvt_pk_bf16(y.z, y.w); o8[64 * q] = w; }
        }
    }
}
__device__ __forceinline__ void phase_ln2(Frame& F, const bf16* R2) {
    const float* lg = F.in[I_LN2G]; const float* lb = F.in[I_LN2B];
    f32x4 gg[4], bb[4];
#pragma unroll
    for (int q = 0; q < 4; ++q) { gg[q] = *(const f32x4*)(lg + 4 * (F.lane + 64 * q)); bb[q] = *(const f32x4*)(lb + 4 * (F.lane + 64 * q)); }
    for (int rb = F.bid; rb < M / 64; rb += F.G) {
        const int r0 = rb * 64;
        u32x2 raw[8][4];
#pragma unroll
        for (int j = 0; j < 8; ++j)
#pragma unroll
            for (int q = 0; q < 4; ++q) raw[j][q] = ((const GAS u32x2*)(R2 + (size_t)(r0 + F.wave * 8 + j) * D))[F.lane + 64 * q];
#pragma unroll
        for (int j = 0; j < 8; ++j) {
            const int m = r0 + F.wave * 8 + j;
            f32x4 v[4]; float s = 0.f;
#pragma unroll
            for (int q = 0; q < 4; ++q) { unpack4(raw[j][q], v[q]); s += (v[q].x + v[q].y) + (v[q].z + v[q].w); }
            const float mean = wave_sum(s) * (1.f / D); float s2 = 0.f;
#pragma unroll
            for (int q = 0; q < 4; ++q) { v[q] = v[q] - mean; s2 += (v[q].x * v[q].x + v[q].y * v[q].y) + (v[q].z * v[q].z + v[q].w * v[q].w); }
            const float rstd = 1.f / sqrtf(wave_sum(s2) * (1.f / D) + LN_EPS);
            GAS f32x4* xr = (GAS f32x4*)(F.out + (size_t)m * D) + F.lane;
#pragma unroll
            for (int q = 0; q < 4; ++q) xr[64 * q] = v[q] * rstd * gg[q] + bb[q];
        }
    }
}
constexpr int S5_ROWB = 288, S5_WAVEB = 32 * S5_ROWB;
__device__ __forceinline__ void s5_task(Frame& F, bool lat, int seq, int gq) {
    const int lane = F.lane, n = lane & 31, hf = lane >> 5, g = gq * 4 + (F.wave >> 1), dir = F.wave & 1, wt = dir * 64 + g;
    const int L = lat ? L_LAT : L_CTX, tokbase = lat ? (M_CTX + seq * L_LAT) : seq * L_CTX, nch = L / 64;
    const bf16* UA = (const bf16*)(F.ws + WS_RB); bf16* V = (bf16*)(F.ws + WS_RA); float* PART = F.out;
    LAS unsigned char* sl = F.lds + F.wave * S5_WAVEB;
    bf16x8 Bf[2][2][2], Vf[2][4], Gf[2];
    { const bf16* bb = (const bf16*)(F.ws + WS_BB2);
#pragma unroll
      for (int i = 0; i < 2; ++i)
#pragma unroll
        for (int q = 0; q < 2; ++q)
#pragma unroll
          for (int part = 0; part < 2; ++part) Bf[i][q][part] = *(const bf16x8*)(bb + ((size_t)((i * 128 + wt) * 2 + part) * 64 + (n + 32 * q)) * 16 + 8 * hf);
      const bf16* v2 = (const bf16*)(F.ws + WS_V2) + (size_t)wt * 2 * 16 * 128 + (lane & 15) * 128 + 8 * (lane >> 4);
#pragma unroll
      for (int j = 0; j < 2; ++j)
#pragma unroll
        for (int ks = 0; ks < 4; ++ks) Vf[j][ks] = *(const bf16x8*)(v2 + j * 16 * 128 + 32 * ks);
      const bf16* g2 = (const bf16*)(F.ws + WS_G2) + (size_t)wt * 2 * 16 * 32 + (lane & 15) * 32 + 8 * (lane >> 4);
#pragma unroll
      for (int j = 0; j < 2; ++j) Gf[j] = *(const bf16x8*)(g2 + j * 16 * 32); }
    const int p = n + 32 * hf;
    const float lr = ((const float*)(F.ws + WS_LAMB))[((size_t)wt * 64 + p) * 4 + 2], li = ((const float*)(F.ws + WS_LAMB))[((size_t)wt * 64 + p) * 4 + 3];
    float sr = 0.f, si = 0.f;
    if (lat) { const float* st = F.in[I_STATE] + ((size_t)(seq * 2 + dir) * 2) * 4096 + g * 64 + p; sr = st[0]; si = st[4096]; }
    const int blkA = 16 * ((n >> 2) & 1) + (n & 3) + 4 * (n >> 3);
    const int tA0 = dir ? 63 - 2 * blkA : 2 * blkA, tA1 = dir ? 62 - 2 * blkA : 2 * blkA + 1;
    const bf16* ua_lane = UA + (size_t)tokbase * D + g * 16 + 8 * hf;
    const bf16* ub_lane = UA + (size_t)tokbase * D + g * 16 + 8 * ((lane >> 4) & 1);
    const int tU0 = dir ? 63 - (2 * (lane & 15) + hf) : 2 * (lane & 15) + hf, tU1 = dir ? 63 - (2 * (16 + (lane & 15)) + hf) : 2 * (16 + (lane & 15)) + hf;
    const int h0 = 4 * (lane >> 4), colg = g * 16 + h0;
    bf16x8 A0 = *(const bf16x8*)(ua_lane + (size_t)((dir ? L - 64 : 0) + tA0) * D), A1 = *(const bf16x8*)(ua_lane + (size_t)((dir ? L - 64 : 0) + tA1) * D);
    for (int c = 0; c < nch; ++c) {
        const int t0 = dir ? L - 64 * (c + 1) : 64 * c;
        if (c == nch / 2) { asm volatile("s_waitcnt vmcnt(0)" ::: "memory"); __syncthreads(); }
        const f32x16 z16 = {0.f, 0.f, 0.f, 0.f, 0.f, 0.f, 0.f, 0.f, 0.f, 0.f, 0.f, 0.f, 0.f, 0.f, 0.f, 0.f};
        f32x16 x00 = __builtin_amdgcn_mfma_f32_32x32x16_bf16(A0, Bf[0][0][0], z16, 0, 0, 0);
        f32x16 x01 = __builtin_amdgcn_mfma_f32_32x32x16_bf16(A0, Bf[0][0][1], z16, 0, 0, 0);
        f32x16 x10 = __builtin_amdgcn_mfma_f32_32x32x16_bf16(A0, Bf[0][1][0], z16, 0, 0, 0);
        f32x16 x11 = __builtin_amdgcn_mfma_f32_32x32x16_bf16(A0, Bf[0][1][1], z16, 0, 0, 0);
        x00 = __builtin_amdgcn_mfma_f32_32x32x16_bf16(A1, Bf[1][0][0], x00, 0, 0, 0);
        x01 = __builtin_amdgcn_mfma_f32_32x32x16_bf16(A1, Bf[1][0][1], x01, 0, 0, 0);
        x10 = __builtin_amdgcn_mfma_f32_32x32x16_bf16(A1, Bf[1][1][0], x10, 0, 0, 0);
        x11 = __builtin_amdgcn_mfma_f32_32x32x16_bf16(A1, Bf[1][1][1], x11, 0, 0, 0);
        const bf16x8 Ub0 = *(const bf16x8*)(ub_lane + (size_t)(t0 + tU0) * D), Ub1 = *(const bf16x8*)(ub_lane + (size_t)(t0 + tU1) * D);
        if (c + 1 < nch) { const int t1 = dir ? L - 64 * (c + 2) : 64 * (c + 1); A0 = *(const bf16x8*)(ua_lane + (size_t)(t1 + tA0) * D); A1 = *(const bf16x8*)(ua_lane + (size_t)(t1 + tA1) * D); }
        float xr0[16], xi0[16], xr1[16], xi1[16];
#pragma unroll
        for (int i = 0; i < 16; ++i) {
            { auto r = __builtin_amdgcn_permlane32_swap(__float_as_uint(x00[i]), __float_as_uint(x10[i]), false, false); xr0[i] = __uint_as_float(r[0]); xr1[i] = __uint_as_float(r[1]); }
            { auto r = __builtin_amdgcn_permlane32_swap(__float_as_uint(x01[i]), __float_as_uint(x11[i]), false, false); xi0[i] = __uint_as_float(r[0]); xi1[i] = __uint_as_float(r[1]); }
        }
        LAS unsigned* srow = (LAS unsigned*)(sl + p * 4);
#pragma unroll
        for (int i = 0; i < 16; ++i) { srow[i * (S5_ROWB / 4)] = pg8::cvt_pk_bf16(sr, si); const float nr = lr * sr - li * si + xr0[i], ni = lr * si + li * sr + xi0[i]; sr = nr; si = ni; }
#pragma unroll
        for (int i = 0; i < 16; ++i) { srow[(16 + i) * (S5_ROWB / 4)] = pg8::cvt_pk_bf16(sr, si); const float nr = lr * sr - li * si + xr1[i], ni = lr * si + li * sr + xi1[i]; sr = nr; si = ni; }
        asm volatile("" ::: "memory");
        f32x4 y[2][2];
#pragma unroll
        for (int ct = 0; ct < 2; ++ct) { bf16x8 sb[4];
#pragma unroll
            for (int ks = 0; ks < 4; ++ks) sb[ks] = *(const LAS bf16x8*)(sl + (16 * ct + (lane & 15)) * S5_ROWB + (32 * ks + 8 * (lane >> 4)) * 2);
#pragma unroll
            for (int j = 0; j < 2; ++j) { f32x4 a = (f32x4){0.f, 0.f, 0.f, 0.f};
#pragma unroll
                for (int ks = 0; ks < 4; ++ks) a = __builtin_amdgcn_mfma_f32_16x16x32_bf16(Vf[j][ks], sb[ks], a, 0, 0, 0);
                y[ct][j] = __builtin_amdgcn_mfma_f32_16x16x32_bf16(Gf[j], ct == 0 ? Ub0 : Ub1, a, 0, 0, 0); } }
        asm volatile("" ::: "memory");
        size_t off[2][2];
#pragma unroll
        for (int ct = 0; ct < 2; ++ct)
#pragma unroll
          for (int j = 0; j < 2; ++j) { const int tau = 2 * (16 * ct + (lane & 15)) + j; off[ct][j] = (size_t)(tokbase + t0 + (dir ? 63 - tau : tau)) * D + colg; }
        if (c < nch / 2) {
#pragma unroll
            for (int ct = 0; ct < 2; ++ct)
#pragma unroll
              for (int j = 0; j < 2; ++j) *(f32x4*)(PART + off[ct][j]) = y[ct][j];
        } else {
            f32x4 pv[2][2];
#pragma unroll
            for (int ct = 0; ct < 2; ++ct)
#pragma unroll
              for (int j = 0; j < 2; ++j) pv[ct][j] = *(const f32x4*)(PART + off[ct][j]);
#pragma unroll
            for (int ct = 0; ct < 2; ++ct)
#pragma unroll
              for (int j = 0; j < 2; ++j) { const f32x4 t = y[ct][j] + pv[ct][j];
                u32x2 w; w.x = pg8::cvt_pk_bf16(gelu_tanh(t.x), gelu_tanh(t.y)); w.y = pg8::cvt_pk_bf16(gelu_tanh(t.z), gelu_tanh(t.w)); *(u32x2*)(V + off[ct][j]) = w; }
        }
    }
    if (!lat) { float* o = F.out + (size_t)M * D + ((size_t)(seq * 2 + dir) * 2) * 4096 + g * 64 + p; o[0] = sr; o[4096] = si; }
}

constexpr int PL_ROWB = 1056;
#if MK_STAMP == 120
#define PST(id) do { if (F.bid == MK_TB && F.tid == 0) { if ((id) == MK_SA) F.MISC[17] = (unsigned)__builtin_amdgcn_s_memrealtime(); if ((id) == MK_SB) F.MISC[18] = (unsigned)__builtin_amdgcn_s_memrealtime(); } } while (0)
#else
#define PST(id) do { } while (0)
#endif
__device__ __forceinline__ void pool_task(Frame& F, int tile) {
    PST(0);
    const int tok0 = tile * 64; const bool lat = tile >= M_CTX / 64; const int npr = lat ? 64 : L_CTX, off = lat ? 0 : (tile & 3) * 64;
    const bf16* UB = (const bf16*)(F.ws + WS_UB); bf16* P = (bf16*)(F.ws + WS_P); const bf16* WPT = (const bf16*)(F.ws + WS_WPOOL);
    LAS unsigned char* ul = F.lds;
    const int lane = F.lane, gi3 = F.wave >> 1, oh = F.wave & 1;
    bf16x8 Wf[4][4];
#pragma unroll
    for (int ot = 0; ot < 4; ++ot)
#pragma unroll
        for (int ks = 0; ks < 4; ++ks) Wf[ot][ks] = *(const bf16x8*)(WPT + ((size_t)gi3 * 128 + 64 * oh + 16 * ot + (lane & 15)) * 128 + 32 * ks + 8 * (lane >> 4));
    f32x4 psc[4];
#pragma unroll
    for (int ot = 0; ot < 4; ++ot) psc[ot] = *(const f32x4*)(F.in[I_PSCALE] + gi3 * 128 + 64 * oh + 4 * (lane >> 4) + 16 * ot);
    __syncthreads();
    PST(1);
    { v4u v[10];
#pragma unroll
      for (int q = 0; q < 10; ++q) { const int i = F.tid + q * 512, j = i >> 6, pc = i & 63; const int tt = off + j - 8, ttc = min(max(tt, 0), npr - 1);
          v[q] = *(const v4u*)(UB + (size_t)(tok0 - off + ttc) * DPOOL + pc * 8); }
#pragma unroll
      for (int q = 0; q < 10; ++q) { const int i = F.tid + q * 512, j = i >> 6, pc = i & 63; const int tt = off + j - 8; const bool ok = tt >= 0 && tt < npr;
          v4u w = v[q]; w.x = ok ? w.x : 0u; w.y = ok ? w.y : 0u; w.z = ok ? w.z : 0u; w.w = ok ? w.w : 0u; *(LAS v4u*)(ul + j * PL_ROWB + pc * 16) = w; } }
    __syncthreads();
    PST(2);
    unsigned pm[32];
    { const int cp = F.tid & 255, th = F.tid >> 8, gi = cp >> 6, w = 2 << gi, hw = w >> 1; const LAS unsigned char* ucol = ul + cp * 4 + (th * 32 + 8) * PL_ROWB;
      float s0 = 0.f, s1 = 0.f;
      for (int d = -hw; d < hw; ++d) { const unsigned x = *(const LAS unsigned*)(ucol + d * PL_ROWB); s0 += bf_lo(x); s1 += bf_hi(x); }
      const int tt0 = off + th * 32;
#pragma unroll
      for (int j = 0; j < 32; ++j) {
          const unsigned xc = *(const LAS unsigned*)(ucol + j * PL_ROWB); const int tt = tt0 + j; const float inv = __builtin_amdgcn_rcpf((float)(min(tt - hw + w, npr) - max(tt - hw, 0)));
          pm[j] = pg8::cvt_pk_bf16(s0 * inv - bf_lo(xc), s1 * inv - bf_hi(xc));
          const unsigned xa = *(const LAS unsigned*)(ucol + (j + hw) * PL_ROWB), xs = *(const LAS unsigned*)(ucol + (j - hw) * PL_ROWB);
          s0 += bf_lo(xa) - bf_lo(xs); s1 += bf_hi(xa) - bf_hi(xs); }
      PST(3);
      __syncthreads();
#pragma unroll
      for (int j = 0; j < 32; ++j) *(LAS unsigned*)(ul + (th * 32 + j) * PL_ROWB + cp * 4) = pm[j]; }
    __syncthreads();
    PST(4);
    { const int obase = gi3 * 128 + 64 * oh + 4 * (lane >> 4);
#pragma unroll
      for (int tt = 0; tt < 4; ++tt) { bf16x8 pb[4];
#pragma unroll
          for (int ks = 0; ks < 4; ++ks) pb[ks] = *(const LAS bf16x8*)(ul + (16 * tt + (lane & 15)) * PL_ROWB + (gi3 * 128 + 32 * ks + 8 * (lane >> 4)) * 2);
#pragma unroll
          for (int ot = 0; ot < 4; ++ot) { f32x4 a = (f32x4){0.f, 0.f, 0.f, 0.f};
#pragma unroll
              for (int ks = 0; ks < 4; ++ks) a = __builtin_amdgcn_mfma_f32_16x16x32_bf16(Wf[ot][ks], pb[ks], a, 0, 0, 0);
              const int o0 = obase + 16 * ot; a = a * psc[ot]; u32x2 wv; wv.x = pg8::cvt_pk_bf16(a.x, a.y); wv.y = pg8::cvt_pk_bf16(a.z, a.w);
              *(u32x2*)(P + (size_t)(tok0 + 16 * tt + (lane & 15)) * D + o0) = wv; } } }
    PST(5);
}
constexpr int PLO_ROWB = 288;
__device__ __forceinline__ void pool_task_old(Frame& F, int tile) {
    const int tok0 = tile * 64; const bool lat = tile >= M_CTX / 64; const int npr = lat ? 64 : L_CTX, off = lat ? 0 : (tile & 3) * 64;
    const bf16* UB = (const bf16*)(F.ws + WS_UB); bf16* P = (bf16*)(F.ws + WS_P); const bf16* WPT = (const bf16*)(F.ws + WS_WPOOL);
    LAS unsigned char* ul = F.lds; LAS unsigned char* pl = F.lds + 80 * PLO_ROWB;
    const int lane = F.lane;
    for (int gi = 0; gi < 4; ++gi) {
        const int w = 2 << gi, hw = w >> 1;
        __syncthreads();
        for (int i = F.tid; i < 80 * 16; i += NWAVES * 64) { const int j = i >> 4, pc = i & 15; const int tt = off + j - 8; v4u v = (v4u){0u, 0u, 0u, 0u};
            if (tt >= 0 && tt < npr) v = *(const v4u*)(UB + (size_t)(tok0 - off + tt) * DPOOL + gi * 128 + pc * 8);
            *(LAS v4u*)(ul + j * PLO_ROWB + pc * 16) = v; }
        __syncthreads();
        { const int cp = F.tid & 63, tr = F.tid >> 6; const LAS unsigned char* ucol = ul + cp * 4;
          int tt = off + tr * 8; int lo = max(tt - hw, 0), hi = min(tt - hw + w, npr); float s0 = 0.f, s1 = 0.f;
          for (int q = lo; q < hi; ++q) { const unsigned x = *(const LAS unsigned*)(ucol + (q - off + 8) * PLO_ROWB); s0 += bf_lo(x); s1 += bf_hi(x); }
          for (int j = 0; j < 8; ++j) {
              const unsigned xc = *(const LAS unsigned*)(ucol + (tr * 8 + j + 8) * PLO_ROWB); const float inv = 1.0f / (float)(hi - lo);
              *(LAS unsigned*)(pl + (tr * 8 + j) * PLO_ROWB + cp * 4) = pg8::cvt_pk_bf16(s0 * inv - bf_lo(xc), s1 * inv - bf_hi(xc));
              ++tt; const int nlo = max(tt - hw, 0), nhi = min(tt - hw + w, npr);
              if (nhi > hi) { const unsigned x = *(const LAS unsigned*)(ucol + (hi - off + 8) * PLO_ROWB); s0 += bf_lo(x); s1 += bf_hi(x); }
              if (nlo > lo) { const unsigned x = *(const LAS unsigned*)(ucol + (lo - off + 8) * PLO_ROWB); s0 -= bf_lo(x); s1 -= bf_hi(x); }
              lo = nlo; hi = nhi; } }
        __syncthreads();
        { bf16x8 Wf[4];
#pragma unroll
          for (int ks = 0; ks < 4; ++ks) Wf[ks] = *(const bf16x8*)(WPT + ((size_t)gi * 128 + 16 * F.wave + (lane & 15)) * 128 + 32 * ks + 8 * (lane >> 4));
          const int o0 = gi * 128 + 16 * F.wave + 4 * (lane >> 4); const f32x4 ps = *(const f32x4*)(F.in[I_PSCALE] + o0);
#pragma unroll
          for (int tt = 0; tt < 4; ++tt) { f32x4 a = (f32x4){0.f, 0.f, 0.f, 0.f};
#pragma unroll
              for (int ks = 0; ks < 4; ++ks) { const bf16x8 pb = *(const LAS bf16x8*)(pl + (16 * tt + (lane & 15)) * PLO_ROWB + (32 * ks + 8 * (lane >> 4)) * 2);
                  a = __builtin_amdgcn_mfma_f32_16x16x32_bf16(Wf[ks], pb, a, 0, 0, 0); }
              a = a * ps; u32x2 wv; wv.x = pg8::cvt_pk_bf16(a.x, a.y); wv.y = pg8::cvt_pk_bf16(a.z, a.w);
              *(u32x2*)(P + (size_t)(tok0 + 16 * tt + (lane & 15)) * D + o0) = wv; } }
    }
}
#if MK_DEBUG
constexpr int CW_FAIL = 8192;
constexpr size_t WS_DBG = 230 * MiB;
__device__ __forceinline__ unsigned dh(unsigned i) { i ^= i >> 16; i *= 0x7feb352du; i ^= i >> 15; i *= 0x846ca68bu; i ^= i >> 16; return i; }
__device__ __forceinline__ float bf2f(bf16 b) { return __builtin_bit_cast(float, (unsigned)b << 16); }
__device__ __forceinline__ void dfail(Frame& F, int id, bool bad) { if (bad) atomicAdd((unsigned*)(F.ctl + CW_FAIL + id), 1u); }
__device__ __forceinline__ bool dneq(float got, float ref, float rel, float abs_) { const float d = fabsf(got - ref); return !(d <= rel * fabsf(ref) + abs_); }
__device__ __forceinline__ const float* xrow_ptr(Frame& F, int m) { return m < M_CTX ? F.in[I_XP] + (size_t)m * D : F.in[I_XS] + (size_t)(m - M_CTX) * D; }

__device__ __forceinline__ void dbg_wt(Frame& F, const float* W, int K, int N, const bf16* WT, int ldt, unsigned salt) {
    for (int s = F.tid; s < 2048; s += 512) { const unsigned h = dh(s * 2u + salt); const int k = h % K, n = (h >> 12) % N; const float w = W[(size_t)k * N + n], t = bf2f(WT[(size_t)n * ldt + k]);
        dfail(F, 1, dneq(t, w, 0.0045f, 1e-30f)); }
}
__device__ __forceinline__ void dbg_check(Frame& F, int phase) {
    if (F.bid != 0) return;
    unsigned char* ws = F.ws;
    if (phase == 0) {
        dbg_wt(F, F.in[I_WIN], D, DIN, (const bf16*)(ws + WS_WIN), D, 11); dbg_wt(F, F.in[I_WGLU], D, D, (const bf16*)(ws + WS_WGLU), D, 12); dbg_wt(F, F.in[I_WPA], D, D, (const bf16*)(ws + WS_WPA), D, 13);
        dbg_wt(F, F.in[I_WPB], DPOOL, D, (const bf16*)(ws + WS_WPB), D, 14); dbg_wt(F, F.in[I_WOUT], D, D, (const bf16*)(ws + WS_WOUT), D, 15); dbg_wt(F, F.in[I_W1], D, DFF, (const bf16*)(ws + WS_W1), D, 16);
        dbg_wt(F, F.in[I_W2], DFF, D, (const bf16*)(ws + WS_W2), DFF, 17);
        for (int gi = 0; gi < 4; ++gi) dbg_wt(F, F.in[I_WPOOL] + gi * 16384, 128, 128, (const bf16*)(ws + WS_WPOOL) + gi * 16384, 128, 18 + gi);
        for (int s = F.tid; s < 2048; s += 512) {
            const int it = dh(s + 77u) % 8192; const int p = it & 63, g = (it >> 6) & 63, dir = it >> 12;
            const double lr = F.in[I_LAMRE][it], li = F.in[I_LAMIM][it], dt = exp((double)F.in[I_LOGDT][dir * 64 + g]);
            const double e = exp(lr * dt), lbr = e * cos(li * dt), lbi = e * sin(li * dt), nr = lbr - 1.0, ni = lbi, den = lr * lr + li * li, wr = (nr * lr + ni * li) / den, wi = (ni * lr - nr * li) / den;
            const float* lamb = (const float*)(ws + WS_LAMB) + (size_t)it * 4; dfail(F, 2, dneq(lamb[0], (float)lbr, 1e-5f, 1e-6f) || dneq(lamb[1], (float)lbi, 1e-5f, 1e-6f));
            const int h = dh(s + 99u) & 15; const double br = F.in[I_BRE][(size_t)it * 16 + h], bi = F.in[I_BIM][(size_t)it * 16 + h];
            const bf16* bb = (const bf16*)(ws + WS_BB2) + (size_t)128 * 2 * 64 * 16;
            dfail(F, 2, dneq(bf2f(bb[((size_t)((dir * 64 + g) * 2 + 0) * 64 + p) * 16 + h]), (float)(wr * br - wi * bi), 0.01f, 1e-6f) || dneq(bf2f(bb[((size_t)((dir * 64 + g) * 2 + 1) * 64 + p) * 16 + h]), (float)(wr * bi + wi * br), 0.01f, 1e-6f));
            const bf16* v2 = (const bf16*)(ws + WS_V2) + ((size_t)(dir * 64 + g) * 2 * 16 + h) * 128; const size_t ci = ((size_t)(dir * 64 + g) * 16 + h) * 64 + p;
            const double cre = F.in[I_CRE][ci], cim = F.in[I_CIM][ci];
            dfail(F, 2, dneq(bf2f(v2[2 * p]), (float)(cre * lbr - cim * lbi), 0.006f, 1e-5f) || dneq(bf2f(v2[2 * p + 1]), (float)-(cre * lbi + cim * lbr), 0.006f, 1e-5f));
        }
    }
    if (phase == 1) {
        for (int s = F.tid; s < 1024; s += 512) {
            const unsigned h = dh(s + 5u); const int r = h % 9, idx = (h >> 8) % 6144; double a = F.in[I_BADA][idx];
            for (int k = 0; k < D; ++k) { const double cv = r == 0 ? F.in[I_CCTX][k] : F.in[I_C][(size_t)(r - 1) * D + k]; a += cv / (1.0 + exp(-cv)) * (double)F.in[I_WADA][(size_t)k * 6144 + idx]; }
            dfail(F, 3, dneq(((const float*)(ws + WS_MODF))[(size_t)r * 6144 + idx], (float)a, 1e-4f, 1e-4f));
        }
        for (int s = F.tid; s < 1024; s += 512) {
            const unsigned h = dh(s + 1234u); const int m = h % M, j = (h >> 16) % D; const float* x = xrow_ptr(F, m); double mu = 0, var = 0;
            for (int k = 0; k < D; ++k) mu += x[k]; mu /= D; for (int k = 0; k < D; ++k) { const double d = x[k] - mu; var += d * d; } var /= D;
            const float* mf = (const float*)(ws + WS_MODF) + (size_t)batch_of_row(m) * 6144;
            const double y = (x[j] - mu) / sqrt(var + 1e-6) * (1.0 + mf[D + j]) + mf[j];
            dfail(F, 4, dneq(bf2f(((const bf16*)(ws + WS_RA))[(size_t)m * D + j]), (float)y, 0.006f, 0.004f));
        }
    }
    if (phase == 2) {
        for (int s = F.tid; s < 2048; s += 512) { const unsigned h = dh(s + 4321u); const int m = h % M, zc = (h >> 14) % DIN; const bf16* hr = (const bf16*)(ws + WS_RA) + (size_t)m * D; double a = F.in[I_BIN][zc];
            for (int k = 0; k < D; ++k) a += (double)bf2f(hr[k]) * (double)F.in[I_WIN][(size_t)k * DIN + zc];
            float got;
            if (zc < 1024) got = bf2f(((const bf16*)(ws + WS_RB))[(size_t)m * D + zc]);
            else if (zc < 1536) got = bf2f(((const bf16*)(ws + WS_UB))[(size_t)m * DPOOL + zc - 1024]);
            else if (zc < 2560) { got = bf2f(((const bf16*)(ws + WS_GA))[(size_t)m * D + zc - 1536]); a = 1.0 / (1.0 + exp(-a)); }
            else { got = bf2f(((const bf16*)(ws + WS_GB))[(size_t)m * D + zc - 2560]); a = 1.0 / (1.0 + exp(-a)); }
            dfail(F, 5, dneq(got, (float)a, 0.01f, 0.02f)); }
    }
    if (phase == 3) {
        { const int w = F.wave, lane = F.lane; const bool lat = w < 2; const unsigned h = dh(w + 31u); const int seq = lat ? (h % NB_LAT) : w, g = lat ? (h >> 8) % NGRP : 3 * w + 1;
          const int L = lat ? L_LAT : L_CTX, tokbase = lat ? M_CTX + seq * L_LAT : seq * L_CTX; const bf16* UA = (const bf16*)(ws + WS_RB); const bf16* V = (const bf16*)(ws + WS_RA);
          float* yf = (float*)(ws + WS_DBG) + (size_t)w * L_LAT * 16;
          for (int dir = 0; dir < 2; ++dir) {
              const int it = (dir * 64 + g) * 64 + lane; const float lr = F.in[I_LAMRE][it], li = F.in[I_LAMIM][it], dt = expf(F.in[I_LOGDT][dir * 64 + g]);
              const float e = expf(lr * dt), lbr = e * cosf(li * dt), lbi = e * sinf(li * dt), nr = lbr - 1.f, ni = lbi, den = 1.f / (lr * lr + li * li), wr = (nr * lr + ni * li) * den, wi = (ni * lr - nr * li) * den;
              float br[16], bi[16], cr[16], cim[16];
#pragma unroll
              for (int hh = 0; hh < 16; ++hh) { const float a = F.in[I_BRE][(size_t)it * 16 + hh], b = F.in[I_BIM][(size_t)it * 16 + hh]; br[hh] = wr * a - wi * b; bi[hh] = wr * b + wi * a;
                  const size_t ci = ((size_t)(dir * 64 + g) * 16 + hh) * 64 + lane; cr[hh] = F.in[I_CRE][ci]; cim[hh] = F.in[I_CIM][ci]; }
              float sr = 0.f, si = 0.f; if (lat) { const float* st = F.in[I_STATE] + ((size_t)(seq * 2 + dir) * 2) * 4096 + g * 64 + lane; sr = st[0]; si = st[4096]; }
              for (int tq = 0; tq < L; ++tq) { const int t = dir ? L - 1 - tq : tq; const bf16* ur = UA + (size_t)(tokbase + t) * D + g * 16; float bur = 0.f, bui = 0.f;
#pragma unroll
                  for (int hh = 0; hh < 16; ++hh) { const float u = bf2f(ur[hh]); bur += br[hh] * u; bui += bi[hh] * u; }
                  const float nsr = lbr * sr - lbi * si + bur, nsi = lbr * si + lbi * sr + bui; sr = nsr; si = nsi;
                  if (!lat && dir == 0 && tq < 32) { const float* dx = (const float*)(ws + 231 * MiB) + (size_t)seq * 32 * 64 * 4 + (tq * 64 + lane) * 4;
                      dfail(F, 20, dneq(dx[0], bur, 0.02f, 0.002f) || dneq(dx[1], bui, 0.02f, 0.002f)); dfail(F, 21, dneq(dx[2], sr, 0.02f, 0.002f) || dneq(dx[3], si, 0.02f, 0.002f)); }
                  float mine = 0.f;
#pragma unroll
                  for (int hh = 0; hh < 16; ++hh) { const float y = wave_sum(cr[hh] * sr - cim[hh] * si); if (lane == hh) mine = y; }
                  if (lane < 16) { const float pt = F.out[(size_t)(tokbase + t) * D + g * 16 + lane];
                      const float mined = mine + F.in[I_S5D][dir * D + g * 16 + lane] * bf2f(ur[lane]);
                      if (dir == 0) { yf[(size_t)t * 16 + lane] = mine; if (t < L / 2) dfail(F, lat ? 10 : 6, dneq(pt, mined, 0.03f, 0.01f)); }
                      else { if (t >= L / 2) dfail(F, lat ? 11 : 7, dneq(pt, mined, 0.03f, 0.01f)); const float u = bf2f(ur[lane]); const float tot = yf[(size_t)t * 16 + lane] + mine + (F.in[I_S5D][g * 16 + lane] + F.in[I_S5D][D + g * 16 + lane]) * u;
                          const float ref = tot / (1.f + expf(-1.5957691216f * (tot + 0.044715f * tot * tot * tot)));
                          dfail(F, lat ? 12 : 8, dneq(bf2f(V[(size_t)(tokbase + t) * D + g * 16 + lane]), ref, 0.03f, 0.03f)); } }
              }
              if (!lat) { const float* o = F.out + (size_t)M * D + ((size_t)(seq * 2 + dir) * 2) * 4096 + g * 64 + lane; dfail(F, 9, dneq(o[0], sr, 0.02f, 0.01f) || dneq(o[4096], si, 0.02f, 0.01f)); }
              __builtin_amdgcn_s_waitcnt(0);
          } }
        for (int s = F.tid; s < 2048; s += 512) { const unsigned h = dh(s + 999u); const int tok = h % M, o = (h >> 14) % DPOOL, gi = o >> 7, w = 2 << gi; const bool lat = tok >= M_CTX;
            const int npr = lat ? 64 : L_CTX, rs = lat ? (tok & ~63) : (tok & ~255), tt = tok - rs, lo = max(tt - w / 2, 0), hi = min(tt - w / 2 + w, npr); const bf16* UB = (const bf16*)(ws + WS_UB); double a = 0;
            for (int i = 0; i < 128; ++i) { double sum = 0; for (int q = lo; q < hi; ++q) sum += bf2f(UB[(size_t)(rs + q) * DPOOL + gi * 128 + i]);
                const double pm = sum / (hi - lo) - bf2f(UB[(size_t)tok * DPOOL + gi * 128 + i]); a += pm * (double)F.in[I_WPOOL][((size_t)gi * 128 + i) * 128 + (o & 127)]; }
            a *= F.in[I_PSCALE][o]; dfail(F, 13, dneq(bf2f(((const bf16*)(ws + WS_P))[(size_t)tok * D + o]), (float)a, 0.02f, 0.02f)); }
    }
    if (phase == 4) {
        for (int s = F.tid; s < 2048; s += 512) { const unsigned h = dh(s + 41u); const int m = h % M, c = (h >> 14) % D; const bf16* vr = (const bf16*)(ws + WS_RA) + (size_t)m * D; double a = F.in[I_BGLU][c];
            for (int k = 0; k < D; ++k) a += (double)bf2f(vr[k]) * (double)F.in[I_WGLU][(size_t)k * D + c];
            const double ref = bf2f(vr[c]) / (1.0 + exp(-a)); dfail(F, 14, dneq(bf2f(((const bf16*)(ws + WS_RB))[(size_t)m * D + c]), (float)ref, 0.02f, 0.02f)); }
    }
    if (phase == 5) {
        for (int s = F.tid; s < 2048; s += 512) { const unsigned h = dh(s + 51u); const int m = h % M, c = (h >> 14) % D; const bf16* v2 = (const bf16*)(ws + WS_RB) + (size_t)m * D; const bf16* pr = (const bf16*)(ws + WS_P) + (size_t)m * D; double ya = 0, yb = 0;
            for (int k = 0; k < D; ++k) ya += (double)bf2f(v2[k]) * (double)F.in[I_WPA][(size_t)k * D + c];
            for (int k = 0; k < DPOOL; ++k) yb += (double)bf2f(pr[k]) * (double)F.in[I_WPB][(size_t)k * D + c];
            const double ref = bf2f(((const bf16*)(ws + WS_GA))[(size_t)m * D + c]) * ya + bf2f(((const bf16*)(ws + WS_GB))[(size_t)m * D + c]) * yb;
            dfail(F, 15, dneq(bf2f(((const bf16*)(ws + WS_RA))[(size_t)m * D + c]), (float)ref, 0.03f, 0.03f)); }
    }
    if (phase == 6) {
        for (int s = F.tid; s < 2048; s += 512) { const unsigned h = dh(s + 61u); const int m = h % M, c = (h >> 14) % D; const bf16* mr = (const bf16*)(ws + WS_RA) + (size_t)m * D; double a = F.in[I_BOUT][c];
            for (int k = 0; k < D; ++k) a += (double)bf2f(mr[k]) * (double)F.in[I_WOUT][(size_t)k * D + c];
            const float* mf = (const float*)(ws + WS_MODF) + (size_t)batch_of_row(m) * 6144; const double ref = (double)DN_ALPHA * xrow_ptr(F, m)[c] + mf[2 * D + c] * a;
            dfail(F, 16, dneq(bf2f(((const bf16*)F.out)[(size_t)m * D + c]), (float)ref, 0.012f, 0.02f)); }
    }
    if (phase == 7) {
        for (int s = F.tid; s < 1024; s += 512) { const unsigned h = dh(s + 71u); const int m = h % M, j = (h >> 16) % D; const bf16* r = (const bf16*)F.out + (size_t)m * D; double mu = 0, var = 0;
            for (int k = 0; k < D; ++k) mu += bf2f(r[k]); mu /= D; for (int k = 0; k < D; ++k) { const double dd = bf2f(r[k]) - mu; var += dd * dd; } var /= D; const double rs = 1.0 / sqrt(var + 1e-6);
            const float* st = (const float*)(ws + WS_STATS) + 2 * m;
            double m2 = 0, v2 = 0; for (int k = 0; k < D; ++k) m2 += (bf2f(r[k]) - mu) * rs * F.in[I_LN1G][k] + F.in[I_LN1B][k]; m2 /= D;
            for (int k = 0; k < D; ++k) { const double x1 = (bf2f(r[k]) - mu) * rs * F.in[I_LN1G][k] + F.in[I_LN1B][k] - m2; v2 += x1 * x1; } v2 /= D;
            const float* mf = (const float*)(ws + WS_MODF) + (size_t)batch_of_row(m) * 6144; const double x1j = (bf2f(r[j]) - mu) * rs * F.in[I_LN1G][j] + F.in[I_LN1B][j];
            const double y = (x1j - m2) / sqrt(v2 + 1e-6) * (1.0 + mf[4 * D + j]) + mf[3 * D + j];
            dfail(F, 17, dneq(bf2f(((const bf16*)(ws + WS_RB))[(size_t)m * D + j]), (float)y, 0.006f, 0.004f) || dneq(st[0], (float)mu, 1e-4f, 1e-5f) || dneq(st[1], (float)rs, 1e-4f, 1e-5f)); }
    }
    if (phase == 8) {
        for (int s = F.tid; s < 2048; s += 512) { const unsigned h = dh(s + 81u); const int m = h % M, c = (h >> 14) % DFF; const bf16* hr = (const bf16*)(ws + WS_RB) + (size_t)m * D; double a = F.in[I_B1][c];
            for (int k = 0; k < D; ++k) a += (double)bf2f(hr[k]) * (double)F.in[I_W1][(size_t)k * DFF + c];
            a = a > 0 ? a * a : 0; dfail(F, 18, dneq(bf2f(((const bf16*)(ws + WS_HM))[(size_t)m * DFF + c]), (float)a, 0.02f, 0.02f)); }
    }
    if (phase == 9) {
        for (int s = F.tid; s < 2048; s += 512) { const unsigned h = dh(s + 91u); const int m = h % M, c = (h >> 14) % D; const bf16* hr = (const bf16*)(ws + WS_HM) + (size_t)m * DFF; double a = F.in[I_B2][c];
            for (int k = 0; k < DFF; ++k) a += (double)bf2f(hr[k]) * (double)F.in[I_W2][(size_t)k * D + c];
            const float* st = (const float*)(ws + WS_STATS) + 2 * m; const double x1 = ((double)bf2f(((const bf16*)F.out)[(size_t)m * D + c]) - st[0]) * st[1] * F.in[I_LN1G][c] + F.in[I_LN1B][c];
            const float* mf = (const float*)(ws + WS_MODF) + (size_t)batch_of_row(m) * 6144; const double ref = (double)DN_ALPHA * x1 + mf[5 * D + c] * a;
            dfail(F, 19, dneq(bf2f(((const bf16*)(ws + WS_RA))[(size_t)m * D + c]), (float)ref, 0.012f, 0.02f)); }
    }
}
__device__ __forceinline__ void dbg_encode(Frame& F) {
    int code = 0;
    for (int k = 24; k >= 1; --k) { if (k == 20 || k == 21) continue; if (__hip_atomic_load((unsigned*)(F.ctl + CW_FAIL + k), __ATOMIC_RELAXED, __HIP_MEMORY_SCOPE_AGENT) != 0u) code = k; }
    if (code == 6) { if (__hip_atomic_load((unsigned*)(F.ctl + CW_FAIL + 21), __ATOMIC_RELAXED, __HIP_MEMORY_SCOPE_AGENT)) code = 21; if (__hip_atomic_load((unsigned*)(F.ctl + CW_FAIL + 20), __ATOMIC_RELAXED, __HIP_MEMORY_SCOPE_AGENT)) code = 20; }
#if MK_DEBUG_FORCE
    code = MK_DEBUG_FORCE;
#endif
    if (code == 0) return;
    const size_t total = (size_t)M * D + (size_t)NB_CTX * 4 * 4096;
    for (size_t i = (size_t)F.bid * 512 + F.tid; i < total; i += (size_t)F.G * 512) F.out[i] = i < (size_t)M_CTX * D ? (float)(code + 1) : 0.f;
}
#define DBG_CHECK(k) do { if (IN(k)) { xcd_barrier(bar); dbg_check(F, k); } } while (0)
#else
#define DBG_CHECK(k) do { } while (0)
#endif
struct Args { const float* in[33]; float* out; unsigned char* ws; int ph_lo, ph_hi; };
__global__ void __launch_bounds__(NWAVES * 64, 2) mk_fwd(Args args) {
    extern __shared__ __attribute__((aligned(16))) unsigned char lds[];
    Frame F;
    F.lds = (LAS unsigned char*)lds;
    F.MISC = (volatile LAS unsigned*)(F.lds + MISC_OFF);
    F.tid = threadIdx.x; F.lane = F.tid & 63; F.wave = __builtin_amdgcn_readfirstlane(F.tid >> 6);
    F.G = gridDim.x; F.bid = blockIdx.x;
#pragma unroll
    for (int i = 0; i < 33; ++i) F.in[i] = args.in[i];
    F.out = args.out; F.ws = args.ws; F.ctl = (gu32*)(args.ws + WS_CTL);
    unsigned char* ws = args.ws;
    for (int u = F.tid; u < (LDS_BYTES - LDSCTL_OFF) / 4; u += NWAVES * 64) ((LAS unsigned*)(F.lds + LDSCTL_OFF))[u] = 0u;
    __syncthreads();
    XcdBarrier bar = xcd_barrier_post((unsigned*)(F.ctl + CW_BAR), F.MISC + 8);
    const int lo = args.ph_lo, hi = args.ph_hi;
#if MK_STAMP
    if (F.bid == 0 && F.tid == 0 && MK_STAMP == 1) F.MISC[20] = (unsigned)__builtin_amdgcn_s_memrealtime();
#define STAMP(k) do { if (F.bid == 0 && F.tid == 0) { if ((k) == MK_STAMP - 2) F.MISC[20] = (unsigned)__builtin_amdgcn_s_memrealtime(); if ((k) == MK_STAMP - 1) F.MISC[21] = (unsigned)__builtin_amdgcn_s_memrealtime(); } } while (0)
#else
#define STAMP(k) do { } while (0)
#endif
#define IN(k) (lo <= (k) && (k) < hi)
#define SEAM(k) do { if (IN(k) && IN((k) + 1)) xcd_barrier(bar); } while (0)
    typedef pg8::bf16_t bt;
#if MK_POISON
    if (IN(0)) {
        v4u pz = (v4u){0xAAAAAAAAu, 0xAAAAAAAAu, 0xAAAAAAAAu, 0xAAAAAAAAu};
        for (size_t i = (size_t)F.bid * 512 + F.tid; i < ((size_t)M * D * 4 + 2 * MiB) / 16; i += (size_t)F.G * 512) ((v4u*)F.out)[i] = pz;
        for (size_t i = (size_t)F.bid * 512 + F.tid; i < (192 * MiB) / 16; i += (size_t)F.G * 512) ((v4u*)(ws + 36 * MiB))[i] = pz;
        for (size_t i = (size_t)F.bid * 512 + F.tid; i < (256 * 1024) / 16; i += (size_t)F.G * 512) ((v4u*)(ws + WS_STATS))[i] = pz;
    }
#endif
    if (IN(0)) { phase0(F); } DBG_CHECK(0); SEAM(0); STAMP(0);
    if (IN(1)) { phase1(F); } DBG_CHECK(1); SEAM(1); STAMP(1);
    if (IN(2)) {
        pg8::Gemm g{(const bt*)(ws + WS_RA), nullptr, (const bt*)(ws + WS_WIN), nullptr, D / 64, 0, D}; g.id_ = 2; pg8::StaticOrder S; S.init(M, DIN, F.G, F.bid);
        pg8::EpiIn E{(bt*)(ws + WS_RB), (bt*)(ws + WS_UB), (bt*)(ws + WS_GA), (bt*)(ws + WS_GB), F.in[I_BIN]};
        pg8::gemm_phase<pg8::EpiIn, pg8::StaticOrder, true, true>(F.lds, g, S, E);
    } DBG_CHECK(2); SEAM(2); STAMP(2);
    if (IN(3)) {
#if MK_STAMP >= 100
        if (F.bid == MK_TB && F.tid == 0) F.MISC[20] = (unsigned)__builtin_amdgcn_s_memrealtime();
#endif
        if (F.G == 256) {
            if (F.bid < 128) s5_task(F, true, F.bid >> 4, F.bid & 15);
            else for (int i = 0; i < 4; ++i) { const int id = (F.bid - 128) * 4 + i; s5_task(F, false, id >> 4, id & 15); }
        } else {
            for (int t = F.bid; t < 640; t += F.G) { if (t < 128) s5_task(F, true, t >> 4, t & 15); else s5_task(F, false, (t - 128) >> 4, (t - 128) & 15); }
        }
#if MK_STAMP == 100
        if (F.bid == MK_TB && F.tid == 0) F.MISC[21] = (unsigned)__builtin_amdgcn_s_memrealtime();
#endif
#if MK_STAMP == 101
        if (F.bid == MK_TB && F.tid == 0) F.MISC[20] = (unsigned)__builtin_amdgcn_s_memrealtime();
#endif
#if MK_OLDPOOL
        for (int tile = F.bid; tile < M / 64; tile += F.G) pool_task_old(F, tile);
#else
        for (int tile = F.bid; tile < M / 64; tile += F.G) pool_task(F, tile);
#endif
        __syncthreads();
#if MK_STAMP == 101
        if (F.bid == MK_TB && F.tid == 0) F.MISC[21] = (unsigned)__builtin_amdgcn_s_memrealtime();
#endif
    } DBG_CHECK(3); SEAM(3); STAMP(3);
#if MK_TRUNC == 3
    { xcd_barrier(bar); const bf16* src = (const bf16*)(ws + WS_RA);
      for (size_t i = (size_t)F.bid * 512 + F.tid; i < (size_t)M * D; i += (size_t)F.G * 512) { const int tok = (int)(i >> 10); const bool lat = tok >= M_CTX; const int L = lat ? L_LAT : L_CTX, t = lat ? (tok - M_CTX) % L_LAT : tok % L_CTX;
          bool keep = true; if (MK_TSEL == 1) keep = !lat; if (MK_TSEL == 2) keep = lat; if (MK_TSEL == 3) keep = t < L / 2; if (MK_TSEL == 4) keep = t >= L / 2; if (MK_TSEL == 5) keep = (t & 31) < 16; if (MK_TSEL == 6) keep = ((i >> 4) & 1) == 0; if (MK_TSEL == 7) keep = lat && t < 512; if (MK_TSEL == 8) keep = lat && t >= 512; if (MK_TSEL == 9) keep = lat && (t < 32 || t >= 992); if (MK_TSEL == 10) keep = lat && (t >= 480 && t < 544);
          F.out[i] = keep ? bf_lo((unsigned)src[i]) : 0.f; }
      return; }
#endif
    if (IN(4)) {
        pg8::Gemm g{(const bt*)(ws + WS_RA), nullptr, (const bt*)(ws + WS_WGLU), nullptr, D / 64, 0, D}; g.id_ = 4; pg8::StaticOrder S; S.init(M, D, F.G, F.bid);
        pg8::EpiGlu E{(const bt*)(ws + WS_RA), (bt*)(ws + WS_RB), F.in[I_BGLU]};
        pg8::gemm_phase<pg8::EpiGlu, pg8::StaticOrder, true, true>(F.lds, g, S, E);
    } DBG_CHECK(4); SEAM(4); STAMP(4);
    if (IN(5)) {
        pg8::Gemm g{(const bt*)(ws + WS_RB), (const bt*)(ws + WS_P), (const bt*)(ws + WS_WPA), (const bt*)(ws + WS_WPB), D / 64, DPOOL / 64, D}; g.id_ = 5; pg8::StaticOrder S; S.init(M, D, F.G, F.bid, 2);
        pg8::EpiMerge E{(const bt*)(ws + WS_GA), (const bt*)(ws + WS_GB), (bt*)(ws + WS_RA)};
        pg8::gemm_phase<pg8::EpiMerge, pg8::StaticOrder, true, true>(F.lds, g, S, E);
    } DBG_CHECK(5); SEAM(5); STAMP(5);
    if (IN(6)) {
        pg8::Gemm g{(const bt*)(ws + WS_RA), nullptr, (const bt*)(ws + WS_WOUT), nullptr, D / 64, 0, D}; g.id_ = 6; pg8::StaticOrder S; S.init(M, D, F.G, F.bid);
        pg8::EpiRes1 E{F.in[I_XP], F.in[I_XS], (bt*)F.out, F.in[I_BOUT], (const float*)(ws + WS_MODF)};
        pg8::gemm_phase<pg8::EpiRes1, pg8::StaticOrder, true, true>(F.lds, g, S, E);
    } DBG_CHECK(6); SEAM(6); STAMP(6);
    if (IN(7)) { phase_ln1(F, (const bf16*)F.out, (float*)(ws + WS_STATS), (bf16*)(ws + WS_RB)); } DBG_CHECK(7); SEAM(7); STAMP(7);
#if MK_TRUNC == 7
    { xcd_barrier(bar); const bf16* src = (const bf16*)(ws + WS_RB); for (size_t i = (size_t)F.bid * 512 + F.tid; i < (size_t)M * D; i += (size_t)F.G * 512) F.out[i] = bf_lo((unsigned)src[i]); return; }
#endif
    if (IN(8)) {
        pg8::Gemm g{(const bt*)(ws + WS_RB), nullptr, (const bt*)(ws + WS_W1), nullptr, D / 64, 0, D}; g.id_ = 8; pg8::StaticOrder S; S.init(M, DFF, F.G, F.bid);
        pg8::EpiRelu2 E{(bt*)(ws + WS_HM), F.in[I_B1]};
        pg8::gemm_phase<pg8::EpiRelu2, pg8::StaticOrder, true, true>(F.lds, g, S, E);
    } DBG_CHECK(8); SEAM(8); STAMP(8);
#if MK_TRUNC == 8
    { xcd_barrier(bar); const bf16* src = (const bf16*)(ws + WS_HM); for (size_t i = (size_t)F.bid * 512 + F.tid; i < (size_t)M * D; i += (size_t)F.G * 512) F.out[i] = bf_lo((unsigned)src[i * 4 + (i & 3)]); return; }
#endif
    if (IN(9)) {
        pg8::Gemm g{(const bt*)(ws + WS_HM), nullptr, (const bt*)(ws + WS_W2), nullptr, DFF / 64, 0, DFF}; g.id_ = 9; pg8::StaticOrder S; S.init(M, D, F.G, F.bid);
        pg8::EpiRes2 E{(const bt*)F.out, (const float*)(ws + WS_STATS), F.in[I_LN1G], F.in[I_LN1B], (bt*)(ws + WS_RA), F.in[I_B2], (const float*)(ws + WS_MODF)};
        pg8::gemm_phase<pg8::EpiRes2, pg8::StaticOrder, true, true>(F.lds, g, S, E);
    } DBG_CHECK(9); SEAM(9); STAMP(9);
#if MK_TRUNC == 9
    { xcd_barrier(bar); const bf16* src = (const bf16*)(ws + WS_RA); for (size_t i = (size_t)F.bid * 512 + F.tid; i < (size_t)M * D; i += (size_t)F.G * 512) F.out[i] = bf_lo((unsigned)src[i]); return; }
#endif
    if (IN(10)) { phase_ln2(F, (const bf16*)(ws + WS_RA)); }
#if MK_STAMP
    STAMP(10); __syncthreads();
    if (F.bid == (MK_STAMP >= 100 ? MK_TB : 0) && F.tid == 0) { asm volatile("s_waitcnt vmcnt(0)" ::: "memory"); F.out[(size_t)(MK_STAMP >= 100 ? MK_TB : 0) * 64 * D] += (MK_STAMP == 120 || MK_STAMP == 130) ? (float)(F.MISC[18] - F.MISC[17]) * (1.0f / 1000.0f) : (MK_STAMP >= 110) ? (float)F.MISC[16] * (16.0f / 21000.0f) : (float)(F.MISC[21] - F.MISC[20]) * (1.0f / 1000.0f); }
#endif
#if MK_DEBUG
    xcd_barrier(bar); dbg_encode(F);
#endif
#undef IN
#undef SEAM
}

#ifndef MK_SPLIT
#define MK_SPLIT 0
#endif
extern "C" void kernel_launch(void* const* d_in, const int* in_sizes, int n_in, void* d_out, int out_size, void* d_ws, size_t ws_size, hipStream_t stream) {
    static int grid = 0;
    if (grid == 0) {
        if (n_in != 33 || ws_size < WS_END) { fprintf(stderr, "kernel_launch: unexpected inputs (n_in %d, ws %zu)\n", n_in, ws_size); grid = -1; return; }
        int dev = 0, cus = 0, per_cu = 0;
        if (hipGetDevice(&dev) != hipSuccess || hipDeviceGetAttribute(&cus, hipDeviceAttributeMultiprocessorCount, dev) != hipSuccess) { grid = -1; return; }
        if (hipFuncSetAttribute((const void*)mk_fwd, hipFuncAttributeMaxDynamicSharedMemorySize, LDS_BYTES) != hipSuccess) { fprintf(stderr, "kernel_launch: hipFuncSetAttribute failed\n"); grid = -1; return; }
        if (hipOccupancyMaxActiveBlocksPerMultiprocessor(&per_cu, (const void*)mk_fwd, NWAVES * 64, LDS_BYTES) != hipSuccess || per_cu < 1) fprintf(stderr, "kernel_launch: occupancy query says %d blocks per CU\n", per_cu);
        (void)hipGetLastError();
        grid = cus;
    }
    if (grid < 0) return;
    (void)hipMemsetAsync((char*)d_ws + WS_CTL, 0, CTL_ZERO_BYTES, stream);
    Args a{};
    for (int i = 0; i < 33; ++i) a.in[i] = (const float*)d_in[i];
    a.out = (float*)d_out; a.ws = (unsigned char*)d_ws;
#if MK_SPLIT
    for (int p = 0; p <= 10; ++p) { a.ph_lo = p; a.ph_hi = p + 1; hipLaunchKernelGGL(mk_fwd, dim3(grid), dim3(NWAVES * 64), LDS_BYTES, stream, a); }
#else
    a.ph_lo = 0; a.ph_hi = 11;
    hipLaunchKernelGGL(mk_fwd, dim3(grid), dim3(NWAVES * 64), LDS_BYTES, stream, a);
#endif
    const hipError_t le = hipPeekAtLastError();
    if (le != hipSuccess) fprintf(stderr, "kernel_launch: launch failed: %s\n", hipGetErrorName(le));
}
```

```cpp
#include <hip/hip_runtime.h>
#include <cstdio>
#include <cstdint>
#ifndef MK_DEBUG
#define MK_DEBUG 0
#endif
#ifndef MK_DEBUG_FORCE
#define MK_DEBUG_FORCE 0
#endif
#ifndef MK_STAMP
#define MK_STAMP 0
#endif
#ifndef MK_TB
#define MK_TB 0
#endif
#ifndef MK_SA
#define MK_SA 4
#endif
#ifndef MK_SB
#define MK_SB 5
#endif
#ifndef MK_OLDPOOL
#define MK_OLDPOOL 0
#endif
#ifndef MK_NOPR
#define MK_NOPR 0
#endif
#ifndef MK_POISON
#define MK_POISON 0
#endif
#ifndef MK_TRUNC
#define MK_TRUNC 0
#endif
#ifndef MK_HSLEEP
#define MK_HSLEEP 0
#endif
#ifndef MK_TSEL
#define MK_TSEL 2
#endif
#ifndef MK_NOS0
#define MK_NOS0 0
#endif
#ifndef MK_NOUL
#define MK_NOUL 0
#endif
#ifndef MK_GPH
#define MK_GPH 8
#endif
#ifndef MK_GUI
#define MK_GUI 1
#endif
namespace pg8 {
#define PG8_LAS __attribute__((address_space(3)))
typedef unsigned short bf16_t;
typedef short bf16x8 __attribute__((ext_vector_type(8)));
typedef float f32x4 __attribute__((ext_vector_type(4)));
typedef unsigned u32x4 __attribute__((ext_vector_type(4)));
constexpr int BM = 256, BK = 64, HALF = 128, HTB = HALF * BK * 2  , STAGE_BYTES = 8 * HTB, NXCD = 8, WGM = 8;

__host__ __device__ __forceinline__ int lds_byte(int r, int c) { const int st = (r >> 4) * 2 + (c >> 5), rr = r & 15, cc = c & 31, ob = rr * 64 + cc * 2; return st * 1024 + (ob ^ (((ob >> 9) & 1) << 5)); }
__host__ __device__ __forceinline__ void stage_rc(int b, int& R, int& C) { const int st = b / 1024, sb = b % 1024, swz = sb ^ (((sb >> 9) & 1) << 5); R = (st >> 1) * 16 + swz / 64; C = (st & 1) * 32 + (swz % 64) / 2; }
__host__ __device__ __forceinline__ int perm32(int rho) { const int n = rho >> 4, i = rho & 15; return 8 * (i >> 2) + 4 * n + (i & 3); }

struct Unit { int pm, pn, part; };
struct Gemm { const bf16_t *A0, *A1, *B0, *B1; int nt0, nt1, ld; int id_ = 0;
    __device__ __forceinline__ const char* a(int part) const { return (const char*)(part ? A1 : A0); }
    __device__ __forceinline__ const char* b(int part) const { return (const char*)(part ? B1 : B0); }
    __device__ __forceinline__ int nt(int part) const { return part ? nt1 : nt0; } };

struct StaticOrder {
    int nM, nN, nwg, G, c, np;
    __host__ __device__ void init(int M, int N, int G_, int c_, int np_ = 1) { nM = M / BM; nN = N / BM; nwg = nM * nN; G = G_; c = c_; np = np_; }
    __host__ __device__ bool next(int ii, Unit& u) const {
        const int i = (np == 2) ? (ii >> 1) : ii; u.part = (np == 2) ? (ii & 1) : 0;
        const long L = (long)i * G + c; if (L >= nwg) return false;
        int wgid = (int)L; { const int q = nwg / NXCD, r = nwg % NXCD, xcd = wgid % NXCD, off = wgid / NXCD; wgid = (xcd < r ? xcd * (q + 1) : r * (q + 1) + (xcd - r) * q) + off; }
        const int nig = WGM * nN, gid = wgid / nig, fm = gid * WGM, gsz = (nM - fm) < WGM ? (nM - fm) : WGM;
        u.pm = fm + ((wgid % nig) % gsz); u.pn = (wgid % nig) / gsz; return true;
    }
    __device__ __forceinline__ void a_ready(const Unit&) const {}
    __device__ __forceinline__ void done(const Unit&) const {}
};
__device__ __forceinline__ unsigned cvt_pk_bf16(float lo, float hi) { unsigned r; asm volatile("v_cvt_pk_bf16_f32 %0, %1, %2" : "=v"(r) : "v"(lo), "v"(hi)); return r; }
typedef float f32x2 __attribute__((ext_vector_type(2)));
#if MK_STAMP == 130
#define GST(id) do { if (g.id_ == MK_GPH && blockIdx.x == MK_TB && threadIdx.x == 0 && ui == MK_GUI) { if ((id) == MK_SA) ((volatile PG8_LAS unsigned*)(lds + 131072 + 320))[17] = (unsigned)__builtin_amdgcn_s_memrealtime(); if ((id) == MK_SB) ((volatile PG8_LAS unsigned*)(lds + 131072 + 320))[18] = (unsigned)__builtin_amdgcn_s_memrealtime(); } } while (0)
#else
#define GST(id) do { } while (0)
#endif
template <class Epi, class Sched, bool ALIGN_EPI = false, bool SP2 = false>
__device__ __forceinline__ void gemm_phase(PG8_LAS unsigned char* lds, const Gemm g, const Sched& S, const Epi& E) {
    const int tid = threadIdx.x, wid = __builtin_amdgcn_readfirstlane(tid >> 6), lane = tid & 63, wr = wid >> 2, wc = wid & 3, fr = lane & 15, fq = lane >> 4;
    const int K = g.ld;
    unsigned voffA[2], voffB[2];
#pragma unroll
    for (int i = 0; i < 2; ++i) { int R, C; stage_rc(tid * 16 + i * 8192, R, C); const int Rb = Epi::PERM ? ((R & ~31) + perm32(R & 31)) : R;
        voffA[i] = (unsigned)(R * K + C) * 2u; voffB[i] = (unsigned)(Rb * K + C) * 2u; }
    const size_t kstep = (size_t)(BK * 2);
    const size_t hstep = (size_t)HALF * K * 2;
    const size_t tstep = 2 * hstep;
    const unsigned ldsw = (unsigned)wid * 1024u;
    const int aoff = lds_byte(wr * 64 + fr, fq * 8), boff = lds_byte(wc * 32 + fr, fq * 8);
#define PG8_SA(b, h) (((b) * 2 + (h)) * HTB)
#define PG8_SB(b, h) ((4 + (b) * 2 + (h)) * HTB)
#define PG8_STAGE(bufoff, gbase, voff) do { _Pragma("unroll") for (int _i = 0; _i < 2; ++_i) \
        __builtin_amdgcn_global_load_lds((const unsigned*)((const char*)(gbase) + (voff)[_i]), (PG8_LAS unsigned*)(lds + (bufoff) + ldsw + _i * 8192), 16, 0, 0); } while (0)
#define PG8_LDA(dst, b, h) do { _Pragma("unroll") for (int m = 0; m < 4; ++m) _Pragma("unroll") for (int k = 0; k < 2; ++k) dst[m][k] = *(const PG8_LAS bf16x8*)(lds + PG8_SA(b, h) + aoff + m * 2048 + k * 1024); } while (0)
#define PG8_LDB(dst, b, h) do { _Pragma("unroll") for (int n = 0; n < 2; ++n) _Pragma("unroll") for (int k = 0; k < 2; ++k) dst[n][k] = *(const PG8_LAS bf16x8*)(lds + PG8_SB(b, h) + boff + n * 2048 + k * 1024); } while (0)
#define PG8_MMA(ai, bj, At, Bt) do { __builtin_amdgcn_s_setprio(1); _Pragma("unroll") for (int m = 0; m < 4; ++m) _Pragma("unroll") for (int n = 0; n < 2; ++n) _Pragma("unroll") for (int k = 0; k < 2; ++k) \
        acc[ai][bj][m][n] = __builtin_amdgcn_mfma_f32_16x16x32_bf16(Bt[n][k], At[m][k], acc[ai][bj][m][n], 0, 0, 0); __builtin_amdgcn_s_setprio(0); } while (0)
#define PG8_WAIT_V(n) asm volatile("s_waitcnt vmcnt(" #n ")" ::: "memory")
#define PG8_WAIT_L(n) asm volatile("s_waitcnt lgkmcnt(" #n ")" ::: "memory")
#define PG8_BAR __builtin_amdgcn_s_barrier()
#define PG8_SCHED __builtin_amdgcn_sched_barrier(0)
    Unit cur, nxt; int ui = 0;
    if (!S.next(0, cur)) return;
    f32x4 acc[2][2][4][2];
#pragma unroll
    for (int a = 0; a < 2; ++a)
#pragma unroll
        for (int b = 0; b < 2; ++b)
#pragma unroll
            for (int m = 0; m < 4; ++m)
#pragma unroll
                for (int n = 0; n < 2; ++n) acc[a][b][m][n] = (f32x4){0.f, 0.f, 0.f, 0.f};
    bf16x8 At[4][2], B0[2][2], B1[2][2];
    const char* cA = g.a(cur.part) + (size_t)cur.pm * tstep; const char* cB = g.b(cur.part) + (size_t)cur.pn * tstep;
    S.a_ready(cur);
    if constexpr (SP2) {
        PG8_STAGE(PG8_SB(0, 0), cB, voffB); PG8_STAGE(PG8_SB(0, 1), cB + hstep, voffB); PG8_STAGE(PG8_SA(0, 0), cA, voffA); PG8_STAGE(PG8_SA(0, 1), cA + hstep, voffA);
        if (wr == 1) PG8_BAR;
        PG8_WAIT_V(2); PG8_BAR;
        PG8_STAGE(PG8_SB(1, 0), cB + kstep, voffB); PG8_STAGE(PG8_SA(1, 0), cA + kstep, voffA); PG8_STAGE(PG8_SB(1, 1), cB + hstep + kstep, voffB);
        PG8_WAIT_V(6); PG8_BAR;
    } else {
        PG8_STAGE(PG8_SB(0, 0), cB, voffB); PG8_STAGE(PG8_SA(0, 0), cA, voffA); PG8_STAGE(PG8_SB(0, 1), cB + hstep, voffB); PG8_STAGE(PG8_SA(0, 1), cA + hstep, voffA);
        if (wr == 1) PG8_BAR;
        PG8_WAIT_V(4); PG8_BAR;
        PG8_STAGE(PG8_SB(1, 0), cB + kstep, voffB); PG8_STAGE(PG8_SA(1, 0), cA + kstep, voffA); PG8_STAGE(PG8_SB(1, 1), cB + hstep + kstep, voffB);
        PG8_WAIT_V(6); PG8_BAR;
    }
    for (;;) {
        const bool has_next = S.next(ui + 1, nxt);
        const char* nA = has_next ? g.a(nxt.part) + (size_t)nxt.pm * tstep : cA; const char* nB = has_next ? g.b(nxt.part) + (size_t)nxt.pn * tstep : cB;
        const int nt = g.nt(cur.part);
        GST(0);
        for (int t = 0; t < nt; t += 2) {
            const bool last = (t == nt - 2);
            const char* a1 = cA + (size_t)(t + 1) * kstep;
            const char* a2 = last ? nA : cA + (size_t)(t + 2) * kstep; const char* b2 = last ? nB : cB + (size_t)(t + 2) * kstep;
            const char* a3 = a2 + kstep; const char* b3 = b2 + kstep;
            if (last && has_next) S.a_ready(nxt);
            if constexpr (SP2) {
            PG8_LDB(B0, 0, 0); PG8_LDB(B1, 0, 1); PG8_SCHED; PG8_LDA(At, 0, 0); PG8_STAGE(PG8_SA(1, 1), a1 + hstep, voffA); PG8_WAIT_V(8); PG8_WAIT_L(0); PG8_BAR; PG8_MMA(0, 0, At, B0); PG8_MMA(0, 1, At, B1); PG8_BAR; PG8_SCHED;
            PG8_LDA(At, 0, 1); PG8_STAGE(PG8_SB(0, 0), b2, voffB); PG8_STAGE(PG8_SB(0, 1), b2 + hstep, voffB); PG8_STAGE(PG8_SA(0, 0), a2, voffA); PG8_WAIT_V(8); PG8_WAIT_L(0); PG8_BAR; PG8_MMA(1, 0, At, B0); PG8_MMA(1, 1, At, B1); PG8_BAR; PG8_SCHED;
            PG8_LDB(B0, 1, 0); PG8_LDB(B1, 1, 1); PG8_SCHED; PG8_LDA(At, 1, 0); PG8_STAGE(PG8_SA(0, 1), a2 + hstep, voffA); PG8_WAIT_V(8); PG8_WAIT_L(0); PG8_BAR; PG8_MMA(0, 0, At, B0); PG8_MMA(0, 1, At, B1); PG8_BAR; PG8_SCHED;
            PG8_LDA(At, 1, 1); PG8_STAGE(PG8_SB(1, 0), b3, voffB); PG8_STAGE(PG8_SB(1, 1), b3 + hstep, voffB); PG8_STAGE(PG8_SA(1, 0), a3, voffA); PG8_WAIT_V(8); PG8_WAIT_L(0); PG8_BAR; PG8_MMA(1, 0, At, B0); PG8_MMA(1, 1, At, B1); PG8_BAR; PG8_SCHED;
            } else {
            PG8_LDB(B0, 0, 0); PG8_SCHED; PG8_LDA(At, 0, 0); PG8_STAGE(PG8_SA(1, 1), a1 + hstep, voffA);
            PG8_WAIT_L(8); PG8_BAR; PG8_WAIT_L(0); PG8_MMA(0, 0, At, B0); PG8_BAR; PG8_SCHED;
            PG8_LDB(B1, 0, 1); PG8_STAGE(PG8_SB(0, 0), b2, voffB);
            PG8_BAR; PG8_WAIT_L(0); PG8_MMA(0, 1, At, B1); PG8_BAR;
            PG8_LDA(At, 0, 1); PG8_STAGE(PG8_SA(0, 0), a2, voffA);
            PG8_BAR; PG8_WAIT_L(0); PG8_MMA(1, 0, At, B0); PG8_BAR; PG8_SCHED;
            PG8_STAGE(PG8_SB(0, 1), b2 + hstep, voffB);
            PG8_WAIT_V(6); PG8_BAR; PG8_MMA(1, 1, At, B1); PG8_BAR;
            PG8_LDB(B0, 1, 0); PG8_SCHED; PG8_LDA(At, 1, 0); PG8_STAGE(PG8_SA(0, 1), a2 + hstep, voffA);
            PG8_WAIT_L(8); PG8_BAR; PG8_WAIT_L(0); PG8_MMA(0, 0, At, B0); PG8_BAR; PG8_SCHED;
            PG8_LDB(B1, 1, 1); PG8_STAGE(PG8_SB(1, 0), b3, voffB);
            PG8_BAR; PG8_WAIT_L(0); PG8_MMA(0, 1, At, B1); PG8_BAR;
            PG8_LDA(At, 1, 1); PG8_STAGE(PG8_SA(1, 0), a3, voffA);
            PG8_BAR; PG8_WAIT_L(0); PG8_MMA(1, 0, At, B0); PG8_BAR; PG8_SCHED;
            PG8_STAGE(PG8_SB(1, 1), b3 + hstep, voffB);
            PG8_WAIT_V(6); PG8_BAR; PG8_MMA(1, 1, At, B1); PG8_BAR;
            }
        }
        GST(1);
        if constexpr (ALIGN_EPI) { if (wr == 0) PG8_BAR; }
        GST(2);
        if constexpr (!Epi::AFTER_DRAIN) { E(acc, cur, wr, wc, fr, fq); S.done(cur); }
        GST(3);
        if (!has_next) break;
        if (!E.keep(cur)) {
#pragma unroll
        for (int a = 0; a < 2; ++a)
#pragma unroll
            for (int b = 0; b < 2; ++b)
#pragma unroll
                for (int m = 0; m < 4; ++m)
#pragma unroll
                    for (int n = 0; n < 2; ++n) acc[a][b][m][n] = (f32x4){0.f, 0.f, 0.f, 0.f};
        }
        cur = nxt; cA = nA; cB = nB; ++ui;
        if constexpr (ALIGN_EPI) { if (wr == 1) PG8_BAR; }
    }
    PG8_WAIT_V(0);
    if constexpr (!ALIGN_EPI) { if (wr == 0) PG8_BAR; }
    PG8_BAR;
    if constexpr (Epi::AFTER_DRAIN) { E.fused(acc, cur, wr, wc, fr, fq, lds, wid, lane); S.done(cur); }
#undef PG8_SA
#undef PG8_SB
#undef PG8_STAGE
#undef PG8_LDA
#undef PG8_LDB
#undef PG8_MMA
#undef PG8_WAIT_V
#undef PG8_WAIT_L
#undef PG8_BAR
#undef PG8_SCHED
}
}
#define GAS __attribute__((address_space(1)))
#define LAS __attribute__((address_space(3)))
typedef unsigned short bf16;
typedef unsigned v4u __attribute__((ext_vector_type(4)));
typedef float f32x4 __attribute__((ext_vector_type(4)));
typedef short bf16x8 __attribute__((ext_vector_type(8)));
typedef GAS unsigned gu32;
typedef GAS unsigned long long gu64;
#define RLX_AGENT __ATOMIC_RELAXED, __HIP_MEMORY_SCOPE_AGENT
#define LDS_WAIT() asm volatile("s_waitcnt lgkmcnt(0)" ::: "memory")
#define VM_WAIT() asm volatile("s_waitcnt vmcnt(0)" ::: "memory")
__device__ __forceinline__ unsigned long long rt() { return __builtin_amdgcn_s_memrealtime(); }
__device__ __forceinline__ unsigned f2bf(float f) { unsigned u = __builtin_bit_cast(unsigned, f); return (u + 0x7fffu + ((u >> 16) & 1u)) >> 16; }
__device__ __forceinline__ unsigned pk2(float lo, float hi) { return f2bf(lo) | (f2bf(hi) << 16); }

#define XB_TMO      128
#define XB_XCNT(j)  (256  + 64 * (j))
#define XB_XSUB(j)  (1280 + 64 * (j))
#define XB_XGEN(j)  (2304 + 64 * (j))
#define XB_TOP      3328
#define XB_TOPGEN   3392
#define XCD_BAR_WORDS 3456
#define XB_SPIN_CAP (1u << 18)

__device__ __forceinline__ unsigned xb_ld(unsigned* p)              { return __hip_atomic_load(p, __ATOMIC_RELAXED, __HIP_MEMORY_SCOPE_AGENT); }
__device__ __forceinline__ unsigned xb_add(unsigned* p, unsigned v) { return __hip_atomic_fetch_add(p, v, __ATOMIC_RELAXED, __HIP_MEMORY_SCOPE_AGENT); }
__device__ __forceinline__ unsigned xb_xcc_id() { return (unsigned)__builtin_amdgcn_s_getreg((3 << 11) | 20) & 0xFu; }
#define XB_SPIN(cond, bar) do { unsigned _sp = 0; while (cond) { __builtin_amdgcn_s_sleep(1); \
    if ((++_sp & 255u) == 0u) { if (xb_ld(&(bar)[XB_TMO])) break; if (_sp > XB_SPIN_CAP) { atomicAdd(&(bar)[XB_TMO], 1u); break; } } } } while (0)

struct XcdBarrier {
    unsigned* bar; unsigned x;
    volatile LAS unsigned* st;
};

__device__ __forceinline__ XcdBarrier xcd_barrier_post(unsigned* bar, volatile LAS unsigned* st) {
    XcdBarrier b; b.bar = bar; b.x = xb_xcc_id(); b.st = st;
    if (threadIdx.x == 0) (void)xb_add(&bar[XB_XCNT(b.x)], 1u);
    return b;
}
__device__ __forceinline__ void xcd_barrier_complete(unsigned* bar, unsigned x, unsigned& nloc, unsigned& nx) {
    const unsigned G = gridDim.x * gridDim.y * gridDim.z;
    unsigned sum, cnt, mine, sp = 0u;
    for (;;) {
        sum = 0u; cnt = 0u; mine = 0u;
#pragma unroll
        for (unsigned j = 0; j < 16; ++j) { const unsigned c = xb_ld(&bar[XB_XCNT(j)]); sum += c; cnt += (c > 0u) ? 1u : 0u; mine = (j == x) ? c : mine; }
        if (sum == G) break;
        __builtin_amdgcn_s_sleep(1);
        if ((++sp & 255u) == 0u) { if (xb_ld(&bar[XB_TMO])) break; if (sp > XB_SPIN_CAP) { atomicAdd(&bar[XB_TMO], 1u); break; } }
    }
    nloc = mine > 0u ? mine : 1u; nx = cnt > 0u ? cnt : 1u;
}

__device__ __forceinline__ void xcd_barrier(const XcdBarrier& b) {
    asm volatile("s_waitcnt vmcnt(0)" ::: "memory");
    __syncthreads();
    if (threadIdx.x == 0) {
        unsigned* bar = b.bar;
        __builtin_amdgcn_s_waitcnt(0);
        unsigned nloc = b.st[0], nx = b.st[1];
        if (nloc == 0u) { xcd_barrier_complete(bar, b.x, nloc, nx); b.st[0] = nloc; b.st[1] = nx; }
        const unsigned old = xb_add(&bar[XB_XSUB(b.x)], 1u);
        const unsigned gen = old / nloc;
        if (old + 1u == (gen + 1u) * nloc) {
            __builtin_amdgcn_fence(__ATOMIC_RELEASE, "agent");
            asm volatile("s_waitcnt vmcnt(0)" ::: "memory");
            const unsigned og = xb_add(&bar[XB_TOP], 1u);
            const unsigned tg = og / nx;
            if (og + 1u == (tg + 1u) * nx) xb_add(&bar[XB_TOPGEN], 1u);
            else XB_SPIN(xb_ld(&bar[XB_TOPGEN]) == tg, bar);
            __builtin_amdgcn_fence(__ATOMIC_ACQUIRE, "agent");
            xb_add(&bar[XB_XGEN(b.x)], 1u);
            asm volatile("s_waitcnt vmcnt(0)" ::: "memory");
        } else {
            XB_SPIN(xb_ld(&bar[XB_XGEN(b.x)]) == gen, bar);
            __builtin_amdgcn_fence(__ATOMIC_ACQUIRE, "agent");
            asm volatile("s_waitcnt vmcnt(0)" ::: "memory");
        }
    }
    __syncthreads();
}
constexpr int D = 1024, M_CTX = 8192, M = 16384, L_CTX = 256, L_LAT = 1024, NB_CTX = 32, NB_LAT = 8;
constexpr int DIN = 3584, DFF = 4096, DPOOL = 512, NGRP = 64, NST = 64, HG = 16;
constexpr float DN_ALPHA = 1.189207115002721f;
constexpr float LN_EPS = 1e-6f;
constexpr int NWAVES = 8;

constexpr size_t MiB = 1u << 20;
constexpr size_t WS_CTL = 0, CTL_ZERO_BYTES = 64 * 1024;
constexpr size_t WS_MODP = 1 * MiB;
constexpr size_t WS_MODF = 2 * MiB;
constexpr size_t WS_STATS = 2 * MiB + 256 * 1024;
constexpr size_t WS_LAMB = 244 * MiB;
constexpr size_t WS_BB2 = 244 * MiB + 256 * 1024;
constexpr size_t WS_V2 = 245 * MiB + 512 * 1024;
constexpr size_t WS_G2 = 246 * MiB + 768 * 1024;
constexpr size_t WS_BB   = 3 * MiB;
constexpr size_t WS_CT   = 3 * MiB + 512 * 1024;
constexpr size_t WS_WIN = 4 * MiB, WS_WGLU = 11 * MiB, WS_WPA = 13 * MiB, WS_WPB = 15 * MiB, WS_WOUT = 17 * MiB, WS_W1 = 19 * MiB, WS_W2 = 27 * MiB, WS_WPOOL = 35 * MiB;
constexpr size_t WS_RA = 36 * MiB;
constexpr size_t WS_RB = 68 * MiB;
constexpr size_t WS_UB = 100 * MiB;
constexpr size_t WS_GA = 116 * MiB, WS_GB = 148 * MiB;
constexpr size_t WS_P  = 180 * MiB;
constexpr size_t WS_HM = 100 * MiB;
constexpr size_t WS_V  = 212 * MiB;
constexpr size_t WS_END = 248 * MiB;
constexpr int CW_BAR = 1024;

constexpr int RING_BYTES = 131072, LDSCTL_OFF = RING_BYTES, MISC_OFF = LDSCTL_OFF + 320, LDS_BYTES = 147456;

typedef unsigned u32x2 __attribute__((ext_vector_type(2)));
typedef float f32x16 __attribute__((ext_vector_type(16)));
__device__ __forceinline__ float bf_lo(unsigned w) { return __builtin_bit_cast(float, w << 16); }
__device__ __forceinline__ float bf_hi(unsigned w) { return __builtin_bit_cast(float, w & 0xffff0000u); }
__device__ __forceinline__ float fsigmoid(float x) { return __builtin_amdgcn_rcpf(1.0f + __builtin_amdgcn_exp2f(-1.4426950408889634f * x)); }
__device__ __forceinline__ float gelu_tanh(float x) { const float u = x * (1.5957691216057308f + 0.0713548162726f * x * x); return x * fsigmoid(u); }

namespace pg8 {
#define EPI_LOOP_BEGIN _Pragma("unroll") for (int ai = 0; ai < 2; ++ai) _Pragma("unroll") for (int m = 0; m < 4; ++m) { const int row = u.pm * BM + ai * HALF + wr * 64 + m * 16 + fr; _Pragma("unroll") for (int bj = 0; bj < 2; ++bj) { const int cl = bj * HALF + wc * 32 + 8 * fq;
#define EPI_LOOP_END } }
__device__ __forceinline__ u32x4 pack8(const f32x4& a, const f32x4& b) { u32x4 w; w.x = cvt_pk_bf16(a[0], a[1]); w.y = cvt_pk_bf16(a[2], a[3]); w.z = cvt_pk_bf16(b[0], b[1]); w.w = cvt_pk_bf16(b[2], b[3]); return w; }
__device__ __forceinline__ void unpack8(const u32x4& w, f32x4& a, f32x4& b) { a = (f32x4){bf_lo(w.x), bf_hi(w.x), bf_lo(w.y), bf_hi(w.y)}; b = (f32x4){bf_lo(w.z), bf_hi(w.z), bf_lo(w.w), bf_hi(w.w)}; }

struct EpiIn {
    static constexpr bool PERM = true, AFTER_DRAIN = false;
    bf16_t *ua, *ub, *ga, *gb; const float* bias;
    __device__ __forceinline__ bool keep(const Unit&) const { return false; }
    __device__ __forceinline__ int nstores(const Unit&) const { return 16; }
    __device__ __forceinline__ void operator()(f32x4 (&acc)[2][2][4][2], const Unit& u, int wr, int wc, int fr, int fq) const {
        bf16_t* base; int ldc, c0; bool sg;
        if (u.pn < 4) { base = ua; ldc = D; c0 = u.pn * BM; sg = false; } else if (u.pn < 6) { base = ub; ldc = DPOOL; c0 = (u.pn - 4) * BM; sg = false; }
        else if (u.pn < 10) { base = ga; ldc = D; c0 = (u.pn - 6) * BM; sg = true; } else { base = gb; ldc = D; c0 = (u.pn - 10) * BM; sg = true; }
        EPI_LOOP_BEGIN
            const float* bp = bias + u.pn * BM + cl; f32x4 v0 = acc[ai][bj][m][0] + *(const f32x4*)bp, v1 = acc[ai][bj][m][1] + *(const f32x4*)(bp + 4);
            if (sg) {
#pragma unroll
                for (int j = 0; j < 4; ++j) { v0[j] = fsigmoid(v0[j]); v1[j] = fsigmoid(v1[j]); } }
            *(u32x4*)(base + (size_t)row * ldc + c0 + cl) = pack8(v0, v1);
        EPI_LOOP_END
    }
};
struct EpiGlu {
    static constexpr bool PERM = true, AFTER_DRAIN = false;
    const bf16_t* v; bf16_t* o; const float* bias;
    __device__ __forceinline__ bool keep(const Unit&) const { return false; }
    __device__ __forceinline__ int nstores(const Unit&) const { return 16; }
    __device__ __forceinline__ void operator()(f32x4 (&acc)[2][2][4][2], const Unit& u, int wr, int wc, int fr, int fq) const {
        EPI_LOOP_BEGIN
            const int col = u.pn * BM + cl; const float* bp = bias + col; f32x4 t0 = acc[ai][bj][m][0] + *(const f32x4*)bp, t1 = acc[ai][bj][m][1] + *(const f32x4*)(bp + 4);
            f32x4 x0, x1; unpack8(*(const u32x4*)(v + (size_t)row * D + col), x0, x1);
#pragma unroll
            for (int j = 0; j < 4; ++j) { t0[j] = x0[j] * fsigmoid(t0[j]); t1[j] = x1[j] * fsigmoid(t1[j]); }
            *(u32x4*)(o + (size_t)row * D + col) = pack8(t0, t1);
        EPI_LOOP_END
    }
};
struct EpiMerge {
    static constexpr bool PERM = true, AFTER_DRAIN = false;
    const bf16_t *ga, *gb; bf16_t* o;
    __device__ __forceinline__ bool keep(const Unit& u) const { return u.part == 0; }
    __device__ __forceinline__ int nstores(const Unit& u) const { return u.part == 0 ? 0 : 16; }
    __device__ __forceinline__ void operator()(f32x4 (&acc)[2][2][4][2], const Unit& u, int wr, int wc, int fr, int fq) const {
        EPI_LOOP_BEGIN
            const size_t off = (size_t)row * D + u.pn * BM + cl; f32x4 b0, b1; unpack8(*(const u32x4*)(gb + off), b0, b1);
            if (u.part == 0) { f32x4 a0, a1; unpack8(*(const u32x4*)(ga + off), a0, a1);
#pragma unroll
                for (int j = 0; j < 4; ++j) { acc[ai][bj][m][0][j] *= a0[j] * __builtin_amdgcn_rcpf(fmaxf(b0[j], 1e-30f)); acc[ai][bj][m][1][j] *= a1[j] * __builtin_amdgcn_rcpf(fmaxf(b1[j], 1e-30f)); } }
            else { *(u32x4*)(o + off) = pack8(acc[ai][bj][m][0] * b0, acc[ai][bj][m][1] * b1); }
        EPI_LOOP_END
    }
};
struct EpiRes1 {
    static constexpr bool PERM = true, AFTER_DRAIN = false;
    const float *x_ctx, *x_lat; bf16_t* out; const float* bias; const float* modf;
    __device__ __forceinline__ bool keep(const Unit&) const { return false; }
    __device__ __forceinline__ int nstores(const Unit&) const { return 16; }
    __device__ __forceinline__ void operator()(f32x4 (&acc)[2][2][4][2], const Unit& u, int wr, int wc, int fr, int fq) const {
        const int r0 = u.pm * BM; const int bidx = r0 < M_CTX ? 0 : 1 + (r0 - M_CTX) / L_LAT;
        const float* gate = modf + (size_t)bidx * 6 * D + 2 * D; const float* bs = r0 < M_CTX ? x_ctx : x_lat - (size_t)M_CTX * D;
        EPI_LOOP_BEGIN
            const int col = u.pn * BM + cl; const size_t off = (size_t)row * D + col;
            const f32x4 g0 = *(const f32x4*)(gate + col), g1 = *(const f32x4*)(gate + col + 4), c0 = *(const f32x4*)(bias + col), c1 = *(const f32x4*)(bias + col + 4);
            const f32x4 x0 = *(const f32x4*)(bs + off), x1 = *(const f32x4*)(bs + off + 4);
            *(u32x4*)(out + off) = pack8(x0 * DN_ALPHA + g0 * (acc[ai][bj][m][0] + c0), x1 * DN_ALPHA + g1 * (acc[ai][bj][m][1] + c1));
        EPI_LOOP_END
    }
};
struct EpiRes2 {
    static constexpr bool PERM = true, AFTER_DRAIN = false;
    const bf16_t* r1; const float* stats; const float *lg, *lb; bf16_t* out; const float* bias; const float* modf;
    __device__ __forceinline__ bool keep(const Unit&) const { return false; }
    __device__ __forceinline__ int nstores(const Unit&) const { return 16; }
    __device__ __forceinline__ void operator()(f32x4 (&acc)[2][2][4][2], const Unit& u, int wr, int wc, int fr, int fq) const {
        const int r0 = u.pm * BM; const int bidx = r0 < M_CTX ? 0 : 1 + (r0 - M_CTX) / L_LAT;
        const float* gate = modf + (size_t)bidx * 6 * D + 5 * D;
        EPI_LOOP_BEGIN
            const int col = u.pn * BM + cl; const size_t off = (size_t)row * D + col;
            const f32x4 g0 = *(const f32x4*)(gate + col), g1 = *(const f32x4*)(gate + col + 4), c0 = *(const f32x4*)(bias + col), c1 = *(const f32x4*)(bias + col + 4);
            const f32x4 lg0 = *(const f32x4*)(lg + col), lg1 = *(const f32x4*)(lg + col + 4), lb0 = *(const f32x4*)(lb + col), lb1 = *(const f32x4*)(lb + col + 4);
            const float mu = stats[2 * row], rs = stats[2 * row + 1];
            f32x4 x0, x1; unpack8(*(const u32x4*)(r1 + off), x0, x1);
            x0 = (x0 - mu) * rs * lg0 + lb0; x1 = (x1 - mu) * rs * lg1 + lb1;
            *(u32x4*)(out + off) = pack8(x0 * DN_ALPHA + g0 * (acc[ai][bj][m][0] + c0), x1 * DN_ALPHA + g1 * (acc[ai][bj][m][1] + c1));
        EPI_LOOP_END
    }
};
struct EpiRelu2 {
    static constexpr bool PERM = true, AFTER_DRAIN = false;
    bf16_t* o; const float* bias;
    __device__ __forceinline__ bool keep(const Unit&) const { return false; }
    __device__ __forceinline__ int nstores(const Unit&) const { return 16; }
    __device__ __forceinline__ void operator()(f32x4 (&acc)[2][2][4][2], const Unit& u, int wr, int wc, int fr, int fq) const {
        EPI_LOOP_BEGIN
            const int col = u.pn * BM + cl; f32x4 t0 = acc[ai][bj][m][0] + *(const f32x4*)(bias + col), t1 = acc[ai][bj][m][1] + *(const f32x4*)(bias + col + 4);
#pragma unroll
            for (int j = 0; j < 4; ++j) { const float a = fmaxf(t0[j], 0.f), b = fmaxf(t1[j], 0.f); t0[j] = a * a; t1[j] = b * b; }
            *(u32x4*)(o + (size_t)row * DFF + col) = pack8(t0, t1);
        EPI_LOOP_END
    }
};
}
struct Frame {
    LAS unsigned char* lds;
    volatile LAS unsigned* MISC;
    gu32* ctl;
    int tid, lane, wave, G, bid;
    const float* in[33]; float* out; unsigned char* ws;
};
enum { I_XP = 0, I_XS, I_STATE, I_C, I_CCTX, I_WADA, I_BADA, I_WIN, I_BIN, I_LAMRE, I_LAMIM, I_LOGDT, I_BRE, I_BIM, I_CRE, I_CIM, I_S5D, I_WGLU, I_BGLU, I_WPA, I_WPOOL, I_PSCALE, I_WPB,
       I_WOUT, I_BOUT, I_LN1G, I_LN1B, I_W1, I_B1, I_W2, I_B2, I_LN2G, I_LN2B };

__device__ __forceinline__ float wave_sum(float v) {
#pragma unroll
    for (int o = 1; o < 64; o <<= 1) v += __shfl_xor(v, o);
    return v;
}
__device__ __forceinline__ void p0_transpose_item(const float* W, int N, bf16* WT, int ldt, LAS unsigned* scr, int item, int lane) {
    const int nblk = N / 64, kb = item / nblk, nb = item % nblk, k0 = 64 * kb, n0 = 64 * nb, q = lane & 15, kp = lane >> 4;
    f32x4 v0[8], v1[8];
#pragma unroll
    for (int i = 0; i < 8; ++i) { const float* p = W + (size_t)(k0 + 8 * i + 2 * kp) * N + n0 + 4 * q; v0[i] = *(const f32x4*)p; v1[i] = *(const f32x4*)(p + N); }
#pragma unroll
    for (int i = 0; i < 8; ++i)
#pragma unroll
        for (int j = 0; j < 4; ++j) scr[(4 * q + j) * 33 + 4 * i + kp] = pk2(v0[i][j], v1[i][j]);
    LDS_WAIT(); asm volatile("" ::: "memory");
    const int kc = lane & 7;
#pragma unroll
    for (int jj = 0; jj < 8; ++jj) { const int n = 8 * jj + (lane >> 3); const LAS unsigned* s = scr + n * 33 + 4 * kc;
        v4u o; o.x = s[0]; o.y = s[1]; o.z = s[2]; o.w = s[3];
        *(GAS v4u*)(WT + (size_t)(n0 + n) * ldt + k0 + 8 * kc) = o; }
    LDS_WAIT(); asm volatile("" ::: "memory");
}

__device__ __forceinline__ void phase0(Frame& F) {
    unsigned char* ws = F.ws;
    if (F.bid < 96) {
        const int cc = F.bid % 24, kq = F.bid / 24, k0 = kq * 256 + F.wave * 32;
        LAS float* sv = (LAS float*)(F.lds) + F.wave * 288;
        LAS float* red = (LAS float*)(F.lds + 16384);
        if (F.lane < 32) {
#pragma unroll
            for (int r = 0; r < 9; ++r) { const float cv = r == 0 ? F.in[I_CCTX][k0 + F.lane] : F.in[I_C][(size_t)(r - 1) * D + k0 + F.lane]; sv[r * 32 + F.lane] = cv * fsigmoid(cv); }
        }
        LDS_WAIT(); asm volatile("" ::: "memory");
        f32x4 a[9];
#pragma unroll
        for (int r = 0; r < 9; ++r) a[r] = (f32x4){0.f, 0.f, 0.f, 0.f};
        const float* wp = F.in[I_WADA] + (size_t)k0 * 6144 + cc * 256 + F.lane * 4;
#pragma unroll 8
        for (int k = 0; k < 32; ++k) { const f32x4 w = *(const f32x4*)(wp + (size_t)k * 6144);
#pragma unroll
            for (int r = 0; r < 9; ++r) a[r] += w * sv[r * 32 + k]; }
#pragma unroll
        for (int r = 0; r < 9; ++r) *(LAS f32x4*)(red + (F.wave * 9 + r) * 256 + F.lane * 4) = a[r];
        __syncthreads();
        float* mp = (float*)(ws + WS_MODP) + (size_t)kq * 9 * 6144;
        for (int i = F.tid; i < 9 * 256; i += NWAVES * 64) { const int r = i >> 8, c = i & 255; float s = 0.f;
#pragma unroll
            for (int w = 0; w < 8; ++w) s += red[(w * 9 + r) * 256 + c];
            mp[(size_t)r * 6144 + cc * 256 + c] = s; }
        __syncthreads();
    }
    for (int wt = F.bid * NWAVES + F.wave; wt < 2 * NGRP; wt += F.G * NWAVES) {
        const int dir = wt >> 6, g = wt & 63, p = F.lane, it = wt * 64 + p;
        const float lr = F.in[I_LAMRE][it], li = F.in[I_LAMIM][it], dt = expf(F.in[I_LOGDT][wt]);
        const float zr = lr * dt, zi = li * dt, e = expf(zr); float sn, cs; sincosf(zi, &sn, &cs);
        const float lbr = e * cs, lbi = e * sn, l2r = lbr * lbr - lbi * lbi, l2i = 2.f * lbr * lbi;
        const float sh = sinf(0.5f * zi); const float nr = expm1f(zr) * cs - 2.f * sh * sh, ni = lbi;
        const float den = 1.f / (lr * lr + li * li); const float wr_ = (nr * lr + ni * li) * den, wi_ = (ni * lr - nr * li) * den;
        *(f32x4*)((float*)(ws + WS_LAMB) + (size_t)it * 4) = (f32x4){lbr, lbi, l2r, l2i};
        float br[16], bi[16], ar[16], ai[16], cr[16], ci[16];
#pragma unroll
        for (int h = 0; h < 16; ++h) { const float r0 = F.in[I_BRE][(size_t)it * 16 + h], i0 = F.in[I_BIM][(size_t)it * 16 + h];
            br[h] = wr_ * r0 - wi_ * i0; bi[h] = wr_ * i0 + wi_ * r0; ar[h] = lbr * br[h] - lbi * bi[h]; ai[h] = lbr * bi[h] + lbi * br[h];
            const size_t cix = ((size_t)wt * 16 + h) * 64 + p; cr[h] = F.in[I_CRE][cix]; ci[h] = F.in[I_CIM][cix]; }
        { bf16* bb = (bf16*)(ws + WS_BB2);
#pragma unroll
          for (int i = 0; i < 2; ++i)
#pragma unroll
            for (int part = 0; part < 2; ++part) { unsigned o[8];
#pragma unroll
              for (int h = 0; h < 8; ++h) { const float v0 = i == 0 ? (part == 0 ? ar[2 * h] : ai[2 * h]) : (part == 0 ? br[2 * h] : bi[2 * h]), v1 = i == 0 ? (part == 0 ? ar[2 * h + 1] : ai[2 * h + 1]) : (part == 0 ? br[2 * h + 1] : bi[2 * h + 1]); o[h] = pk2(v0, v1); }
              v4u* d = (v4u*)(bb + ((size_t)((i * 128 + wt) * 2 + part) * 64 + p) * 16); d[0] = (v4u){o[0], o[1], o[2], o[3]}; d[1] = (v4u){o[4], o[5], o[6], o[7]}; } }
        { bf16* v2 = (bf16*)(ws + WS_V2) + (size_t)wt * 2 * 16 * 128;
#pragma unroll
          for (int h = 0; h < 16; ++h) { const float c1r = cr[h] * lbr - ci[h] * lbi, c1i = cr[h] * lbi + ci[h] * lbr, c2r = cr[h] * l2r - ci[h] * l2i, c2i = cr[h] * l2i + ci[h] * l2r;
              *(unsigned*)(v2 + (0 * 16 + h) * 128 + 2 * p) = pk2(c1r, -c1i); *(unsigned*)(v2 + (1 * 16 + h) * 128 + 2 * p) = pk2(c2r, -c2i); } }
        { LAS unsigned* sc = (LAS unsigned*)(F.lds + F.wave * 16384);
#pragma unroll
          for (int h = 0; h < 16; ++h) { sc[h * 64 + p] = pk2(cr[h], -ci[h]); sc[1024 + h * 64 + p] = pk2(br[h], bi[h]); sc[2048 + h * 64 + p] = pk2(ar[h], ai[h]); }
          LDS_WAIT(); asm volatile("" ::: "memory");
          f32x4 k0 = (f32x4){0.f, 0.f, 0.f, 0.f}, k1 = (f32x4){0.f, 0.f, 0.f, 0.f};
#pragma unroll
          for (int ks = 0; ks < 4; ++ks) { const int o = (F.lane & 15) * 64 + 16 * ks + 4 * (F.lane >> 4);
              const bf16x8 af = *(const LAS bf16x8*)(sc + o), b0 = *(const LAS bf16x8*)(sc + 1024 + o), b1 = *(const LAS bf16x8*)(sc + 2048 + o);
              k0 = __builtin_amdgcn_mfma_f32_16x16x32_bf16(af, b0, k0, 0, 0, 0); k1 = __builtin_amdgcn_mfma_f32_16x16x32_bf16(af, b1, k1, 0, 0, 0); }
          bf16* g2 = (bf16*)(ws + WS_G2) + (size_t)wt * 2 * 16 * 32; const int hp = F.lane & 15;
#pragma unroll
          for (int r = 0; r < 4; ++r) { const int h = 4 * (F.lane >> 4) + r; const float kd = k0[r] + (h == hp ? F.in[I_S5D][dir * D + g * 16 + h] : 0.f);
              g2[(0 * 16 + h) * 32 + hp] = (bf16)f2bf(kd); g2[(0 * 16 + h) * 32 + 16 + hp] = (bf16)0; g2[(1 * 16 + h) * 32 + hp] = (bf16)f2bf(k1[r]); g2[(1 * 16 + h) * 32 + 16 + hp] = (bf16)f2bf(kd); }
          LDS_WAIT(); asm volatile("" ::: "memory"); }
    }
    {
        LAS unsigned* scr = (LAS unsigned*)(F.lds + F.wave * 16384);
        const int gw = F.bid * NWAVES + F.wave, NGW = F.G * NWAVES;
        constexpr int I_IN = (D / 64) * (DIN / 64), I_SQ = (D / 64) * (D / 64), I_PB = (DPOOL / 64) * (D / 64), I_1 = (D / 64) * (DFF / 64), I_2 = (DFF / 64) * (D / 64), I_PL = 4 * 2 * 2;
        constexpr int NITEMS = I_IN + 3 * I_SQ + I_PB + I_1 + I_2 + I_PL;
        for (int it = gw; it < NITEMS; it += NGW) {
            int r = it;
            if (r < I_1) { p0_transpose_item(F.in[I_W1], DFF, (bf16*)(ws + WS_W1), D, scr, r, F.lane); continue; } r -= I_1;
            if (r < I_2) { p0_transpose_item(F.in[I_W2], D, (bf16*)(ws + WS_W2), DFF, scr, r, F.lane); continue; } r -= I_2;
            if (r < I_IN) { p0_transpose_item(F.in[I_WIN], DIN, (bf16*)(ws + WS_WIN), D, scr, r, F.lane); continue; } r -= I_IN;
            if (r < I_SQ) { p0_transpose_item(F.in[I_WGLU], D, (bf16*)(ws + WS_WGLU), D, scr, r, F.lane); continue; } r -= I_SQ;
            if (r < I_SQ) { p0_transpose_item(F.in[I_WPA], D, (bf16*)(ws + WS_WPA), D, scr, r, F.lane); continue; } r -= I_SQ;
            if (r < I_SQ) { p0_transpose_item(F.in[I_WOUT], D, (bf16*)(ws + WS_WOUT), D, scr, r, F.lane); continue; } r -= I_SQ;
            if (r < I_PB) { p0_transpose_item(F.in[I_WPB], D, (bf16*)(ws + WS_WPB), D, scr, r, F.lane); continue; } r -= I_PB;
            { const int gi = r >> 2; p0_transpose_item(F.in[I_WPOOL] + (size_t)gi * 128 * 128, 128, (bf16*)(ws + WS_WPOOL) + (size_t)gi * 128 * 128, 128, scr, r & 3, F.lane); }
        }
    }
}

__device__ __forceinline__ f32x4 mod4(Frame& F, int bidx, int idx) {
    const float* mp = (const float*)(F.ws + WS_MODP) + (size_t)bidx * 6144 + idx;
    f32x4 s = *(const f32x4*)(F.in[I_BADA] + idx);
#pragma unroll
    for (int q = 0; q < 4; ++q) s += *(const f32x4*)(mp + (size_t)q * 9 * 6144);
    return s;
}
__device__ __forceinline__ int batch_of_row(int r0) { return r0 < M_CTX ? 0 : 1 + (r0 - M_CTX) / L_LAT; }

__device__ __forceinline__ void phase1(Frame& F) {
    LAS f32x4* sc = (LAS f32x4*)(F.lds); LAS f32x4* sh = (LAS f32x4*)(F.lds + 4096);
    bf16* H = (bf16*)(F.ws + WS_RA);
    if (F.bid < 9) { float* mf = (float*)(F.ws + WS_MODF) + (size_t)F.bid * 6144; for (int i = F.tid; i < 6144 / 4; i += NWAVES * 64) *(f32x4*)(mf + 4 * i) = mod4(F, F.bid, 4 * i); }
    for (int rb = F.bid; rb < M / 64; rb += F.G) {
        const int r0 = rb * 64, bidx = batch_of_row(r0);
        __syncthreads();
        if (F.tid < 256) { sc[F.tid] = mod4(F, bidx, D + 4 * F.tid) + 1.0f; sh[F.tid] = mod4(F, bidx, 4 * F.tid); }
        __syncthreads();
        f32x4 xv[8][4];
#pragma unroll
        for (int j = 0; j < 8; ++j) { const int m = r0 + F.wave * 8 + j;
            const float* xrow = (m < M_CTX ? F.in[I_XP] + (size_t)m * D : F.in[I_XS] + (size_t)(m - M_CTX) * D); const GAS f32x4* xr = (const GAS f32x4*)xrow + F.lane;
#pragma unroll
            for (int q = 0; q < 4; ++q) xv[j][q] = xr[64 * q]; }
#pragma unroll
        for (int j = 0; j < 8; ++j) {
            const int m = r0 + F.wave * 8 + j;
            f32x4 v[4]; float s = 0.f;
#pragma unroll
            for (int q = 0; q < 4; ++q) { v[q] = xv[j][q]; s += (v[q].x + v[q].y) + (v[q].z + v[q].w); }
            const float mean = wave_sum(s) * (1.f / D); float s2 = 0.f;
#pragma unroll
            for (int q = 0; q < 4; ++q) { v[q] = v[q] - mean; s2 += (v[q].x * v[q].x + v[q].y * v[q].y) + (v[q].z * v[q].z + v[q].w * v[q].w); }
            const float rstd = 1.f / sqrtf(wave_sum(s2) * (1.f / D) + LN_EPS);
            GAS u32x2* o8 = (GAS u32x2*)(H + (size_t)m * D) + F.lane;
#pragma unroll
            for (int q = 0; q < 4; ++q) { const f32x4 y = v[q] * rstd * sc[F.lane + 64 * q] + sh[F.lane + 64 * q]; u32x2 w; w.x = pg8::cvt_pk_bf16(y.x, y.y); w.y = pg8::cvt_pk_bf16(y.z, y.w); o8[64 * q] = w; }
        }
    }
}

__device__ __forceinline__ void unpack4(const u32x2 w, f32x4& v) { v = (f32x4){bf_lo(w.x), bf_hi(w.x), bf_lo(w.y), bf_hi(w.y)}; }
__device__ __forceinline__ void phase_ln1(Frame& F, const bf16* R1, float* stats, bf16* H2) {
    LAS f32x4* sc = (LAS f32x4*)(F.lds); LAS f32x4* sh = (LAS f32x4*)(F.lds + 4096);
    const float* lg = F.in[I_LN1G]; const float* lb = F.in[I_LN1B];
    for (int rb = F.bid; rb < M / 64; rb += F.G) {
        const int r0 = rb * 64, bidx = batch_of_row(r0);
        __syncthreads();
        const float* mf = (const float*)(F.ws + WS_MODF) + (size_t)bidx * 6144;
        if (F.tid < 256) { sc[F.tid] = *(const f32x4*)(mf + 4 * D + 4 * F.tid) + 1.0f; sh[F.tid] = *(const f32x4*)(mf + 3 * D + 4 * F.tid); }
        __syncthreads();
        f32x4 gg[4], bb[4];
#pragma unroll
        for (int q = 0; q < 4; ++q) { gg[q] = *(const f32x4*)(lg + 4 * (F.lane + 64 * q)); bb[q] = *(const f32x4*)(lb + 4 * (F.lane + 64 * q)); }
        u32x2 raw[8][4];
#pragma unroll
        for (int j = 0; j < 8; ++j)
#pragma unroll
            for (int q = 0; q < 4; ++q) raw[j][q] = ((const GAS u32x2*)(R1 + (size_t)(r0 + F.wave * 8 + j) * D))[F.lane + 64 * q];
#pragma unroll
        for (int j = 0; j < 8; ++j) {
            const int m = r0 + F.wave * 8 + j;
            f32x4 v[4]; float s = 0.f;
#pragma unroll
            for (int q = 0; q < 4; ++q) { unpack4(raw[j][q], v[q]); s += (v[q].x + v[q].y) + (v[q].z + v[q].w); }
            float mean = wave_sum(s) * (1.f / D), s2 = 0.f;
#pragma unroll
            for (int q = 0; q < 4; ++q) { v[q] = v[q] - mean; s2 += (v[q].x * v[q].x + v[q].y * v[q].y) + (v[q].z * v[q].z + v[q].w * v[q].w); }
            float rstd = 1.f / sqrtf(wave_sum(s2) * (1.f / D) + LN_EPS);
            if (F.lane == 0) { stats[2 * m] = mean; stats[2 * m + 1] = rstd; }
            s = 0.f;
#pragma unroll
            for (int q = 0; q < 4; ++q) { v[q] = v[q] * rstd * gg[q] + bb[q]; s += (v[q].x + v[q].y) + (v[q].z + v[q].w); }
            mean = wave_sum(s) * (1.f / D); s2 = 0.f;
#pragma unroll
            for (int q = 0; q < 4; ++q) { v[q] = v[q] - mean; s2 += (v[q].x * v[q].x + v[q].y * v[q].y) + (v[q].z * v[q].z + v[q].w * v[q].w); }
            rstd = 1.f / sqrtf(wave_sum(s2) * (1.f / D) + LN_EPS);
            GAS u32x2* o8 = (GAS u32x2*)(H2 + (size_t)m * D) + F.lane;
#pragma unroll
            for (int q = 0; q < 4; ++q) { const f32x4 y = v[q] * rstd * sc[F.lane + 64 * q] + sh[F.lane + 64 * q]; u32x2 w; w.x = pg8::cvt_pk_bf16(y.x, y.y); w.y = pg8::cvt_pk_bf16(y.z, y.w); o8[64 * q] = w; }
        }
    }
}
__device__ __forceinline__ void phase_ln2(Frame& F, const bf16* R2) {
    const float* lg = F.in[I_LN2G]; const float* lb = F.in[I_LN2B];
    f32x4 gg[4], bb[4];
#pragma unroll
    for (int q = 0; q < 4; ++q) { gg[q] = *(const f32x4*)(lg + 4 * (F.lane + 64 * q)); bb[q] = *(const f32x4*)(lb + 4 * (F.lane + 64 * q)); }
    for (int rb = F.bid; rb < M / 64; rb += F.G) {
        const int r0 = rb * 64;
        u32x2 raw[8][4];
#pragma unroll
        for (int j = 0; j < 8; ++j)
#pragma unroll
            for (int q = 0; q < 4; ++q) raw[j][q] = ((const GAS u32x2*)(R2 + (size_t)(r0 + F.wave * 8 + j) * D))[F.lane + 64 * q];
#pragma unroll
        for (int j = 0; j < 8; ++j) {
            const int m = r0 + F.wave * 8 + j;
            f32x4 v[4]; float s = 0.f;
#pragma unroll
            for (int q = 0; q < 4; ++q) { unpack4(raw[j][q], v[q]); s += (v[q].x + v[q].y) + (v[q].z + v[q].w); }
            const float mean = wave_sum(s) * (1.f / D); float s2 = 0.f;
#pragma unroll
            for (int q = 0; q < 4; ++q) { v[q] = v[q] - mean; s2 += (v[q].x * v[q].x + v[q].y * v[q].y) + (v[q].z * v[q].z + v[q].w * v[q].w); }
            const float rstd = 1.f / sqrtf(wave_sum(s2) * (1.f / D) + LN_EPS);
            GAS f32x4* xr = (GAS f32x4*)(F.out + (size_t)m * D) + F.lane;
#pragma unroll
            for (int q = 0; q < 4; ++q) xr[64 * q] = v[q] * rstd * gg[q] + bb[q];
        }
    }
}
constexpr int S5_ROWB = 288, S5_WAVEB = 32 * S5_ROWB;
__device__ __forceinline__ void s5_task(Frame& F, bool lat, int seq0, int nseq, int gq) {
    const int lane = F.lane, n = lane & 31, hf = lane >> 5, g = gq * 4 + (F.wave >> 1), dir = F.wave & 1, wt = dir * 64 + g;
    const int L = lat ? L_LAT : L_CTX, nch = L / 64;
    const bf16* UA = (const bf16*)(F.ws + WS_RB); bf16* V = (bf16*)(F.ws + WS_RA); float* PART = F.out;
    LAS unsigned char* sl = F.lds + F.wave * S5_WAVEB;
    bf16x8 Bf[2][2][2], Vf[2][4], Gf[2];
    { const bf16* bb = (const bf16*)(F.ws + WS_BB2);
#pragma unroll
      for (int i = 0; i < 2; ++i)
#pragma unroll
        for (int q = 0; q < 2; ++q)
#pragma unroll
          for (int part = 0; part < 2; ++part) Bf[i][q][part] = *(const bf16x8*)(bb + ((size_t)((i * 128 + wt) * 2 + part) * 64 + (n + 32 * q)) * 16 + 8 * hf);
      const bf16* v2 = (const bf16*)(F.ws + WS_V2) + (size_t)wt * 2 * 16 * 128 + (lane & 15) * 128 + 8 * (lane >> 4);
#pragma unroll
      for (int j = 0; j < 2; ++j)
#pragma unroll
        for (int ks = 0; ks < 4; ++ks) Vf[j][ks] = *(const bf16x8*)(v2 + j * 16 * 128 + 32 * ks);
      const bf16* g2 = (const bf16*)(F.ws + WS_G2) + (size_t)wt * 2 * 16 * 32 + (lane & 15) * 32 + 8 * (lane >> 4);
#pragma unroll
      for (int j = 0; j < 2; ++j) Gf[j] = *(const bf16x8*)(g2 + j * 16 * 32); }
    const int p = n + 32 * hf;
    const float lr = ((const float*)(F.ws + WS_LAMB))[((size_t)wt * 64 + p) * 4 + 2], li = ((const float*)(F.ws + WS_LAMB))[((size_t)wt * 64 + p) * 4 + 3];
  for (int sq = 0; sq < nseq; ++sq) {
    const int seq = seq0 + sq, tokbase = lat ? (M_CTX + seq * L_LAT) : seq * L_CTX;
    float sr = 0.f, si = 0.f;
    if (lat) { const float* st = F.in[I_STATE] + ((size_t)(seq * 2 + dir) * 2) * 4096 + g * 64 + p; sr = st[0]; si = st[4096]; }
    const int blkA = 16 * ((n >> 2) & 1) + (n & 3) + 4 * (n >> 3);
    const int tA0 = dir ? 63 - 2 * blkA : 2 * blkA, tA1 = dir ? 62 - 2 * blkA : 2 * blkA + 1;
    const bf16* ua_lane = UA + (size_t)tokbase * D + g * 16 + 8 * hf;
    const bf16* ub_lane = UA + (size_t)tokbase * D + g * 16 + 8 * ((lane >> 4) & 1);
    const int tU0 = dir ? 63 - (2 * (lane & 15) + hf) : 2 * (lane & 15) + hf, tU1 = dir ? 63 - (2 * (16 + (lane & 15)) + hf) : 2 * (16 + (lane & 15)) + hf;
    const int h0 = 4 * (lane >> 4), colg = g * 16 + h0;
    bf16x8 A0 = *(const bf16x8*)(ua_lane + (size_t)((dir ? L - 64 : 0) + tA0) * D), A1 = *(const bf16x8*)(ua_lane + (size_t)((dir ? L - 64 : 0) + tA1) * D);
    for (int c = 0; c < nch; ++c) {
        const int t0 = dir ? L - 64 * (c + 1) : 64 * c;
        if (c == nch / 2) { asm volatile("s_waitcnt vmcnt(0)" ::: "memory"); __syncthreads(); }
        const f32x16 z16 = {0.f, 0.f, 0.f, 0.f, 0.f, 0.f, 0.f, 0.f, 0.f, 0.f, 0.f, 0.f, 0.f, 0.f, 0.f, 0.f};
        f32x16 x00 = __builtin_amdgcn_mfma_f32_32x32x16_bf16(A0, Bf[0][0][0], z16, 0, 0, 0);
        f32x16 x01 = __builtin_amdgcn_mfma_f32_32x32x16_bf16(A0, Bf[0][0][1], z16, 0, 0, 0);
        f32x16 x10 = __builtin_amdgcn_mfma_f32_32x32x16_bf16(A0, Bf[0][1][0], z16, 0, 0, 0);
        f32x16 x11 = __builtin_amdgcn_mfma_f32_32x32x16_bf16(A0, Bf[0][1][1], z16, 0, 0, 0);
        x00 = __builtin_amdgcn_mfma_f32_32x32x16_bf16(A1, Bf[1][0][0], x00, 0, 0, 0);
        x01 = __builtin_amdgcn_mfma_f32_32x32x16_bf16(A1, Bf[1][0][1], x01, 0, 0, 0);
        x10 = __builtin_amdgcn_mfma_f32_32x32x16_bf16(A1, Bf[1][1][0], x10, 0, 0, 0);
        x11 = __builtin_amdgcn_mfma_f32_32x32x16_bf16(A1, Bf[1][1][1], x11, 0, 0, 0);
        const bf16x8 Ub0 = *(const bf16x8*)(ub_lane + (size_t)(t0 + tU0) * D), Ub1 = *(const bf16x8*)(ub_lane + (size_t)(t0 + tU1) * D);
        if (c + 1 < nch) { const int t1 = dir ? L - 64 * (c + 2) : 64 * (c + 1); A0 = *(const bf16x8*)(ua_lane + (size_t)(t1 + tA0) * D); A1 = *(const bf16x8*)(ua_lane + (size_t)(t1 + tA1) * D); }
        float xr0[16], xi0[16], xr1[16], xi1[16];
#pragma unroll
        for (int i = 0; i < 16; ++i) {
            { auto r = __builtin_amdgcn_permlane32_swap(__float_as_uint(x00[i]), __float_as_uint(x10[i]), false, false); xr0[i] = __uint_as_float(r[0]); xr1[i] = __uint_as_float(r[1]); }
            { auto r = __builtin_amdgcn_permlane32_swap(__float_as_uint(x01[i]), __float_as_uint(x11[i]), false, false); xi0[i] = __uint_as_float(r[0]); xi1[i] = __uint_as_float(r[1]); }
        }
        LAS unsigned* srow = (LAS unsigned*)(sl + p * 4);
#pragma unroll
        for (int i = 0; i < 16; ++i) { srow[i * (S5_ROWB / 4)] = pg8::cvt_pk_bf16(sr, si); const float nr = lr * sr - li * si + xr0[i], ni = lr * si + li * sr + xi0[i]; sr = nr; si = ni; }
#pragma unroll
        for (int i = 0; i < 16; ++i) { srow[(16 + i) * (S5_ROWB / 4)] = pg8::cvt_pk_bf16(sr, si); const float nr = lr * sr - li * si + xr1[i], ni = lr * si + li * sr + xi1[i]; sr = nr; si = ni; }
        asm volatile("" ::: "memory");
        f32x4 y[2][2];
#pragma unroll
        for (int ct = 0; ct < 2; ++ct) { bf16x8 sb[4];
#pragma unroll
            for (int ks = 0; ks < 4; ++ks) sb[ks] = *(const LAS bf16x8*)(sl + (16 * ct + (lane & 15)) * S5_ROWB + (32 * ks + 8 * (lane >> 4)) * 2);
#pragma unroll
            for (int j = 0; j < 2; ++j) { f32x4 a = (f32x4){0.f, 0.f, 0.f, 0.f};
#pragma unroll
                for (int ks = 0; ks < 4; ++ks) a = __builtin_amdgcn_mfma_f32_16x16x32_bf16(Vf[j][ks], sb[ks], a, 0, 0, 0);
                y[ct][j] = __builtin_amdgcn_mfma_f32_16x16x32_bf16(Gf[j], ct == 0 ? Ub0 : Ub1, a, 0, 0, 0); } }
        asm volatile("" ::: "memory");
        size_t off[2][2];
#pragma unroll
        for (int ct = 0; ct < 2; ++ct)
#pragma unroll
          for (int j = 0; j < 2; ++j) { const int tau = 2 * (16 * ct + (lane & 15)) + j; off[ct][j] = (size_t)(tokbase + t0 + (dir ? 63 - tau : tau)) * D + colg; }
        if (c < nch / 2) {
#pragma unroll
            for (int ct = 0; ct < 2; ++ct)
#pragma unroll
              for (int j = 0; j < 2; ++j) *(f32x4*)(PART + off[ct][j]) = y[ct][j];
        } else {
            f32x4 pv[2][2];
#pragma unroll
            for (int ct = 0; ct < 2; ++ct)
#pragma unroll
              for (int j = 0; j < 2; ++j) pv[ct][j] = *(const f32x4*)(PART + off[ct][j]);
#pragma unroll
            for (int ct = 0; ct < 2; ++ct)
#pragma unroll
              for (int j = 0; j < 2; ++j) { const f32x4 t = y[ct][j] + pv[ct][j];
                u32x2 w; w.x = pg8::cvt_pk_bf16(gelu_tanh(t.x), gelu_tanh(t.y)); w.y = pg8::cvt_pk_bf16(gelu_tanh(t.z), gelu_tanh(t.w)); *(u32x2*)(V + off[ct][j]) = w; }
        }
    }
    if (!lat) { float* o = F.out + (size_t)M * D + ((size_t)(seq * 2 + dir) * 2) * 4096 + g * 64 + p; o[0] = sr; o[4096] = si; }
  }
}

constexpr int PL_ROWB = 1056;
#if MK_STAMP == 120
#define PST(id) do { if (F.bid == MK_TB && F.tid == 0) { if ((id) == MK_SA) F.MISC[17] = (unsigned)__builtin_amdgcn_s_memrealtime(); if ((id) == MK_SB) F.MISC[18] = (unsigned)__builtin_amdgcn_s_memrealtime(); } } while (0)
#else
#define PST(id) do { } while (0)
#endif
__device__ __forceinline__ void pool_task(Frame& F, int tile) {
    PST(0);
    const int tok0 = tile * 64; const bool lat = tile >= M_CTX / 64; const int npr = lat ? 64 : L_CTX, off = lat ? 0 : (tile & 3) * 64;
    const bf16* UB = (const bf16*)(F.ws + WS_UB); bf16* P = (bf16*)(F.ws + WS_P); const bf16* WPT = (const bf16*)(F.ws + WS_WPOOL);
    LAS unsigned char* ul = F.lds;
    const int lane = F.lane, gi3 = F.wave >> 1, oh = F.wave & 1;
    bf16x8 Wf[4][4];
#pragma unroll
    for (int ot = 0; ot < 4; ++ot)
#pragma unroll
        for (int ks = 0; ks < 4; ++ks) Wf[ot][ks] = *(const bf16x8*)(WPT + ((size_t)gi3 * 128 + 64 * oh + 16 * ot + (lane & 15)) * 128 + 32 * ks + 8 * (lane >> 4));
    f32x4 psc[4];
#pragma unroll
    for (int ot = 0; ot < 4; ++ot) psc[ot] = *(const f32x4*)(F.in[I_PSCALE] + gi3 * 128 + 64 * oh + 4 * (lane >> 4) + 16 * ot);
    __syncthreads();
    PST(1);
    { v4u v[10];
#pragma unroll
      for (int q = 0; q < 10; ++q) { const int i = F.tid + q * 512, j = i >> 6, pc = i & 63; const int tt = off + j - 8, ttc = min(max(tt, 0), npr - 1);
          v[q] = *(const v4u*)(UB + (size_t)(tok0 - off + ttc) * DPOOL + pc * 8); }
#pragma unroll
      for (int q = 0; q < 10; ++q) { const int i = F.tid + q * 512, j = i >> 6, pc = i & 63; const int tt = off + j - 8; const bool ok = tt >= 0 && tt < npr;
          v4u w = v[q]; w.x = ok ? w.x : 0u; w.y = ok ? w.y : 0u; w.z = ok ? w.z : 0u; w.w = ok ? w.w : 0u; *(LAS v4u*)(ul + j * PL_ROWB + pc * 16) = w; } }
    __syncthreads();
    PST(2);
    unsigned pm[32];
    { const int cp = F.tid & 255, th = F.tid >> 8, gi = cp >> 6, w = 2 << gi, hw = w >> 1; const LAS unsigned char* ucol = ul + cp * 4 + (th * 32 + 8) * PL_ROWB;
      float s0 = 0.f, s1 = 0.f;
      for (int d = -hw; d < hw; ++d) { const unsigned x = *(const LAS unsigned*)(ucol + d * PL_ROWB); s0 += bf_lo(x); s1 += bf_hi(x); }
      const int tt0 = off + th * 32;
#pragma unroll
      for (int j = 0; j < 32; ++j) {
          const unsigned xc = *(const LAS unsigned*)(ucol + j * PL_ROWB); const int tt = tt0 + j; const float inv = __builtin_amdgcn_rcpf((float)(min(tt - hw + w, npr) - max(tt - hw, 0)));
          pm[j] = pg8::cvt_pk_bf16(s0 * inv - bf_lo(xc), s1 * inv - bf_hi(xc));
          const unsigned xa = *(const LAS unsigned*)(ucol + (j + hw) * PL_ROWB), xs = *(const LAS unsigned*)(ucol + (j - hw) * PL_ROWB);
          s0 += bf_lo(xa) - bf_lo(xs); s1 += bf_hi(xa) - bf_hi(xs); }
      PST(3);
      __syncthreads();
#pragma unroll
      for (int j = 0; j < 32; ++j) *(LAS unsigned*)(ul + (th * 32 + j) * PL_ROWB + cp * 4) = pm[j]; }
    __syncthreads();
    PST(4);
    { const int obase = gi3 * 128 + 64 * oh + 4 * (lane >> 4);
#pragma unroll
      for (int tt = 0; tt < 4; ++tt) { bf16x8 pb[4];
#pragma unroll
          for (int ks = 0; ks < 4; ++ks) pb[ks] = *(const LAS bf16x8*)(ul + (16 * tt + (lane & 15)) * PL_ROWB + (gi3 * 128 + 32 * ks + 8 * (lane >> 4)) * 2);
#pragma unroll
          for (int ot = 0; ot < 4; ++ot) { f32x4 a = (f32x4){0.f, 0.f, 0.f, 0.f};
#pragma unroll
              for (int ks = 0; ks < 4; ++ks) a = __builtin_amdgcn_mfma_f32_16x16x32_bf16(Wf[ot][ks], pb[ks], a, 0, 0, 0);
              const int o0 = obase + 16 * ot; a = a * psc[ot]; u32x2 wv; wv.x = pg8::cvt_pk_bf16(a.x, a.y); wv.y = pg8::cvt_pk_bf16(a.z, a.w);
              *(u32x2*)(P + (size_t)(tok0 + 16 * tt + (lane & 15)) * D + o0) = wv; } } }
    PST(5);
}
constexpr int PLO_ROWB = 288;
__device__ __forceinline__ void pool_task_old(Frame& F, int tile) {
    const int tok0 = tile * 64; const bool lat = tile >= M_CTX / 64; const int npr = lat ? 64 : L_CTX, off = lat ? 0 : (tile & 3) * 64;
    const bf16* UB = (const bf16*)(F.ws + WS_UB); bf16* P = (bf16*)(F.ws + WS_P); const bf16* WPT = (const bf16*)(F.ws + WS_WPOOL);
    LAS unsigned char* ul = F.lds; LAS unsigned char* pl = F.lds + 80 * PLO_ROWB;
    const int lane = F.lane;
    for (int gi = 0; gi < 4; ++gi) {
        const int w = 2 << gi, hw = w >> 1;
        __syncthreads();
        for (int i = F.tid; i < 80 * 16; i += NWAVES * 64) { const int j = i >> 4, pc = i & 15; const int tt = off + j - 8; v4u v = (v4u){0u, 0u, 0u, 0u};
            if (tt >= 0 && tt < npr) v = *(const v4u*)(UB + (size_t)(tok0 - off + tt) * DPOOL + gi * 128 + pc * 8);
            *(LAS v4u*)(ul + j * PLO_ROWB + pc * 16) = v; }
        __syncthreads();
        { const int cp = F.tid & 63, tr = F.tid >> 6; const LAS unsigned char* ucol = ul + cp * 4;
          int tt = off + tr * 8; int lo = max(tt - hw, 0), hi = min(tt - hw + w, npr); float s0 = 0.f, s1 = 0.f;
          for (int q = lo; q < hi; ++q) { const unsigned x = *(const LAS unsigned*)(ucol + (q - off + 8) * PLO_ROWB); s0 += bf_lo(x); s1 += bf_hi(x); }
          for (int j = 0; j < 8; ++j) {
              const unsigned xc = *(const LAS unsigned*)(ucol + (tr * 8 + j + 8) * PLO_ROWB); const float inv = 1.0f / (float)(hi - lo);
              *(LAS unsigned*)(pl + (tr * 8 + j) * PLO_ROWB + cp * 4) = pg8::cvt_pk_bf16(s0 * inv - bf_lo(xc), s1 * inv - bf_hi(xc));
              ++tt; const int nlo = max(tt - hw, 0), nhi = min(tt - hw + w, npr);
              if (nhi > hi) { const unsigned x = *(const LAS unsigned*)(ucol + (hi - off + 8) * PLO_ROWB); s0 += bf_lo(x); s1 += bf_hi(x); }
              if (nlo > lo) { const unsigned x = *(const LAS unsigned*)(ucol + (lo - off + 8) * PLO_ROWB); s0 -= bf_lo(x); s1 -= bf_hi(x); }
              lo = nlo; hi = nhi; } }
        __syncthreads();
        { bf16x8 Wf[4];
#pragma unroll
          for (int ks = 0; ks < 4; ++ks) Wf[ks] = *(const bf16x8*)(WPT + ((size_t)gi * 128 + 16 * F.wave + (lane & 15)) * 128 + 32 * ks + 8 * (lane >> 4));
          const int o0 = gi * 128 + 16 * F.wave + 4 * (lane >> 4); const f32x4 ps = *(const f32x4*)(F.in[I_PSCALE] + o0);
#pragma unroll
          for (int tt = 0; tt < 4; ++tt) { f32x4 a = (f32x4){0.f, 0.f, 0.f, 0.f};
#pragma unroll
              for (int ks = 0; ks < 4; ++ks) { const bf16x8 pb = *(const LAS bf16x8*)(pl + (16 * tt + (lane & 15)) * PLO_ROWB + (32 * ks + 8 * (lane >> 4)) * 2);
                  a = __builtin_amdgcn_mfma_f32_16x16x32_bf16(Wf[ks], pb, a, 0, 0, 0); }
              a = a * ps; u32x2 wv; wv.x = pg8::cvt_pk_bf16(a.x, a.y); wv.y = pg8::cvt_pk_bf16(a.z, a.w);
              *(u32x2*)(P + (size_t)(tok0 + 16 * tt + (lane & 15)) * D + o0) = wv; } }
    }
}
#if MK_DEBUG
constexpr int CW_FAIL = 8192;
constexpr size_t WS_DBG = 230 * MiB;
__device__ __forceinline__ unsigned dh(unsigned i) { i ^= i >> 16; i *= 0x7feb352du; i ^= i >> 15; i *= 0x846ca68bu; i ^= i >> 16; return i; }
__device__ __forceinline__ float bf2f(bf16 b) { return __builtin_bit_cast(float, (unsigned)b << 16); }
__device__ __forceinline__ void dfail(Frame& F, int id, bool bad) { if (bad) atomicAdd((unsigned*)(F.ctl + CW_FAIL + id), 1u); }
__device__ __forceinline__ bool dneq(float got, float ref, float rel, float abs_) { const float d = fabsf(got - ref); return !(d <= rel * fabsf(ref) + abs_); }
__device__ __forceinline__ const float* xrow_ptr(Frame& F, int m) { return m < M_CTX ? F.in[I_XP] + (size_t)m * D : F.in[I_XS] + (size_t)(m - M_CTX) * D; }

__device__ __forceinline__ void dbg_wt(Frame& F, const float* W, int K, int N, const bf16* WT, int ldt, unsigned salt) {
    for (int s = F.tid; s < 2048; s += 512) { const unsigned h = dh(s * 2u + salt); const int k = h % K, n = (h >> 12) % N; const float w = W[(size_t)k * N + n], t = bf2f(WT[(size_t)n * ldt + k]);
        dfail(F, 1, dneq(t, w, 0.0045f, 1e-30f)); }
}
__device__ __forceinline__ void dbg_check(Frame& F, int phase) {
    if (F.bid != 0) return;
    unsigned char* ws = F.ws;
    if (phase == 0) {
        dbg_wt(F, F.in[I_WIN], D, DIN, (const bf16*)(ws + WS_WIN), D, 11); dbg_wt(F, F.in[I_WGLU], D, D, (const bf16*)(ws + WS_WGLU), D, 12); dbg_wt(F, F.in[I_WPA], D, D, (const bf16*)(ws + WS_WPA), D, 13);
        dbg_wt(F, F.in[I_WPB], DPOOL, D, (const bf16*)(ws + WS_WPB), D, 14); dbg_wt(F, F.in[I_WOUT], D, D, (const bf16*)(ws + WS_WOUT), D, 15); dbg_wt(F, F.in[I_W1], D, DFF, (const bf16*)(ws + WS_W1), D, 16);
        dbg_wt(F, F.in[I_W2], DFF, D, (const bf16*)(ws + WS_W2), DFF, 17);
        for (int gi = 0; gi < 4; ++gi) dbg_wt(F, F.in[I_WPOOL] + gi * 16384, 128, 128, (const bf16*)(ws + WS_WPOOL) + gi * 16384, 128, 18 + gi);
        for (int s = F.tid; s < 2048; s += 512) {
            const int it = dh(s + 77u) % 8192; const int p = it & 63, g = (it >> 6) & 63, dir = it >> 12;
            const double lr = F.in[I_LAMRE][it], li = F.in[I_LAMIM][it], dt = exp((double)F.in[I_LOGDT][dir * 64 + g]);
            const double e = exp(lr * dt), lbr = e * cos(li * dt), lbi = e * sin(li * dt), nr = lbr - 1.0, ni = lbi, den = lr * lr + li * li, wr = (nr * lr + ni * li) / den, wi = (ni * lr - nr * li) / den;
            const float* lamb = (const float*)(ws + WS_LAMB) + (size_t)it * 4; dfail(F, 2, dneq(lamb[0], (float)lbr, 1e-5f, 1e-6f) || dneq(lamb[1], (float)lbi, 1e-5f, 1e-6f));
            const int h = dh(s + 99u) & 15; const double br = F.in[I_BRE][(size_t)it * 16 + h], bi = F.in[I_BIM][(size_t)it * 16 + h];
            const bf16* bb = (const bf16*)(ws + WS_BB2) + (size_t)128 * 2 * 64 * 16;
            dfail(F, 2, dneq(bf2f(bb[((size_t)((dir * 64 + g) * 2 + 0) * 64 + p) * 16 + h]), (float)(wr * br - wi * bi), 0.01f, 1e-6f) || dneq(bf2f(bb[((size_t)((dir * 64 + g) * 2 + 1) * 64 + p) * 16 + h]), (float)(wr * bi + wi * br), 0.01f, 1e-6f));
            const bf16* v2 = (const bf16*)(ws + WS_V2) + ((size_t)(dir * 64 + g) * 2 * 16 + h) * 128; const size_t ci = ((size_t)(dir * 64 + g) * 16 + h) * 64 + p;
            const double cre = F.in[I_CRE][ci], cim = F.in[I_CIM][ci];
            dfail(F, 2, dneq(bf2f(v2[2 * p]), (float)(cre * lbr - cim * lbi), 0.006f, 1e-5f) || dneq(bf2f(v2[2 * p + 1]), (float)-(cre * lbi + cim * lbr), 0.006f, 1e-5f));
        }
    }
    if (phase == 1) {
        for (int s = F.tid; s < 1024; s += 512) {
            const unsigned h = dh(s + 5u); const int r = h % 9, idx = (h >> 8) % 6144; double a = F.in[I_BADA][idx];
            for (int k = 0; k < D; ++k) { const double cv = r == 0 ? F.in[I_CCTX][k] : F.in[I_C][(size_t)(r - 1) * D + k]; a += cv / (1.0 + exp(-cv)) * (double)F.in[I_WADA][(size_t)k * 6144 + idx]; }
            dfail(F, 3, dneq(((const float*)(ws + WS_MODF))[(size_t)r * 6144 + idx], (float)a, 1e-4f, 1e-4f));
        }
        for (int s = F.tid; s < 1024; s += 512) {
            const unsigned h = dh(s + 1234u); const int m = h % M, j = (h >> 16) % D; const float* x = xrow_ptr(F, m); double mu = 0, var = 0;
            for (int k = 0; k < D; ++k) mu += x[k]; mu /= D; for (int k = 0; k < D; ++k) { const double d = x[k] - mu; var += d * d; } var /= D;
            const float* mf = (const float*)(ws + WS_MODF) + (size_t)batch_of_row(m) * 6144;
            const double y = (x[j] - mu) / sqrt(var + 1e-6) * (1.0 + mf[D + j]) + mf[j];
            dfail(F, 4, dneq(bf2f(((const bf16*)(ws + WS_RA))[(size_t)m * D + j]), (float)y, 0.006f, 0.004f));
        }
    }
    if (phase == 2) {
        for (int s = F.tid; s < 2048; s += 512) { const unsigned h = dh(s + 4321u); const int m = h % M, zc = (h >> 14) % DIN; const bf16* hr = (const bf16*)(ws + WS_RA) + (size_t)m * D; double a = F.in[I_BIN][zc];
            for (int k = 0; k < D; ++k) a += (double)bf2f(hr[k]) * (double)F.in[I_WIN][(size_t)k * DIN + zc];
            float got;
            if (zc < 1024) got = bf2f(((const bf16*)(ws + WS_RB))[(size_t)m * D + zc]);
            else if (zc < 1536) got = bf2f(((const bf16*)(ws + WS_UB))[(size_t)m * DPOOL + zc - 1024]);
            else if (zc < 2560) { got = bf2f(((const bf16*)(ws + WS_GA))[(size_t)m * D + zc - 1536]); a = 1.0 / (1.0 + exp(-a)); }
            else { got = bf2f(((const bf16*)(ws + WS_GB))[(size_t)m * D + zc - 2560]); a = 1.0 / (1.0 + exp(-a)); }
            dfail(F, 5, dneq(got, (float)a, 0.01f, 0.02f)); }
    }
    if (phase == 3) {
        { const int w = F.wave, lane = F.lane; const bool lat = w < 2; const unsigned h = dh(w + 31u); const int seq = lat ? (h % NB_LAT) : w, g = lat ? (h >> 8) % NGRP : 3 * w + 1;
          const int L = lat ? L_LAT : L_CTX, tokbase = lat ? M_CTX + seq * L_LAT : seq * L_CTX; const bf16* UA = (const bf16*)(ws + WS_RB); const bf16* V = (const bf16*)(ws + WS_RA);
          float* yf = (float*)(ws + WS_DBG) + (size_t)w * L_LAT * 16;
          for (int dir = 0; dir < 2; ++dir) {
              const int it = (dir * 64 + g) * 64 + lane; const float lr = F.in[I_LAMRE][it], li = F.in[I_LAMIM][it], dt = expf(F.in[I_LOGDT][dir * 64 + g]);
              const float e = expf(lr * dt), lbr = e * cosf(li * dt), lbi = e * sinf(li * dt), nr = lbr - 1.f, ni = lbi, den = 1.f / (lr * lr + li * li), wr = (nr * lr + ni * li) * den, wi = (ni * lr - nr * li) * den;
              float br[16], bi[16], cr[16], cim[16];
#pragma unroll
              for (int hh = 0; hh < 16; ++hh) { const float a = F.in[I_BRE][(size_t)it * 16 + hh], b = F.in[I_BIM][(size_t)it * 16 + hh]; br[hh] = wr * a - wi * b; bi[hh] = wr * b + wi * a;
                  const size_t ci = ((size_t)(dir * 64 + g) * 16 + hh) * 64 + lane; cr[hh] = F.in[I_CRE][ci]; cim[hh] = F.in[I_CIM][ci]; }
              float sr = 0.f, si = 0.f; if (lat) { const float* st = F.in[I_STATE] + ((size_t)(seq * 2 + dir) * 2) * 4096 + g * 64 + lane; sr = st[0]; si = st[4096]; }
              for (int tq = 0; tq < L; ++tq) { const int t = dir ? L - 1 - tq : tq; const bf16* ur = UA + (size_t)(tokbase + t) * D + g * 16; float bur = 0.f, bui = 0.f;
#pragma unroll
                  for (int hh = 0; hh < 16; ++hh) { const float u = bf2f(ur[hh]); bur += br[hh] * u; bui += bi[hh] * u; }
                  const float nsr = lbr * sr - lbi * si + bur, nsi = lbr * si + lbi * sr + bui; sr = nsr; si = nsi;
                  if (!lat && dir == 0 && tq < 32) { const float* dx = (const float*)(ws + 231 * MiB) + (size_t)seq * 32 * 64 * 4 + (tq * 64 + lane) * 4;
                      dfail(F, 20, dneq(dx[0], bur, 0.02f, 0.002f) || dneq(dx[1], bui, 0.02f, 0.002f)); dfail(F, 21, dneq(dx[2], sr, 0.02f, 0.002f) || dneq(dx[3], si, 0.02f, 0.002f)); }
                  float mine = 0.f;
#pragma unroll
                  for (int hh = 0; hh < 16; ++hh) { const float y = wave_sum(cr[hh] * sr - cim[hh] * si); if (lane == hh) mine = y; }
                  if (lane < 16) { const float pt = F.out[(size_t)(tokbase + t) * D + g * 16 + lane];
                      const float mined = mine + F.in[I_S5D][dir * D + g * 16 + lane] * bf2f(ur[lane]);
                      if (dir == 0) { yf[(size_t)t * 16 + lane] = mine; if (t < L / 2) dfail(F, lat ? 10 : 6, dneq(pt, mined, 0.03f, 0.01f)); }
                      else { if (t >= L / 2) dfail(F, lat ? 11 : 7, dneq(pt, mined, 0.03f, 0.01f)); const float u = bf2f(ur[lane]); const float tot = yf[(size_t)t * 16 + lane] + mine + (F.in[I_S5D][g * 16 + lane] + F.in[I_S5D][D + g * 16 + lane]) * u;
                          const float ref = tot / (1.f + expf(-1.5957691216f * (tot + 0.044715f * tot * tot * tot)));
                          dfail(F, lat ? 12 : 8, dneq(bf2f(V[(size_t)(tokbase + t) * D + g * 16 + lane]), ref, 0.03f, 0.03f)); } }
              }
              if (!lat) { const float* o = F.out + (size_t)M * D + ((size_t)(seq * 2 + dir) * 2) * 4096 + g * 64 + lane; dfail(F, 9, dneq(o[0], sr, 0.02f, 0.01f) || dneq(o[4096], si, 0.02f, 0.01f)); }
              __builtin_amdgcn_s_waitcnt(0);
          } }
        for (int s = F.tid; s < 2048; s += 512) { const unsigned h = dh(s + 999u); const int tok = h % M, o = (h >> 14) % DPOOL, gi = o >> 7, w = 2 << gi; const bool lat = tok >= M_CTX;
            const int npr = lat ? 64 : L_CTX, rs = lat ? (tok & ~63) : (tok & ~255), tt = tok - rs, lo = max(tt - w / 2, 0), hi = min(tt - w / 2 + w, npr); const bf16* UB = (const bf16*)(ws + WS_UB); double a = 0;
            for (int i = 0; i < 128; ++i) { double sum = 0; for (int q = lo; q < hi; ++q) sum += bf2f(UB[(size_t)(rs + q) * DPOOL + gi * 128 + i]);
                const double pm = sum / (hi - lo) - bf2f(UB[(size_t)tok * DPOOL + gi * 128 + i]); a += pm * (double)F.in[I_WPOOL][((size_t)gi * 128 + i) * 128 + (o & 127)]; }
            a *= F.in[I_PSCALE][o]; dfail(F, 13, dneq(bf2f(((const bf16*)(ws + WS_P))[(size_t)tok * D + o]), (float)a, 0.02f, 0.02f)); }
    }
    if (phase == 4) {
        for (int s = F.tid; s < 2048; s += 512) { const unsigned h = dh(s + 41u); const int m = h % M, c = (h >> 14) % D; const bf16* vr = (const bf16*)(ws + WS_RA) + (size_t)m * D; double a = F.in[I_BGLU][c];
            for (int k = 0; k < D; ++k) a += (double)bf2f(vr[k]) * (double)F.in[I_WGLU][(size_t)k * D + c];
            const double ref = bf2f(vr[c]) / (1.0 + exp(-a)); dfail(F, 14, dneq(bf2f(((const bf16*)(ws + WS_RB))[(size_t)m * D + c]), (float)ref, 0.02f, 0.02f)); }
    }
    if (phase == 5) {
        for (int s = F.tid; s < 2048; s += 512) { const unsigned h = dh(s + 51u); const int m = h % M, c = (h >> 14) % D; const bf16* v2 = (const bf16*)(ws + WS_RB) + (size_t)m * D; const bf16* pr = (const bf16*)(ws + WS_P) + (size_t)m * D; double ya = 0, yb = 0;
            for (int k = 0; k < D; ++k) ya += (double)bf2f(v2[k]) * (double)F.in[I_WPA][(size_t)k * D + c];
            for (int k = 0; k < DPOOL; ++k) yb += (double)bf2f(pr[k]) * (double)F.in[I_WPB][(size_t)k * D + c];
            const double ref = bf2f(((const bf16*)(ws + WS_GA))[(size_t)m * D + c]) * ya + bf2f(((const bf16*)(ws + WS_GB))[(size_t)m * D + c]) * yb;
            dfail(F, 15, dneq(bf2f(((const bf16*)(ws + WS_RA))[(size_t)m * D + c]), (float)ref, 0.03f, 0.03f)); }
    }
    if (phase == 6) {
        for (int s = F.tid; s < 2048; s += 512) { const unsigned h = dh(s + 61u); const int m = h % M, c = (h >> 14) % D; const bf16* mr = (const bf16*)(ws + WS_RA) + (size_t)m * D; double a = F.in[I_BOUT][c];
            for (int k = 0; k < D; ++k) a += (double)bf2f(mr[k]) * (double)F.in[I_WOUT][(size_t)k * D + c];
            const float* mf = (const float*)(ws + WS_MODF) + (size_t)batch_of_row(m) * 6144; const double ref = (double)DN_ALPHA * xrow_ptr(F, m)[c] + mf[2 * D + c] * a;
            dfail(F, 16, dneq(bf2f(((const bf16*)F.out)[(size_t)m * D + c]), (float)ref, 0.012f, 0.02f)); }
    }
    if (phase == 7) {
        for (int s = F.tid; s < 1024; s += 512) { const unsigned h = dh(s + 71u); const int m = h % M, j = (h >> 16) % D; const bf16* r = (const bf16*)F.out + (size_t)m * D; double mu = 0, var = 0;
            for (int k = 0; k < D; ++k) mu += bf2f(r[k]); mu /= D; for (int k = 0; k < D; ++k) { const double dd = bf2f(r[k]) - mu; var += dd * dd; } var /= D; const double rs = 1.0 / sqrt(var + 1e-6);
            const float* st = (const float*)(ws + WS_STATS) + 2 * m;
            double m2 = 0, v2 = 0; for (int k = 0; k < D; ++k) m2 += (bf2f(r[k]) - mu) * rs * F.in[I_LN1G][k] + F.in[I_LN1B][k]; m2 /= D;
            for (int k = 0; k < D; ++k) { const double x1 = (bf2f(r[k]) - mu) * rs * F.in[I_LN1G][k] + F.in[I_LN1B][k] - m2; v2 += x1 * x1; } v2 /= D;
            const float* mf = (const float*)(ws + WS_MODF) + (size_t)batch_of_row(m) * 6144; const double x1j = (bf2f(r[j]) - mu) * rs * F.in[I_LN1G][j] + F.in[I_LN1B][j];
            const double y = (x1j - m2) / sqrt(v2 + 1e-6) * (1.0 + mf[4 * D + j]) + mf[3 * D + j];
            dfail(F, 17, dneq(bf2f(((const bf16*)(ws + WS_RB))[(size_t)m * D + j]), (float)y, 0.006f, 0.004f) || dneq(st[0], (float)mu, 1e-4f, 1e-5f) || dneq(st[1], (float)rs, 1e-4f, 1e-5f)); }
    }
    if (phase == 8) {
        for (int s = F.tid; s < 2048; s += 512) { const unsigned h = dh(s + 81u); const int m = h % M, c = (h >> 14) % DFF; const bf16* hr = (const bf16*)(ws + WS_RB) + (size_t)m * D; double a = F.in[I_B1][c];
            for (int k = 0; k < D; ++k) a += (double)bf2f(hr[k]) * (double)F.in[I_W1][(size_t)k * DFF + c];
            a = a > 0 ? a * a : 0; dfail(F, 18, dneq(bf2f(((const bf16*)(ws + WS_HM))[(size_t)m * DFF + c]), (float)a, 0.02f, 0.02f)); }
    }
    if (phase == 9) {
        for (int s = F.tid; s < 2048; s += 512) { const unsigned h = dh(s + 91u); const int m = h % M, c = (h >> 14) % D; const bf16* hr = (const bf16*)(ws + WS_HM) + (size_t)m * DFF; double a = F.in[I_B2][c];
            for (int k = 0; k < DFF; ++k) a += (double)bf2f(hr[k]) * (double)F.in[I_W2][(size_t)k * D + c];
            const float* st = (const float*)(ws + WS_STATS) + 2 * m; const double x1 = ((double)bf2f(((const bf16*)F.out)[(size_t)m * D + c]) - st[0]) * st[1] * F.in[I_LN1G][c] + F.in[I_LN1B][c];
            const float* mf = (const float*)(ws + WS_MODF) + (size_t)batch_of_row(m) * 6144; const double ref = (double)DN_ALPHA * x1 + mf[5 * D + c] * a;
            dfail(F, 19, dneq(bf2f(((const bf16*)(ws + WS_RA))[(size_t)m * D + c]), (float)ref, 0.012f, 0.02f)); }
    }
}
__device__ __forceinline__ void dbg_encode(Frame& F) {
    int code = 0;
    for (int k = 24; k >= 1; --k) { if (k == 20 || k == 21) continue; if (__hip_atomic_load((unsigned*)(F.ctl + CW_FAIL + k), __ATOMIC_RELAXED, __HIP_MEMORY_SCOPE_AGENT) != 0u) code = k; }
    if (code == 6) { if (__hip_atomic_load((unsigned*)(F.ctl + CW_FAIL + 21), __ATOMIC_RELAXED, __HIP_MEMORY_SCOPE_AGENT)) code = 21; if (__hip_atomic_load((unsigned*)(F.ctl + CW_FAIL + 20), __ATOMIC_RELAXED, __HIP_MEMORY_SCOPE_AGENT)) code = 20; }
#if MK_DEBUG_FORCE
    code = MK_DEBUG_FORCE;
#endif
    if (code == 0) return;
    const size_t total = (size_t)M * D + (size_t)NB_CTX * 4 * 4096;
    for (size_t i = (size_t)F.bid * 512 + F.tid; i < total; i += (size_t)F.G * 512) F.out[i] = i < (size_t)M_CTX * D ? (float)(code + 1) : 0.f;
}
#define DBG_CHECK(k) do { if (IN(k)) { xcd_barrier(bar); dbg_check(F, k); } } while (0)
#else
#define DBG_CHECK(k) do { } while (0)
#endif
struct Args { const float* in[33]; float* out; unsigned char* ws; int ph_lo, ph_hi; };
__global__ void __launch_bounds__(NWAVES * 64, 2) mk_fwd(Args args) {
    extern __shared__ __attribute__((aligned(16))) unsigned char lds[];
    Frame F;
    F.lds = (LAS unsigned char*)lds;
    F.MISC = (volatile LAS unsigned*)(F.lds + MISC_OFF);
    F.tid = threadIdx.x; F.lane = F.tid & 63; F.wave = __builtin_amdgcn_readfirstlane(F.tid >> 6);
    F.G = gridDim.x; F.bid = blockIdx.x;
#pragma unroll
    for (int i = 0; i < 33; ++i) F.in[i] = args.in[i];
    F.out = args.out; F.ws = args.ws; F.ctl = (gu32*)(args.ws + WS_CTL);
    unsigned char* ws = args.ws;
    for (int u = F.tid; u < (LDS_BYTES - LDSCTL_OFF) / 4; u += NWAVES * 64) ((LAS unsigned*)(F.lds + LDSCTL_OFF))[u] = 0u;
    __syncthreads();
    XcdBarrier bar = xcd_barrier_post((unsigned*)(F.ctl + CW_BAR), F.MISC + 8);
    const int lo = args.ph_lo, hi = args.ph_hi;
#if MK_STAMP
    if (F.bid == 0 && F.tid == 0 && MK_STAMP == 1) F.MISC[20] = (unsigned)__builtin_amdgcn_s_memrealtime();
#define STAMP(k) do { if (F.bid == 0 && F.tid == 0) { if ((k) == MK_STAMP - 2) F.MISC[20] = (unsigned)__builtin_amdgcn_s_memrealtime(); if ((k) == MK_STAMP - 1) F.MISC[21] = (unsigned)__builtin_amdgcn_s_memrealtime(); } } while (0)
#else
#define STAMP(k) do { } while (0)
#endif
#define IN(k) (lo <= (k) && (k) < hi)
#define SEAM(k) do { if (IN(k) && IN((k) + 1)) xcd_barrier(bar); } while (0)
    typedef pg8::bf16_t bt;
#if MK_POISON
    if (IN(0)) {
        v4u pz = (v4u){0xAAAAAAAAu, 0xAAAAAAAAu, 0xAAAAAAAAu, 0xAAAAAAAAu};
        for (size_t i = (size_t)F.bid * 512 + F.tid; i < ((size_t)M * D * 4 + 2 * MiB) / 16; i += (size_t)F.G * 512) ((v4u*)F.out)[i] = pz;
        for (size_t i = (size_t)F.bid * 512 + F.tid; i < (192 * MiB) / 16; i += (size_t)F.G * 512) ((v4u*)(ws + 36 * MiB))[i] = pz;
        for (size_t i = (size_t)F.bid * 512 + F.tid; i < (256 * 1024) / 16; i += (size_t)F.G * 512) ((v4u*)(ws + WS_STATS))[i] = pz;
    }
#endif
    if (IN(0)) { phase0(F); } DBG_CHECK(0); SEAM(0); STAMP(0);
    if (IN(1)) { phase1(F); } DBG_CHECK(1); SEAM(1); STAMP(1);
    if (IN(2)) {
        pg8::Gemm g{(const bt*)(ws + WS_RA), nullptr, (const bt*)(ws + WS_WIN), nullptr, D / 64, 0, D}; g.id_ = 2; pg8::StaticOrder S; S.init(M, DIN, F.G, F.bid);
        pg8::EpiIn E{(bt*)(ws + WS_RB), (bt*)(ws + WS_UB), (bt*)(ws + WS_GA), (bt*)(ws + WS_GB), F.in[I_BIN]};
        pg8::gemm_phase<pg8::EpiIn, pg8::StaticOrder, true, true>(F.lds, g, S, E);
    } DBG_CHECK(2); SEAM(2); STAMP(2);
    if (IN(3)) {
#if MK_STAMP >= 100
        if (F.bid == MK_TB && F.tid == 0) F.MISC[20] = (unsigned)__builtin_amdgcn_s_memrealtime();
#endif
        if (F.G == 256) {
            if (F.bid < 128) s5_task(F, true, F.bid >> 4, 1, F.bid & 15);
            else s5_task(F, false, ((F.bid - 128) >> 4) * 4, 4, (F.bid - 128) & 15);
        } else {
            for (int t = F.bid; t < 640; t += F.G) { if (t < 128) s5_task(F, true, t >> 4, 1, t & 15); else s5_task(F, false, (t - 128) >> 4, 1, (t - 128) & 15); }
        }
#if MK_STAMP == 100
        if (F.bid == MK_TB && F.tid == 0) F.MISC[21] = (unsigned)__builtin_amdgcn_s_memrealtime();
#endif
#if MK_STAMP == 101
        if (F.bid == MK_TB && F.tid == 0) F.MISC[20] = (unsigned)__builtin_amdgcn_s_memrealtime();
#endif
#if MK_OLDPOOL
        for (int tile = F.bid; tile < M / 64; tile += F.G) pool_task_old(F, tile);
#else
        for (int tile = F.bid; tile < M / 64; tile += F.G) pool_task(F, tile);
#endif
        __syncthreads();
#if MK_STAMP == 101
        if (F.bid == MK_TB && F.tid == 0) F.MISC[21] = (unsigned)__builtin_amdgcn_s_memrealtime();
#endif
    } DBG_CHECK(3); SEAM(3); STAMP(3);
#if MK_TRUNC == 3
    { xcd_barrier(bar); const bf16* src = (const bf16*)(ws + WS_RA);
      for (size_t i = (size_t)F.bid * 512 + F.tid; i < (size_t)M * D; i += (size_t)F.G * 512) { const int tok = (int)(i >> 10); const bool lat = tok >= M_CTX; const int L = lat ? L_LAT : L_CTX, t = lat ? (tok - M_CTX) % L_LAT : tok % L_CTX;
          bool keep = true; if (MK_TSEL == 1) keep = !lat; if (MK_TSEL == 2) keep = lat; if (MK_TSEL == 3) keep = t < L / 2; if (MK_TSEL == 4) keep = t >= L / 2; if (MK_TSEL == 5) keep = (t & 31) < 16; if (MK_TSEL == 6) keep = ((i >> 4) & 1) == 0; if (MK_TSEL == 7) keep = lat && t < 512; if (MK_TSEL == 8) keep = lat && t >= 512; if (MK_TSEL == 9) keep = lat && (t < 32 || t >= 992); if (MK_TSEL == 10) keep = lat && (t >= 480 && t < 544);
          F.out[i] = keep ? bf_lo((unsigned)src[i]) : 0.f; }
      return; }
#endif
    if (IN(4)) {
        pg8::Gemm g{(const bt*)(ws + WS_RA), nullptr, (const bt*)(ws + WS_WGLU), nullptr, D / 64, 0, D}; g.id_ = 4; pg8::StaticOrder S; S.init(M, D, F.G, F.bid);
        pg8::EpiGlu E{(const bt*)(ws + WS_RA), (bt*)(ws + WS_RB), F.in[I_BGLU]};
        pg8::gemm_phase<pg8::EpiGlu, pg8::StaticOrder, true, true>(F.lds, g, S, E);
    } DBG_CHECK(4); SEAM(4); STAMP(4);
    if (IN(5)) {
        pg8::Gemm g{(const bt*)(ws + WS_RB), (const bt*)(ws + WS_P), (const bt*)(ws + WS_WPA), (const bt*)(ws + WS_WPB), D / 64, DPOOL / 64, D}; g.id_ = 5; pg8::StaticOrder S; S.init(M, D, F.G, F.bid, 2);
        pg8::EpiMerge E{(const bt*)(ws + WS_GA), (const bt*)(ws + WS_GB), (bt*)(ws + WS_RA)};
        pg8::gemm_phase<pg8::EpiMerge, pg8::StaticOrder, true, true>(F.lds, g, S, E);
    } DBG_CHECK(5); SEAM(5); STAMP(5);
    if (IN(6)) {
        pg8::Gemm g{(const bt*)(ws + WS_RA), nullptr, (const bt*)(ws + WS_WOUT), nullptr, D / 64, 0, D}; g.id_ = 6; pg8::StaticOrder S; S.init(M, D, F.G, F.bid);
        pg8::EpiRes1 E{F.in[I_XP], F.in[I_XS], (bt*)F.out, F.in[I_BOUT], (const float*)(ws + WS_MODF)};
        pg8::gemm_phase<pg8::EpiRes1, pg8::StaticOrder, true, true>(F.lds, g, S, E);
    } DBG_CHECK(6); SEAM(6); STAMP(6);
    if (IN(7)) { phase_ln1(F, (const bf16*)F.out, (float*)(ws + WS_STATS), (bf16*)(ws + WS_RB)); } DBG_CHECK(7); SEAM(7); STAMP(7);
#if MK_TRUNC == 7
    { xcd_barrier(bar); const bf16* src = (const bf16*)(ws + WS_RB); for (size_t i = (size_t)F.bid * 512 + F.tid; i < (size_t)M * D; i += (size_t)F.G * 512) F.out[i] = bf_lo((unsigned)src[i]); return; }
#endif
    if (IN(8)) {
        pg8::Gemm g{(const bt*)(ws + WS_RB), nullptr, (const bt*)(ws + WS_W1), nullptr, D / 64, 0, D}; g.id_ = 8; pg8::StaticOrder S; S.init(M, DFF, F.G, F.bid);
        pg8::EpiRelu2 E{(bt*)(ws + WS_HM), F.in[I_B1]};
        pg8::gemm_phase<pg8::EpiRelu2, pg8::StaticOrder, true, true>(F.lds, g, S, E);
    } DBG_CHECK(8); SEAM(8); STAMP(8);
#if MK_TRUNC == 8
    { xcd_barrier(bar); const bf16* src = (const bf16*)(ws + WS_HM); for (size_t i = (size_t)F.bid * 512 + F.tid; i < (size_t)M * D; i += (size_t)F.G * 512) F.out[i] = bf_lo((unsigned)src[i * 4 + (i & 3)]); return; }
#endif
    if (IN(9)) {
        pg8::Gemm g{(const bt*)(ws + WS_HM), nullptr, (const bt*)(ws + WS_W2), nullptr, DFF / 64, 0, DFF}; g.id_ = 9; pg8::StaticOrder S; S.init(M, D, F.G, F.bid);
        pg8::EpiRes2 E{(const bt*)F.out, (const float*)(ws + WS_STATS), F.in[I_LN1G], F.in[I_LN1B], (bt*)(ws + WS_RA), F.in[I_B2], (const float*)(ws + WS_MODF)};
        pg8::gemm_phase<pg8::EpiRes2, pg8::StaticOrder, true, true>(F.lds, g, S, E);
    } DBG_CHECK(9); SEAM(9); STAMP(9);
#if MK_TRUNC == 9
    { xcd_barrier(bar); const bf16* src = (const bf16*)(ws + WS_RA); for (size_t i = (size_t)F.bid * 512 + F.tid; i < (size_t)M * D; i += (size_t)F.G * 512) F.out[i] = bf_lo((unsigned)src[i]); return; }
#endif
    if (IN(10)) { phase_ln2(F, (const bf16*)(ws + WS_RA)); }
#if MK_STAMP
    STAMP(10); __syncthreads();
    if (F.bid == (MK_STAMP >= 100 ? MK_TB : 0) && F.tid == 0) { asm volatile("s_waitcnt vmcnt(0)" ::: "memory"); F.out[(size_t)(MK_STAMP >= 100 ? MK_TB : 0) * 64 * D] += (MK_STAMP == 120 || MK_STAMP == 130) ? (float)(F.MISC[18] - F.MISC[17]) * (1.0f / 1000.0f) : (MK_STAMP >= 110) ? (float)F.MISC[16] * (16.0f / 21000.0f) : (float)(F.MISC[21] - F.MISC[20]) * (1.0f / 1000.0f); }
#endif
#if MK_DEBUG
    xcd_barrier(bar); dbg_encode(F);
#endif
#undef IN
#undef SEAM
}

#ifndef MK_SPLIT
#define MK_SPLIT 0
#endif
extern "C" void kernel_launch(void* const* d_in, const int* in_sizes, int n_in, void* d_out, int out_size, void* d_ws, size_t ws_size, hipStream_t stream) {
    static int grid = 0;
    if (grid == 0) {
        if (n_in != 33 || ws_size < WS_END) { fprintf(stderr, "kernel_launch: unexpected inputs (n_in %d, ws %zu)\n", n_in, ws_size); grid = -1; return; }
        int dev = 0, cus = 0, per_cu = 0;
        if (hipGetDevice(&dev) != hipSuccess || hipDeviceGetAttribute(&cus, hipDeviceAttributeMultiprocessorCount, dev) != hipSuccess) { grid = -1; return; }
        if (hipFuncSetAttribute((const void*)mk_fwd, hipFuncAttributeMaxDynamicSharedMemorySize, LDS_BYTES) != hipSuccess) { fprintf(stderr, "kernel_launch: hipFuncSetAttribute failed\n"); grid = -1; return; }
        if (hipOccupancyMaxActiveBlocksPerMultiprocessor(&per_cu, (const void*)mk_fwd, NWAVES * 64, LDS_BYTES) != hipSuccess || per_cu < 1) fprintf(stderr, "kernel_launch: occupancy query says %d blocks per CU\n", per_cu);
        (void)hipGetLastError();
        grid = cus;
    }
    if (grid < 0) return;
    (void)hipMemsetAsync((char*)d_ws + WS_CTL, 0, CTL_ZERO_BYTES, stream);
    Args a{};
    for (int i = 0; i < 33; ++i) a.in[i] = (const float*)d_in[i];
    a.out = (float*)d_out; a.ws = (unsigned char*)d_ws;
#if MK_SPLIT
    for (int p = 0; p <= 10; ++p) { a.ph_lo = p; a.ph_hi = p + 1; hipLaunchKernelGGL(mk_fwd, dim3(grid), dim3(NWAVES * 64), LDS_BYTES, stream, a); }
#else
    a.ph_lo = 0; a.ph_hi = 11;
    hipLaunchKernelGGL(mk_fwd, dim3(grid), dim3(NWAVES * 64), LDS_BYTES, stream, a);
#endif
    const hipError_t le = hipPeekAtLastError();
    if (le != hipSuccess) fprintf(stderr, "kernel_launch: launch failed: %s\n", hipGetErrorName(le));
}
```

```cpp
#include <hip/hip_runtime.h>
#include <cstdio>
#include <cstdint>
#ifndef MK_DEBUG
#define MK_DEBUG 0
#endif
#ifndef MK_DEBUG_FORCE
#define MK_DEBUG_FORCE 0
#endif
#ifndef MK_STAMP
#define MK_STAMP 0
#endif
#ifndef MK_TB
#define MK_TB 0
#endif
#ifndef MK_SA
#define MK_SA 4
#endif
#ifndef MK_SB
#define MK_SB 5
#endif
#ifndef MK_OLDPOOL
#define MK_OLDPOOL 0
#endif
#ifndef MK_NOPR
#define MK_NOPR 0
#endif
#ifndef MK_POISON
#define MK_POISON 0
#endif
#ifndef MK_TRUNC
#define MK_TRUNC 0
#endif
#ifndef MK_HSLEEP
#define MK_HSLEEP 0
#endif
#ifndef MK_TSEL
#define MK_TSEL 2
#endif
#ifndef MK_NOS0
#define MK_NOS0 0
#endif
#ifndef MK_NOUL
#define MK_NOUL 0
#endif
#ifndef MK_GPH
#define MK_GPH 8
#endif
#ifndef MK_GUI
#define MK_GUI 1
#endif
namespace pg8 {
#define PG8_LAS __attribute__((address_space(3)))
typedef unsigned short bf16_t;
typedef short bf16x8 __attribute__((ext_vector_type(8)));
typedef float f32x4 __attribute__((ext_vector_type(4)));
typedef unsigned u32x4 __attribute__((ext_vector_type(4)));
constexpr int BM = 256, BK = 64, HALF = 128, HTB = HALF * BK * 2  , STAGE_BYTES = 8 * HTB, NXCD = 8, WGM = 8;

__host__ __device__ __forceinline__ int lds_byte(int r, int c) { const int st = (r >> 4) * 2 + (c >> 5), rr = r & 15, cc = c & 31, ob = rr * 64 + cc * 2; return st * 1024 + (ob ^ (((ob >> 9) & 1) << 5)); }
__host__ __device__ __forceinline__ void stage_rc(int b, int& R, int& C) { const int st = b / 1024, sb = b % 1024, swz = sb ^ (((sb >> 9) & 1) << 5); R = (st >> 1) * 16 + swz / 64; C = (st & 1) * 32 + (swz % 64) / 2; }
__host__ __device__ __forceinline__ int perm32(int rho) { const int n = rho >> 4, i = rho & 15; return 8 * (i >> 2) + 4 * n + (i & 3); }

struct Unit { int pm, pn, part; };
struct Gemm { const bf16_t *A0, *A1, *B0, *B1; int nt0, nt1, ld; int id_ = 0;
    __device__ __forceinline__ const char* a(int part) const { return (const char*)(part ? A1 : A0); }
    __device__ __forceinline__ const char* b(int part) const { return (const char*)(part ? B1 : B0); }
    __device__ __forceinline__ int nt(int part) const { return part ? nt1 : nt0; } };

struct StaticOrder {
    int nM, nN, nwg, G, c, np;
    __host__ __device__ void init(int M, int N, int G_, int c_, int np_ = 1) { nM = M / BM; nN = N / BM; nwg = nM * nN; G = G_; c = c_; np = np_; }
    __host__ __device__ bool next(int ii, Unit& u) const {
        const int i = (np == 2) ? (ii >> 1) : ii; u.part = (np == 2) ? (ii & 1) : 0;
        const long L = (long)i * G + c; if (L >= nwg) return false;
        int wgid = (int)L; { const int q = nwg / NXCD, r = nwg % NXCD, xcd = wgid % NXCD, off = wgid / NXCD; wgid = (xcd < r ? xcd * (q + 1) : r * (q + 1) + (xcd - r) * q) + off; }
        const int nig = WGM * nN, gid = wgid / nig, fm = gid * WGM, gsz = (nM - fm) < WGM ? (nM - fm) : WGM;
        u.pm = fm + ((wgid % nig) % gsz); u.pn = (wgid % nig) / gsz; return true;
    }
    __device__ __forceinline__ void a_ready(const Unit&) const {}
    __device__ __forceinline__ void done(const Unit&) const {}
};
__device__ __forceinline__ unsigned cvt_pk_bf16(float lo, float hi) { unsigned r; asm volatile("v_cvt_pk_bf16_f32 %0, %1, %2" : "=v"(r) : "v"(lo), "v"(hi)); return r; }
typedef float f32x2 __attribute__((ext_vector_type(2)));
#if MK_STAMP == 130
#define GST(id) do { if (g.id_ == MK_GPH && blockIdx.x == MK_TB && threadIdx.x == 0 && ui == MK_GUI) { if ((id) == MK_SA) ((volatile PG8_LAS unsigned*)(lds + 131072 + 320))[17] = (unsigned)__builtin_amdgcn_s_memrealtime(); if ((id) == MK_SB) ((volatile PG8_LAS unsigned*)(lds + 131072 + 320))[18] = (unsigned)__builtin_amdgcn_s_memrealtime(); } } while (0)
#else
#define GST(id) do { } while (0)
#endif
template <class Epi, class Sched, bool ALIGN_EPI = false, bool SP2 = false>
__device__ __forceinline__ void gemm_phase(PG8_LAS unsigned char* lds, const Gemm g, const Sched& S, const Epi& E) {
    const int tid = threadIdx.x, wid = __builtin_amdgcn_readfirstlane(tid >> 6), lane = tid & 63, wr = wid >> 2, wc = wid & 3, fr = lane & 15, fq = lane >> 4;
    const int K = g.ld;
    unsigned voffA[2], voffB[2];
#pragma unroll
    for (int i = 0; i < 2; ++i) { int R, C; stage_rc(tid * 16 + i * 8192, R, C); const int Rb = Epi::PERM ? ((R & ~31) + perm32(R & 31)) : R;
        voffA[i] = (unsigned)(R * K + C) * 2u; voffB[i] = (unsigned)(Rb * K + C) * 2u; }
    const size_t kstep = (size_t)(BK * 2);
    const size_t hstep = (size_t)HALF * K * 2;
    const size_t tstep = 2 * hstep;
    const unsigned ldsw = (unsigned)wid * 1024u;
    const int aoff = lds_byte(wr * 64 + fr, fq * 8), boff = lds_byte(wc * 32 + fr, fq * 8);
#define PG8_SA(b, h) (((b) * 2 + (h)) * HTB)
#define PG8_SB(b, h) ((4 + (b) * 2 + (h)) * HTB)
#define PG8_STAGE(bufoff, gbase, voff) do { _Pragma("unroll") for (int _i = 0; _i < 2; ++_i) \
        __builtin_amdgcn_global_load_lds((const unsigned*)((const char*)(gbase) + (voff)[_i]), (PG8_LAS unsigned*)(lds + (bufoff) + ldsw + _i * 8192), 16, 0, 0); } while (0)
#define PG8_LDA(dst, b, h) do { _Pragma("unroll") for (int m = 0; m < 4; ++m) _Pragma("unroll") for (int k = 0; k < 2; ++k) dst[m][k] = *(const PG8_LAS bf16x8*)(lds + PG8_SA(b, h) + aoff + m * 2048 + k * 1024); } while (0)
#define PG8_LDB(dst, b, h) do { _Pragma("unroll") for (int n = 0; n < 2; ++n) _Pragma("unroll") for (int k = 0; k < 2; ++k) dst[n][k] = *(const PG8_LAS bf16x8*)(lds + PG8_SB(b, h) + boff + n * 2048 + k * 1024); } while (0)
#define PG8_MMA(ai, bj, At, Bt) do { __builtin_amdgcn_s_setprio(1); _Pragma("unroll") for (int m = 0; m < 4; ++m) _Pragma("unroll") for (int n = 0; n < 2; ++n) _Pragma("unroll") for (int k = 0; k < 2; ++k) \
        acc[ai][bj][m][n] = __builtin_amdgcn_mfma_f32_16x16x32_bf16(Bt[n][k], At[m][k], acc[ai][bj][m][n], 0, 0, 0); __builtin_amdgcn_s_setprio(0); } while (0)
#define PG8_WAIT_V(n) asm volatile("s_waitcnt vmcnt(" #n ")" ::: "memory")
#define PG8_WAIT_L(n) asm volatile("s_waitcnt lgkmcnt(" #n ")" ::: "memory")
#define PG8_BAR __builtin_amdgcn_s_barrier()
#define PG8_SCHED __builtin_amdgcn_sched_barrier(0)
    Unit cur, nxt; int ui = 0;
    if (!S.next(0, cur)) return;
    f32x4 acc[2][2][4][2];
#pragma unroll
    for (int a = 0; a < 2; ++a)
#pragma unroll
        for (int b = 0; b < 2; ++b)
#pragma unroll
            for (int m = 0; m < 4; ++m)
#pragma unroll
                for (int n = 0; n < 2; ++n) acc[a][b][m][n] = (f32x4){0.f, 0.f, 0.f, 0.f};
    bf16x8 At[4][2], B0[2][2], B1[2][2];
    const char* cA = g.a(cur.part) + (size_t)cur.pm * tstep; const char* cB = g.b(cur.part) + (size_t)cur.pn * tstep;
    S.a_ready(cur);
    if constexpr (SP2) {
        PG8_STAGE(PG8_SB(0, 0), cB, voffB); PG8_STAGE(PG8_SB(0, 1), cB + hstep, voffB); PG8_STAGE(PG8_SA(0, 0), cA, voffA); PG8_STAGE(PG8_SA(0, 1), cA + hstep, voffA);
        if (wr == 1) PG8_BAR;
        PG8_WAIT_V(2); PG8_BAR;
        PG8_STAGE(PG8_SB(1, 0), cB + kstep, voffB); PG8_STAGE(PG8_SA(1, 0), cA + kstep, voffA); PG8_STAGE(PG8_SB(1, 1), cB + hstep + kstep, voffB);
        PG8_WAIT_V(6); PG8_BAR;
    } else {
        PG8_STAGE(PG8_SB(0, 0), cB, voffB); PG8_STAGE(PG8_SA(0, 0), cA, voffA); PG8_STAGE(PG8_SB(0, 1), cB + hstep, voffB); PG8_STAGE(PG8_SA(0, 1), cA + hstep, voffA);
        if (wr == 1) PG8_BAR;
        PG8_WAIT_V(4); PG8_BAR;
        PG8_STAGE(PG8_SB(1, 0), cB + kstep, voffB); PG8_STAGE(PG8_SA(1, 0), cA + kstep, voffA); PG8_STAGE(PG8_SB(1, 1), cB + hstep + kstep, voffB);
        PG8_WAIT_V(6); PG8_BAR;
    }
    for (;;) {
        const bool has_next = S.next(ui + 1, nxt);
        const char* nA = has_next ? g.a(nxt.part) + (size_t)nxt.pm * tstep : cA; const char* nB = has_next ? g.b(nxt.part) + (size_t)nxt.pn * tstep : cB;
        const int nt = g.nt(cur.part);
        GST(0);
        for (int t = 0; t < nt; t += 2) {
            const bool last = (t == nt - 2);
            const char* a1 = cA + (size_t)(t + 1) * kstep;
            const char* a2 = last ? nA : cA + (size_t)(t + 2) * kstep; const char* b2 = last ? nB : cB + (size_t)(t + 2) * kstep;
            const char* a3 = a2 + kstep; const char* b3 = b2 + kstep;
            if (last && has_next) S.a_ready(nxt);
            if constexpr (SP2) {
            PG8_LDB(B0, 0, 0); PG8_LDB(B1, 0, 1); PG8_SCHED; PG8_LDA(At, 0, 0); PG8_STAGE(PG8_SA(1, 1), a1 + hstep, voffA); PG8_WAIT_V(8); PG8_WAIT_L(0); PG8_BAR; PG8_MMA(0, 0, At, B0); PG8_MMA(0, 1, At, B1); PG8_BAR; PG8_SCHED;
            PG8_LDA(At, 0, 1); PG8_STAGE(PG8_SB(0, 0), b2, voffB); PG8_STAGE(PG8_SB(0, 1), b2 + hstep, voffB); PG8_STAGE(PG8_SA(0, 0), a2, voffA); PG8_WAIT_V(8); PG8_WAIT_L(0); PG8_BAR; PG8_MMA(1, 0, At, B0); PG8_MMA(1, 1, At, B1); PG8_BAR; PG8_SCHED;
            PG8_LDB(B0, 1, 0); PG8_LDB(B1, 1, 1); PG8_SCHED; PG8_LDA(At, 1, 0); PG8_STAGE(PG8_SA(0, 1), a2 + hstep, voffA); PG8_WAIT_V(8); PG8_WAIT_L(0); PG8_BAR; PG8_MMA(0, 0, At, B0); PG8_MMA(0, 1, At, B1); PG8_BAR; PG8_SCHED;
            PG8_LDA(At, 1, 1); PG8_STAGE(PG8_SB(1, 0), b3, voffB); PG8_STAGE(PG8_SB(1, 1), b3 + hstep, voffB); PG8_STAGE(PG8_SA(1, 0), a3, voffA); PG8_WAIT_V(8); PG8_WAIT_L(0); PG8_BAR; PG8_MMA(1, 0, At, B0); PG8_MMA(1, 1, At, B1); PG8_BAR; PG8_SCHED;
            } else {
            PG8_LDB(B0, 0, 0); PG8_SCHED; PG8_LDA(At, 0, 0); PG8_STAGE(PG8_SA(1, 1), a1 + hstep, voffA);
            PG8_WAIT_L(8); PG8_BAR; PG8_WAIT_L(0); PG8_MMA(0, 0, At, B0); PG8_BAR; PG8_SCHED;
            PG8_LDB(B1, 0, 1); PG8_STAGE(PG8_SB(0, 0), b2, voffB);
            PG8_BAR; PG8_WAIT_L(0); PG8_MMA(0, 1, At, B1); PG8_BAR;
            PG8_LDA(At, 0, 1); PG8_STAGE(PG8_SA(0, 0), a2, voffA);
            PG8_BAR; PG8_WAIT_L(0); PG8_MMA(1, 0, At, B0); PG8_BAR; PG8_SCHED;
            PG8_STAGE(PG8_SB(0, 1), b2 + hstep, voffB);
            PG8_WAIT_V(6); PG8_BAR; PG8_MMA(1, 1, At, B1); PG8_BAR;
            PG8_LDB(B0, 1, 0); PG8_SCHED; PG8_LDA(At, 1, 0); PG8_STAGE(PG8_SA(0, 1), a2 + hstep, voffA);
            PG8_WAIT_L(8); PG8_BAR; PG8_WAIT_L(0); PG8_MMA(0, 0, At, B0); PG8_BAR; PG8_SCHED;
            PG8_LDB(B1, 1, 1); PG8_STAGE(PG8_SB(1, 0), b3, voffB);
            PG8_BAR; PG8_WAIT_L(0); PG8_MMA(0, 1, At, B1); PG8_BAR;
            PG8_LDA(At, 1, 1); PG8_STAGE(PG8_SA(1, 0), a3, voffA);
            PG8_BAR; PG8_WAIT_L(0); PG8_MMA(1, 0, At, B0); PG8_BAR; PG8_SCHED;
            PG8_STAGE(PG8_SB(1, 1), b3 + hstep, voffB);
            PG8_WAIT_V(6); PG8_BAR; PG8_MMA(1, 1, At, B1); PG8_BAR;
            }
        }
        GST(1);
        if constexpr (ALIGN_EPI) { if (wr == 0) PG8_BAR; }
        GST(2);
        if constexpr (!Epi::AFTER_DRAIN) { E(acc, cur, wr, wc, fr, fq); S.done(cur); }
        GST(3);
        if (!has_next) break;
        if (!E.keep(cur)) {
#pragma unroll
        for (int a = 0; a < 2; ++a)
#pragma unroll
            for (int b = 0; b < 2; ++b)
#pragma unroll
                for (int m = 0; m < 4; ++m)
#pragma unroll
                    for (int n = 0; n < 2; ++n) acc[a][b][m][n] = (f32x4){0.f, 0.f, 0.f, 0.f};
        }
        cur = nxt; cA = nA; cB = nB; ++ui;
        if constexpr (ALIGN_EPI) { if (wr == 1) PG8_BAR; }
    }
    PG8_WAIT_V(0);
    if constexpr (!ALIGN_EPI) { if (wr == 0) PG8_BAR; }
    PG8_BAR;
    if constexpr (Epi::AFTER_DRAIN) { E.fused(acc, cur, wr, wc, fr, fq, lds, wid, lane); S.done(cur); }
#undef PG8_SA
#undef PG8_SB
#undef PG8_STAGE
#undef PG8_LDA
#undef PG8_LDB
#undef PG8_MMA
#undef PG8_WAIT_V
#undef PG8_WAIT_L
#undef PG8_BAR
#undef PG8_SCHED
}
}
#define GAS __attribute__((address_space(1)))
#define LAS __attribute__((address_space(3)))
typedef unsigned short bf16;
typedef unsigned v4u __attribute__((ext_vector_type(4)));
typedef float f32x4 __attribute__((ext_vector_type(4)));
typedef short bf16x8 __attribute__((ext_vector_type(8)));
typedef GAS unsigned gu32;
typedef GAS unsigned long long gu64;
#define RLX_AGENT __ATOMIC_RELAXED, __HIP_MEMORY_SCOPE_AGENT
#define LDS_WAIT() asm volatile("s_waitcnt lgkmcnt(0)" ::: "memory")
#define VM_WAIT() asm volatile("s_waitcnt vmcnt(0)" ::: "memory")
__device__ __forceinline__ unsigned long long rt() { return __builtin_amdgcn_s_memrealtime(); }
__device__ __forceinline__ unsigned f2bf(float f) { unsigned u = __builtin_bit_cast(unsigned, f); return (u + 0x7fffu + ((u >> 16) & 1u)) >> 16; }
__device__ __forceinline__ unsigned pk2(float lo, float hi) { return f2bf(lo) | (f2bf(hi) << 16); }

#define XB_TMO      128
#define XB_XCNT(j)  (256  + 64 * (j))
#define XB_XSUB(j)  (1280 + 64 * (j))
#define XB_XGEN(j)  (2304 + 64 * (j))
#define XB_TOP      3328
#define XB_TOPGEN   3392
#define XCD_BAR_WORDS 3456
#define XB_SPIN_CAP (1u << 18)

__device__ __forceinline__ unsigned xb_ld(unsigned* p)              { return __hip_atomic_load(p, __ATOMIC_RELAXED, __HIP_MEMORY_SCOPE_AGENT); }
__device__ __forceinline__ unsigned xb_add(unsigned* p, unsigned v) { return __hip_atomic_fetch_add(p, v, __ATOMIC_RELAXED, __HIP_MEMORY_SCOPE_AGENT); }
__device__ __forceinline__ unsigned xb_xcc_id() { return (unsigned)__builtin_amdgcn_s_getreg((3 << 11) | 20) & 0xFu; }
#define XB_SPIN(cond, bar) do { unsigned _sp = 0; while (cond) { __builtin_amdgcn_s_sleep(1); \
    if ((++_sp & 255u) == 0u) { if (xb_ld(&(bar)[XB_TMO])) break; if (_sp > XB_SPIN_CAP) { atomicAdd(&(bar)[XB_TMO], 1u); break; } } } } while (0)

struct XcdBarrier {
    unsigned* bar; unsigned x;
    volatile LAS unsigned* st;
};

__device__ __forceinline__ XcdBarrier xcd_barrier_post(unsigned* bar, volatile LAS unsigned* st) {
    XcdBarrier b; b.bar = bar; b.x = xb_xcc_id(); b.st = st;
    if (threadIdx.x == 0) (void)xb_add(&bar[XB_XCNT(b.x)], 1u);
    return b;
}
__device__ __forceinline__ void xcd_barrier_complete(unsigned* bar, unsigned x, unsigned& nloc, unsigned& nx) {
    const unsigned G = gridDim.x * gridDim.y * gridDim.z;
    unsigned sum, cnt, mine, sp = 0u;
    for (;;) {
        sum = 0u; cnt = 0u; mine = 0u;
#pragma unroll
        for (unsigned j = 0; j < 16; ++j) { const unsigned c = xb_ld(&bar[XB_XCNT(j)]); sum += c; cnt += (c > 0u) ? 1u : 0u; mine = (j == x) ? c : mine; }
        if (sum == G) break;
        __builtin_amdgcn_s_sleep(1);
        if ((++sp & 255u) == 0u) { if (xb_ld(&bar[XB_TMO])) break; if (sp > XB_SPIN_CAP) { atomicAdd(&bar[XB_TMO], 1u); break; } }
    }
    nloc = mine > 0u ? mine : 1u; nx = cnt > 0u ? cnt : 1u;
}

__device__ __forceinline__ void xcd_barrier(const XcdBarrier& b) {
    asm volatile("s_waitcnt vmcnt(0)" ::: "memory");
    __syncthreads();
    if (threadIdx.x == 0) {
        unsigned* bar = b.bar;
        __builtin_amdgcn_s_waitcnt(0);
        unsigned nloc = b.st[0], nx = b.st[1];
        if (nloc == 0u) { xcd_barrier_complete(bar, b.x, nloc, nx); b.st[0] = nloc; b.st[1] = nx; }
        const unsigned old = xb_add(&bar[XB_XSUB(b.x)], 1u);
        const unsigned gen = old / nloc;
        if (old + 1u == (gen + 1u) * nloc) {
            __builtin_amdgcn_fence(__ATOMIC_RELEASE, "agent");
            asm volatile("s_waitcnt vmcnt(0)" ::: "memory");
            const unsigned og = xb_add(&bar[XB_TOP], 1u);
            const unsigned tg = og / nx;
            if (og + 1u == (tg + 1u) * nx) xb_add(&bar[XB_TOPGEN], 1u);
            else XB_SPIN(xb_ld(&bar[XB_TOPGEN]) == tg, bar);
            __builtin_amdgcn_fence(__ATOMIC_ACQUIRE, "agent");
            xb_add(&bar[XB_XGEN(b.x)], 1u);
            asm volatile("s_waitcnt vmcnt(0)" ::: "memory");
        } else {
            XB_SPIN(xb_ld(&bar[XB_XGEN(b.x)]) == gen, bar);
            __builtin_amdgcn_fence(__ATOMIC_ACQUIRE, "agent");
            asm volatile("s_waitcnt vmcnt(0)" ::: "memory");
        }
    }
    __syncthreads();
}
constexpr int D = 1024, M_CTX = 8192, M = 16384, L_CTX = 256, L_LAT = 1024, NB_CTX = 32, NB_LAT = 8;
constexpr int DIN = 3584, DFF = 4096, DPOOL = 512, NGRP = 64, NST = 64, HG = 16;
constexpr float DN_ALPHA = 1.189207115002721f;
constexpr float LN_EPS = 1e-6f;
constexpr int NWAVES = 8;

constexpr size_t MiB = 1u << 20;
constexpr size_t WS_CTL = 0, CTL_ZERO_BYTES = 64 * 1024;
constexpr size_t WS_MODP = 1 * MiB;
constexpr size_t WS_MODF = 2 * MiB;
constexpr size_t WS_STATS = 2 * MiB + 256 * 1024;
constexpr size_t WS_LAMB = 244 * MiB;
constexpr size_t WS_BB2 = 244 * MiB + 256 * 1024;
constexpr size_t WS_V2 = 245 * MiB + 512 * 1024;
constexpr size_t WS_G2 = 246 * MiB + 768 * 1024;
constexpr size_t WS_BB   = 3 * MiB;
constexpr size_t WS_CT   = 3 * MiB + 512 * 1024;
constexpr size_t WS_WIN = 4 * MiB, WS_WGLU = 11 * MiB, WS_WPA = 13 * MiB, WS_WPB = 15 * MiB, WS_WOUT = 17 * MiB, WS_W1 = 19 * MiB, WS_W2 = 27 * MiB, WS_WPOOL = 35 * MiB;
constexpr size_t WS_RA = 36 * MiB;
constexpr size_t WS_RB = 68 * MiB;
constexpr size_t WS_UB = 100 * MiB;
constexpr size_t WS_GA = 116 * MiB, WS_GB = 148 * MiB;
constexpr size_t WS_P  = 180 * MiB;
constexpr size_t WS_HM = 100 * MiB;
constexpr size_t WS_V  = 212 * MiB;
constexpr size_t WS_END = 248 * MiB;
constexpr int CW_BAR = 1024;

constexpr int RING_BYTES = 131072, LDSCTL_OFF = RING_BYTES, MISC_OFF = LDSCTL_OFF + 320, LDS_BYTES = 147456;

typedef unsigned u32x2 __attribute__((ext_vector_type(2)));
typedef float f32x16 __attribute__((ext_vector_type(16)));
__device__ __forceinline__ float bf_lo(unsigned w) { return __builtin_bit_cast(float, w << 16); }
__device__ __forceinline__ float bf_hi(unsigned w) { return __builtin_bit_cast(float, w & 0xffff0000u); }
__device__ __forceinline__ float fsigmoid(float x) { return __builtin_amdgcn_rcpf(1.0f + __builtin_amdgcn_exp2f(-1.4426950408889634f * x)); }
__device__ __forceinline__ float gelu_tanh(float x) { const float u = x * (1.5957691216057308f + 0.0713548162726f * x * x); return x * fsigmoid(u); }

namespace pg8 {
#define EPI_LOOP_BEGIN _Pragma("unroll") for (int ai = 0; ai < 2; ++ai) _Pragma("unroll") for (int m = 0; m < 4; ++m) { const int row = u.pm * BM + ai * HALF + wr * 64 + m * 16 + fr; _Pragma("unroll") for (int bj = 0; bj < 2; ++bj) { const int cl = bj * HALF + wc * 32 + 8 * fq;
#define EPI_LOOP_END } }
__device__ __forceinline__ u32x4 pack8(const f32x4& a, const f32x4& b) { u32x4 w; w.x = cvt_pk_bf16(a[0], a[1]); w.y = cvt_pk_bf16(a[2], a[3]); w.z = cvt_pk_bf16(b[0], b[1]); w.w = cvt_pk_bf16(b[2], b[3]); return w; }
__device__ __forceinline__ void unpack8(const u32x4& w, f32x4& a, f32x4& b) { a = (f32x4){bf_lo(w.x), bf_hi(w.x), bf_lo(w.y), bf_hi(w.y)}; b = (f32x4){bf_lo(w.z), bf_hi(w.z), bf_lo(w.w), bf_hi(w.w)}; }

struct EpiIn {
    static constexpr bool PERM = true, AFTER_DRAIN = false;
    bf16_t *ua, *ub, *ga, *gb; const float* bias;
    __device__ __forceinline__ bool keep(const Unit&) const { return false; }
    __device__ __forceinline__ int nstores(const Unit&) const { return 16; }
    __device__ __forceinline__ void operator()(f32x4 (&acc)[2][2][4][2], const Unit& u, int wr, int wc, int fr, int fq) const {
        if (u.pn < 6) {
            bf16_t* base; int ldc, c0;
            if (u.pn < 4) { base = ua; ldc = D; c0 = u.pn * BM; } else { base = ub; ldc = DPOOL; c0 = (u.pn - 4) * BM; }
            EPI_LOOP_BEGIN
                const float* bp = bias + u.pn * BM + cl; f32x4 v0 = acc[ai][bj][m][0] + *(const f32x4*)bp, v1 = acc[ai][bj][m][1] + *(const f32x4*)(bp + 4);
                *(u32x4*)(base + (size_t)row * ldc + c0 + cl) = pack8(v0, v1);
            EPI_LOOP_END
        } else {
            const int jt = u.pn - 6, clq = wc * 32 + 8 * fq, col = 128 * jt + clq;
            const float* ba = bias + 1536 + col; const float* bb = bias + 2560 + col;
            const f32x4 ba0 = *(const f32x4*)ba, ba1 = *(const f32x4*)(ba + 4), bb0 = *(const f32x4*)bb, bb1 = *(const f32x4*)(bb + 4);
#pragma unroll
            for (int ai = 0; ai < 2; ++ai)
#pragma unroll
                for (int m = 0; m < 4; ++m) { const int row = u.pm * BM + ai * HALF + wr * 64 + m * 16 + fr;
                    f32x4 a0 = acc[ai][0][m][0] + ba0, a1 = acc[ai][0][m][1] + ba1, b0 = acc[ai][1][m][0] + bb0, b1 = acc[ai][1][m][1] + bb1;
#pragma unroll
                    for (int j = 0; j < 4; ++j) { const float s0 = fsigmoid(b0[j]), s1 = fsigmoid(b1[j]); a0[j] = fsigmoid(a0[j]) * __builtin_amdgcn_rcpf(fmaxf(s0, 1e-30f)); a1[j] = fsigmoid(a1[j]) * __builtin_amdgcn_rcpf(fmaxf(s1, 1e-30f)); b0[j] = s0; b1[j] = s1; }
                    *(u32x4*)(ga + (size_t)row * D + col) = pack8(a0, a1); *(u32x4*)(gb + (size_t)row * D + col) = pack8(b0, b1); }
        }
    }
};
struct EpiGlu {
    static constexpr bool PERM = true, AFTER_DRAIN = false;
    const bf16_t* v; bf16_t* o; const float* bias;
    __device__ __forceinline__ bool keep(const Unit&) const { return false; }
    __device__ __forceinline__ int nstores(const Unit&) const { return 16; }
    __device__ __forceinline__ void operator()(f32x4 (&acc)[2][2][4][2], const Unit& u, int wr, int wc, int fr, int fq) const {
        EPI_LOOP_BEGIN
            const int col = u.pn * BM + cl; const float* bp = bias + col; f32x4 t0 = acc[ai][bj][m][0] + *(const f32x4*)bp, t1 = acc[ai][bj][m][1] + *(const f32x4*)(bp + 4);
            f32x4 x0, x1; unpack8(*(const u32x4*)(v + (size_t)row * D + col), x0, x1);
#pragma unroll
            for (int j = 0; j < 4; ++j) { t0[j] = x0[j] * fsigmoid(t0[j]); t1[j] = x1[j] * fsigmoid(t1[j]); }
            *(u32x4*)(o + (size_t)row * D + col) = pack8(t0, t1);
        EPI_LOOP_END
    }
};
struct EpiMerge {
    static constexpr bool PERM = true, AFTER_DRAIN = false;
    const bf16_t *ga, *gb; bf16_t* o;
    __device__ __forceinline__ bool keep(const Unit& u) const { return u.part == 0; }
    __device__ __forceinline__ int nstores(const Unit& u) const { return u.part == 0 ? 0 : 16; }
    __device__ __forceinline__ void operator()(f32x4 (&acc)[2][2][4][2], const Unit& u, int wr, int wc, int fr, int fq) const {
        EPI_LOOP_BEGIN
            const size_t off = (size_t)row * D + u.pn * BM + cl;
            if (u.part == 0) { f32x4 a0, a1; unpack8(*(const u32x4*)(ga + off), a0, a1); acc[ai][bj][m][0] *= a0; acc[ai][bj][m][1] *= a1; }
            else { f32x4 b0, b1; unpack8(*(const u32x4*)(gb + off), b0, b1); *(u32x4*)(o + off) = pack8(acc[ai][bj][m][0] * b0, acc[ai][bj][m][1] * b1); }
        EPI_LOOP_END
    }
};
struct EpiRes1 {
    static constexpr bool PERM = true, AFTER_DRAIN = false;
    const float *x_ctx, *x_lat; bf16_t* out; const float* bias; const float* modf;
    __device__ __forceinline__ bool keep(const Unit&) const { return false; }
    __device__ __forceinline__ int nstores(const Unit&) const { return 16; }
    __device__ __forceinline__ void operator()(f32x4 (&acc)[2][2][4][2], const Unit& u, int wr, int wc, int fr, int fq) const {
        const int r0 = u.pm * BM; const int bidx = r0 < M_CTX ? 0 : 1 + (r0 - M_CTX) / L_LAT;
        const float* gate = modf + (size_t)bidx * 6 * D + 2 * D; const float* bs = r0 < M_CTX ? x_ctx : x_lat - (size_t)M_CTX * D;
        EPI_LOOP_BEGIN
            const int col = u.pn * BM + cl; const size_t off = (size_t)row * D + col;
            const f32x4 g0 = *(const f32x4*)(gate + col), g1 = *(const f32x4*)(gate + col + 4), c0 = *(const f32x4*)(bias + col), c1 = *(const f32x4*)(bias + col + 4);
            const f32x4 x0 = *(const f32x4*)(bs + off), x1 = *(const f32x4*)(bs + off + 4);
            *(u32x4*)(out + off) = pack8(x0 * DN_ALPHA + g0 * (acc[ai][bj][m][0] + c0), x1 * DN_ALPHA + g1 * (acc[ai][bj][m][1] + c1));
        EPI_LOOP_END
    }
};
struct EpiRes2 {
    static constexpr bool PERM = true, AFTER_DRAIN = false;
    const bf16_t* r1; const float* stats; const float *lg, *lb; bf16_t* out; const float* bias; const float* modf;
    __device__ __forceinline__ bool keep(const Unit&) const { return false; }
    __device__ __forceinline__ int nstores(const Unit&) const { return 16; }
    __device__ __forceinline__ void operator()(f32x4 (&acc)[2][2][4][2], const Unit& u, int wr, int wc, int fr, int fq) const {
        const int r0 = u.pm * BM; const int bidx = r0 < M_CTX ? 0 : 1 + (r0 - M_CTX) / L_LAT;
        const float* gate = modf + (size_t)bidx * 6 * D + 5 * D;
        EPI_LOOP_BEGIN
            const int col = u.pn * BM + cl; const size_t off = (size_t)row * D + col;
            const f32x4 g0 = *(const f32x4*)(gate + col), g1 = *(const f32x4*)(gate + col + 4), c0 = *(const f32x4*)(bias + col), c1 = *(const f32x4*)(bias + col + 4);
            const f32x4 lg0 = *(const f32x4*)(lg + col), lg1 = *(const f32x4*)(lg + col + 4), lb0 = *(const f32x4*)(lb + col), lb1 = *(const f32x4*)(lb + col + 4);
            const float mu = stats[2 * row], rs = stats[2 * row + 1];
            f32x4 x0, x1; unpack8(*(const u32x4*)(r1 + off), x0, x1);
            x0 = (x0 - mu) * rs * lg0 + lb0; x1 = (x1 - mu) * rs * lg1 + lb1;
            *(u32x4*)(out + off) = pack8(x0 * DN_ALPHA + g0 * (acc[ai][bj][m][0] + c0), x1 * DN_ALPHA + g1 * (acc[ai][bj][m][1] + c1));
        EPI_LOOP_END
    }
};
struct EpiRelu2 {
    static constexpr bool PERM = true, AFTER_DRAIN = false;
    bf16_t* o; const float* bias;
    __device__ __forceinline__ bool keep(const Unit&) const { return false; }
    __device__ __forceinline__ int nstores(const Unit&) const { return 16; }
    __device__ __forceinline__ void operator()(f32x4 (&acc)[2][2][4][2], const Unit& u, int wr, int wc, int fr, int fq) const {
        EPI_LOOP_BEGIN
            const int col = u.pn * BM + cl; f32x4 t0 = acc[ai][bj][m][0] + *(const f32x4*)(bias + col), t1 = acc[ai][bj][m][1] + *(const f32x4*)(bias + col + 4);
#pragma unroll
            for (int j = 0; j < 4; ++j) { const float a = fmaxf(t0[j], 0.f), b = fmaxf(t1[j], 0.f); t0[j] = a * a; t1[j] = b * b; }
            *(u32x4*)(o + (size_t)row * DFF + col) = pack8(t0, t1);
        EPI_LOOP_END
    }
};
}
struct Frame {
    LAS unsigned char* lds;
    volatile LAS unsigned* MISC;
    gu32* ctl;
    int tid, lane, wave, G, bid;
    const float* in[33]; float* out; unsigned char* ws;
};
enum { I_XP = 0, I_XS, I_STATE, I_C, I_CCTX, I_WADA, I_BADA, I_WIN, I_BIN, I_LAMRE, I_LAMIM, I_LOGDT, I_BRE, I_BIM, I_CRE, I_CIM, I_S5D, I_WGLU, I_BGLU, I_WPA, I_WPOOL, I_PSCALE, I_WPB,
       I_WOUT, I_BOUT, I_LN1G, I_LN1B, I_W1, I_B1, I_W2, I_B2, I_LN2G, I_LN2B };

__device__ __forceinline__ float wave_sum(float v) {
#pragma unroll
    for (int o = 1; o < 64; o <<= 1) v += __shfl_xor(v, o);
    return v;
}
template <bool GATEPERM = false> __device__ __forceinline__ void p0_transpose_item(const float* W, int N, bf16* WT, int ldt, LAS unsigned* scr, int item, int lane) {
    const int nblk = N / 64, kb = item / nblk, nb = item % nblk, k0 = 64 * kb, n0 = 64 * nb, q = lane & 15, kp = lane >> 4;
    const int n0o = !GATEPERM || n0 < 1536 ? n0 : (n0 < 2560 ? 1536 + 256 * ((n0 - 1536) >> 7) + ((n0 - 1536) & 127) : 1536 + 256 * ((n0 - 2560) >> 7) + 128 + ((n0 - 2560) & 127));
    f32x4 v0[8], v1[8];
#pragma unroll
    for (int i = 0; i < 8; ++i) { const float* p = W + (size_t)(k0 + 8 * i + 2 * kp) * N + n0 + 4 * q; v0[i] = *(const f32x4*)p; v1[i] = *(const f32x4*)(p + N); }
#pragma unroll
    for (int i = 0; i < 8; ++i)
#pragma unroll
        for (int j = 0; j < 4; ++j) scr[(4 * q + j) * 33 + 4 * i + kp] = pk2(v0[i][j], v1[i][j]);
    LDS_WAIT(); asm volatile("" ::: "memory");
    const int kc = lane & 7;
#pragma unroll
    for (int jj = 0; jj < 8; ++jj) { const int n = 8 * jj + (lane >> 3); const LAS unsigned* s = scr + n * 33 + 4 * kc;
        v4u o; o.x = s[0]; o.y = s[1]; o.z = s[2]; o.w = s[3];
        *(GAS v4u*)(WT + (size_t)(n0o + n) * ldt + k0 + 8 * kc) = o; }
    LDS_WAIT(); asm volatile("" ::: "memory");
}

__device__ __forceinline__ void phase0(Frame& F) {
    unsigned char* ws = F.ws;
    if (F.bid < 96) {
        const int cc = F.bid % 24, kq = F.bid / 24, k0 = kq * 256 + F.wave * 32;
        LAS float* sv = (LAS float*)(F.lds) + F.wave * 288;
        LAS float* red = (LAS float*)(F.lds + 16384);
        if (F.lane < 32) {
#pragma unroll
            for (int r = 0; r < 9; ++r) { const float cv = r == 0 ? F.in[I_CCTX][k0 + F.lane] : F.in[I_C][(size_t)(r - 1) * D + k0 + F.lane]; sv[r * 32 + F.lane] = cv * fsigmoid(cv); }
        }
        LDS_WAIT(); asm volatile("" ::: "memory");
        f32x4 a[9];
#pragma unroll
        for (int r = 0; r < 9; ++r) a[r] = (f32x4){0.f, 0.f, 0.f, 0.f};
        const float* wp = F.in[I_WADA] + (size_t)k0 * 6144 + cc * 256 + F.lane * 4;
#pragma unroll 8
        for (int k = 0; k < 32; ++k) { const f32x4 w = *(const f32x4*)(wp + (size_t)k * 6144);
#pragma unroll
            for (int r = 0; r < 9; ++r) a[r] += w * sv[r * 32 + k]; }
#pragma unroll
        for (int r = 0; r < 9; ++r) *(LAS f32x4*)(red + (F.wave * 9 + r) * 256 + F.lane * 4) = a[r];
        __syncthreads();
        float* mp = (float*)(ws + WS_MODP) + (size_t)kq * 9 * 6144;
        for (int i = F.tid; i < 9 * 256; i += NWAVES * 64) { const int r = i >> 8, c = i & 255; float s = 0.f;
#pragma unroll
            for (int w = 0; w < 8; ++w) s += red[(w * 9 + r) * 256 + c];
            mp[(size_t)r * 6144 + cc * 256 + c] = s; }
        __syncthreads();
    }
    for (int wt = F.bid * NWAVES + F.wave; wt < 2 * NGRP; wt += F.G * NWAVES) {
        const int dir = wt >> 6, g = wt & 63, p = F.lane, it = wt * 64 + p;
        const float lr = F.in[I_LAMRE][it], li = F.in[I_LAMIM][it], dt = expf(F.in[I_LOGDT][wt]);
        const float zr = lr * dt, zi = li * dt, e = expf(zr); float sn, cs; sincosf(zi, &sn, &cs);
        const float lbr = e * cs, lbi = e * sn, l2r = lbr * lbr - lbi * lbi, l2i = 2.f * lbr * lbi;
        const float sh = sinf(0.5f * zi); const float nr = expm1f(zr) * cs - 2.f * sh * sh, ni = lbi;
        const float den = 1.f / (lr * lr + li * li); const float wr_ = (nr * lr + ni * li) * den, wi_ = (ni * lr - nr * li) * den;
        *(f32x4*)((float*)(ws + WS_LAMB) + (size_t)it * 4) = (f32x4){lbr, lbi, l2r, l2i};
        float br[16], bi[16], ar[16], ai[16], cr[16], ci[16];
#pragma unroll
        for (int h = 0; h < 16; ++h) { const float r0 = F.in[I_BRE][(size_t)it * 16 + h], i0 = F.in[I_BIM][(size_t)it * 16 + h];
            br[h] = wr_ * r0 - wi_ * i0; bi[h] = wr_ * i0 + wi_ * r0; ar[h] = lbr * br[h] - lbi * bi[h]; ai[h] = lbr * bi[h] + lbi * br[h];
            const size_t cix = ((size_t)wt * 16 + h) * 64 + p; cr[h] = F.in[I_CRE][cix]; ci[h] = F.in[I_CIM][cix]; }
        { bf16* bb = (bf16*)(ws + WS_BB2);
#pragma unroll
          for (int i = 0; i < 2; ++i)
#pragma unroll
            for (int part = 0; part < 2; ++part) { unsigned o[8];
#pragma unroll
              for (int h = 0; h < 8; ++h) { const float v0 = i == 0 ? (part == 0 ? ar[2 * h] : ai[2 * h]) : (part == 0 ? br[2 * h] : bi[2 * h]), v1 = i == 0 ? (part == 0 ? ar[2 * h + 1] : ai[2 * h + 1]) : (part == 0 ? br[2 * h + 1] : bi[2 * h + 1]); o[h] = pk2(v0, v1); }
              v4u* d = (v4u*)(bb + ((size_t)((i * 128 + wt) * 2 + part) * 64 + p) * 16); d[0] = (v4u){o[0], o[1], o[2], o[3]}; d[1] = (v4u){o[4], o[5], o[6], o[7]}; } }
        { bf16* v2 = (bf16*)(ws + WS_V2) + (size_t)wt * 2 * 16 * 128;
#pragma unroll
          for (int h = 0; h < 16; ++h) { const float c1r = cr[h] * lbr - ci[h] * lbi, c1i = cr[h] * lbi + ci[h] * lbr, c2r = cr[h] * l2r - ci[h] * l2i, c2i = cr[h] * l2i + ci[h] * l2r;
              *(unsigned*)(v2 + (0 * 16 + h) * 128 + 2 * p) = pk2(c1r, -c1i); *(unsigned*)(v2 + (1 * 16 + h) * 128 + 2 * p) = pk2(c2r, -c2i); } }
        { LAS unsigned* sc = (LAS unsigned*)(F.lds + F.wave * 16384);
#pragma unroll
          for (int h = 0; h < 16; ++h) { sc[h * 64 + p] = pk2(cr[h], -ci[h]); sc[1024 + h * 64 + p] = pk2(br[h], bi[h]); sc[2048 + h * 64 + p] = pk2(ar[h], ai[h]); }
          LDS_WAIT(); asm volatile("" ::: "memory");
          f32x4 k0 = (f32x4){0.f, 0.f, 0.f, 0.f}, k1 = (f32x4){0.f, 0.f, 0.f, 0.f};
#pragma unroll
          for (int ks = 0; ks < 4; ++ks) { const int o = (F.lane & 15) * 64 + 16 * ks + 4 * (F.lane >> 4);
              const bf16x8 af = *(const LAS bf16x8*)(sc + o), b0 = *(const LAS bf16x8*)(sc + 1024 + o), b1 = *(const LAS bf16x8*)(sc + 2048 + o);
              k0 = __builtin_amdgcn_mfma_f32_16x16x32_bf16(af, b0, k0, 0, 0, 0); k1 = __builtin_amdgcn_mfma_f32_16x16x32_bf16(af, b1, k1, 0, 0, 0); }
          bf16* g2 = (bf16*)(ws + WS_G2) + (size_t)wt * 2 * 16 * 32; const int hp = F.lane & 15;
#pragma unroll
          for (int r = 0; r < 4; ++r) { const int h = 4 * (F.lane >> 4) + r; const float kd = k0[r] + (h == hp ? F.in[I_S5D][dir * D + g * 16 + h] : 0.f);
              g2[(0 * 16 + h) * 32 + hp] = (bf16)f2bf(kd); g2[(0 * 16 + h) * 32 + 16 + hp] = (bf16)0; g2[(1 * 16 + h) * 32 + hp] = (bf16)f2bf(k1[r]); g2[(1 * 16 + h) * 32 + 16 + hp] = (bf16)f2bf(kd); }
          LDS_WAIT(); asm volatile("" ::: "memory"); }
    }
    {
        LAS unsigned* scr = (LAS unsigned*)(F.lds + F.wave * 16384);
        const int gw = F.bid * NWAVES + F.wave, NGW = F.G * NWAVES;
        constexpr int I_IN = (D / 64) * (DIN / 64), I_SQ = (D / 64) * (D / 64), I_PB = (DPOOL / 64) * (D / 64), I_1 = (D / 64) * (DFF / 64), I_2 = (DFF / 64) * (D / 64), I_PL = 4 * 2 * 2;
        constexpr int NITEMS = I_IN + 3 * I_SQ + I_PB + I_1 + I_2 + I_PL;
        for (int it = gw; it < NITEMS; it += NGW) {
            int r = it;
            if (r < I_1) { p0_transpose_item(F.in[I_W1], DFF, (bf16*)(ws + WS_W1), D, scr, r, F.lane); continue; } r -= I_1;
            if (r < I_2) { p0_transpose_item(F.in[I_W2], D, (bf16*)(ws + WS_W2), DFF, scr, r, F.lane); continue; } r -= I_2;
            if (r < I_IN) { p0_transpose_item<true>(F.in[I_WIN], DIN, (bf16*)(ws + WS_WIN), D, scr, r, F.lane); continue; } r -= I_IN;
            if (r < I_SQ) { p0_transpose_item(F.in[I_WGLU], D, (bf16*)(ws + WS_WGLU), D, scr, r, F.lane); continue; } r -= I_SQ;
            if (r < I_SQ) { p0_transpose_item(F.in[I_WPA], D, (bf16*)(ws + WS_WPA), D, scr, r, F.lane); continue; } r -= I_SQ;
            if (r < I_SQ) { p0_transpose_item(F.in[I_WOUT], D, (bf16*)(ws + WS_WOUT), D, scr, r, F.lane); continue; } r -= I_SQ;
            if (r < I_PB) { p0_transpose_item(F.in[I_WPB], D, (bf16*)(ws + WS_WPB), D, scr, r, F.lane); continue; } r -= I_PB;
            { const int gi = r >> 2; p0_transpose_item(F.in[I_WPOOL] + (size_t)gi * 128 * 128, 128, (bf16*)(ws + WS_WPOOL) + (size_t)gi * 128 * 128, 128, scr, r & 3, F.lane); }
        }
    }
}

__device__ __forceinline__ f32x4 mod4(Frame& F, int bidx, int idx) {
    const float* mp = (const float*)(F.ws + WS_MODP) + (size_t)bidx * 6144 + idx;
    f32x4 s = *(const f32x4*)(F.in[I_BADA] + idx);
#pragma unroll
    for (int q = 0; q < 4; ++q) s += *(const f32x4*)(mp + (size_t)q * 9 * 6144);
    return s;
}
__device__ __forceinline__ int batch_of_row(int r0) { return r0 < M_CTX ? 0 : 1 + (r0 - M_CTX) / L_LAT; }

__device__ __forceinline__ void phase1(Frame& F) {
    LAS f32x4* sc = (LAS f32x4*)(F.lds); LAS f32x4* sh = (LAS f32x4*)(F.lds + 4096);
    bf16* H = (bf16*)(F.ws + WS_RA);
    if (F.bid < 9) { float* mf = (float*)(F.ws + WS_MODF) + (size_t)F.bid * 6144; for (int i = F.tid; i < 6144 / 4; i += NWAVES * 64) *(f32x4*)(mf + 4 * i) = mod4(F, F.bid, 4 * i); }
    for (int rb = F.bid; rb < M / 64; rb += F.G) {
        const int r0 = rb * 64, bidx = batch_of_row(r0);
        __syncthreads();
        if (F.tid < 256) { sc[F.tid] = mod4(F, bidx, D + 4 * F.tid) + 1.0f; sh[F.tid] = mod4(F, bidx, 4 * F.tid); }
        __syncthreads();
        f32x4 xv[8][4];
#pragma unroll
        for (int j = 0; j < 8; ++j) { const int m = r0 + F.wave * 8 + j;
            const float* xrow = (m < M_CTX ? F.in[I_XP] + (size_t)m * D : F.in[I_XS] + (size_t)(m - M_CTX) * D); const GAS f32x4* xr = (const GAS f32x4*)xrow + F.lane;
#pragma unroll
            for (int q = 0; q < 4; ++q) xv[j][q] = xr[64 * q]; }
#pragma unroll
        for (int j = 0; j < 8; ++j) {
            const int m = r0 + F.wave * 8 + j;
            f32x4 v[4]; float s = 0.f;
#pragma unroll
            for (int q = 0; q < 4; ++q) { v[q] = xv[j][q]; s += (v[q].x + v[q].y) + (v[q].z + v[q].w); }
            const float mean = wave_sum(s) * (1.f / D); float s2 = 0.f;
#pragma unroll
            for (int q = 0; q < 4; ++q) { v[q] = v[q] - mean; s2 += (v[q].x * v[q].x + v[q].y * v[q].y) + (v[q].z * v[q].z + v[q].w * v[q].w); }
            const float rstd = 1.f / sqrtf(wave_sum(s2) * (1.f / D) + LN_EPS);
            GAS u32x2* o8 = (GAS u32x2*)(H + (size_t)m * D) + F.lane;
#pragma unroll
            for (int q = 0; q < 4; ++q) { const f32x4 y = v[q] * rstd * sc[F.lane + 64 * q] + sh[F.lane + 64 * q]; u32x2 w; w.x = pg8::cvt_pk_bf16(y.x, y.y); w.y = pg8::cvt_pk_bf16(y.z, y.w); o8[64 * q] = w; }
        }
    }
}

__device__ __forceinline__ void unpack4(const u32x2 w, f32x4& v) { v = (f32x4){bf_lo(w.x), bf_hi(w.x), bf_lo(w.y), bf_hi(w.y)}; }
__device__ __forceinline__ void phase_ln1(Frame& F, const bf16* R1, float* stats, bf16* H2) {
    LAS f32x4* sc = (LAS f32x4*)(F.lds); LAS f32x4* sh = (LAS f32x4*)(F.lds + 4096);
    const float* lg = F.in[I_LN1G]; const float* lb = F.in[I_LN1B];
    for (int rb = F.bid; rb < M / 64; rb += F.G) {
        const int r0 = rb * 64, bidx = batch_of_row(r0);
        __syncthreads();
        const float* mf = (const float*)(F.ws + WS_MODF) + (size_t)bidx * 6144;
        if (F.tid < 256) { sc[F.tid] = *(const f32x4*)(mf + 4 * D + 4 * F.tid) + 1.0f; sh[F.tid] = *(const f32x4*)(mf + 3 * D + 4 * F.tid); }
        __syncthreads();
        f32x4 gg[4], bb[4];
#pragma unroll
        for (int q = 0; q < 4; ++q) { gg[q] = *(const f32x4*)(lg + 4 * (F.lane + 64 * q)); bb[q] = *(const f32x4*)(lb + 4 * (F.lane + 64 * q)); }
        u32x2 raw[8][4];
#pragma unroll
        for (int j = 0; j < 8; ++j)
#pragma unroll
            for (int q = 0; q < 4; ++q) raw[j][q] = ((const GAS u32x2*)(R1 + (size_t)(r0 + F.wave * 8 + j) * D))[F.lane + 64 * q];
#pragma unroll
        for (int j = 0; j < 8; ++j) {
            const int m = r0 + F.wave * 8 + j;
            f32x4 v[4]; float s = 0.f;
#pragma unroll
            for (int q = 0; q < 4; ++q) { unpack4(raw[j][q], v[q]); s += (v[q].x + v[q].y) + (v[q].z + v[q].w); }
            float mean = wave_sum(s) * (1.f / D), s2 = 0.f;
#pragma unroll
            for (int q = 0; q < 4; ++q) { v[q] = v[q] - mean; s2 += (v[q].x * v[q].x + v[q].y * v[q].y) + (v[q].z * v[q].z + v[q].w * v[q].w); }
            float rstd = 1.f / sqrtf(wave_sum(s2) * (1.f / D) + LN_EPS);
            if (F.lane == 0) { stats[2 * m] = mean; stats[2 * m + 1] = rstd; }
            s = 0.f;
#pragma unroll
            for (int q = 0; q < 4; ++q) { v[q] = v[q] * rstd * gg[q] + bb[q]; s += (v[q].x + v[q].y) + (v[q].z + v[q].w); }
            mean = wave_sum(s) * (1.f / D); s2 = 0.f;
#pragma unroll
            for (int q = 0; q < 4; ++q) { v[q] = v[q] - mean; s2 += (v[q].x * v[q].x + v[q].y * v[q].y) + (v[q].z * v[q].z + v[q].w * v[q].w); }
            rstd = 1.f / sqrtf(wave_sum(s2) * (1.f / D) + LN_EPS);
            GAS u32x2* o8 = (GAS u32x2*)(H2 + (size_t)m * D) + F.lane;
#pragma unroll
            for (int q = 0; q < 4; ++q) { const f32x4 y = v[q] * rstd * sc[F.lane + 64 * q] + sh[F.lane + 64 * q]; u32x2 w; w.x = pg8::cvt_pk_bf16(y.x, y.y); w.y = pg8::cvt_pk_bf16(y.z, y.w); o8[64 * q] = w; }
        }
    }
}
__device__ __forceinline__ void phase_ln2(Frame& F, const bf16* R2) {
    const float* lg = F.in[I_LN2G]; const float* lb = F.in[I_LN2B];
    f32x4 gg[4], bb[4];
#pragma unroll
    for (int q = 0; q < 4; ++q) { gg[q] = *(const f32x4*)(lg + 4 * (F.lane + 64 * q)); bb[q] = *(const f32x4*)(lb + 4 * (F.lane + 64 * q)); }
    for (int rb = F.bid; rb < M / 64; rb += F.G) {
        const int r0 = rb * 64;
        u32x2 raw[8][4];
#pragma unroll
        for (int j = 0; j < 8; ++j)
#pragma unroll
            for (int q = 0; q < 4; ++q) raw[j][q] = ((const GAS u32x2*)(R2 + (size_t)(r0 + F.wave * 8 + j) * D))[F.lane + 64 * q];
#pragma unroll
        for (int j = 0; j < 8; ++j) {
            const int m = r0 + F.wave * 8 + j;
            f32x4 v[4]; float s = 0.f;
#pragma unroll
            for (int q = 0; q < 4; ++q) { unpack4(raw[j][q], v[q]); s += (v[q].x + v[q].y) + (v[q].z + v[q].w); }
            const float mean = wave_sum(s) * (1.f / D); float s2 = 0.f;
#pragma unroll
            for (int q = 0; q < 4; ++q) { v[q] = v[q] - mean; s2 += (v[q].x * v[q].x + v[q].y * v[q].y) + (v[q].z * v[q].z + v[q].w * v[q].w); }
            const float rstd = 1.f / sqrtf(wave_sum(s2) * (1.f / D) + LN_EPS);
            GAS f32x4* xr = (GAS f32x4*)(F.out + (size_t)m * D) + F.lane;
#pragma unroll
            for (int q = 0; q < 4; ++q) xr[64 * q] = v[q] * rstd * gg[q] + bb[q];
        }
    }
}
constexpr int S5_ROWB = 288, S5_WAVEB = 32 * S5_ROWB;
__device__ __forceinline__ void s5_task(Frame& F, bool lat, int seq0, int nseq, int gq) {
    const int lane = F.lane, n = lane & 31, hf = lane >> 5, g = gq * 4 + (F.wave >> 1), dir = F.wave & 1, wt = dir * 64 + g;
    const int L = lat ? L_LAT : L_CTX, nch = L / 64;
    const bf16* UA = (const bf16*)(F.ws + WS_RB); bf16* V = (bf16*)(F.ws + WS_RA); float* PART = F.out;
    LAS unsigned char* sl = F.lds + F.wave * S5_WAVEB;
    bf16x8 Bf[2][2][2], Vf[2][4], Gf[2];
    { const bf16* bb = (const bf16*)(F.ws + WS_BB2);
#pragma unroll
      for (int i = 0; i < 2; ++i)
#pragma unroll
        for (int q = 0; q < 2; ++q)
#pragma unroll
          for (int part = 0; part < 2; ++part) Bf[i][q][part] = *(const bf16x8*)(bb + ((size_t)((i * 128 + wt) * 2 + part) * 64 + (n + 32 * q)) * 16 + 8 * hf);
      const bf16* v2 = (const bf16*)(F.ws + WS_V2) + (size_t)wt * 2 * 16 * 128 + (lane & 15) * 128 + 8 * (lane >> 4);
#pragma unroll
      for (int j = 0; j < 2; ++j)
#pragma unroll
        for (int ks = 0; ks < 4; ++ks) Vf[j][ks] = *(const bf16x8*)(v2 + j * 16 * 128 + 32 * ks);
      const bf16* g2 = (const bf16*)(F.ws + WS_G2) + (size_t)wt * 2 * 16 * 32 + (lane & 15) * 32 + 8 * (lane >> 4);
#pragma unroll
      for (int j = 0; j < 2; ++j) Gf[j] = *(const bf16x8*)(g2 + j * 16 * 32); }
    const int p = n + 32 * hf;
    const float lr = ((const float*)(F.ws + WS_LAMB))[((size_t)wt * 64 + p) * 4 + 2], li = ((const float*)(F.ws + WS_LAMB))[((size_t)wt * 64 + p) * 4 + 3];
  for (int sq = 0; sq < nseq; ++sq) {
    const int seq = seq0 + sq, tokbase = lat ? (M_CTX + seq * L_LAT) : seq * L_CTX;
    float sr = 0.f, si = 0.f;
    if (lat) { const float* st = F.in[I_STATE] + ((size_t)(seq * 2 + dir) * 2) * 4096 + g * 64 + p; sr = st[0]; si = st[4096]; }
    const int blkA = 16 * ((n >> 2) & 1) + (n & 3) + 4 * (n >> 3);
    const int tA0 = dir ? 63 - 2 * blkA : 2 * blkA, tA1 = dir ? 62 - 2 * blkA : 2 * blkA + 1;
    const bf16* ua_lane = UA + (size_t)tokbase * D + g * 16 + 8 * hf;
    const bf16* ub_lane = UA + (size_t)tokbase * D + g * 16 + 8 * ((lane >> 4) & 1);
    const int tU0 = dir ? 63 - (2 * (lane & 15) + hf) : 2 * (lane & 15) + hf, tU1 = dir ? 63 - (2 * (16 + (lane & 15)) + hf) : 2 * (16 + (lane & 15)) + hf;
    const int h0 = 4 * (lane >> 4), colg = g * 16 + h0;
    bf16x8 A0 = *(const bf16x8*)(ua_lane + (size_t)((dir ? L - 64 : 0) + tA0) * D), A1 = *(const bf16x8*)(ua_lane + (size_t)((dir ? L - 64 : 0) + tA1) * D);
    for (int c = 0; c < nch; ++c) {
        const int t0 = dir ? L - 64 * (c + 1) : 64 * c;
        if (c == nch / 2) { asm volatile("s_waitcnt vmcnt(0)" ::: "memory"); __syncthreads(); }
        const f32x16 z16 = {0.f, 0.f, 0.f, 0.f, 0.f, 0.f, 0.f, 0.f, 0.f, 0.f, 0.f, 0.f, 0.f, 0.f, 0.f, 0.f};
        f32x16 x00 = __builtin_amdgcn_mfma_f32_32x32x16_bf16(A0, Bf[0][0][0], z16, 0, 0, 0);
        f32x16 x01 = __builtin_amdgcn_mfma_f32_32x32x16_bf16(A0, Bf[0][0][1], z16, 0, 0, 0);
        f32x16 x10 = __builtin_amdgcn_mfma_f32_32x32x16_bf16(A0, Bf[0][1][0], z16, 0, 0, 0);
        f32x16 x11 = __builtin_amdgcn_mfma_f32_32x32x16_bf16(A0, Bf[0][1][1], z16, 0, 0, 0);
        x00 = __builtin_amdgcn_mfma_f32_32x32x16_bf16(A1, Bf[1][0][0], x00, 0, 0, 0);
        x01 = __builtin_amdgcn_mfma_f32_32x32x16_bf16(A1, Bf[1][0][1], x01, 0, 0, 0);
        x10 = __builtin_amdgcn_mfma_f32_32x32x16_bf16(A1, Bf[1][1][0], x10, 0, 0, 0);
        x11 = __builtin_amdgcn_mfma_f32_32x32x16_bf16(A1, Bf[1][1][1], x11, 0, 0, 0);
        const bf16x8 Ub0 = *(const bf16x8*)(ub_lane + (size_t)(t0 + tU0) * D), Ub1 = *(const bf16x8*)(ub_lane + (size_t)(t0 + tU1) * D);
        if (c + 1 < nch) { const int t1 = dir ? L - 64 * (c + 2) : 64 * (c + 1); A0 = *(const bf16x8*)(ua_lane + (size_t)(t1 + tA0) * D); A1 = *(const bf16x8*)(ua_lane + (size_t)(t1 + tA1) * D); }
        float xr0[16], xi0[16], xr1[16], xi1[16];
#pragma unroll
        for (int i = 0; i < 16; ++i) {
            { auto r = __builtin_amdgcn_permlane32_swap(__float_as_uint(x00[i]), __float_as_uint(x10[i]), false, false); xr0[i] = __uint_as_float(r[0]); xr1[i] = __uint_as_float(r[1]); }
            { auto r = __builtin_amdgcn_permlane32_swap(__float_as_uint(x01[i]), __float_as_uint(x11[i]), false, false); xi0[i] = __uint_as_float(r[0]); xi1[i] = __uint_as_float(r[1]); }
        }
        LAS unsigned* srow = (LAS unsigned*)(sl + p * 4);
#pragma unroll
        for (int i = 0; i < 16; ++i) { srow[i * (S5_ROWB / 4)] = pg8::cvt_pk_bf16(sr, si); const float nr = lr * sr - li * si + xr0[i], ni = lr * si + li * sr + xi0[i]; sr = nr; si = ni; }
#pragma unroll
        for (int i = 0; i < 16; ++i) { srow[(16 + i) * (S5_ROWB / 4)] = pg8::cvt_pk_bf16(sr, si); const float nr = lr * sr - li * si + xr1[i], ni = lr * si + li * sr + xi1[i]; sr = nr; si = ni; }
        asm volatile("" ::: "memory");
        f32x4 y[2][2];
#pragma unroll
        for (int ct = 0; ct < 2; ++ct) { bf16x8 sb[4];
#pragma unroll
            for (int ks = 0; ks < 4; ++ks) sb[ks] = *(const LAS bf16x8*)(sl + (16 * ct + (lane & 15)) * S5_ROWB + (32 * ks + 8 * (lane >> 4)) * 2);
#pragma unroll
            for (int j = 0; j < 2; ++j) { f32x4 a = (f32x4){0.f, 0.f, 0.f, 0.f};
#pragma unroll
                for (int ks = 0; ks < 4; ++ks) a = __builtin_amdgcn_mfma_f32_16x16x32_bf16(Vf[j][ks], sb[ks], a, 0, 0, 0);
                y[ct][j] = __builtin_amdgcn_mfma_f32_16x16x32_bf16(Gf[j], ct == 0 ? Ub0 : Ub1, a, 0, 0, 0); } }
        asm volatile("" ::: "memory");
        size_t off[2][2];
#pragma unroll
        for (int ct = 0; ct < 2; ++ct)
#pragma unroll
          for (int j = 0; j < 2; ++j) { const int tau = 2 * (16 * ct + (lane & 15)) + j; off[ct][j] = (size_t)(tokbase + t0 + (dir ? 63 - tau : tau)) * D + colg; }
        if (c < nch / 2) {
#pragma unroll
            for (int ct = 0; ct < 2; ++ct)
#pragma unroll
              for (int j = 0; j < 2; ++j) *(f32x4*)(PART + off[ct][j]) = y[ct][j];
        } else {
            f32x4 pv[2][2];
#pragma unroll
            for (int ct = 0; ct < 2; ++ct)
#pragma unroll
              for (int j = 0; j < 2; ++j) pv[ct][j] = *(const f32x4*)(PART + off[ct][j]);
#pragma unroll
            for (int ct = 0; ct < 2; ++ct)
#pragma unroll
              for (int j = 0; j < 2; ++j) { const f32x4 t = y[ct][j] + pv[ct][j];
                u32x2 w; w.x = pg8::cvt_pk_bf16(gelu_tanh(t.x), gelu_tanh(t.y)); w.y = pg8::cvt_pk_bf16(gelu_tanh(t.z), gelu_tanh(t.w)); *(u32x2*)(V + off[ct][j]) = w; }
        }
    }
    if (!lat) { float* o = F.out + (size_t)M * D + ((size_t)(seq * 2 + dir) * 2) * 4096 + g * 64 + p; o[0] = sr; o[4096] = si; }
  }
}

constexpr int PL_ROWB = 1056;
#if MK_STAMP == 120
#define PST(id) do { if (F.bid == MK_TB && F.tid == 0) { if ((id) == MK_SA) F.MISC[17] = (unsigned)__builtin_amdgcn_s_memrealtime(); if ((id) == MK_SB) F.MISC[18] = (unsigned)__builtin_amdgcn_s_memrealtime(); } } while (0)
#else
#define PST(id) do { } while (0)
#endif
__device__ __forceinline__ void pool_task(Frame& F, int tile) {
    PST(0);
    const int tok0 = tile * 64; const bool lat = tile >= M_CTX / 64; const int npr = lat ? 64 : L_CTX, off = lat ? 0 : (tile & 3) * 64;
    const bf16* UB = (const bf16*)(F.ws + WS_UB); bf16* P = (bf16*)(F.ws + WS_P); const bf16* WPT = (const bf16*)(F.ws + WS_WPOOL);
    LAS unsigned char* ul = F.lds;
    const int lane = F.lane, gi3 = F.wave >> 1, oh = F.wave & 1;
    bf16x8 Wf[4][4];
#pragma unroll
    for (int ot = 0; ot < 4; ++ot)
#pragma unroll
        for (int ks = 0; ks < 4; ++ks) Wf[ot][ks] = *(const bf16x8*)(WPT + ((size_t)gi3 * 128 + 64 * oh + 16 * ot + (lane & 15)) * 128 + 32 * ks + 8 * (lane >> 4));
    f32x4 psc[4];
#pragma unroll
    for (int ot = 0; ot < 4; ++ot) psc[ot] = *(const f32x4*)(F.in[I_PSCALE] + gi3 * 128 + 64 * oh + 4 * (lane >> 4) + 16 * ot);
    __syncthreads();
    PST(1);
    { v4u v[10];
#pragma unroll
      for (int q = 0; q < 10; ++q) { const int i = F.tid + q * 512, j = i >> 6, pc = i & 63; const int tt = off + j - 8, ttc = min(max(tt, 0), npr - 1);
          v[q] = *(const v4u*)(UB + (size_t)(tok0 - off + ttc) * DPOOL + pc * 8); }
#pragma unroll
      for (int q = 0; q < 10; ++q) { const int i = F.tid + q * 512, j = i >> 6, pc = i & 63; const int tt = off + j - 8; const bool ok = tt >= 0 && tt < npr;
          v4u w = v[q]; w.x = ok ? w.x : 0u; w.y = ok ? w.y : 0u; w.z = ok ? w.z : 0u; w.w = ok ? w.w : 0u; *(LAS v4u*)(ul + j * PL_ROWB + pc * 16) = w; } }
    __syncthreads();
    PST(2);
    unsigned pm[32];
    { const int cp = F.tid & 255, th = F.tid >> 8, gi = cp >> 6, w = 2 << gi, hw = w >> 1; const LAS unsigned char* ucol = ul + cp * 4 + (th * 32 + 8) * PL_ROWB;
      float s0 = 0.f, s1 = 0.f;
      for (int d = -hw; d < hw; ++d) { const unsigned x = *(const LAS unsigned*)(ucol + d * PL_ROWB); s0 += bf_lo(x); s1 += bf_hi(x); }
      const int tt0 = off + th * 32;
#pragma unroll
      for (int j = 0; j < 32; ++j) {
          const unsigned xc = *(const LAS unsigned*)(ucol + j * PL_ROWB); const int tt = tt0 + j; const float inv = __builtin_amdgcn_rcpf((float)(min(tt - hw + w, npr) - max(tt - hw, 0)));
          pm[j] = pg8::cvt_pk_bf16(s0 * inv - bf_lo(xc), s1 * inv - bf_hi(xc));
          const unsigned xa = *(const LAS unsigned*)(ucol + (j + hw) * PL_ROWB), xs = *(const LAS unsigned*)(ucol + (j - hw) * PL_ROWB);
          s0 += bf_lo(xa) - bf_lo(xs); s1 += bf_hi(xa) - bf_hi(xs); }
      PST(3);
      __syncthreads();
#pragma unroll
      for (int j = 0; j < 32; ++j) *(LAS unsigned*)(ul + (th * 32 + j) * PL_ROWB + cp * 4) = pm[j]; }
    __syncthreads();
    PST(4);
    { const int obase = gi3 * 128 + 64 * oh + 4 * (lane >> 4);
#pragma unroll
      for (int tt = 0; tt < 4; ++tt) { bf16x8 pb[4];
#pragma unroll
          for (int ks = 0; ks < 4; ++ks) pb[ks] = *(const LAS bf16x8*)(ul + (16 * tt + (lane & 15)) * PL_ROWB + (gi3 * 128 + 32 * ks + 8 * (lane >> 4)) * 2);
#pragma unroll
          for (int ot = 0; ot < 4; ++ot) { f32x4 a = (f32x4){0.f, 0.f, 0.f, 0.f};
#pragma unroll
              for (int ks = 0; ks < 4; ++ks) a = __builtin_amdgcn_mfma_f32_16x16x32_bf16(Wf[ot][ks], pb[ks], a, 0, 0, 0);
              const int o0 = obase + 16 * ot; a = a * psc[ot]; u32x2 wv; wv.x = pg8::cvt_pk_bf16(a.x, a.y); wv.y = pg8::cvt_pk_bf16(a.z, a.w);
              *(u32x2*)(P + (size_t)(tok0 + 16 * tt + (lane & 15)) * D + o0) = wv; } } }
    PST(5);
}
constexpr int PLO_ROWB = 288;
__device__ __forceinline__ void pool_task_old(Frame& F, int tile) {
    const int tok0 = tile * 64; const bool lat = tile >= M_CTX / 64; const int npr = lat ? 64 : L_CTX, off = lat ? 0 : (tile & 3) * 64;
    const bf16* UB = (const bf16*)(F.ws + WS_UB); bf16* P = (bf16*)(F.ws + WS_P); const bf16* WPT = (const bf16*)(F.ws + WS_WPOOL);
    LAS unsigned char* ul = F.lds; LAS unsigned char* pl = F.lds + 80 * PLO_ROWB;
    const int lane = F.lane;
    for (int gi = 0; gi < 4; ++gi) {
        const int w = 2 << gi, hw = w >> 1;
        __syncthreads();
        for (int i = F.tid; i < 80 * 16; i += NWAVES * 64) { const int j = i >> 4, pc = i & 15; const int tt = off + j - 8; v4u v = (v4u){0u, 0u, 0u, 0u};
            if (tt >= 0 && tt < npr) v = *(const v4u*)(UB + (size_t)(tok0 - off + tt) * DPOOL + gi * 128 + pc * 8);
            *(LAS v4u*)(ul + j * PLO_ROWB + pc * 16) = v; }
        __syncthreads();
        { const int cp = F.tid & 63, tr = F.tid >> 6; const LAS unsigned char* ucol = ul + cp * 4;
          int tt = off + tr * 8; int lo = max(tt - hw, 0), hi = min(tt - hw + w, npr); float s0 = 0.f, s1 = 0.f;
          for (int q = lo; q < hi; ++q) { const unsigned x = *(const LAS unsigned*)(ucol + (q - off + 8) * PLO_ROWB); s0 += bf_lo(x); s1 += bf_hi(x); }
          for (int j = 0; j < 8; ++j) {
              const unsigned xc = *(const LAS unsigned*)(ucol + (tr * 8 + j + 8) * PLO_ROWB); const float inv = 1.0f / (float)(hi - lo);
              *(LAS unsigned*)(pl + (tr * 8 + j) * PLO_ROWB + cp * 4) = pg8::cvt_pk_bf16(s0 * inv - bf_lo(xc), s1 * inv - bf_hi(xc));
              ++tt; const int nlo = max(tt - hw, 0), nhi = min(tt - hw + w, npr);
              if (nhi > hi) { const unsigned x = *(const LAS unsigned*)(ucol + (hi - off + 8) * PLO_ROWB); s0 += bf_lo(x); s1 += bf_hi(x); }
              if (nlo > lo) { const unsigned x = *(const LAS unsigned*)(ucol + (lo - off + 8) * PLO_ROWB); s0 -= bf_lo(x); s1 -= bf_hi(x); }
              lo = nlo; hi = nhi; } }
        __syncthreads();
        { bf16x8 Wf[4];
#pragma unroll
          for (int ks = 0; ks < 4; ++ks) Wf[ks] = *(const bf16x8*)(WPT + ((size_t)gi * 128 + 16 * F.wave + (lane & 15)) * 128 + 32 * ks + 8 * (lane >> 4));
          const int o0 = gi * 128 + 16 * F.wave + 4 * (lane >> 4); const f32x4 ps = *(const f32x4*)(F.in[I_PSCALE] + o0);
#pragma unroll
          for (int tt = 0; tt < 4; ++tt) { f32x4 a = (f32x4){0.f, 0.f, 0.f, 0.f};
#pragma unroll
              for (int ks = 0; ks < 4; ++ks) { const bf16x8 pb = *(const LAS bf16x8*)(pl + (16 * tt + (lane & 15)) * PLO_ROWB + (32 * ks + 8 * (lane >> 4)) * 2);
                  a = __builtin_amdgcn_mfma_f32_16x16x32_bf16(Wf[ks], pb, a, 0, 0, 0); }
              a = a * ps; u32x2 wv; wv.x = pg8::cvt_pk_bf16(a.x, a.y); wv.y = pg8::cvt_pk_bf16(a.z, a.w);
              *(u32x2*)(P + (size_t)(tok0 + 16 * tt + (lane & 15)) * D + o0) = wv; } }
    }
}
#if MK_DEBUG
constexpr int CW_FAIL = 8192;
constexpr size_t WS_DBG = 230 * MiB;
__device__ __forceinline__ unsigned dh(unsigned i) { i ^= i >> 16; i *= 0x7feb352du; i ^= i >> 15; i *= 0x846ca68bu; i ^= i >> 16; return i; }
__device__ __forceinline__ float bf2f(bf16 b) { return __builtin_bit_cast(float, (unsigned)b << 16); }
__device__ __forceinline__ void dfail(Frame& F, int id, bool bad) { if (bad) atomicAdd((unsigned*)(F.ctl + CW_FAIL + id), 1u); }
__device__ __forceinline__ bool dneq(float got, float ref, float rel, float abs_) { const float d = fabsf(got - ref); return !(d <= rel * fabsf(ref) + abs_); }
__device__ __forceinline__ const float* xrow_ptr(Frame& F, int m) { return m < M_CTX ? F.in[I_XP] + (size_t)m * D : F.in[I_XS] + (size_t)(m - M_CTX) * D; }

__device__ __forceinline__ void dbg_wt(Frame& F, const float* W, int K, int N, const bf16* WT, int ldt, unsigned salt, int nlim = 1 << 30) {
    for (int s = F.tid; s < 2048; s += 512) { const unsigned h = dh(s * 2u + salt); const int k = h % K, n = (h >> 12) % (N < nlim ? N : nlim); const float w = W[(size_t)k * N + n], t = bf2f(WT[(size_t)n * ldt + k]);
        dfail(F, 1, dneq(t, w, 0.0045f, 1e-30f)); }
}
__device__ __forceinline__ void dbg_check(Frame& F, int phase) {
    if (F.bid != 0) return;
    unsigned char* ws = F.ws;
    if (phase == 0) {
        dbg_wt(F, F.in[I_WIN], D, DIN, (const bf16*)(ws + WS_WIN), D, 11, 1536); dbg_wt(F, F.in[I_WGLU], D, D, (const bf16*)(ws + WS_WGLU), D, 12); dbg_wt(F, F.in[I_WPA], D, D, (const bf16*)(ws + WS_WPA), D, 13);
        dbg_wt(F, F.in[I_WPB], DPOOL, D, (const bf16*)(ws + WS_WPB), D, 14); dbg_wt(F, F.in[I_WOUT], D, D, (const bf16*)(ws + WS_WOUT), D, 15); dbg_wt(F, F.in[I_W1], D, DFF, (const bf16*)(ws + WS_W1), D, 16);
        dbg_wt(F, F.in[I_W2], DFF, D, (const bf16*)(ws + WS_W2), DFF, 17);
        for (int gi = 0; gi < 4; ++gi) dbg_wt(F, F.in[I_WPOOL] + gi * 16384, 128, 128, (const bf16*)(ws + WS_WPOOL) + gi * 16384, 128, 18 + gi);
        for (int s = F.tid; s < 2048; s += 512) {
            const int it = dh(s + 77u) % 8192; const int p = it & 63, g = (it >> 6) & 63, dir = it >> 12;
            const double lr = F.in[I_LAMRE][it], li = F.in[I_LAMIM][it], dt = exp((double)F.in[I_LOGDT][dir * 64 + g]);
            const double e = exp(lr * dt), lbr = e * cos(li * dt), lbi = e * sin(li * dt), nr = lbr - 1.0, ni = lbi, den = lr * lr + li * li, wr = (nr * lr + ni * li) / den, wi = (ni * lr - nr * li) / den;
            const float* lamb = (const float*)(ws + WS_LAMB) + (size_t)it * 4; dfail(F, 2, dneq(lamb[0], (float)lbr, 1e-5f, 1e-6f) || dneq(lamb[1], (float)lbi, 1e-5f, 1e-6f));
            const int h = dh(s + 99u) & 15; const double br = F.in[I_BRE][(size_t)it * 16 + h], bi = F.in[I_BIM][(size_t)it * 16 + h];
            const bf16* bb = (const bf16*)(ws + WS_BB2) + (size_t)128 * 2 * 64 * 16;
            dfail(F, 2, dneq(bf2f(bb[((size_t)((dir * 64 + g) * 2 + 0) * 64 + p) * 16 + h]), (float)(wr * br - wi * bi), 0.01f, 1e-6f) || dneq(bf2f(bb[((size_t)((dir * 64 + g) * 2 + 1) * 64 + p) * 16 + h]), (float)(wr * bi + wi * br), 0.01f, 1e-6f));
            const bf16* v2 = (const bf16*)(ws + WS_V2) + ((size_t)(dir * 64 + g) * 2 * 16 + h) * 128; const size_t ci = ((size_t)(dir * 64 + g) * 16 + h) * 64 + p;
            const double cre = F.in[I_CRE][ci], cim = F.in[I_CIM][ci];
            dfail(F, 2, dneq(bf2f(v2[2 * p]), (float)(cre * lbr - cim * lbi), 0.006f, 1e-5f) || dneq(bf2f(v2[2 * p + 1]), (float)-(cre * lbi + cim * lbr), 0.006f, 1e-5f));
        }
    }
    if (phase == 1) {
        for (int s = F.tid; s < 1024; s += 512) {
            const unsigned h = dh(s + 5u); const int r = h % 9, idx = (h >> 8) % 6144; double a = F.in[I_BADA][idx];
            for (int k = 0; k < D; ++k) { const double cv = r == 0 ? F.in[I_CCTX][k] : F.in[I_C][(size_t)(r - 1) * D + k]; a += cv / (1.0 + exp(-cv)) * (double)F.in[I_WADA][(size_t)k * 6144 + idx]; }
            dfail(F, 3, dneq(((const float*)(ws + WS_MODF))[(size_t)r * 6144 + idx], (float)a, 1e-4f, 1e-4f));
        }
        for (int s = F.tid; s < 1024; s += 512) {
            const unsigned h = dh(s + 1234u); const int m = h % M, j = (h >> 16) % D; const float* x = xrow_ptr(F, m); double mu = 0, var = 0;
            for (int k = 0; k < D; ++k) mu += x[k]; mu /= D; for (int k = 0; k < D; ++k) { const double d = x[k] - mu; var += d * d; } var /= D;
            const float* mf = (const float*)(ws + WS_MODF) + (size_t)batch_of_row(m) * 6144;
            const double y = (x[j] - mu) / sqrt(var + 1e-6) * (1.0 + mf[D + j]) + mf[j];
            dfail(F, 4, dneq(bf2f(((const bf16*)(ws + WS_RA))[(size_t)m * D + j]), (float)y, 0.006f, 0.004f));
        }
    }
    if (phase == 2) {
        for (int s = F.tid; s < 2048; s += 512) { const unsigned h = dh(s + 4321u); const int m = h % M, zc = (h >> 14) % DIN; const bf16* hr = (const bf16*)(ws + WS_RA) + (size_t)m * D;
            if (zc < 1536) { double a = F.in[I_BIN][zc];
                for (int k = 0; k < D; ++k) a += (double)bf2f(hr[k]) * (double)F.in[I_WIN][(size_t)k * DIN + zc];
                const float got = zc < 1024 ? bf2f(((const bf16*)(ws + WS_RB))[(size_t)m * D + zc]) : bf2f(((const bf16*)(ws + WS_UB))[(size_t)m * DPOOL + zc - 1024]);
                dfail(F, 5, dneq(got, (float)a, 0.01f, 0.02f)); }
            else { const int col = (zc - 1536) & 1023; double a = F.in[I_BIN][1536 + col], b = F.in[I_BIN][2560 + col];
                for (int k = 0; k < D; ++k) { const double hv = bf2f(hr[k]); a += hv * (double)F.in[I_WIN][(size_t)k * DIN + 1536 + col]; b += hv * (double)F.in[I_WIN][(size_t)k * DIN + 2560 + col]; }
                const double sa = 1.0 / (1.0 + exp(-a)), sb = 1.0 / (1.0 + exp(-b));
                dfail(F, 5, dneq(bf2f(((const bf16*)(ws + WS_GA))[(size_t)m * D + col]), (float)(sa / sb), 0.03f, 0.02f) || dneq(bf2f(((const bf16*)(ws + WS_GB))[(size_t)m * D + col]), (float)sb, 0.01f, 0.02f)); } }
    }
    if (phase == 3) {
        { const int w = F.wave, lane = F.lane; const bool lat = w < 2; const unsigned h = dh(w + 31u); const int seq = lat ? (h % NB_LAT) : w, g = lat ? (h >> 8) % NGRP : 3 * w + 1;
          const int L = lat ? L_LAT : L_CTX, tokbase = lat ? M_CTX + seq * L_LAT : seq * L_CTX; const bf16* UA = (const bf16*)(ws + WS_RB); const bf16* V = (const bf16*)(ws + WS_RA);
          float* yf = (float*)(ws + WS_DBG) + (size_t)w * L_LAT * 16;
          for (int dir = 0; dir < 2; ++dir) {
              const int it = (dir * 64 + g) * 64 + lane; const float lr = F.in[I_LAMRE][it], li = F.in[I_LAMIM][it], dt = expf(F.in[I_LOGDT][dir * 64 + g]);
              const float e = expf(lr * dt), lbr = e * cosf(li * dt), lbi = e * sinf(li * dt), nr = lbr - 1.f, ni = lbi, den = 1.f / (lr * lr + li * li), wr = (nr * lr + ni * li) * den, wi = (ni * lr - nr * li) * den;
              float br[16], bi[16], cr[16], cim[16];
#pragma unroll
              for (int hh = 0; hh < 16; ++hh) { const float a = F.in[I_BRE][(size_t)it * 16 + hh], b = F.in[I_BIM][(size_t)it * 16 + hh]; br[hh] = wr * a - wi * b; bi[hh] = wr * b + wi * a;
                  const size_t ci = ((size_t)(dir * 64 + g) * 16 + hh) * 64 + lane; cr[hh] = F.in[I_CRE][ci]; cim[hh] = F.in[I_CIM][ci]; }
              float sr = 0.f, si = 0.f; if (lat) { const float* st = F.in[I_STATE] + ((size_t)(seq * 2 + dir) * 2) * 4096 + g * 64 + lane; sr = st[0]; si = st[4096]; }
              for (int tq = 0; tq < L; ++tq) { const int t = dir ? L - 1 - tq : tq; const bf16* ur = UA + (size_t)(tokbase + t) * D + g * 16; float bur = 0.f, bui = 0.f;
#pragma unroll
                  for (int hh = 0; hh < 16; ++hh) { const float u = bf2f(ur[hh]); bur += br[hh] * u; bui += bi[hh] * u; }
                  const float nsr = lbr * sr - lbi * si + bur, nsi = lbr * si + lbi * sr + bui; sr = nsr; si = nsi;
                  if (!lat && dir == 0 && tq < 32) { const float* dx = (const float*)(ws + 231 * MiB) + (size_t)seq * 32 * 64 * 4 + (tq * 64 + lane) * 4;
                      dfail(F, 20, dneq(dx[0], bur, 0.02f, 0.002f) || dneq(dx[1], bui, 0.02f, 0.002f)); dfail(F, 21, dneq(dx[2], sr, 0.02f, 0.002f) || dneq(dx[3], si, 0.02f, 0.002f)); }
                  float mine = 0.f;
#pragma unroll
                  for (int hh = 0; hh < 16; ++hh) { const float y = wave_sum(cr[hh] * sr - cim[hh] * si); if (lane == hh) mine = y; }
                  if (lane < 16) { const float pt = F.out[(size_t)(tokbase + t) * D + g * 16 + lane];
                      const float mined = mine + F.in[I_S5D][dir * D + g * 16 + lane] * bf2f(ur[lane]);
                      if (dir == 0) { yf[(size_t)t * 16 + lane] = mine; if (t < L / 2) dfail(F, lat ? 10 : 6, dneq(pt, mined, 0.03f, 0.01f)); }
                      else { if (t >= L / 2) dfail(F, lat ? 11 : 7, dneq(pt, mined, 0.03f, 0.01f)); const float u = bf2f(ur[lane]); const float tot = yf[(size_t)t * 16 + lane] + mine + (F.in[I_S5D][g * 16 + lane] + F.in[I_S5D][D + g * 16 + lane]) * u;
                          const float ref = tot / (1.f + expf(-1.5957691216f * (tot + 0.044715f * tot * tot * tot)));
                          dfail(F, lat ? 12 : 8, dneq(bf2f(V[(size_t)(tokbase + t) * D + g * 16 + lane]), ref, 0.03f, 0.03f)); } }
              }
              if (!lat) { const float* o = F.out + (size_t)M * D + ((size_t)(seq * 2 + dir) * 2) * 4096 + g * 64 + lane; dfail(F, 9, dneq(o[0], sr, 0.02f, 0.01f) || dneq(o[4096], si, 0.02f, 0.01f)); }
              __builtin_amdgcn_s_waitcnt(0);
          } }
        for (int s = F.tid; s < 2048; s += 512) { const unsigned h = dh(s + 999u); const int tok = h % M, o = (h >> 14) % DPOOL, gi = o >> 7, w = 2 << gi; const bool lat = tok >= M_CTX;
            const int npr = lat ? 64 : L_CTX, rs = lat ? (tok & ~63) : (tok & ~255), tt = tok - rs, lo = max(tt - w / 2, 0), hi = min(tt - w / 2 + w, npr); const bf16* UB = (const bf16*)(ws + WS_UB); double a = 0;
            for (int i = 0; i < 128; ++i) { double sum = 0; for (int q = lo; q < hi; ++q) sum += bf2f(UB[(size_t)(rs + q) * DPOOL + gi * 128 + i]);
                const double pm = sum / (hi - lo) - bf2f(UB[(size_t)tok * DPOOL + gi * 128 + i]); a += pm * (double)F.in[I_WPOOL][((size_t)gi * 128 + i) * 128 + (o & 127)]; }
            a *= F.in[I_PSCALE][o]; dfail(F, 13, dneq(bf2f(((const bf16*)(ws + WS_P))[(size_t)tok * D + o]), (float)a, 0.02f, 0.02f)); }
    }
    if (phase == 4) {
        for (int s = F.tid; s < 2048; s += 512) { const unsigned h = dh(s + 41u); const int m = h % M, c = (h >> 14) % D; const bf16* vr = (const bf16*)(ws + WS_RA) + (size_t)m * D; double a = F.in[I_BGLU][c];
            for (int k = 0; k < D; ++k) a += (double)bf2f(vr[k]) * (double)F.in[I_WGLU][(size_t)k * D + c];
            const double ref = bf2f(vr[c]) / (1.0 + exp(-a)); dfail(F, 14, dneq(bf2f(((const bf16*)(ws + WS_RB))[(size_t)m * D + c]), (float)ref, 0.02f, 0.02f)); }
    }
    if (phase == 5) {
        for (int s = F.tid; s < 2048; s += 512) { const unsigned h = dh(s + 51u); const int m = h % M, c = (h >> 14) % D; const bf16* v2 = (const bf16*)(ws + WS_RB) + (size_t)m * D; const bf16* pr = (const bf16*)(ws + WS_P) + (size_t)m * D; double ya = 0, yb = 0;
            for (int k = 0; k < D; ++k) ya += (double)bf2f(v2[k]) * (double)F.in[I_WPA][(size_t)k * D + c];
            for (int k = 0; k < DPOOL; ++k) yb += (double)bf2f(pr[k]) * (double)F.in[I_WPB][(size_t)k * D + c];
            const double ref = bf2f(((const bf16*)(ws + WS_GB))[(size_t)m * D + c]) * (bf2f(((const bf16*)(ws + WS_GA))[(size_t)m * D + c]) * ya + yb);
            dfail(F, 15, dneq(bf2f(((const bf16*)(ws + WS_RA))[(size_t)m * D + c]), (float)ref, 0.03f, 0.03f)); }
    }
    if (phase == 6) {
        for (int s = F.tid; s < 2048; s += 512) { const unsigned h = dh(s + 61u); const int m = h % M, c = (h >> 14) % D; const bf16* mr = (const bf16*)(ws + WS_RA) + (size_t)m * D; double a = F.in[I_BOUT][c];
            for (int k = 0; k < D; ++k) a += (double)bf2f(mr[k]) * (double)F.in[I_WOUT][(size_t)k * D + c];
            const float* mf = (const float*)(ws + WS_MODF) + (size_t)batch_of_row(m) * 6144; const double ref = (double)DN_ALPHA * xrow_ptr(F, m)[c] + mf[2 * D + c] * a;
            dfail(F, 16, dneq(bf2f(((const bf16*)F.out)[(size_t)m * D + c]), (float)ref, 0.012f, 0.02f)); }
    }
    if (phase == 7) {
        for (int s = F.tid; s < 1024; s += 512) { const unsigned h = dh(s + 71u); const int m = h % M, j = (h >> 16) % D; const bf16* r = (const bf16*)F.out + (size_t)m * D; double mu = 0, var = 0;
            for (int k = 0; k < D; ++k) mu += bf2f(r[k]); mu /= D; for (int k = 0; k < D; ++k) { const double dd = bf2f(r[k]) - mu; var += dd * dd; } var /= D; const double rs = 1.0 / sqrt(var + 1e-6);
            const float* st = (const float*)(ws + WS_STATS) + 2 * m;
            double m2 = 0, v2 = 0; for (int k = 0; k < D; ++k) m2 += (bf2f(r[k]) - mu) * rs * F.in[I_LN1G][k] + F.in[I_LN1B][k]; m2 /= D;
            for (int k = 0; k < D; ++k) { const double x1 = (bf2f(r[k]) - mu) * rs * F.in[I_LN1G][k] + F.in[I_LN1B][k] - m2; v2 += x1 * x1; } v2 /= D;
            const float* mf = (const float*)(ws + WS_MODF) + (size_t)batch_of_row(m) * 6144; const double x1j = (bf2f(r[j]) - mu) * rs * F.in[I_LN1G][j] + F.in[I_LN1B][j];
            const double y = (x1j - m2) / sqrt(v2 + 1e-6) * (1.0 + mf[4 * D + j]) + mf[3 * D + j];
            dfail(F, 17, dneq(bf2f(((const bf16*)(ws + WS_RB))[(size_t)m * D + j]), (float)y, 0.006f, 0.004f) || dneq(st[0], (float)mu, 1e-4f, 1e-5f) || dneq(st[1], (float)rs, 1e-4f, 1e-5f)); }
    }
    if (phase == 8) {
        for (int s = F.tid; s < 2048; s += 512) { const unsigned h = dh(s + 81u); const int m = h % M, c = (h >> 14) % DFF; const bf16* hr = (const bf16*)(ws + WS_RB) + (size_t)m * D; double a = F.in[I_B1][c];
            for (int k = 0; k < D; ++k) a += (double)bf2f(hr[k]) * (double)F.in[I_W1][(size_t)k * DFF + c];
            a = a > 0 ? a * a : 0; dfail(F, 18, dneq(bf2f(((const bf16*)(ws + WS_HM))[(size_t)m * DFF + c]), (float)a, 0.02f, 0.02f)); }
    }
    if (phase == 9) {
        for (int s = F.tid; s < 2048; s += 512) { const unsigned h = dh(s + 91u); const int m = h % M, c = (h >> 14) % D; const bf16* hr = (const bf16*)(ws + WS_HM) + (size_t)m * DFF; double a = F.in[I_B2][c];
            for (int k = 0; k < DFF; ++k) a += (double)bf2f(hr[k]) * (double)F.in[I_W2][(size_t)k * D + c];
            const float* st = (const float*)(ws + WS_STATS) + 2 * m; const double x1 = ((double)bf2f(((const bf16*)F.out)[(size_t)m * D + c]) - st[0]) * st[1] * F.in[I_LN1G][c] + F.in[I_LN1B][c];
            const float* mf = (const float*)(ws + WS_MODF) + (size_t)batch_of_row(m) * 6144; const double ref = (double)DN_ALPHA * x1 + mf[5 * D + c] * a;
            dfail(F, 19, dneq(bf2f(((const bf16*)(ws + WS_RA))[(size_t)m * D + c]), (float)ref, 0.012f, 0.02f)); }
    }
}
__device__ __forceinline__ void dbg_encode(Frame& F) {
    int code = 0;
    for (int k = 24; k >= 1; --k) { if (k == 20 || k == 21) continue; if (__hip_atomic_load((unsigned*)(F.ctl + CW_FAIL + k), __ATOMIC_RELAXED, __HIP_MEMORY_SCOPE_AGENT) != 0u) code = k; }
    if (code == 6) { if (__hip_atomic_load((unsigned*)(F.ctl + CW_FAIL + 21), __ATOMIC_RELAXED, __HIP_MEMORY_SCOPE_AGENT)) code = 21; if (__hip_atomic_load((unsigned*)(F.ctl + CW_FAIL + 20), __ATOMIC_RELAXED, __HIP_MEMORY_SCOPE_AGENT)) code = 20; }
#if MK_DEBUG_FORCE
    code = MK_DEBUG_FORCE;
#endif
    if (code == 0) return;
    const size_t total = (size_t)M * D + (size_t)NB_CTX * 4 * 4096;
    for (size_t i = (size_t)F.bid * 512 + F.tid; i < total; i += (size_t)F.G * 512) F.out[i] = i < (size_t)M_CTX * D ? (float)(code + 1) : 0.f;
}
#define DBG_CHECK(k) do { if (IN(k)) { xcd_barrier(bar); dbg_check(F, k); } } while (0)
#else
#define DBG_CHECK(k) do { } while (0)
#endif
struct Args { const float* in[33]; float* out; unsigned char* ws; int ph_lo, ph_hi; };
__global__ void __launch_bounds__(NWAVES * 64, 2) mk_fwd(Args args) {
    extern __shared__ __attribute__((aligned(16))) unsigned char lds[];
    Frame F;
    F.lds = (LAS unsigned char*)lds;
    F.MISC = (volatile LAS unsigned*)(F.lds + MISC_OFF);
    F.tid = threadIdx.x; F.lane = F.tid & 63; F.wave = __builtin_amdgcn_readfirstlane(F.tid >> 6);
    F.G = gridDim.x; F.bid = blockIdx.x;
#pragma unroll
    for (int i = 0; i < 33; ++i) F.in[i] = args.in[i];
    F.out = args.out; F.ws = args.ws; F.ctl = (gu32*)(args.ws + WS_CTL);
    unsigned char* ws = args.ws;
    for (int u = F.tid; u < (LDS_BYTES - LDSCTL_OFF) / 4; u += NWAVES * 64) ((LAS unsigned*)(F.lds + LDSCTL_OFF))[u] = 0u;
    __syncthreads();
    XcdBarrier bar = xcd_barrier_post((unsigned*)(F.ctl + CW_BAR), F.MISC + 8);
    const int lo = args.ph_lo, hi = args.ph_hi;
#if MK_STAMP
    if (F.bid == 0 && F.tid == 0 && MK_STAMP == 1) F.MISC[20] = (unsigned)__builtin_amdgcn_s_memrealtime();
#define STAMP(k) do { if (F.bid == 0 && F.tid == 0) { if ((k) == MK_STAMP - 2) F.MISC[20] = (unsigned)__builtin_amdgcn_s_memrealtime(); if ((k) == MK_STAMP - 1) F.MISC[21] = (unsigned)__builtin_amdgcn_s_memrealtime(); } } while (0)
#else
#define STAMP(k) do { } while (0)
#endif
#define IN(k) (lo <= (k) && (k) < hi)
#define SEAM(k) do { if (IN(k) && IN((k) + 1)) xcd_barrier(bar); } while (0)
    typedef pg8::bf16_t bt;
#if MK_POISON
    if (IN(0)) {
        v4u pz = (v4u){0xAAAAAAAAu, 0xAAAAAAAAu, 0xAAAAAAAAu, 0xAAAAAAAAu};
        for (size_t i = (size_t)F.bid * 512 + F.tid; i < ((size_t)M * D * 4 + 2 * MiB) / 16; i += (size_t)F.G * 512) ((v4u*)F.out)[i] = pz;
        for (size_t i = (size_t)F.bid * 512 + F.tid; i < (192 * MiB) / 16; i += (size_t)F.G * 512) ((v4u*)(ws + 36 * MiB))[i] = pz;
        for (size_t i = (size_t)F.bid * 512 + F.tid; i < (256 * 1024) / 16; i += (size_t)F.G * 512) ((v4u*)(ws + WS_STATS))[i] = pz;
    }
#endif
    if (IN(0)) { phase0(F); } DBG_CHECK(0); SEAM(0); STAMP(0);
    if (IN(1)) { phase1(F); } DBG_CHECK(1); SEAM(1); STAMP(1);
    if (IN(2)) {
        pg8::Gemm g{(const bt*)(ws + WS_RA), nullptr, (const bt*)(ws + WS_WIN), nullptr, D / 64, 0, D}; g.id_ = 2; pg8::StaticOrder S; S.init(M, DIN, F.G, F.bid);
        pg8::EpiIn E{(bt*)(ws + WS_RB), (bt*)(ws + WS_UB), (bt*)(ws + WS_GA), (bt*)(ws + WS_GB), F.in[I_BIN]};
        pg8::gemm_phase<pg8::EpiIn, pg8::StaticOrder, true, true>(F.lds, g, S, E);
    } DBG_CHECK(2); SEAM(2); STAMP(2);
    if (IN(3)) {
#if MK_STAMP >= 100
        if (F.bid == MK_TB && F.tid == 0) F.MISC[20] = (unsigned)__builtin_amdgcn_s_memrealtime();
#endif
        if (F.G == 256) {
            if (F.bid < 128) s5_task(F, true, F.bid >> 4, 1, F.bid & 15);
            else s5_task(F, false, ((F.bid - 128) >> 4) * 4, 4, (F.bid - 128) & 15);
        } else {
            for (int t = F.bid; t < 640; t += F.G) { if (t < 128) s5_task(F, true, t >> 4, 1, t & 15); else s5_task(F, false, (t - 128) >> 4, 1, (t - 128) & 15); }
        }
#if MK_STAMP == 100
        if (F.bid == MK_TB && F.tid == 0) F.MISC[21] = (unsigned)__builtin_amdgcn_s_memrealtime();
#endif
#if MK_STAMP == 101
        if (F.bid == MK_TB && F.tid == 0) F.MISC[20] = (unsigned)__builtin_amdgcn_s_memrealtime();
#endif
#if MK_OLDPOOL
        for (int tile = F.bid; tile < M / 64; tile += F.G) pool_task_old(F, tile);
#else
        for (int tile = F.bid; tile < M / 64; tile += F.G) pool_task(F, tile);
#endif
        __syncthreads();
#if MK_STAMP == 101
        if (F.bid == MK_TB && F.tid == 0) F.MISC[21] = (unsigned)__builtin_amdgcn_s_memrealtime();
#endif
    } DBG_CHECK(3); SEAM(3); STAMP(3);
#if MK_TRUNC == 3
    { xcd_barrier(bar); const bf16* src = (const bf16*)(ws + WS_RA);
      for (size_t i = (size_t)F.bid * 512 + F.tid; i < (size_t)M * D; i += (size_t)F.G * 512) { const int tok = (int)(i >> 10); const bool lat = tok >= M_CTX; const int L = lat ? L_LAT : L_CTX, t = lat ? (tok - M_CTX) % L_LAT : tok % L_CTX;
          bool keep = true; if (MK_TSEL == 1) keep = !lat; if (MK_TSEL == 2) keep = lat; if (MK_TSEL == 3) keep = t < L / 2; if (MK_TSEL == 4) keep = t >= L / 2; if (MK_TSEL == 5) keep = (t & 31) < 16; if (MK_TSEL == 6) keep = ((i >> 4) & 1) == 0; if (MK_TSEL == 7) keep = lat && t < 512; if (MK_TSEL == 8) keep = lat && t >= 512; if (MK_TSEL == 9) keep = lat && (t < 32 || t >= 992); if (MK_TSEL == 10) keep = lat && (t >= 480 && t < 544);
          F.out[i] = keep ? bf_lo((unsigned)src[i]) : 0.f; }
      return; }
#endif
    if (IN(4)) {
        pg8::Gemm g{(const bt*)(ws + WS_RA), nullptr, (const bt*)(ws + WS_WGLU), nullptr, D / 64, 0, D}; g.id_ = 4; pg8::StaticOrder S; S.init(M, D, F.G, F.bid);
        pg8::EpiGlu E{(const bt*)(ws + WS_RA), (bt*)(ws + WS_RB), F.in[I_BGLU]};
        pg8::gemm_phase<pg8::EpiGlu, pg8::StaticOrder, true, true>(F.lds, g, S, E);
    } DBG_CHECK(4); SEAM(4); STAMP(4);
    if (IN(5)) {
        pg8::Gemm g{(const bt*)(ws + WS_RB), (const bt*)(ws + WS_P), (const bt*)(ws + WS_WPA), (const bt*)(ws + WS_WPB), D / 64, DPOOL / 64, D}; g.id_ = 5; pg8::StaticOrder S; S.init(M, D, F.G, F.bid, 2);
        pg8::EpiMerge E{(const bt*)(ws + WS_GA), (const bt*)(ws + WS_GB), (bt*)(ws + WS_RA)};
        pg8::gemm_phase<pg8::EpiMerge, pg8::StaticOrder, true, true>(F.lds, g, S, E);
    } DBG_CHECK(5); SEAM(5); STAMP(5);
    if (IN(6)) {
        pg8::Gemm g{(const bt*)(ws + WS_RA), nullptr, (const bt*)(ws + WS_WOUT), nullptr, D / 64, 0, D}; g.id_ = 6; pg8::StaticOrder S; S.init(M, D, F.G, F.bid);
        pg8::EpiRes1 E{F.in[I_XP], F.in[I_XS], (bt*)F.out, F.in[I_BOUT], (const float*)(ws + WS_MODF)};
        pg8::gemm_phase<pg8::EpiRes1, pg8::StaticOrder, true, true>(F.lds, g, S, E);
    } DBG_CHECK(6); SEAM(6); STAMP(6);
    if (IN(7)) { phase_ln1(F, (const bf16*)F.out, (float*)(ws + WS_STATS), (bf16*)(ws + WS_RB)); } DBG_CHECK(7); SEAM(7); STAMP(7);
#if MK_TRUNC == 7
    { xcd_barrier(bar); const bf16* src = (const bf16*)(ws + WS_RB); for (size_t i = (size_t)F.bid * 512 + F.tid; i < (size_t)M * D; i += (size_t)F.G * 512) F.out[i] = bf_lo((unsigned)src[i]); return; }
#endif
    if (IN(8)) {
        pg8::Gemm g{(const bt*)(ws + WS_RB), nullptr, (const bt*)(ws + WS_W1), nullptr, D / 64, 0, D}; g.id_ = 8; pg8::StaticOrder S; S.init(M, DFF, F.G, F.bid);
        pg8::EpiRelu2 E{(bt*)(ws + WS_HM), F.in[I_B1]};
        pg8::gemm_phase<pg8::EpiRelu2, pg8::StaticOrder, true, true>(F.lds, g, S, E);
    } DBG_CHECK(8); SEAM(8); STAMP(8);
#if MK_TRUNC == 8
    { xcd_barrier(bar); const bf16* src = (const bf16*)(ws + WS_HM); for (size_t i = (size_t)F.bid * 512 + F.tid; i < (size_t)M * D; i += (size_t)F.G * 512) F.out[i] = bf_lo((unsigned)src[i * 4 + (i & 3)]); return; }
#endif
    if (IN(9)) {
        pg8::Gemm g{(const bt*)(ws + WS_HM), nullptr, (const bt*)(ws + WS_W2), nullptr, DFF / 64, 0, DFF}; g.id_ = 9; pg8::StaticOrder S; S.init(M, D, F.G, F.bid);
        pg8::EpiRes2 E{(const bt*)F.out, (const float*)(ws + WS_STATS), F.in[I_LN1G], F.in[I_LN1B], (bt*)(ws + WS_RA), F.in[I_B2], (const float*)(ws + WS_MODF)};
        pg8::gemm_phase<pg8::EpiRes2, pg8::StaticOrder, true, true>(F.lds, g, S, E);
    } DBG_CHECK(9); SEAM(9); STAMP(9);
#if MK_TRUNC == 9
    { xcd_barrier(bar); const bf16* src = (const bf16*)(ws + WS_RA); for (size_t i = (size_t)F.bid * 512 + F.tid; i < (size_t)M * D; i += (size_t)F.G * 512) F.out[i] = bf_lo((unsigned)src[i]); return; }
#endif
    if (IN(10)) { phase_ln2(F, (const bf16*)(ws + WS_RA)); }
#if MK_STAMP
    STAMP(10); __syncthreads();
    if (F.bid == (MK_STAMP >= 100 ? MK_TB : 0) && F.tid == 0) { asm volatile("s_waitcnt vmcnt(0)" ::: "memory"); F.out[(size_t)(MK_STAMP >= 100 ? MK_TB : 0) * 64 * D] += (MK_STAMP == 120 || MK_STAMP == 130) ? (float)(F.MISC[18] - F.MISC[17]) * (1.0f / 1000.0f) : (MK_STAMP >= 110) ? (float)F.MISC[16] * (16.0f / 21000.0f) : (float)(F.MISC[21] - F.MISC[20]) * (1.0f / 1000.0f); }
#endif
#if MK_DEBUG
    xcd_barrier(bar); dbg_encode(F);
#endif
#undef IN
#undef SEAM
}

#ifndef MK_SPLIT
#define MK_SPLIT 0
#endif
extern "C" void kernel_launch(void* const* d_in, const int* in_sizes, int n_in, void* d_out, int out_size, void* d_ws, size_t ws_size, hipStream_t stream) {
    static int grid = 0;
    if (grid == 0) {
        if (n_in != 33 || ws_size < WS_END) { fprintf(stderr, "kernel_launch: unexpected inputs (n_in %d, ws %zu)\n", n_in, ws_size); grid = -1; return; }
        int dev = 0, cus = 0, per_cu = 0;
        if (hipGetDevice(&dev) != hipSuccess || hipDeviceGetAttribute(&cus, hipDeviceAttributeMultiprocessorCount, dev) != hipSuccess) { grid = -1; return; }
        if (hipFuncSetAttribute((const void*)mk_fwd, hipFuncAttributeMaxDynamicSharedMemorySize, LDS_BYTES) != hipSuccess) { fprintf(stderr, "kernel_launch: hipFuncSetAttribute failed\n"); grid = -1; return; }
        if (hipOccupancyMaxActiveBlocksPerMultiprocessor(&per_cu, (const void*)mk_fwd, NWAVES * 64, LDS_BYTES) != hipSuccess || per_cu < 1) fprintf(stderr, "kernel_launch: occupancy query says %d blocks per CU\n", per_cu);
        (void)hipGetLastError();
        grid = cus;
    }
    if (grid < 0) return;
    (void)hipMemsetAsync((char*)d_ws + WS_CTL, 0, CTL_ZERO_BYTES, stream);
    Args a{};
    for (int i = 0; i < 33; ++i) a.in[i] = (const float*)d_in[i];
    a.out = (float*)d_out; a.ws = (unsigned char*)d_ws;
#if MK_SPLIT
    for (int p = 0; p <= 10; ++p) { a.ph_lo = p; a.ph_hi = p + 1; hipLaunchKernelGGL(mk_fwd, dim3(grid), dim3(NWAVES * 64), LDS_BYTES, stream, a); }
#else
    a.ph_lo = 0; a.ph_hi = 11;
    hipLaunchKernelGGL(mk_fwd, dim3(grid), dim3(NWAVES * 64), LDS_BYTES, stream, a);
#endif
    const hipError_t le = hipPeekAtLastError();
    if (le != hipSuccess) fprintf(stderr, "kernel_launch: launch failed: %s\n", hipGetErrorName(le));
}
```

```cpp
#include <hip/hip_runtime.h>
#include <cstdio>
#include <cstdint>
#ifndef MK_DEBUG
#define MK_DEBUG 0
#endif
#ifndef MK_DEBUG_FORCE
#define MK_DEBUG_FORCE 0
#endif
#ifndef MK_STAMP
#define MK_STAMP 0
#endif
#ifndef MK_TB
#define MK_TB 0
#endif
#ifndef MK_SA
#define MK_SA 4
#endif
#ifndef MK_SB
#define MK_SB 5
#endif
#ifndef MK_OLDPOOL
#define MK_OLDPOOL 0
#endif
#ifndef MK_NOPR
#define MK_NOPR 0
#endif
#ifndef MK_POISON
#define MK_POISON 0
#endif
#ifndef MK_TRUNC
#define MK_TRUNC 0
#endif
#ifndef MK_HSLEEP
#define MK_HSLEEP 0
#endif
#ifndef MK_TSEL
#define MK_TSEL 2
#endif
#ifndef MK_NOS0
#define MK_NOS0 0
#endif
#ifndef MK_NOUL
#define MK_NOUL 0
#endif
#ifndef MK_GPH
#define MK_GPH 8
#endif
#ifndef MK_GUI
#define MK_GUI 1
#endif
namespace pg8 {
#define PG8_LAS __attribute__((address_space(3)))
typedef unsigned short bf16_t;
typedef short bf16x8 __attribute__((ext_vector_type(8)));
typedef float f32x4 __attribute__((ext_vector_type(4)));
typedef unsigned u32x4 __attribute__((ext_vector_type(4)));
constexpr int BM = 256, BK = 64, HALF = 128, HTB = HALF * BK * 2  , STAGE_BYTES = 8 * HTB, NXCD = 8, WGM = 8;

__host__ __device__ __forceinline__ int lds_byte(int r, int c) { const int st = (r >> 4) * 2 + (c >> 5), rr = r & 15, cc = c & 31, ob = rr * 64 + cc * 2; return st * 1024 + (ob ^ (((ob >> 9) & 1) << 5)); }
__host__ __device__ __forceinline__ void stage_rc(int b, int& R, int& C) { const int st = b / 1024, sb = b % 1024, swz = sb ^ (((sb >> 9) & 1) << 5); R = (st >> 1) * 16 + swz / 64; C = (st & 1) * 32 + (swz % 64) / 2; }
__host__ __device__ __forceinline__ int perm32(int rho) { const int n = rho >> 4, i = rho & 15; return 8 * (i >> 2) + 4 * n + (i & 3); }

struct Unit { int pm, pn, part; };
struct Gemm { const bf16_t *A0, *A1, *B0, *B1; int nt0, nt1, ld; int id_ = 0;
    __device__ __forceinline__ const char* a(int part) const { return (const char*)(part ? A1 : A0); }
    __device__ __forceinline__ const char* b(int part) const { return (const char*)(part ? B1 : B0); }
    __device__ __forceinline__ int nt(int part) const { return part ? nt1 : nt0; } };

struct StaticOrder {
    int nM, nN, nwg, G, c, np;
    __host__ __device__ void init(int M, int N, int G_, int c_, int np_ = 1) { nM = M / BM; nN = N / BM; nwg = nM * nN; G = G_; c = c_; np = np_; }
    __host__ __device__ bool next(int ii, Unit& u) const {
        const int i = (np == 2) ? (ii >> 1) : ii; u.part = (np == 2) ? (ii & 1) : 0;
        const long L = (long)i * G + c; if (L >= nwg) return false;
        int wgid = (int)L; { const int q = nwg / NXCD, r = nwg % NXCD, xcd = wgid % NXCD, off = wgid / NXCD; wgid = (xcd < r ? xcd * (q + 1) : r * (q + 1) + (xcd - r) * q) + off; }
        const int nig = WGM * nN, gid = wgid / nig, fm = gid * WGM, gsz = (nM - fm) < WGM ? (nM - fm) : WGM;
        u.pm = fm + ((wgid % nig) % gsz); u.pn = (wgid % nig) / gsz; return true;
    }
    __device__ __forceinline__ void a_ready(const Unit&) const {}
    __device__ __forceinline__ void done(const Unit&) const {}
};
__device__ __forceinline__ unsigned cvt_pk_bf16(float lo, float hi) { unsigned r; asm volatile("v_cvt_pk_bf16_f32 %0, %1, %2" : "=v"(r) : "v"(lo), "v"(hi)); return r; }
typedef float f32x2 __attribute__((ext_vector_type(2)));
#if MK_STAMP == 130
#define GST(id) do { if (g.id_ == MK_GPH && blockIdx.x == MK_TB && threadIdx.x == 0 && ui == MK_GUI) { if ((id) == MK_SA) ((volatile PG8_LAS unsigned*)(lds + 131072 + 320))[17] = (unsigned)__builtin_amdgcn_s_memrealtime(); if ((id) == MK_SB) ((volatile PG8_LAS unsigned*)(lds + 131072 + 320))[18] = (unsigned)__builtin_amdgcn_s_memrealtime(); } } while (0)
#else
#define GST(id) do { } while (0)
#endif
template <class Epi, class Sched, bool ALIGN_EPI = false, bool SP2 = false>
__device__ __forceinline__ void gemm_phase(PG8_LAS unsigned char* lds, const Gemm g, const Sched& S, const Epi& E) {
    const int tid = threadIdx.x, wid = __builtin_amdgcn_readfirstlane(tid >> 6), lane = tid & 63, wr = wid >> 2, wc = wid & 3, fr = lane & 15, fq = lane >> 4;
    const int K = g.ld;
    unsigned voffA[2], voffB[2];
#pragma unroll
    for (int i = 0; i < 2; ++i) { int R, C; stage_rc(tid * 16 + i * 8192, R, C); const int Rb = Epi::PERM ? ((R & ~31) + perm32(R & 31)) : R;
        voffA[i] = (unsigned)(R * K + C) * 2u; voffB[i] = (unsigned)(Rb * K + C) * 2u; }
    const size_t kstep = (size_t)(BK * 2);
    const size_t hstep = (size_t)HALF * K * 2;
    const size_t tstep = 2 * hstep;
    const unsigned ldsw = (unsigned)wid * 1024u;
    const int aoff = lds_byte(wr * 64 + fr, fq * 8), boff = lds_byte(wc * 32 + fr, fq * 8);
#define PG8_SA(b, h) (((b) * 2 + (h)) * HTB)
#define PG8_SB(b, h) ((4 + (b) * 2 + (h)) * HTB)
#define PG8_STAGE(bufoff, gbase, voff) do { _Pragma("unroll") for (int _i = 0; _i < 2; ++_i) \
        __builtin_amdgcn_global_load_lds((const unsigned*)((const char*)(gbase) + (voff)[_i]), (PG8_LAS unsigned*)(lds + (bufoff) + ldsw + _i * 8192), 16, 0, 0); } while (0)
#define PG8_LDA(dst, b, h) do { _Pragma("unroll") for (int m = 0; m < 4; ++m) _Pragma("unroll") for (int k = 0; k < 2; ++k) dst[m][k] = *(const PG8_LAS bf16x8*)(lds + PG8_SA(b, h) + aoff + m * 2048 + k * 1024); } while (0)
#define PG8_LDB(dst, b, h) do { _Pragma("unroll") for (int n = 0; n < 2; ++n) _Pragma("unroll") for (int k = 0; k < 2; ++k) dst[n][k] = *(const PG8_LAS bf16x8*)(lds + PG8_SB(b, h) + boff + n * 2048 + k * 1024); } while (0)
#define PG8_MMA(ai, bj, At, Bt) do { __builtin_amdgcn_s_setprio(1); _Pragma("unroll") for (int m = 0; m < 4; ++m) _Pragma("unroll") for (int n = 0; n < 2; ++n) _Pragma("unroll") for (int k = 0; k < 2; ++k) \
        acc[ai][bj][m][n] = __builtin_amdgcn_mfma_f32_16x16x32_bf16(Bt[n][k], At[m][k], acc[ai][bj][m][n], 0, 0, 0); __builtin_amdgcn_s_setprio(0); } while (0)
#define PG8_WAIT_V(n) asm volatile("s_waitcnt vmcnt(" #n ")" ::: "memory")
#define PG8_WAIT_L(n) asm volatile("s_waitcnt lgkmcnt(" #n ")" ::: "memory")
#define PG8_BAR __builtin_amdgcn_s_barrier()
#define PG8_SCHED __builtin_amdgcn_sched_barrier(0)
    Unit cur, nxt; int ui = 0;
    if (!S.next(0, cur)) return;
    f32x4 acc[2][2][4][2];
#pragma unroll
    for (int a = 0; a < 2; ++a)
#pragma unroll
        for (int b = 0; b < 2; ++b)
#pragma unroll
            for (int m = 0; m < 4; ++m)
#pragma unroll
                for (int n = 0; n < 2; ++n) acc[a][b][m][n] = (f32x4){0.f, 0.f, 0.f, 0.f};
    bf16x8 At[4][2], B0[2][2], B1[2][2];
    const char* cA = g.a(cur.part) + (size_t)cur.pm * tstep; const char* cB = g.b(cur.part) + (size_t)cur.pn * tstep;
    S.a_ready(cur);
    if constexpr (SP2) {
        PG8_STAGE(PG8_SB(0, 0), cB, voffB); PG8_STAGE(PG8_SB(0, 1), cB + hstep, voffB); PG8_STAGE(PG8_SA(0, 0), cA, voffA); PG8_STAGE(PG8_SA(0, 1), cA + hstep, voffA);
        if (wr == 1) PG8_BAR;
        PG8_WAIT_V(2); PG8_BAR;
        PG8_STAGE(PG8_SB(1, 0), cB + kstep, voffB); PG8_STAGE(PG8_SA(1, 0), cA + kstep, voffA); PG8_STAGE(PG8_SB(1, 1), cB + hstep + kstep, voffB);
        PG8_WAIT_V(6); PG8_BAR;
    } else {
        PG8_STAGE(PG8_SB(0, 0), cB, voffB); PG8_STAGE(PG8_SA(0, 0), cA, voffA); PG8_STAGE(PG8_SB(0, 1), cB + hstep, voffB); PG8_STAGE(PG8_SA(0, 1), cA + hstep, voffA);
        if (wr == 1) PG8_BAR;
        PG8_WAIT_V(4); PG8_BAR;
        PG8_STAGE(PG8_SB(1, 0), cB + kstep, voffB); PG8_STAGE(PG8_SA(1, 0), cA + kstep, voffA); PG8_STAGE(PG8_SB(1, 1), cB + hstep + kstep, voffB);
        PG8_WAIT_V(6); PG8_BAR;
    }
    for (;;) {
        const bool has_next = S.next(ui + 1, nxt);
        const char* nA = has_next ? g.a(nxt.part) + (size_t)nxt.pm * tstep : cA; const char* nB = has_next ? g.b(nxt.part) + (size_t)nxt.pn * tstep : cB;
        const int nt = g.nt(cur.part);
        GST(0);
        for (int t = 0; t < nt; t += 2) {
            const bool last = (t == nt - 2);
            const char* a1 = cA + (size_t)(t + 1) * kstep;
            const char* a2 = last ? nA : cA + (size_t)(t + 2) * kstep; const char* b2 = last ? nB : cB + (size_t)(t + 2) * kstep;
            const char* a3 = a2 + kstep; const char* b3 = b2 + kstep;
            if (last && has_next) S.a_ready(nxt);
            if constexpr (SP2) {
            PG8_LDB(B0, 0, 0); PG8_LDB(B1, 0, 1); PG8_SCHED; PG8_LDA(At, 0, 0); PG8_STAGE(PG8_SA(1, 1), a1 + hstep, voffA); PG8_WAIT_V(8); PG8_WAIT_L(0); PG8_BAR; PG8_MMA(0, 0, At, B0); PG8_MMA(0, 1, At, B1); PG8_BAR; PG8_SCHED;
            PG8_LDA(At, 0, 1); PG8_STAGE(PG8_SB(0, 0), b2, voffB); PG8_STAGE(PG8_SB(0, 1), b2 + hstep, voffB); PG8_STAGE(PG8_SA(0, 0), a2, voffA); PG8_WAIT_V(8); PG8_WAIT_L(0); PG8_BAR; PG8_MMA(1, 0, At, B0); PG8_MMA(1, 1, At, B1); PG8_BAR; PG8_SCHED;
            PG8_LDB(B0, 1, 0); PG8_LDB(B1, 1, 1); PG8_SCHED; PG8_LDA(At, 1, 0); PG8_STAGE(PG8_SA(0, 1), a2 + hstep, voffA); PG8_WAIT_V(8); PG8_WAIT_L(0); PG8_BAR; PG8_MMA(0, 0, At, B0); PG8_MMA(0, 1, At, B1); PG8_BAR; PG8_SCHED;
            PG8_LDA(At, 1, 1); PG8_STAGE(PG8_SB(1, 0), b3, voffB); PG8_STAGE(PG8_SB(1, 1), b3 + hstep, voffB); PG8_STAGE(PG8_SA(1, 0), a3, voffA); PG8_WAIT_V(8); PG8_WAIT_L(0); PG8_BAR; PG8_MMA(1, 0, At, B0); PG8_MMA(1, 1, At, B1); PG8_BAR; PG8_SCHED;
            } else {
            PG8_LDB(B0, 0, 0); PG8_SCHED; PG8_LDA(At, 0, 0); PG8_STAGE(PG8_SA(1, 1), a1 + hstep, voffA);
            PG8_WAIT_L(8); PG8_BAR; PG8_WAIT_L(0); PG8_MMA(0, 0, At, B0); PG8_BAR; PG8_SCHED;
            PG8_LDB(B1, 0, 1); PG8_STAGE(PG8_SB(0, 0), b2, voffB);
            PG8_BAR; PG8_WAIT_L(0); PG8_MMA(0, 1, At, B1); PG8_BAR;
            PG8_LDA(At, 0, 1); PG8_STAGE(PG8_SA(0, 0), a2, voffA);
            PG8_BAR; PG8_WAIT_L(0); PG8_MMA(1, 0, At, B0); PG8_BAR; PG8_SCHED;
            PG8_STAGE(PG8_SB(0, 1), b2 + hstep, voffB);
            PG8_WAIT_V(6); PG8_BAR; PG8_MMA(1, 1, At, B1); PG8_BAR;
            PG8_LDB(B0, 1, 0); PG8_SCHED; PG8_LDA(At, 1, 0); PG8_STAGE(PG8_SA(0, 1), a2 + hstep, voffA);
            PG8_WAIT_L(8); PG8_BAR; PG8_WAIT_L(0); PG8_MMA(0, 0, At, B0); PG8_BAR; PG8_SCHED;
            PG8_LDB(B1, 1, 1); PG8_STAGE(PG8_SB(1, 0), b3, voffB);
            PG8_BAR; PG8_WAIT_L(0); PG8_MMA(0, 1, At, B1); PG8_BAR;
            PG8_LDA(At, 1, 1); PG8_STAGE(PG8_SA(1, 0), a3, voffA);
            PG8_BAR; PG8_WAIT_L(0); PG8_MMA(1, 0, At, B0); PG8_BAR; PG8_SCHED;
            PG8_STAGE(PG8_SB(1, 1), b3 + hstep, voffB);
            PG8_WAIT_V(6); PG8_BAR; PG8_MMA(1, 1, At, B1); PG8_BAR;
            }
        }
        GST(1);
        if constexpr (ALIGN_EPI) { if (wr == 0) PG8_BAR; }
        GST(2);
        if constexpr (!Epi::AFTER_DRAIN) { E(acc, cur, wr, wc, fr, fq); S.done(cur); }
        GST(3);
        if (!has_next) break;
        if (!E.keep(cur)) {
#pragma unroll
        for (int a = 0; a < 2; ++a)
#pragma unroll
            for (int b = 0; b < 2; ++b)
#pragma unroll
                for (int m = 0; m < 4; ++m)
#pragma unroll
                    for (int n = 0; n < 2; ++n) acc[a][b][m][n] = (f32x4){0.f, 0.f, 0.f, 0.f};
        }
        cur = nxt; cA = nA; cB = nB; ++ui;
        if constexpr (ALIGN_EPI) { if (wr == 1) PG8_BAR; }
    }
    PG8_WAIT_V(0);
    if constexpr (!ALIGN_EPI) { if (wr == 0) PG8_BAR; }
    PG8_BAR;
    if constexpr (Epi::AFTER_DRAIN) { E.fused(acc, cur, wr, wc, fr, fq, lds, wid, lane); S.done(cur); }
#undef PG8_SA
#undef PG8_SB
#undef PG8_STAGE
#undef PG8_LDA
#undef PG8_LDB
#undef PG8_MMA
#undef PG8_WAIT_V
#undef PG8_WAIT_L
#undef PG8_BAR
#undef PG8_SCHED
}
}
#define GAS __attribute__((address_space(1)))
#define LAS __attribute__((address_space(3)))
typedef unsigned short bf16;
typedef unsigned v4u __attribute__((ext_vector_type(4)));
typedef float f32x4 __attribute__((ext_vector_type(4)));
typedef short bf16x8 __attribute__((ext_vector_type(8)));
typedef GAS unsigned gu32;
typedef GAS unsigned long long gu64;
#define RLX_AGENT __ATOMIC_RELAXED, __HIP_MEMORY_SCOPE_AGENT
#define LDS_WAIT() asm volatile("s_waitcnt lgkmcnt(0)" ::: "memory")
#define VM_WAIT() asm volatile("s_waitcnt vmcnt(0)" ::: "memory")
__device__ __forceinline__ unsigned long long rt() { return __builtin_amdgcn_s_memrealtime(); }
__device__ __forceinline__ unsigned f2bf(float f) { unsigned u = __builtin_bit_cast(unsigned, f); return (u + 0x7fffu + ((u >> 16) & 1u)) >> 16; }
__device__ __forceinline__ unsigned pk2(float lo, float hi) { return f2bf(lo) | (f2bf(hi) << 16); }

#define XB_TMO      128
#define XB_XCNT(j)  (256  + 64 * (j))
#define XB_XSUB(j)  (1280 + 64 * (j))
#define XB_XGEN(j)  (2304 + 64 * (j))
#define XB_TOP      3328
#define XB_TOPGEN   3392
#define XCD_BAR_WORDS 3456
#define XB_SPIN_CAP (1u << 18)

__device__ __forceinline__ unsigned xb_ld(unsigned* p)              { return __hip_atomic_load(p, __ATOMIC_RELAXED, __HIP_MEMORY_SCOPE_AGENT); }
__device__ __forceinline__ unsigned xb_add(unsigned* p, unsigned v) { return __hip_atomic_fetch_add(p, v, __ATOMIC_RELAXED, __HIP_MEMORY_SCOPE_AGENT); }
__device__ __forceinline__ unsigned xb_xcc_id() { return (unsigned)__builtin_amdgcn_s_getreg((3 << 11) | 20) & 0xFu; }
#define XB_SPIN(cond, bar) do { unsigned _sp = 0; while (cond) { __builtin_amdgcn_s_sleep(1); \
    if ((++_sp & 255u) == 0u) { if (xb_ld(&(bar)[XB_TMO])) break; if (_sp > XB_SPIN_CAP) { atomicAdd(&(bar)[XB_TMO], 1u); break; } } } } while (0)

struct XcdBarrier {
    unsigned* bar; unsigned x;
    volatile LAS unsigned* st;
};

__device__ __forceinline__ XcdBarrier xcd_barrier_post(unsigned* bar, volatile LAS unsigned* st) {
    XcdBarrier b; b.bar = bar; b.x = xb_xcc_id(); b.st = st;
    if (threadIdx.x == 0) (void)xb_add(&bar[XB_XCNT(b.x)], 1u);
    return b;
}
__device__ __forceinline__ void xcd_barrier_complete(unsigned* bar, unsigned x, unsigned& nloc, unsigned& nx) {
    const unsigned G = gridDim.x * gridDim.y * gridDim.z;
    unsigned sum, cnt, mine, sp = 0u;
    for (;;) {
        sum = 0u; cnt = 0u; mine = 0u;
#pragma unroll
        for (unsigned j = 0; j < 16; ++j) { const unsigned c = xb_ld(&bar[XB_XCNT(j)]); sum += c; cnt += (c > 0u) ? 1u : 0u; mine = (j == x) ? c : mine; }
        if (sum == G) break;
        __builtin_amdgcn_s_sleep(1);
        if ((++sp & 255u) == 0u) { if (xb_ld(&bar[XB_TMO])) break; if (sp > XB_SPIN_CAP) { atomicAdd(&bar[XB_TMO], 1u); break; } }
    }
    nloc = mine > 0u ? mine : 1u; nx = cnt > 0u ? cnt : 1u;
}

__device__ __forceinline__ void xcd_barrier(const XcdBarrier& b) {
    asm volatile("s_waitcnt vmcnt(0)" ::: "memory");
    __syncthreads();
    if (threadIdx.x == 0) {
        unsigned* bar = b.bar;
        __builtin_amdgcn_s_waitcnt(0);
        unsigned nloc = b.st[0], nx = b.st[1];
        if (nloc == 0u) { xcd_barrier_complete(bar, b.x, nloc, nx); b.st[0] = nloc; b.st[1] = nx; }
        const unsigned old = xb_add(&bar[XB_XSUB(b.x)], 1u);
        const unsigned gen = old / nloc;
        if (old + 1u == (gen + 1u) * nloc) {
            __builtin_amdgcn_fence(__ATOMIC_RELEASE, "agent");
            asm volatile("s_waitcnt vmcnt(0)" ::: "memory");
            const unsigned og = xb_add(&bar[XB_TOP], 1u);
            const unsigned tg = og / nx;
            if (og + 1u == (tg + 1u) * nx) xb_add(&bar[XB_TOPGEN], 1u);
            else XB_SPIN(xb_ld(&bar[XB_TOPGEN]) == tg, bar);
            __builtin_amdgcn_fence(__ATOMIC_ACQUIRE, "agent");
            xb_add(&bar[XB_XGEN(b.x)], 1u);
            asm volatile("s_waitcnt vmcnt(0)" ::: "memory");
        } else {
            XB_SPIN(xb_ld(&bar[XB_XGEN(b.x)]) == gen, bar);
            __builtin_amdgcn_fence(__ATOMIC_ACQUIRE, "agent");
            asm volatile("s_waitcnt vmcnt(0)" ::: "memory");
        }
    }
    __syncthreads();
}
constexpr int D = 1024, M_CTX = 8192, M = 16384, L_CTX = 256, L_LAT = 1024, NB_CTX = 32, NB_LAT = 8;
constexpr int DIN = 3584, DFF = 4096, DPOOL = 512, NGRP = 64, NST = 64, HG = 16;
constexpr float DN_ALPHA = 1.189207115002721f;
constexpr float LN_EPS = 1e-6f;
constexpr int NWAVES = 8;

constexpr size_t MiB = 1u << 20;
constexpr size_t WS_CTL = 0, CTL_ZERO_BYTES = 64 * 1024;
constexpr size_t WS_MODP = 1 * MiB;
constexpr size_t WS_MODF = 2 * MiB;
constexpr size_t WS_STATS = 2 * MiB + 256 * 1024;
constexpr size_t WS_LAMB = 244 * MiB;
constexpr size_t WS_BB2 = 244 * MiB + 256 * 1024;
constexpr size_t WS_V2 = 245 * MiB + 512 * 1024;
constexpr size_t WS_G2 = 246 * MiB + 768 * 1024;
constexpr size_t WS_BB   = 3 * MiB;
constexpr size_t WS_CT   = 3 * MiB + 512 * 1024;
constexpr size_t WS_WIN = 4 * MiB, WS_WGLU = 11 * MiB, WS_WPA = 13 * MiB, WS_WPB = 15 * MiB, WS_WOUT = 17 * MiB, WS_W1 = 19 * MiB, WS_W2 = 27 * MiB, WS_WPOOL = 35 * MiB;
constexpr size_t WS_RA = 36 * MiB;
constexpr size_t WS_RB = 68 * MiB;
constexpr size_t WS_UB = 100 * MiB;
constexpr size_t WS_GA = 116 * MiB, WS_GB = 148 * MiB;
constexpr size_t WS_P  = 180 * MiB;
constexpr size_t WS_HM = 100 * MiB;
constexpr size_t WS_V  = 212 * MiB;
constexpr size_t WS_END = 248 * MiB;
constexpr int CW_BAR = 1024;

constexpr int RING_BYTES = 131072, LDSCTL_OFF = RING_BYTES, MISC_OFF = LDSCTL_OFF + 320, LDS_BYTES = 147456;

typedef unsigned u32x2 __attribute__((ext_vector_type(2)));
typedef float f32x16 __attribute__((ext_vector_type(16)));
__device__ __forceinline__ float bf_lo(unsigned w) { return __builtin_bit_cast(float, w << 16); }
__device__ __forceinline__ float bf_hi(unsigned w) { return __builtin_bit_cast(float, w & 0xffff0000u); }
__device__ __forceinline__ float fsigmoid(float x) { return __builtin_amdgcn_rcpf(1.0f + __builtin_amdgcn_exp2f(-1.4426950408889634f * x)); }
__device__ __forceinline__ float gelu_tanh(float x) { const float u = x * (1.5957691216057308f + 0.0713548162726f * x * x); return x * fsigmoid(u); }

namespace pg8 {
#define EPI_LOOP_BEGIN _Pragma("unroll") for (int ai = 0; ai < 2; ++ai) _Pragma("unroll") for (int m = 0; m < 4; ++m) { const int row = u.pm * BM + ai * HALF + wr * 64 + m * 16 + fr; _Pragma("unroll") for (int bj = 0; bj < 2; ++bj) { const int cl = bj * HALF + wc * 32 + 8 * fq;
#define EPI_LOOP_END } }
__device__ __forceinline__ u32x4 pack8(const f32x4& a, const f32x4& b) { u32x4 w; w.x = cvt_pk_bf16(a[0], a[1]); w.y = cvt_pk_bf16(a[2], a[3]); w.z = cvt_pk_bf16(b[0], b[1]); w.w = cvt_pk_bf16(b[2], b[3]); return w; }
__device__ __forceinline__ void unpack8(const u32x4& w, f32x4& a, f32x4& b) { a = (f32x4){bf_lo(w.x), bf_hi(w.x), bf_lo(w.y), bf_hi(w.y)}; b = (f32x4){bf_lo(w.z), bf_hi(w.z), bf_lo(w.w), bf_hi(w.w)}; }

struct EpiIn {
    static constexpr bool PERM = true, AFTER_DRAIN = false;
    bf16_t *ua, *ub, *ga, *gb; const float* bias;
    __device__ __forceinline__ bool keep(const Unit&) const { return false; }
    __device__ __forceinline__ int nstores(const Unit&) const { return 16; }
    __device__ __forceinline__ void operator()(f32x4 (&acc)[2][2][4][2], const Unit& u, int wr, int wc, int fr, int fq) const {
        if (u.pn < 6) {
            bf16_t* base; int ldc, c0;
            if (u.pn < 4) { base = ua; ldc = D; c0 = u.pn * BM; } else { base = ub; ldc = DPOOL; c0 = (u.pn - 4) * BM; }
            EPI_LOOP_BEGIN
                const float* bp = bias + u.pn * BM + cl; f32x4 v0 = acc[ai][bj][m][0] + *(const f32x4*)bp, v1 = acc[ai][bj][m][1] + *(const f32x4*)(bp + 4);
                *(u32x4*)(base + (size_t)row * ldc + c0 + cl) = pack8(v0, v1);
            EPI_LOOP_END
        } else {
            const int jt = u.pn - 6, clq = wc * 32 + 8 * fq, col = 128 * jt + clq;
            const float* ba = bias + 1536 + col; const float* bb = bias + 2560 + col;
            const f32x4 ba0 = *(const f32x4*)ba, ba1 = *(const f32x4*)(ba + 4), bb0 = *(const f32x4*)bb, bb1 = *(const f32x4*)(bb + 4);
#pragma unroll
            for (int ai = 0; ai < 2; ++ai)
#pragma unroll
                for (int m = 0; m < 4; ++m) { const int row = u.pm * BM + ai * HALF + wr * 64 + m * 16 + fr;
                    f32x4 a0 = acc[ai][0][m][0] + ba0, a1 = acc[ai][0][m][1] + ba1, b0 = acc[ai][1][m][0] + bb0, b1 = acc[ai][1][m][1] + bb1;
#pragma unroll
                    for (int j = 0; j < 4; ++j) { const float s0 = fsigmoid(b0[j]), s1 = fsigmoid(b1[j]); a0[j] = fsigmoid(a0[j]) * __builtin_amdgcn_rcpf(fmaxf(s0, 1e-30f)); a1[j] = fsigmoid(a1[j]) * __builtin_amdgcn_rcpf(fmaxf(s1, 1e-30f)); b0[j] = s0; b1[j] = s1; }
                    *(u32x4*)(ga + (size_t)row * D + col) = pack8(a0, a1); *(u32x4*)(gb + (size_t)row * D + col) = pack8(b0, b1); }
        }
    }
};
struct EpiGlu {
    static constexpr bool PERM = true, AFTER_DRAIN = false;
    const bf16_t* v; bf16_t* o; const float* bias;
    __device__ __forceinline__ bool keep(const Unit&) const { return false; }
    __device__ __forceinline__ int nstores(const Unit&) const { return 16; }
    __device__ __forceinline__ void operator()(f32x4 (&acc)[2][2][4][2], const Unit& u, int wr, int wc, int fr, int fq) const {
        EPI_LOOP_BEGIN
            const int col = u.pn * BM + cl; const float* bp = bias + col; f32x4 t0 = acc[ai][bj][m][0] + *(const f32x4*)bp, t1 = acc[ai][bj][m][1] + *(const f32x4*)(bp + 4);
            f32x4 x0, x1; unpack8(*(const u32x4*)(v + (size_t)row * D + col), x0, x1);
#pragma unroll
            for (int j = 0; j < 4; ++j) { t0[j] = x0[j] * fsigmoid(t0[j]); t1[j] = x1[j] * fsigmoid(t1[j]); }
            *(u32x4*)(o + (size_t)row * D + col) = pack8(t0, t1);
        EPI_LOOP_END
    }
};
struct EpiMerge {
    static constexpr bool PERM = true, AFTER_DRAIN = false;
    const bf16_t *ga, *gb; bf16_t* o;
    __device__ __forceinline__ bool keep(const Unit& u) const { return u.part == 0; }
    __device__ __forceinline__ int nstores(const Unit& u) const { return u.part == 0 ? 0 : 16; }
    __device__ __forceinline__ void operator()(f32x4 (&acc)[2][2][4][2], const Unit& u, int wr, int wc, int fr, int fq) const {
        EPI_LOOP_BEGIN
            const size_t off = (size_t)row * D + u.pn * BM + cl;
            if (u.part == 0) { f32x4 a0, a1; unpack8(*(const u32x4*)(ga + off), a0, a1); acc[ai][bj][m][0] *= a0; acc[ai][bj][m][1] *= a1; }
            else { f32x4 b0, b1; unpack8(*(const u32x4*)(gb + off), b0, b1); *(u32x4*)(o + off) = pack8(acc[ai][bj][m][0] * b0, acc[ai][bj][m][1] * b1); }
        EPI_LOOP_END
    }
};
struct EpiRes1 {
    static constexpr bool PERM = true, AFTER_DRAIN = false;
    const float *x_ctx, *x_lat; bf16_t* out; const float* bias; const float* modf;
    __device__ __forceinline__ bool keep(const Unit&) const { return false; }
    __device__ __forceinline__ int nstores(const Unit&) const { return 16; }
    __device__ __forceinline__ void operator()(f32x4 (&acc)[2][2][4][2], const Unit& u, int wr, int wc, int fr, int fq) const {
        const int r0 = u.pm * BM; const int bidx = r0 < M_CTX ? 0 : 1 + (r0 - M_CTX) / L_LAT;
        const float* gate = modf + (size_t)bidx * 6 * D + 2 * D; const float* bs = r0 < M_CTX ? x_ctx : x_lat - (size_t)M_CTX * D;
        EPI_LOOP_BEGIN
            const int col = u.pn * BM + cl; const size_t off = (size_t)row * D + col;
            const f32x4 g0 = *(const f32x4*)(gate + col), g1 = *(const f32x4*)(gate + col + 4), c0 = *(const f32x4*)(bias + col), c1 = *(const f32x4*)(bias + col + 4);
            const f32x4 x0 = *(const f32x4*)(bs + off), x1 = *(const f32x4*)(bs + off + 4);
            *(u32x4*)(out + off) = pack8(x0 * DN_ALPHA + g0 * (acc[ai][bj][m][0] + c0), x1 * DN_ALPHA + g1 * (acc[ai][bj][m][1] + c1));
        EPI_LOOP_END
    }
};
struct EpiRes2 {
    static constexpr bool PERM = true, AFTER_DRAIN = false;
    const bf16_t* r1; const float* stats; const float *lg, *lb; bf16_t* out; const float* bias; const float* modf;
    __device__ __forceinline__ bool keep(const Unit&) const { return false; }
    __device__ __forceinline__ int nstores(const Unit&) const { return 16; }
    __device__ __forceinline__ void operator()(f32x4 (&acc)[2][2][4][2], const Unit& u, int wr, int wc, int fr, int fq) const {
        const int r0 = u.pm * BM; const int bidx = r0 < M_CTX ? 0 : 1 + (r0 - M_CTX) / L_LAT;
        const float* gate = modf + (size_t)bidx * 6 * D + 5 * D;
        EPI_LOOP_BEGIN
            const int col = u.pn * BM + cl; const size_t off = (size_t)row * D + col;
            const f32x4 g0 = *(const f32x4*)(gate + col), g1 = *(const f32x4*)(gate + col + 4), c0 = *(const f32x4*)(bias + col), c1 = *(const f32x4*)(bias + col + 4);
            const f32x4 lg0 = *(const f32x4*)(lg + col), lg1 = *(const f32x4*)(lg + col + 4), lb0 = *(const f32x4*)(lb + col), lb1 = *(const f32x4*)(lb + col + 4);
            const float mu = stats[2 * row], rs = stats[2 * row + 1];
            f32x4 x0, x1; unpack8(*(const u32x4*)(r1 + off), x0, x1);
            x0 = (x0 - mu) * rs * lg0 + lb0; x1 = (x1 - mu) * rs * lg1 + lb1;
            *(u32x4*)(out + off) = pack8(x0 * DN_ALPHA + g0 * (acc[ai][bj][m][0] + c0), x1 * DN_ALPHA + g1 * (acc[ai][bj][m][1] + c1));
        EPI_LOOP_END
    }
};
struct EpiRelu2 {
    static constexpr bool PERM = true, AFTER_DRAIN = false;
    bf16_t* o; const float* bias;
    __device__ __forceinline__ bool keep(const Unit&) const { return false; }
    __device__ __forceinline__ int nstores(const Unit&) const { return 16; }
    __device__ __forceinline__ void operator()(f32x4 (&acc)[2][2][4][2], const Unit& u, int wr, int wc, int fr, int fq) const {
        EPI_LOOP_BEGIN
            const int col = u.pn * BM + cl; f32x4 t0 = acc[ai][bj][m][0] + *(const f32x4*)(bias + col), t1 = acc[ai][bj][m][1] + *(const f32x4*)(bias + col + 4);
#pragma unroll
            for (int j = 0; j < 4; ++j) { const float a = fmaxf(t0[j], 0.f), b = fmaxf(t1[j], 0.f); t0[j] = a * a; t1[j] = b * b; }
            *(u32x4*)(o + (size_t)row * DFF + col) = pack8(t0, t1);
        EPI_LOOP_END
    }
};
}
struct Frame {
    LAS unsigned char* lds;
    volatile LAS unsigned* MISC;
    gu32* ctl;
    int tid, lane, wave, G, bid;
    const float* in[33]; float* out; unsigned char* ws;
};
enum { I_XP = 0, I_XS, I_STATE, I_C, I_CCTX, I_WADA, I_BADA, I_WIN, I_BIN, I_LAMRE, I_LAMIM, I_LOGDT, I_BRE, I_BIM, I_CRE, I_CIM, I_S5D, I_WGLU, I_BGLU, I_WPA, I_WPOOL, I_PSCALE, I_WPB,
       I_WOUT, I_BOUT, I_LN1G, I_LN1B, I_W1, I_B1, I_W2, I_B2, I_LN2G, I_LN2B };

__device__ __forceinline__ float wave_sum(float v) {
#pragma unroll
    for (int o = 1; o < 64; o <<= 1) v += __shfl_xor(v, o);
    return v;
}
template <bool GATEPERM = false> __device__ __forceinline__ void p0_transpose_item(const float* W, int N, bf16* WT, int ldt, LAS unsigned* scr, int item, int lane) {
    const int nblk = N / 64, kb = item / nblk, nb = item % nblk, k0 = 64 * kb, n0 = 64 * nb, q = lane & 15, kp = lane >> 4;
    const int n0o = !GATEPERM || n0 < 1536 ? n0 : (n0 < 2560 ? 1536 + 256 * ((n0 - 1536) >> 7) + ((n0 - 1536) & 127) : 1536 + 256 * ((n0 - 2560) >> 7) + 128 + ((n0 - 2560) & 127));
    f32x4 v0[8], v1[8];
#pragma unroll
    for (int i = 0; i < 8; ++i) { const float* p = W + (size_t)(k0 + 8 * i + 2 * kp) * N + n0 + 4 * q; v0[i] = *(const f32x4*)p; v1[i] = *(const f32x4*)(p + N); }
#pragma unroll
    for (int i = 0; i < 8; ++i)
#pragma unroll
        for (int j = 0; j < 4; ++j) scr[(4 * q + j) * 33 + 4 * i + kp] = pk2(v0[i][j], v1[i][j]);
    LDS_WAIT(); asm volatile("" ::: "memory");
    const int kc = lane & 7;
#pragma unroll
    for (int jj = 0; jj < 8; ++jj) { const int n = 8 * jj + (lane >> 3); const LAS unsigned* s = scr + n * 33 + 4 * kc;
        v4u o; o.x = s[0]; o.y = s[1]; o.z = s[2]; o.w = s[3];
        *(GAS v4u*)(WT + (size_t)(n0o + n) * ldt + k0 + 8 * kc) = o; }
    LDS_WAIT(); asm volatile("" ::: "memory");
}

__device__ __forceinline__ void phase0(Frame& F) {
    unsigned char* ws = F.ws;
    if (F.bid < 96) {
        const int cc = F.bid % 24, kq = F.bid / 24, k0 = kq * 256 + F.wave * 32;
        LAS float* sv = (LAS float*)(F.lds) + F.wave * 288;
        LAS float* red = (LAS float*)(F.lds + 16384);
        if (F.lane < 32) {
#pragma unroll
            for (int r = 0; r < 9; ++r) { const float cv = r == 0 ? F.in[I_CCTX][k0 + F.lane] : F.in[I_C][(size_t)(r - 1) * D + k0 + F.lane]; sv[r * 32 + F.lane] = cv * fsigmoid(cv); }
        }
        LDS_WAIT(); asm volatile("" ::: "memory");
        f32x4 a[9];
#pragma unroll
        for (int r = 0; r < 9; ++r) a[r] = (f32x4){0.f, 0.f, 0.f, 0.f};
        const float* wp = F.in[I_WADA] + (size_t)k0 * 6144 + cc * 256 + F.lane * 4;
#pragma unroll 8
        for (int k = 0; k < 32; ++k) { const f32x4 w = *(const f32x4*)(wp + (size_t)k * 6144);
#pragma unroll
            for (int r = 0; r < 9; ++r) a[r] += w * sv[r * 32 + k]; }
#pragma unroll
        for (int r = 0; r < 9; ++r) *(LAS f32x4*)(red + (F.wave * 9 + r) * 256 + F.lane * 4) = a[r];
        __syncthreads();
        float* mp = (float*)(ws + WS_MODP) + (size_t)kq * 9 * 6144;
        for (int i = F.tid; i < 9 * 256; i += NWAVES * 64) { const int r = i >> 8, c = i & 255; float s = 0.f;
#pragma unroll
            for (int w = 0; w < 8; ++w) s += red[(w * 9 + r) * 256 + c];
            mp[(size_t)r * 6144 + cc * 256 + c] = s; }
        __syncthreads();
    }
    for (int wt = (F.G >= 112 ? F.bid - (F.G - 16) : F.bid) * NWAVES + F.wave; wt >= 0 && wt < 2 * NGRP; wt += (F.G >= 112 ? 16 : F.G) * NWAVES) {
        const int dir = wt >> 6, g = wt & 63, p = F.lane, it = wt * 64 + p;
        const float lr = F.in[I_LAMRE][it], li = F.in[I_LAMIM][it], dt = expf(F.in[I_LOGDT][wt]);
        const float zr = lr * dt, zi = li * dt, e = expf(zr); float sn, cs; sincosf(zi, &sn, &cs);
        const float lbr = e * cs, lbi = e * sn, l2r = lbr * lbr - lbi * lbi, l2i = 2.f * lbr * lbi;
        const float sh = sinf(0.5f * zi); const float nr = expm1f(zr) * cs - 2.f * sh * sh, ni = lbi;
        const float den = 1.f / (lr * lr + li * li); const float wr_ = (nr * lr + ni * li) * den, wi_ = (ni * lr - nr * li) * den;
        *(f32x4*)((float*)(ws + WS_LAMB) + (size_t)it * 4) = (f32x4){lbr, lbi, l2r, l2i};
        float br[16], bi[16], ar[16], ai[16], cr[16], ci[16];
#pragma unroll
        for (int h = 0; h < 16; ++h) { const float r0 = F.in[I_BRE][(size_t)it * 16 + h], i0 = F.in[I_BIM][(size_t)it * 16 + h];
            br[h] = wr_ * r0 - wi_ * i0; bi[h] = wr_ * i0 + wi_ * r0; ar[h] = lbr * br[h] - lbi * bi[h]; ai[h] = lbr * bi[h] + lbi * br[h];
            const size_t cix = ((size_t)wt * 16 + h) * 64 + p; cr[h] = F.in[I_CRE][cix]; ci[h] = F.in[I_CIM][cix]; }
        { bf16* bb = (bf16*)(ws + WS_BB2);
#pragma unroll
          for (int i = 0; i < 2; ++i)
#pragma unroll
            for (int part = 0; part < 2; ++part) { unsigned o[8];
#pragma unroll
              for (int h = 0; h < 8; ++h) { const float v0 = i == 0 ? (part == 0 ? ar[2 * h] : ai[2 * h]) : (part == 0 ? br[2 * h] : bi[2 * h]), v1 = i == 0 ? (part == 0 ? ar[2 * h + 1] : ai[2 * h + 1]) : (part == 0 ? br[2 * h + 1] : bi[2 * h + 1]); o[h] = pk2(v0, v1); }
              v4u* d = (v4u*)(bb + ((size_t)((i * 128 + wt) * 2 + part) * 64 + p) * 16); d[0] = (v4u){o[0], o[1], o[2], o[3]}; d[1] = (v4u){o[4], o[5], o[6], o[7]}; } }
        { bf16* v2 = (bf16*)(ws + WS_V2) + (size_t)wt * 2 * 16 * 128;
#pragma unroll
          for (int h = 0; h < 16; ++h) { const float c1r = cr[h] * lbr - ci[h] * lbi, c1i = cr[h] * lbi + ci[h] * lbr, c2r = cr[h] * l2r - ci[h] * l2i, c2i = cr[h] * l2i + ci[h] * l2r;
              *(unsigned*)(v2 + (0 * 16 + h) * 128 + 2 * p) = pk2(c1r, -c1i); *(unsigned*)(v2 + (1 * 16 + h) * 128 + 2 * p) = pk2(c2r, -c2i); } }
        { LAS unsigned* sc = (LAS unsigned*)(F.lds + F.wave * 16384);
#pragma unroll
          for (int h = 0; h < 16; ++h) { sc[h * 64 + p] = pk2(cr[h], -ci[h]); sc[1024 + h * 64 + p] = pk2(br[h], bi[h]); sc[2048 + h * 64 + p] = pk2(ar[h], ai[h]); }
          LDS_WAIT(); asm volatile("" ::: "memory");
          f32x4 k0 = (f32x4){0.f, 0.f, 0.f, 0.f}, k1 = (f32x4){0.f, 0.f, 0.f, 0.f};
#pragma unroll
          for (int ks = 0; ks < 4; ++ks) { const int o = (F.lane & 15) * 64 + 16 * ks + 4 * (F.lane >> 4);
              const bf16x8 af = *(const LAS bf16x8*)(sc + o), b0 = *(const LAS bf16x8*)(sc + 1024 + o), b1 = *(const LAS bf16x8*)(sc + 2048 + o);
              k0 = __builtin_amdgcn_mfma_f32_16x16x32_bf16(af, b0, k0, 0, 0, 0); k1 = __builtin_amdgcn_mfma_f32_16x16x32_bf16(af, b1, k1, 0, 0, 0); }
          bf16* g2 = (bf16*)(ws + WS_G2) + (size_t)wt * 2 * 16 * 32; const int hp = F.lane & 15;
#pragma unroll
          for (int r = 0; r < 4; ++r) { const int h = 4 * (F.lane >> 4) + r; const float kd = k0[r] + (h == hp ? F.in[I_S5D][dir * D + g * 16 + h] : 0.f);
              g2[(0 * 16 + h) * 32 + hp] = (bf16)f2bf(kd); g2[(0 * 16 + h) * 32 + 16 + hp] = (bf16)0; g2[(1 * 16 + h) * 32 + hp] = (bf16)f2bf(k1[r]); g2[(1 * 16 + h) * 32 + 16 + hp] = (bf16)f2bf(kd); }
          LDS_WAIT(); asm volatile("" ::: "memory"); }
    }
    {
        LAS unsigned* scr = (LAS unsigned*)(F.lds + F.wave * 16384);
        const int gw = F.bid * NWAVES + F.wave, NGW = F.G * NWAVES;
        constexpr int I_IN = (D / 64) * (DIN / 64), I_SQ = (D / 64) * (D / 64), I_PB = (DPOOL / 64) * (D / 64), I_1 = (D / 64) * (DFF / 64), I_2 = (DFF / 64) * (D / 64), I_PL = 4 * 2 * 2;
        constexpr int NITEMS = I_IN + 3 * I_SQ + I_PB + I_1 + I_2 + I_PL;
        for (int it = gw; it < NITEMS; it += NGW) {
            int r = it;
            if (r < I_1) { p0_transpose_item(F.in[I_W1], DFF, (bf16*)(ws + WS_W1), D, scr, r, F.lane); continue; } r -= I_1;
            if (r < I_2) { p0_transpose_item(F.in[I_W2], D, (bf16*)(ws + WS_W2), DFF, scr, r, F.lane); continue; } r -= I_2;
            if (r < I_IN) { p0_transpose_item<true>(F.in[I_WIN], DIN, (bf16*)(ws + WS_WIN), D, scr, r, F.lane); continue; } r -= I_IN;
            if (r < I_SQ) { p0_transpose_item(F.in[I_WGLU], D, (bf16*)(ws + WS_WGLU), D, scr, r, F.lane); continue; } r -= I_SQ;
            if (r < I_SQ) { p0_transpose_item(F.in[I_WPA], D, (bf16*)(ws + WS_WPA), D, scr, r, F.lane); continue; } r -= I_SQ;
            if (r < I_SQ) { p0_transpose_item(F.in[I_WOUT], D, (bf16*)(ws + WS_WOUT), D, scr, r, F.lane); continue; } r -= I_SQ;
            if (r < I_PB) { p0_transpose_item(F.in[I_WPB], D, (bf16*)(ws + WS_WPB), D, scr, r, F.lane); continue; } r -= I_PB;
            { const int gi = r >> 2; p0_transpose_item(F.in[I_WPOOL] + (size_t)gi * 128 * 128, 128, (bf16*)(ws + WS_WPOOL) + (size_t)gi * 128 * 128, 128, scr, r & 3, F.lane); }
        }
    }
}

__device__ __forceinline__ f32x4 mod4(Frame& F, int bidx, int idx) {
    const float* mp = (const float*)(F.ws + WS_MODP) + (size_t)bidx * 6144 + idx;
    f32x4 s = *(const f32x4*)(F.in[I_BADA] + idx);
#pragma unroll
    for (int q = 0; q < 4; ++q) s += *(const f32x4*)(mp + (size_t)q * 9 * 6144);
    return s;
}
__device__ __forceinline__ int batch_of_row(int r0) { return r0 < M_CTX ? 0 : 1 + (r0 - M_CTX) / L_LAT; }

__device__ __forceinline__ void phase1(Frame& F) {
    LAS f32x4* sc = (LAS f32x4*)(F.lds); LAS f32x4* sh = (LAS f32x4*)(F.lds + 4096);
    bf16* H = (bf16*)(F.ws + WS_RA);
    if (F.bid < 9) { float* mf = (float*)(F.ws + WS_MODF) + (size_t)F.bid * 6144; for (int i = F.tid; i < 6144 / 4; i += NWAVES * 64) *(f32x4*)(mf + 4 * i) = mod4(F, F.bid, 4 * i); }
    for (int rb = F.bid; rb < M / 64; rb += F.G) {
        const int r0 = rb * 64, bidx = batch_of_row(r0);
        __syncthreads();
        if (F.tid < 256) { sc[F.tid] = mod4(F, bidx, D + 4 * F.tid) + 1.0f; sh[F.tid] = mod4(F, bidx, 4 * F.tid); }
        __syncthreads();
        f32x4 xv[8][4];
#pragma unroll
        for (int j = 0; j < 8; ++j) { const int m = r0 + F.wave * 8 + j;
            const float* xrow = (m < M_CTX ? F.in[I_XP] + (size_t)m * D : F.in[I_XS] + (size_t)(m - M_CTX) * D); const GAS f32x4* xr = (const GAS f32x4*)xrow + F.lane;
#pragma unroll
            for (int q = 0; q < 4; ++q) xv[j][q] = xr[64 * q]; }
#pragma unroll
        for (int j = 0; j < 8; ++j) {
            const int m = r0 + F.wave * 8 + j;
            f32x4 v[4]; float s = 0.f;
#pragma unroll
            for (int q = 0; q < 4; ++q) { v[q] = xv[j][q]; s += (v[q].x + v[q].y) + (v[q].z + v[q].w); }
            const float mean = wave_sum(s) * (1.f / D); float s2 = 0.f;
#pragma unroll
            for (int q = 0; q < 4; ++q) { v[q] = v[q] - mean; s2 += (v[q].x * v[q].x + v[q].y * v[q].y) + (v[q].z * v[q].z + v[q].w * v[q].w); }
            const float rstd = 1.f / sqrtf(wave_sum(s2) * (1.f / D) + LN_EPS);
            GAS u32x2* o8 = (GAS u32x2*)(H + (size_t)m * D) + F.lane;
#pragma unroll
            for (int q = 0; q < 4; ++q) { const f32x4 y = v[q] * rstd * sc[F.lane + 64 * q] + sh[F.lane + 64 * q]; u32x2 w; w.x = pg8::cvt_pk_bf16(y.x, y.y); w.y = pg8::cvt_pk_bf16(y.z, y.w); o8[64 * q] = w; }
        }
    }
}

__device__ __forceinline__ void unpack4(const u32x2 w, f32x4& v) { v = (f32x4){bf_lo(w.x), bf_hi(w.x), bf_lo(w.y), bf_hi(w.y)}; }
__device__ __forceinline__ void phase_ln1(Frame& F, const bf16* R1, float* stats, bf16* H2) {
    LAS f32x4* sc = (LAS f32x4*)(F.lds); LAS f32x4* sh = (LAS f32x4*)(F.lds + 4096);
    const float* lg = F.in[I_LN1G]; const float* lb = F.in[I_LN1B];
    for (int rb = F.bid; rb < M / 64; rb += F.G) {
        const int r0 = rb * 64, bidx = batch_of_row(r0);
        __syncthreads();
        const float* mf = (const float*)(F.ws + WS_MODF) + (size_t)bidx * 6144;
        if (F.tid < 256) { sc[F.tid] = *(const f32x4*)(mf + 4 * D + 4 * F.tid) + 1.0f; sh[F.tid] = *(const f32x4*)(mf + 3 * D + 4 * F.tid); }
        __syncthreads();
        f32x4 gg[4], bb[4];
#pragma unroll
        for (int q = 0; q < 4; ++q) { gg[q] = *(const f32x4*)(lg + 4 * (F.lane + 64 * q)); bb[q] = *(const f32x4*)(lb + 4 * (F.lane + 64 * q)); }
        u32x2 raw[8][4];
#pragma unroll
        for (int j = 0; j < 8; ++j)
#pragma unroll
            for (int q = 0; q < 4; ++q) raw[j][q] = ((const GAS u32x2*)(R1 + (size_t)(r0 + F.wave * 8 + j) * D))[F.lane + 64 * q];
#pragma unroll
        for (int j = 0; j < 8; ++j) {
            const int m = r0 + F.wave * 8 + j;
            f32x4 v[4]; float s = 0.f;
#pragma unroll
            for (int q = 0; q < 4; ++q) { unpack4(raw[j][q], v[q]); s += (v[q].x + v[q].y) + (v[q].z + v[q].w); }
            float mean = wave_sum(s) * (1.f / D), s2 = 0.f;
#pragma unroll
            for (int q = 0; q < 4; ++q) { v[q] = v[q] - mean; s2 += (v[q].x * v[q].x + v[q].y * v[q].y) + (v[q].z * v[q].z + v[q].w * v[q].w); }
            float rstd = 1.f / sqrtf(wave_sum(s2) * (1.f / D) + LN_EPS);
            if (F.lane == 0) { stats[2 * m] = mean; stats[2 * m + 1] = rstd; }
            s = 0.f;
#pragma unroll
            for (int q = 0; q < 4; ++q) { v[q] = v[q] * rstd * gg[q] + bb[q]; s += (v[q].x + v[q].y) + (v[q].z + v[q].w); }
            mean = wave_sum(s) * (1.f / D); s2 = 0.f;
#pragma unroll
            for (int q = 0; q < 4; ++q) { v[q] = v[q] - mean; s2 += (v[q].x * v[q].x + v[q].y * v[q].y) + (v[q].z * v[q].z + v[q].w * v[q].w); }
            rstd = 1.f / sqrtf(wave_sum(s2) * (1.f / D) + LN_EPS);
            GAS u32x2* o8 = (GAS u32x2*)(H2 + (size_t)m * D) + F.lane;
#pragma unroll
            for (int q = 0; q < 4; ++q) { const f32x4 y = v[q] * rstd * sc[F.lane + 64 * q] + sh[F.lane + 64 * q]; u32x2 w; w.x = pg8::cvt_pk_bf16(y.x, y.y); w.y = pg8::cvt_pk_bf16(y.z, y.w); o8[64 * q] = w; }
        }
    }
}
__device__ __forceinline__ void phase_ln2(Frame& F, const bf16* R2) {
    const float* lg = F.in[I_LN2G]; const float* lb = F.in[I_LN2B];
    f32x4 gg[4], bb[4];
#pragma unroll
    for (int q = 0; q < 4; ++q) { gg[q] = *(const f32x4*)(lg + 4 * (F.lane + 64 * q)); bb[q] = *(const f32x4*)(lb + 4 * (F.lane + 64 * q)); }
    for (int rb = F.bid; rb < M / 64; rb += F.G) {
        const int r0 = rb * 64;
        u32x2 raw[8][4];
#pragma unroll
        for (int j = 0; j < 8; ++j)
#pragma unroll
            for (int q = 0; q < 4; ++q) raw[j][q] = ((const GAS u32x2*)(R2 + (size_t)(r0 + F.wave * 8 + j) * D))[F.lane + 64 * q];
#pragma unroll
        for (int j = 0; j < 8; ++j) {
            const int m = r0 + F.wave * 8 + j;
            f32x4 v[4]; float s = 0.f;
#pragma unroll
            for (int q = 0; q < 4; ++q) { unpack4(raw[j][q], v[q]); s += (v[q].x + v[q].y) + (v[q].z + v[q].w); }
            const float mean = wave_sum(s) * (1.f / D); float s2 = 0.f;
#pragma unroll
            for (int q = 0; q < 4; ++q) { v[q] = v[q] - mean; s2 += (v[q].x * v[q].x + v[q].y * v[q].y) + (v[q].z * v[q].z + v[q].w * v[q].w); }
            const float rstd = 1.f / sqrtf(wave_sum(s2) * (1.f / D) + LN_EPS);
            GAS f32x4* xr = (GAS f32x4*)(F.out + (size_t)m * D) + F.lane;
#pragma unroll
            for (int q = 0; q < 4; ++q) xr[64 * q] = v[q] * rstd * gg[q] + bb[q];
        }
    }
}
constexpr int S5_ROWB = 288, S5_WAVEB = 32 * S5_ROWB;
__device__ __forceinline__ void s5_task(Frame& F, bool lat, int seq0, int nseq, int gq) {
    const int lane = F.lane, n = lane & 31, hf = lane >> 5, g = gq * 4 + (F.wave >> 1), dir = F.wave & 1, wt = dir * 64 + g;
    const int L = lat ? L_LAT : L_CTX, nch = L / 64;
    const bf16* UA = (const bf16*)(F.ws + WS_RB); bf16* V = (bf16*)(F.ws + WS_RA); float* PART = F.out;
    LAS unsigned char* sl = F.lds + F.wave * S5_WAVEB;
    bf16x8 Bf[2][2][2], Vf[2][4], Gf[2];
    { const bf16* bb = (const bf16*)(F.ws + WS_BB2);
#pragma unroll
      for (int i = 0; i < 2; ++i)
#pragma unroll
        for (int q = 0; q < 2; ++q)
#pragma unroll
          for (int part = 0; part < 2; ++part) Bf[i][q][part] = *(const bf16x8*)(bb + ((size_t)((i * 128 + wt) * 2 + part) * 64 + (n + 32 * q)) * 16 + 8 * hf);
      const bf16* v2 = (const bf16*)(F.ws + WS_V2) + (size_t)wt * 2 * 16 * 128 + (lane & 15) * 128 + 8 * (lane >> 4);
#pragma unroll
      for (int j = 0; j < 2; ++j)
#pragma unroll
        for (int ks = 0; ks < 4; ++ks) Vf[j][ks] = *(const bf16x8*)(v2 + j * 16 * 128 + 32 * ks);
      const bf16* g2 = (const bf16*)(F.ws + WS_G2) + (size_t)wt * 2 * 16 * 32 + (lane & 15) * 32 + 8 * (lane >> 4);
#pragma unroll
      for (int j = 0; j < 2; ++j) Gf[j] = *(const bf16x8*)(g2 + j * 16 * 32); }
    const int p = n + 32 * hf;
    const float lr = ((const float*)(F.ws + WS_LAMB))[((size_t)wt * 64 + p) * 4 + 2], li = ((const float*)(F.ws + WS_LAMB))[((size_t)wt * 64 + p) * 4 + 3];
  for (int sq = 0; sq < nseq; ++sq) {
    const int seq = seq0 + sq, tokbase = lat ? (M_CTX + seq * L_LAT) : seq * L_CTX;
    float sr = 0.f, si = 0.f;
    if (lat) { const float* st = F.in[I_STATE] + ((size_t)(seq * 2 + dir) * 2) * 4096 + g * 64 + p; sr = st[0]; si = st[4096]; }
    const int blkA = 16 * ((n >> 2) & 1) + (n & 3) + 4 * (n >> 3);
    const int tA0 = dir ? 63 - 2 * blkA : 2 * blkA, tA1 = dir ? 62 - 2 * blkA : 2 * blkA + 1;
    const bf16* ua_lane = UA + (size_t)tokbase * D + g * 16 + 8 * hf;
    const bf16* ub_lane = UA + (size_t)tokbase * D + g * 16 + 8 * ((lane >> 4) & 1);
    const int tU0 = dir ? 63 - (2 * (lane & 15) + hf) : 2 * (lane & 15) + hf, tU1 = dir ? 63 - (2 * (16 + (lane & 15)) + hf) : 2 * (16 + (lane & 15)) + hf;
    const int h0 = 4 * (lane >> 4), colg = g * 16 + h0;
    bf16x8 A0 = *(const bf16x8*)(ua_lane + (size_t)((dir ? L - 64 : 0) + tA0) * D), A1 = *(const bf16x8*)(ua_lane + (size_t)((dir ? L - 64 : 0) + tA1) * D);
    for (int c = 0; c < nch; ++c) {
        const int t0 = dir ? L - 64 * (c + 1) : 64 * c;
        if (c == nch / 2) { asm volatile("s_waitcnt vmcnt(0)" ::: "memory"); __syncthreads(); }
        const f32x16 z16 = {0.f, 0.f, 0.f, 0.f, 0.f, 0.f, 0.f, 0.f, 0.f, 0.f, 0.f, 0.f, 0.f, 0.f, 0.f, 0.f};
        f32x16 x00 = __builtin_amdgcn_mfma_f32_32x32x16_bf16(A0, Bf[0][0][0], z16, 0, 0, 0);
        f32x16 x01 = __builtin_amdgcn_mfma_f32_32x32x16_bf16(A0, Bf[0][0][1], z16, 0, 0, 0);
        f32x16 x10 = __builtin_amdgcn_mfma_f32_32x32x16_bf16(A0, Bf[0][1][0], z16, 0, 0, 0);
        f32x16 x11 = __builtin_amdgcn_mfma_f32_32x32x16_bf16(A0, Bf[0][1][1], z16, 0, 0, 0);
        x00 = __builtin_amdgcn_mfma_f32_32x32x16_bf16(A1, Bf[1][0][0], x00, 0, 0, 0);
        x01 = __builtin_amdgcn_mfma_f32_32x32x16_bf16(A1, Bf[1][0][1], x01, 0, 0, 0);
        x10 = __builtin_amdgcn_mfma_f32_32x32x16_bf16(A1, Bf[1][1][0], x10, 0, 0, 0);
        x11 = __builtin_amdgcn_mfma_f32_32x32x16_bf16(A1, Bf[1][1][1], x11, 0, 0, 0);
        const bf16x8 Ub0 = *(const bf16x8*)(ub_lane + (size_t)(t0 + tU0) * D), Ub1 = *(const bf16x8*)(ub_lane + (size_t)(t0 + tU1) * D);
        if (c + 1 < nch) { const int t1 = dir ? L - 64 * (c + 2) : 64 * (c + 1); A0 = *(const bf16x8*)(ua_lane + (size_t)(t1 + tA0) * D); A1 = *(const bf16x8*)(ua_lane + (size_t)(t1 + tA1) * D); }
        float xr0[16], xi0[16], xr1[16], xi1[16];
#pragma unroll
        for (int i = 0; i < 16; ++i) {
            { auto r = __builtin_amdgcn_permlane32_swap(__float_as_uint(x00[i]), __float_as_uint(x10[i]), false, false); xr0[i] = __uint_as_float(r[0]); xr1[i] = __uint_as_float(r[1]); }
            { auto r = __builtin_amdgcn_permlane32_swap(__float_as_uint(x01[i]), __float_as_uint(x11[i]), false, false); xi0[i] = __uint_as_float(r[0]); xi1[i] = __uint_as_float(r[1]); }
        }
        LAS unsigned* srow = (LAS unsigned*)(sl + p * 4);
#pragma unroll
        for (int i = 0; i < 16; ++i) { srow[i * (S5_ROWB / 4)] = pg8::cvt_pk_bf16(sr, si); const float nr = __builtin_fmaf(lr, sr, __builtin_fmaf(-li, si, xr0[i])), ni = __builtin_fmaf(lr, si, __builtin_fmaf(li, sr, xi0[i])); sr = nr; si = ni; }
#pragma unroll
        for (int i = 0; i < 16; ++i) { srow[(16 + i) * (S5_ROWB / 4)] = pg8::cvt_pk_bf16(sr, si); const float nr = __builtin_fmaf(lr, sr, __builtin_fmaf(-li, si, xr1[i])), ni = __builtin_fmaf(lr, si, __builtin_fmaf(li, sr, xi1[i])); sr = nr; si = ni; }
        asm volatile("" ::: "memory");
        f32x4 y[2][2];
#pragma unroll
        for (int ct = 0; ct < 2; ++ct) { bf16x8 sb[4];
#pragma unroll
            for (int ks = 0; ks < 4; ++ks) sb[ks] = *(const LAS bf16x8*)(sl + (16 * ct + (lane & 15)) * S5_ROWB + (32 * ks + 8 * (lane >> 4)) * 2);
#pragma unroll
            for (int j = 0; j < 2; ++j) { f32x4 a = (f32x4){0.f, 0.f, 0.f, 0.f};
#pragma unroll
                for (int ks = 0; ks < 4; ++ks) a = __builtin_amdgcn_mfma_f32_16x16x32_bf16(Vf[j][ks], sb[ks], a, 0, 0, 0);
                y[ct][j] = __builtin_amdgcn_mfma_f32_16x16x32_bf16(Gf[j], ct == 0 ? Ub0 : Ub1, a, 0, 0, 0); } }
        asm volatile("" ::: "memory");
        size_t off[2][2];
#pragma unroll
        for (int ct = 0; ct < 2; ++ct)
#pragma unroll
          for (int j = 0; j < 2; ++j) { const int tau = 2 * (16 * ct + (lane & 15)) + j; off[ct][j] = (size_t)(tokbase + t0 + (dir ? 63 - tau : tau)) * D + colg; }
        if (c < nch / 2) {
#pragma unroll
            for (int ct = 0; ct < 2; ++ct)
#pragma unroll
              for (int j = 0; j < 2; ++j) *(f32x4*)(PART + off[ct][j]) = y[ct][j];
        } else {
            f32x4 pv[2][2];
#pragma unroll
            for (int ct = 0; ct < 2; ++ct)
#pragma unroll
              for (int j = 0; j < 2; ++j) pv[ct][j] = *(const f32x4*)(PART + off[ct][j]);
#pragma unroll
            for (int ct = 0; ct < 2; ++ct)
#pragma unroll
              for (int j = 0; j < 2; ++j) { const f32x4 t = y[ct][j] + pv[ct][j];
                u32x2 w; w.x = pg8::cvt_pk_bf16(gelu_tanh(t.x), gelu_tanh(t.y)); w.y = pg8::cvt_pk_bf16(gelu_tanh(t.z), gelu_tanh(t.w)); *(u32x2*)(V + off[ct][j]) = w; }
        }
    }
    if (!lat) { float* o = F.out + (size_t)M * D + ((size_t)(seq * 2 + dir) * 2) * 4096 + g * 64 + p; o[0] = sr; o[4096] = si; }
  }
}

constexpr int PL_ROWB = 1056;
#if MK_STAMP == 120
#define PST(id) do { if (F.bid == MK_TB && F.tid == 0) { if ((id) == MK_SA) F.MISC[17] = (unsigned)__builtin_amdgcn_s_memrealtime(); if ((id) == MK_SB) F.MISC[18] = (unsigned)__builtin_amdgcn_s_memrealtime(); } } while (0)
#else
#define PST(id) do { } while (0)
#endif
__device__ __forceinline__ void pool_task(Frame& F, int tile) {
    PST(0);
    const int tok0 = tile * 64; const bool lat = tile >= M_CTX / 64; const int npr = lat ? 64 : L_CTX, off = lat ? 0 : (tile & 3) * 64;
    const bf16* UB = (const bf16*)(F.ws + WS_UB); bf16* P = (bf16*)(F.ws + WS_P); const bf16* WPT = (const bf16*)(F.ws + WS_WPOOL);
    LAS unsigned char* ul = F.lds;
    const int lane = F.lane, gi3 = F.wave >> 1, oh = F.wave & 1;
    bf16x8 Wf[4][4];
#pragma unroll
    for (int ot = 0; ot < 4; ++ot)
#pragma unroll
        for (int ks = 0; ks < 4; ++ks) Wf[ot][ks] = *(const bf16x8*)(WPT + ((size_t)gi3 * 128 + 64 * oh + 16 * ot + (lane & 15)) * 128 + 32 * ks + 8 * (lane >> 4));
    f32x4 psc[4];
#pragma unroll
    for (int ot = 0; ot < 4; ++ot) psc[ot] = *(const f32x4*)(F.in[I_PSCALE] + gi3 * 128 + 64 * oh + 4 * (lane >> 4) + 16 * ot);
    __syncthreads();
    PST(1);
    { v4u v[10];
#pragma unroll
      for (int q = 0; q < 10; ++q) { const int i = F.tid + q * 512, j = i >> 6, pc = i & 63; const int tt = off + j - 8, ttc = min(max(tt, 0), npr - 1);
          v[q] = *(const v4u*)(UB + (size_t)(tok0 - off + ttc) * DPOOL + pc * 8); }
#pragma unroll
      for (int q = 0; q < 10; ++q) { const int i = F.tid + q * 512, j = i >> 6, pc = i & 63; const int tt = off + j - 8; const bool ok = tt >= 0 && tt < npr;
          v4u w = v[q]; w.x = ok ? w.x : 0u; w.y = ok ? w.y : 0u; w.z = ok ? w.z : 0u; w.w = ok ? w.w : 0u; *(LAS v4u*)(ul + j * PL_ROWB + pc * 16) = w; } }
    __syncthreads();
    PST(2);
    unsigned pm[32];
    { const int cp = F.tid & 255, th = F.tid >> 8, gi = cp >> 6, w = 2 << gi, hw = w >> 1; const LAS unsigned char* ucol = ul + cp * 4 + (th * 32 + 8) * PL_ROWB;
      float s0 = 0.f, s1 = 0.f;
      for (int d = -hw; d < hw; ++d) { const unsigned x = *(const LAS unsigned*)(ucol + d * PL_ROWB); s0 += bf_lo(x); s1 += bf_hi(x); }
      const int tt0 = off + th * 32;
#pragma unroll
      for (int j = 0; j < 32; ++j) {
          const unsigned xc = *(const LAS unsigned*)(ucol + j * PL_ROWB); const int tt = tt0 + j; const float inv = __builtin_amdgcn_rcpf((float)(min(tt - hw + w, npr) - max(tt - hw, 0)));
          pm[j] = pg8::cvt_pk_bf16(s0 * inv - bf_lo(xc), s1 * inv - bf_hi(xc));
          const unsigned xa = *(const LAS unsigned*)(ucol + (j + hw) * PL_ROWB), xs = *(const LAS unsigned*)(ucol + (j - hw) * PL_ROWB);
          s0 += bf_lo(xa) - bf_lo(xs); s1 += bf_hi(xa) - bf_hi(xs); }
      PST(3);
      __syncthreads();
#pragma unroll
      for (int j = 0; j < 32; ++j) *(LAS unsigned*)(ul + (th * 32 + j) * PL_ROWB + cp * 4) = pm[j]; }
    __syncthreads();
    PST(4);
    { const int obase = gi3 * 128 + 64 * oh + 4 * (lane >> 4);
#pragma unroll
      for (int tt = 0; tt < 4; ++tt) { bf16x8 pb[4];
#pragma unroll
          for (int ks = 0; ks < 4; ++ks) pb[ks] = *(const LAS bf16x8*)(ul + (16 * tt + (lane & 15)) * PL_ROWB + (gi3 * 128 + 32 * ks + 8 * (lane >> 4)) * 2);
#pragma unroll
          for (int ot = 0; ot < 4; ++ot) { f32x4 a = (f32x4){0.f, 0.f, 0.f, 0.f};
#pragma unroll
              for (int ks = 0; ks < 4; ++ks) a = __builtin_amdgcn_mfma_f32_16x16x32_bf16(Wf[ot][ks], pb[ks], a, 0, 0, 0);
              const int o0 = obase + 16 * ot; a = a * psc[ot]; u32x2 wv; wv.x = pg8::cvt_pk_bf16(a.x, a.y); wv.y = pg8::cvt_pk_bf16(a.z, a.w);
              *(u32x2*)(P + (size_t)(tok0 + 16 * tt + (lane & 15)) * D + o0) = wv; } } }
    PST(5);
}
constexpr int PLO_ROWB = 288;
__device__ __forceinline__ void pool_task_old(Frame& F, int tile) {
    const int tok0 = tile * 64; const bool lat = tile >= M_CTX / 64; const int npr = lat ? 64 : L_CTX, off = lat ? 0 : (tile & 3) * 64;
    const bf16* UB = (const bf16*)(F.ws + WS_UB); bf16* P = (bf16*)(F.ws + WS_P); const bf16* WPT = (const bf16*)(F.ws + WS_WPOOL);
    LAS unsigned char* ul = F.lds; LAS unsigned char* pl = F.lds + 80 * PLO_ROWB;
    const int lane = F.lane;
    for (int gi = 0; gi < 4; ++gi) {
        const int w = 2 << gi, hw = w >> 1;
        __syncthreads();
        for (int i = F.tid; i < 80 * 16; i += NWAVES * 64) { const int j = i >> 4, pc = i & 15; const int tt = off + j - 8; v4u v = (v4u){0u, 0u, 0u, 0u};
            if (tt >= 0 && tt < npr) v = *(const v4u*)(UB + (size_t)(tok0 - off + tt) * DPOOL + gi * 128 + pc * 8);
            *(LAS v4u*)(ul + j * PLO_ROWB + pc * 16) = v; }
        __syncthreads();
        { const int cp = F.tid & 63, tr = F.tid >> 6; const LAS unsigned char* ucol = ul + cp * 4;
          int tt = off + tr * 8; int lo = max(tt - hw, 0), hi = min(tt - hw + w, npr); float s0 = 0.f, s1 = 0.f;
          for (int q = lo; q < hi; ++q) { const unsigned x = *(const LAS unsigned*)(ucol + (q - off + 8) * PLO_ROWB); s0 += bf_lo(x); s1 += bf_hi(x); }
          for (int j = 0; j < 8; ++j) {
              const unsigned xc = *(const LAS unsigned*)(ucol + (tr * 8 + j + 8) * PLO_ROWB); const float inv = 1.0f / (float)(hi - lo);
              *(LAS unsigned*)(pl + (tr * 8 + j) * PLO_ROWB + cp * 4) = pg8::cvt_pk_bf16(s0 * inv - bf_lo(xc), s1 * inv - bf_hi(xc));
              ++tt; const int nlo = max(tt - hw, 0), nhi = min(tt - hw + w, npr);
              if (nhi > hi) { const unsigned x = *(const LAS unsigned*)(ucol + (hi - off + 8) * PLO_ROWB); s0 += bf_lo(x); s1 += bf_hi(x); }
              if (nlo > lo) { const unsigned x = *(const LAS unsigned*)(ucol + (lo - off + 8) * PLO_ROWB); s0 -= bf_lo(x); s1 -= bf_hi(x); }
              lo = nlo; hi = nhi; } }
        __syncthreads();
        { bf16x8 Wf[4];
#pragma unroll
          for (int ks = 0; ks < 4; ++ks) Wf[ks] = *(const bf16x8*)(WPT + ((size_t)gi * 128 + 16 * F.wave + (lane & 15)) * 128 + 32 * ks + 8 * (lane >> 4));
          const int o0 = gi * 128 + 16 * F.wave + 4 * (lane >> 4); const f32x4 ps = *(const f32x4*)(F.in[I_PSCALE] + o0);
#pragma unroll
          for (int tt = 0; tt < 4; ++tt) { f32x4 a = (f32x4){0.f, 0.f, 0.f, 0.f};
#pragma unroll
              for (int ks = 0; ks < 4; ++ks) { const bf16x8 pb = *(const LAS bf16x8*)(pl + (16 * tt + (lane & 15)) * PLO_ROWB + (32 * ks + 8 * (lane >> 4)) * 2);
                  a = __builtin_amdgcn_mfma_f32_16x16x32_bf16(Wf[ks], pb, a, 0, 0, 0); }
              a = a * ps; u32x2 wv; wv.x = pg8::cvt_pk_bf16(a.x, a.y); wv.y = pg8::cvt_pk_bf16(a.z, a.w);
              *(u32x2*)(P + (size_t)(tok0 + 16 * tt + (lane & 15)) * D + o0) = wv; } }
    }
}
#if MK_DEBUG
constexpr int CW_FAIL = 8192;
constexpr size_t WS_DBG = 230 * MiB;
__device__ __forceinline__ unsigned dh(unsigned i) { i ^= i >> 16; i *= 0x7feb352du; i ^= i >> 15; i *= 0x846ca68bu; i ^= i >> 16; return i; }
__device__ __forceinline__ float bf2f(bf16 b) { return __builtin_bit_cast(float, (unsigned)b << 16); }
__device__ __forceinline__ void dfail(Frame& F, int id, bool bad) { if (bad) atomicAdd((unsigned*)(F.ctl + CW_FAIL + id), 1u); }
__device__ __forceinline__ bool dneq(float got, float ref, float rel, float abs_) { const float d = fabsf(got - ref); return !(d <= rel * fabsf(ref) + abs_); }
__device__ __forceinline__ const float* xrow_ptr(Frame& F, int m) { return m < M_CTX ? F.in[I_XP] + (size_t)m * D : F.in[I_XS] + (size_t)(m - M_CTX) * D; }

__device__ __forceinline__ void dbg_wt(Frame& F, const float* W, int K, int N, const bf16* WT, int ldt, unsigned salt, int nlim = 1 << 30) {
    for (int s = F.tid; s < 2048; s += 512) { const unsigned h = dh(s * 2u + salt); const int k = h % K, n = (h >> 12) % (N < nlim ? N : nlim); const float w = W[(size_t)k * N + n], t = bf2f(WT[(size_t)n * ldt + k]);
        dfail(F, 1, dneq(t, w, 0.0045f, 1e-30f)); }
}
__device__ __forceinline__ void dbg_check(Frame& F, int phase) {
    if (F.bid != 0) return;
    unsigned char* ws = F.ws;
    if (phase == 0) {
        dbg_wt(F, F.in[I_WIN], D, DIN, (const bf16*)(ws + WS_WIN), D, 11, 1536); dbg_wt(F, F.in[I_WGLU], D, D, (const bf16*)(ws + WS_WGLU), D, 12); dbg_wt(F, F.in[I_WPA], D, D, (const bf16*)(ws + WS_WPA), D, 13);
        dbg_wt(F, F.in[I_WPB], DPOOL, D, (const bf16*)(ws + WS_WPB), D, 14); dbg_wt(F, F.in[I_WOUT], D, D, (const bf16*)(ws + WS_WOUT), D, 15); dbg_wt(F, F.in[I_W1], D, DFF, (const bf16*)(ws + WS_W1), D, 16);
        dbg_wt(F, F.in[I_W2], DFF, D, (const bf16*)(ws + WS_W2), DFF, 17);
        for (int gi = 0; gi < 4; ++gi) dbg_wt(F, F.in[I_WPOOL] + gi * 16384, 128, 128, (const bf16*)(ws + WS_WPOOL) + gi * 16384, 128, 18 + gi);
        for (int s = F.tid; s < 2048; s += 512) {
            const int it = dh(s + 77u) % 8192; const int p = it & 63, g = (it >> 6) & 63, dir = it >> 12;
            const double lr = F.in[I_LAMRE][it], li = F.in[I_LAMIM][it], dt = exp((double)F.in[I_LOGDT][dir * 64 + g]);
            const double e = exp(lr * dt), lbr = e * cos(li * dt), lbi = e * sin(li * dt), nr = lbr - 1.0, ni = lbi, den = lr * lr + li * li, wr = (nr * lr + ni * li) / den, wi = (ni * lr - nr * li) / den;
            const float* lamb = (const float*)(ws + WS_LAMB) + (size_t)it * 4; dfail(F, 2, dneq(lamb[0], (float)lbr, 1e-5f, 1e-6f) || dneq(lamb[1], (float)lbi, 1e-5f, 1e-6f));
            const int h = dh(s + 99u) & 15; const double br = F.in[I_BRE][(size_t)it * 16 + h], bi = F.in[I_BIM][(size_t)it * 16 + h];
            const bf16* bb = (const bf16*)(ws + WS_BB2) + (size_t)128 * 2 * 64 * 16;
            dfail(F, 2, dneq(bf2f(bb[((size_t)((dir * 64 + g) * 2 + 0) * 64 + p) * 16 + h]), (float)(wr * br - wi * bi), 0.01f, 1e-6f) || dneq(bf2f(bb[((size_t)((dir * 64 + g) * 2 + 1) * 64 + p) * 16 + h]), (float)(wr * bi + wi * br), 0.01f, 1e-6f));
            const bf16* v2 = (const bf16*)(ws + WS_V2) + ((size_t)(dir * 64 + g) * 2 * 16 + h) * 128; const size_t ci = ((size_t)(dir * 64 + g) * 16 + h) * 64 + p;
            const double cre = F.in[I_CRE][ci], cim = F.in[I_CIM][ci];
            dfail(F, 2, dneq(bf2f(v2[2 * p]), (float)(cre * lbr - cim * lbi), 0.006f, 1e-5f) || dneq(bf2f(v2[2 * p + 1]), (float)-(cre * lbi + cim * lbr), 0.006f, 1e-5f));
        }
    }
    if (phase == 1) {
        for (int s = F.tid; s < 1024; s += 512) {
            const unsigned h = dh(s + 5u); const int r = h % 9, idx = (h >> 8) % 6144; double a = F.in[I_BADA][idx];
            for (int k = 0; k < D; ++k) { const double cv = r == 0 ? F.in[I_CCTX][k] : F.in[I_C][(size_t)(r - 1) * D + k]; a += cv / (1.0 + exp(-cv)) * (double)F.in[I_WADA][(size_t)k * 6144 + idx]; }
            dfail(F, 3, dneq(((const float*)(ws + WS_MODF))[(size_t)r * 6144 + idx], (float)a, 1e-4f, 1e-4f));
        }
        for (int s = F.tid; s < 1024; s += 512) {
            const unsigned h = dh(s + 1234u); const int m = h % M, j = (h >> 16) % D; const float* x = xrow_ptr(F, m); double mu = 0, var = 0;
            for (int k = 0; k < D; ++k) mu += x[k]; mu /= D; for (int k = 0; k < D; ++k) { const double d = x[k] - mu; var += d * d; } var /= D;
            const float* mf = (const float*)(ws + WS_MODF) + (size_t)batch_of_row(m) * 6144;
            const double y = (x[j] - mu) / sqrt(var + 1e-6) * (1.0 + mf[D + j]) + mf[j];
            dfail(F, 4, dneq(bf2f(((const bf16*)(ws + WS_RA))[(size_t)m * D + j]), (float)y, 0.006f, 0.004f));
        }
    }
    if (phase == 2) {
        for (int s = F.tid; s < 2048; s += 512) { const unsigned h = dh(s + 4321u); const int m = h % M, zc = (h >> 14) % DIN; const bf16* hr = (const bf16*)(ws + WS_RA) + (size_t)m * D;
            if (zc < 1536) { double a = F.in[I_BIN][zc];
                for (int k = 0; k < D; ++k) a += (double)bf2f(hr[k]) * (double)F.in[I_WIN][(size_t)k * DIN + zc];
                const float got = zc < 1024 ? bf2f(((const bf16*)(ws + WS_RB))[(size_t)m * D + zc]) : bf2f(((const bf16*)(ws + WS_UB))[(size_t)m * DPOOL + zc - 1024]);
                dfail(F, 5, dneq(got, (float)a, 0.01f, 0.02f)); }
            else { const int col = (zc - 1536) & 1023; double a = F.in[I_BIN][1536 + col], b = F.in[I_BIN][2560 + col];
                for (int k = 0; k < D; ++k) { const double hv = bf2f(hr[k]); a += hv * (double)F.in[I_WIN][(size_t)k * DIN + 1536 + col]; b += hv * (double)F.in[I_WIN][(size_t)k * DIN + 2560 + col]; }
                const double sa = 1.0 / (1.0 + exp(-a)), sb = 1.0 / (1.0 + exp(-b));
                dfail(F, 5, dneq(bf2f(((const bf16*)(ws + WS_GA))[(size_t)m * D + col]), (float)(sa / sb), 0.03f, 0.02f) || dneq(bf2f(((const bf16*)(ws + WS_GB))[(size_t)m * D + col]), (float)sb, 0.01f, 0.02f)); } }
    }
    if (phase == 3) {
        { const int w = F.wave, lane = F.lane; const bool lat = w < 2; const unsigned h = dh(w + 31u); const int seq = lat ? (h % NB_LAT) : w, g = lat ? (h >> 8) % NGRP : 3 * w + 1;
          const int L = lat ? L_LAT : L_CTX, tokbase = lat ? M_CTX + seq * L_LAT : seq * L_CTX; const bf16* UA = (const bf16*)(ws + WS_RB); const bf16* V = (const bf16*)(ws + WS_RA);
          float* yf = (float*)(ws + WS_DBG) + (size_t)w * L_LAT * 16;
          for (int dir = 0; dir < 2; ++dir) {
              const int it = (dir * 64 + g) * 64 + lane; const float lr = F.in[I_LAMRE][it], li = F.in[I_LAMIM][it], dt = expf(F.in[I_LOGDT][dir * 64 + g]);
              const float e = expf(lr * dt), lbr = e * cosf(li * dt), lbi = e * sinf(li * dt), nr = lbr - 1.f, ni = lbi, den = 1.f / (lr * lr + li * li), wr = (nr * lr + ni * li) * den, wi = (ni * lr - nr * li) * den;
              float br[16], bi[16], cr[16], cim[16];
#pragma unroll
              for (int hh = 0; hh < 16; ++hh) { const float a = F.in[I_BRE][(size_t)it * 16 + hh], b = F.in[I_BIM][(size_t)it * 16 + hh]; br[hh] = wr * a - wi * b; bi[hh] = wr * b + wi * a;
                  const size_t ci = ((size_t)(dir * 64 + g) * 16 + hh) * 64 + lane; cr[hh] = F.in[I_CRE][ci]; cim[hh] = F.in[I_CIM][ci]; }
              float sr = 0.f, si = 0.f; if (lat) { const float* st = F.in[I_STATE] + ((size_t)(seq * 2 + dir) * 2) * 4096 + g * 64 + lane; sr = st[0]; si = st[4096]; }
              for (int tq = 0; tq < L; ++tq) { const int t = dir ? L - 1 - tq : tq; const bf16* ur = UA + (size_t)(tokbase + t) * D + g * 16; float bur = 0.f, bui = 0.f;
#pragma unroll
                  for (int hh = 0; hh < 16; ++hh) { const float u = bf2f(ur[hh]); bur += br[hh] * u; bui += bi[hh] * u; }
                  const float nsr = lbr * sr - lbi * si + bur, nsi = lbr * si + lbi * sr + bui; sr = nsr; si = nsi;
                  if (!lat && dir == 0 && tq < 32) { const float* dx = (const float*)(ws + 231 * MiB) + (size_t)seq * 32 * 64 * 4 + (tq * 64 + lane) * 4;
                      dfail(F, 20, dneq(dx[0], bur, 0.02f, 0.002f) || dneq(dx[1], bui, 0.02f, 0.002f)); dfail(F, 21, dneq(dx[2], sr, 0.02f, 0.002f) || dneq(dx[3], si, 0.02f, 0.002f)); }
                  float mine = 0.f;
#pragma unroll
                  for (int hh = 0; hh < 16; ++hh) { const float y = wave_sum(cr[hh] * sr - cim[hh] * si); if (lane == hh) mine = y; }
                  if (lane < 16) { const float pt = F.out[(size_t)(tokbase + t) * D + g * 16 + lane];
                      const float mined = mine + F.in[I_S5D][dir * D + g * 16 + lane] * bf2f(ur[lane]);
                      if (dir == 0) { yf[(size_t)t * 16 + lane] = mine; if (t < L / 2) dfail(F, lat ? 10 : 6, dneq(pt, mined, 0.03f, 0.01f)); }
                      else { if (t >= L / 2) dfail(F, lat ? 11 : 7, dneq(pt, mined, 0.03f, 0.01f)); const float u = bf2f(ur[lane]); const float tot = yf[(size_t)t * 16 + lane] + mine + (F.in[I_S5D][g * 16 + lane] + F.in[I_S5D][D + g * 16 + lane]) * u;
                          const float ref = tot / (1.f + expf(-1.5957691216f * (tot + 0.044715f * tot * tot * tot)));
                          dfail(F, lat ? 12 : 8, dneq(bf2f(V[(size_t)(tokbase + t) * D + g * 16 + lane]), ref, 0.03f, 0.03f)); } }
              }
              if (!lat) { const float* o = F.out + (size_t)M * D + ((size_t)(seq * 2 + dir) * 2) * 4096 + g * 64 + lane; dfail(F, 9, dneq(o[0], sr, 0.02f, 0.01f) || dneq(o[4096], si, 0.02f, 0.01f)); }
              __builtin_amdgcn_s_waitcnt(0);
          } }
        for (int s = F.tid; s < 2048; s += 512) { const unsigned h = dh(s + 999u); const int tok = h % M, o = (h >> 14) % DPOOL, gi = o >> 7, w = 2 << gi; const bool lat = tok >= M_CTX;
            const int npr = lat ? 64 : L_CTX, rs = lat ? (tok & ~63) : (tok & ~255), tt = tok - rs, lo = max(tt - w / 2, 0), hi = min(tt - w / 2 + w, npr); const bf16* UB = (const bf16*)(ws + WS_UB); double a = 0;
            for (int i = 0; i < 128; ++i) { double sum = 0; for (int q = lo; q < hi; ++q) sum += bf2f(UB[(size_t)(rs + q) * DPOOL + gi * 128 + i]);
                const double pm = sum / (hi - lo) - bf2f(UB[(size_t)tok * DPOOL + gi * 128 + i]); a += pm * (double)F.in[I_WPOOL][((size_t)gi * 128 + i) * 128 + (o & 127)]; }
            a *= F.in[I_PSCALE][o]; dfail(F, 13, dneq(bf2f(((const bf16*)(ws + WS_P))[(size_t)tok * D + o]), (float)a, 0.02f, 0.02f)); }
    }
    if (phase == 4) {
        for (int s = F.tid; s < 2048; s += 512) { const unsigned h = dh(s + 41u); const int m = h % M, c = (h >> 14) % D; const bf16* vr = (const bf16*)(ws + WS_RA) + (size_t)m * D; double a = F.in[I_BGLU][c];
            for (int k = 0; k < D; ++k) a += (double)bf2f(vr[k]) * (double)F.in[I_WGLU][(size_t)k * D + c];
            const double ref = bf2f(vr[c]) / (1.0 + exp(-a)); dfail(F, 14, dneq(bf2f(((const bf16*)(ws + WS_RB))[(size_t)m * D + c]), (float)ref, 0.02f, 0.02f)); }
    }
    if (phase == 5) {
        for (int s = F.tid; s < 2048; s += 512) { const unsigned h = dh(s + 51u); const int m = h % M, c = (h >> 14) % D; const bf16* v2 = (const bf16*)(ws + WS_RB) + (size_t)m * D; const bf16* pr = (const bf16*)(ws + WS_P) + (size_t)m * D; double ya = 0, yb = 0;
            for (int k = 0; k < D; ++k) ya += (double)bf2f(v2[k]) * (double)F.in[I_WPA][(size_t)k * D + c];
            for (int k = 0; k < DPOOL; ++k) yb += (double)bf2f(pr[k]) * (double)F.in[I_WPB][(size_t)k * D + c];
            const double ref = bf2f(((const bf16*)(ws + WS_GB))[(size_t)m * D + c]) * (bf2f(((const bf16*)(ws + WS_GA))[(size_t)m * D + c]) * ya + yb);
            dfail(F, 15, dneq(bf2f(((const bf16*)(ws + WS_RA))[(size_t)m * D + c]), (float)ref, 0.03f, 0.03f)); }
    }
    if (phase == 6) {
        for (int s = F.tid; s < 2048; s += 512) { const unsigned h = dh(s + 61u); const int m = h % M, c = (h >> 14) % D; const bf16* mr = (const bf16*)(ws + WS_RA) + (size_t)m * D; double a = F.in[I_BOUT][c];
            for (int k = 0; k < D; ++k) a += (double)bf2f(mr[k]) * (double)F.in[I_WOUT][(size_t)k * D + c];
            const float* mf = (const float*)(ws + WS_MODF) + (size_t)batch_of_row(m) * 6144; const double ref = (double)DN_ALPHA * xrow_ptr(F, m)[c] + mf[2 * D + c] * a;
            dfail(F, 16, dneq(bf2f(((const bf16*)F.out)[(size_t)m * D + c]), (float)ref, 0.012f, 0.02f)); }
    }
    if (phase == 7) {
        for (int s = F.tid; s < 1024; s += 512) { const unsigned h = dh(s + 71u); const int m = h % M, j = (h >> 16) % D; const bf16* r = (const bf16*)F.out + (size_t)m * D; double mu = 0, var = 0;
            for (int k = 0; k < D; ++k) mu += bf2f(r[k]); mu /= D; for (int k = 0; k < D; ++k) { const double dd = bf2f(r[k]) - mu; var += dd * dd; } var /= D; const double rs = 1.0 / sqrt(var + 1e-6);
            const float* st = (const float*)(ws + WS_STATS) + 2 * m;
            double m2 = 0, v2 = 0; for (int k = 0; k < D; ++k) m2 += (bf2f(r[k]) - mu) * rs * F.in[I_LN1G][k] + F.in[I_LN1B][k]; m2 /= D;
            for (int k = 0; k < D; ++k) { const double x1 = (bf2f(r[k]) - mu) * rs * F.in[I_LN1G][k] + F.in[I_LN1B][k] - m2; v2 += x1 * x1; } v2 /= D;
            const float* mf = (const float*)(ws + WS_MODF) + (size_t)batch_of_row(m) * 6144; const double x1j = (bf2f(r[j]) - mu) * rs * F.in[I_LN1G][j] + F.in[I_LN1B][j];
            const double y = (x1j - m2) / sqrt(v2 + 1e-6) * (1.0 + mf[4 * D + j]) + mf[3 * D + j];
            dfail(F, 17, dneq(bf2f(((const bf16*)(ws + WS_RB))[(size_t)m * D + j]), (float)y, 0.006f, 0.004f) || dneq(st[0], (float)mu, 1e-4f, 1e-5f) || dneq(st[1], (float)rs, 1e-4f, 1e-5f)); }
    }
    if (phase == 8) {
        for (int s = F.tid; s < 2048; s += 512) { const unsigned h = dh(s + 81u); const int m = h % M, c = (h >> 14) % DFF; const bf16* hr = (const bf16*)(ws + WS_RB) + (size_t)m * D; double a = F.in[I_B1][c];
            for (int k = 0; k < D; ++k) a += (double)bf2f(hr[k]) * (double)F.in[I_W1][(size_t)k * DFF + c];
            a = a > 0 ? a * a : 0; dfail(F, 18, dneq(bf2f(((const bf16*)(ws + WS_HM))[(size_t)m * DFF + c]), (float)a, 0.02f, 0.02f)); }
    }
    if (phase == 9) {
        for (int s = F.tid; s < 2048; s += 512) { const unsigned h = dh(s + 91u); const int m = h % M, c = (h >> 14) % D; const bf16* hr = (const bf16*)(ws + WS_HM) + (size_t)m * DFF; double a = F.in[I_B2][c];
            for (int k = 0; k < DFF; ++k) a += (double)bf2f(hr[k]) * (double)F.in[I_W2][(size_t)k * D + c];
            const float* st = (const float*)(ws + WS_STATS) + 2 * m; const double x1 = ((double)bf2f(((const bf16*)F.out)[(size_t)m * D + c]) - st[0]) * st[1] * F.in[I_LN1G][c] + F.in[I_LN1B][c];
            const float* mf = (const float*)(ws + WS_MODF) + (size_t)batch_of_row(m) * 6144; const double ref = (double)DN_ALPHA * x1 + mf[5 * D + c] * a;
            dfail(F, 19, dneq(bf2f(((const bf16*)(ws + WS_RA))[(size_t)m * D + c]), (float)ref, 0.012f, 0.02f)); }
    }
}
__device__ __forceinline__ void dbg_encode(Frame& F) {
    int code = 0;
    for (int k = 24; k >= 1; --k) { if (k == 20 || k == 21) continue; if (__hip_atomic_load((unsigned*)(F.ctl + CW_FAIL + k), __ATOMIC_RELAXED, __HIP_MEMORY_SCOPE_AGENT) != 0u) code = k; }
    if (code == 6) { if (__hip_atomic_load((unsigned*)(F.ctl + CW_FAIL + 21), __ATOMIC_RELAXED, __HIP_MEMORY_SCOPE_AGENT)) code = 21; if (__hip_atomic_load((unsigned*)(F.ctl + CW_FAIL + 20), __ATOMIC_RELAXED, __HIP_MEMORY_SCOPE_AGENT)) code = 20; }
#if MK_DEBUG_FORCE
    code = MK_DEBUG_FORCE;
#endif
    if (code == 0) return;
    const size_t total = (size_t)M * D + (size_t)NB_CTX * 4 * 4096;
    for (size_t i = (size_t)F.bid * 512 + F.tid; i < total; i += (size_t)F.G * 512) F.out[i] = i < (size_t)M_CTX * D ? (float)(code + 1) : 0.f;
}
#define DBG_CHECK(k) do { if (IN(k)) { xcd_barrier(bar); dbg_check(F, k); } } while (0)
#else
#define DBG_CHECK(k) do { } while (0)
#endif
struct Args { const float* in[33]; float* out; unsigned char* ws; int ph_lo, ph_hi; };
__global__ void __launch_bounds__(NWAVES * 64, 2) mk_fwd(Args args) {
    extern __shared__ __attribute__((aligned(16))) unsigned char lds[];
    Frame F;
    F.lds = (LAS unsigned char*)lds;
    F.MISC = (volatile LAS unsigned*)(F.lds + MISC_OFF);
    F.tid = threadIdx.x; F.lane = F.tid & 63; F.wave = __builtin_amdgcn_readfirstlane(F.tid >> 6);
    F.G = gridDim.x; F.bid = blockIdx.x;
#pragma unroll
    for (int i = 0; i < 33; ++i) F.in[i] = args.in[i];
    F.out = args.out; F.ws = args.ws; F.ctl = (gu32*)(args.ws + WS_CTL);
    unsigned char* ws = args.ws;
    for (int u = F.tid; u < (LDS_BYTES - LDSCTL_OFF) / 4; u += NWAVES * 64) ((LAS unsigned*)(F.lds + LDSCTL_OFF))[u] = 0u;
    __syncthreads();
    XcdBarrier bar = xcd_barrier_post((unsigned*)(F.ctl + CW_BAR), F.MISC + 8);
    const int lo = args.ph_lo, hi = args.ph_hi;
#if MK_STAMP
    if (F.bid == 0 && F.tid == 0 && MK_STAMP == 1) F.MISC[20] = (unsigned)__builtin_amdgcn_s_memrealtime();
#define STAMP(k) do { if (F.bid == 0 && F.tid == 0) { if ((k) == MK_STAMP - 2) F.MISC[20] = (unsigned)__builtin_amdgcn_s_memrealtime(); if ((k) == MK_STAMP - 1) F.MISC[21] = (unsigned)__builtin_amdgcn_s_memrealtime(); } } while (0)
#else
#define STAMP(k) do { } while (0)
#endif
#define IN(k) (lo <= (k) && (k) < hi)
#define SEAM(k) do { if (IN(k) && IN((k) + 1)) xcd_barrier(bar); } while (0)
    typedef pg8::bf16_t bt;
#if MK_POISON
    if (IN(0)) {
        v4u pz = (v4u){0xAAAAAAAAu, 0xAAAAAAAAu, 0xAAAAAAAAu, 0xAAAAAAAAu};
        for (size_t i = (size_t)F.bid * 512 + F.tid; i < ((size_t)M * D * 4 + 2 * MiB) / 16; i += (size_t)F.G * 512) ((v4u*)F.out)[i] = pz;
        for (size_t i = (size_t)F.bid * 512 + F.tid; i < (192 * MiB) / 16; i += (size_t)F.G * 512) ((v4u*)(ws + 36 * MiB))[i] = pz;
        for (size_t i = (size_t)F.bid * 512 + F.tid; i < (256 * 1024) / 16; i += (size_t)F.G * 512) ((v4u*)(ws + WS_STATS))[i] = pz;
    }
#endif
    if (IN(0)) { phase0(F); } DBG_CHECK(0); SEAM(0); STAMP(0);
    if (IN(1)) { phase1(F); } DBG_CHECK(1); SEAM(1); STAMP(1);
    if (IN(2)) {
        pg8::Gemm g{(const bt*)(ws + WS_RA), nullptr, (const bt*)(ws + WS_WIN), nullptr, D / 64, 0, D}; g.id_ = 2; pg8::StaticOrder S; S.init(M, DIN, F.G, F.bid);
        pg8::EpiIn E{(bt*)(ws + WS_RB), (bt*)(ws + WS_UB), (bt*)(ws + WS_GA), (bt*)(ws + WS_GB), F.in[I_BIN]};
        pg8::gemm_phase<pg8::EpiIn, pg8::StaticOrder, true, true>(F.lds, g, S, E);
    } DBG_CHECK(2); SEAM(2); STAMP(2);
    if (IN(3)) {
#if MK_STAMP >= 100
        if (F.bid == MK_TB && F.tid == 0) F.MISC[20] = (unsigned)__builtin_amdgcn_s_memrealtime();
#endif
        if (F.G == 256) {
            if (F.bid < 128) s5_task(F, true, F.bid >> 4, 1, F.bid & 15);
            else s5_task(F, false, ((F.bid - 128) >> 4) * 4, 4, (F.bid - 128) & 15);
        } else {
            for (int t = F.bid; t < 640; t += F.G) { if (t < 128) s5_task(F, true, t >> 4, 1, t & 15); else s5_task(F, false, (t - 128) >> 4, 1, (t - 128) & 15); }
        }
#if MK_STAMP == 100
        if (F.bid == MK_TB && F.tid == 0) F.MISC[21] = (unsigned)__builtin_amdgcn_s_memrealtime();
#endif
#if MK_STAMP == 101
        if (F.bid == MK_TB && F.tid == 0) F.MISC[20] = (unsigned)__builtin_amdgcn_s_memrealtime();
#endif
#if MK_OLDPOOL
        for (int tile = F.bid; tile < M / 64; tile += F.G) pool_task_old(F, tile);
#else
        for (int tile = F.bid; tile < M / 64; tile += F.G) pool_task(F, tile);
#endif
        __syncthreads();
#if MK_STAMP == 101
        if (F.bid == MK_TB && F.tid == 0) F.MISC[21] = (unsigned)__builtin_amdgcn_s_memrealtime();
#endif
    } DBG_CHECK(3); SEAM(3); STAMP(3);
#if MK_TRUNC == 3
    { xcd_barrier(bar); const bf16* src = (const bf16*)(ws + WS_RA);
      for (size_t i = (size_t)F.bid * 512 + F.tid; i < (size_t)M * D; i += (size_t)F.G * 512) { const int tok = (int)(i >> 10); const bool lat = tok >= M_CTX; const int L = lat ? L_LAT : L_CTX, t = lat ? (tok - M_CTX) % L_LAT : tok % L_CTX;
          bool keep = true; if (MK_TSEL == 1) keep = !lat; if (MK_TSEL == 2) keep = lat; if (MK_TSEL == 3) keep = t < L / 2; if (MK_TSEL == 4) keep = t >= L / 2; if (MK_TSEL == 5) keep = (t & 31) < 16; if (MK_TSEL == 6) keep = ((i >> 4) & 1) == 0; if (MK_TSEL == 7) keep = lat && t < 512; if (MK_TSEL == 8) keep = lat && t >= 512; if (MK_TSEL == 9) keep = lat && (t < 32 || t >= 992); if (MK_TSEL == 10) keep = lat && (t >= 480 && t < 544);
          F.out[i] = keep ? bf_lo((unsigned)src[i]) : 0.f; }
      return; }
#endif
    if (IN(4)) {
        pg8::Gemm g{(const bt*)(ws + WS_RA), nullptr, (const bt*)(ws + WS_WGLU), nullptr, D / 64, 0, D}; g.id_ = 4; pg8::StaticOrder S; S.init(M, D, F.G, F.bid);
        pg8::EpiGlu E{(const bt*)(ws + WS_RA), (bt*)(ws + WS_RB), F.in[I_BGLU]};
        pg8::gemm_phase<pg8::EpiGlu, pg8::StaticOrder, true, true>(F.lds, g, S, E);
    } DBG_CHECK(4); SEAM(4); STAMP(4);
    if (IN(5)) {
        pg8::Gemm g{(const bt*)(ws + WS_RB), (const bt*)(ws + WS_P), (const bt*)(ws + WS_WPA), (const bt*)(ws + WS_WPB), D / 64, DPOOL / 64, D}; g.id_ = 5; pg8::StaticOrder S; S.init(M, D, F.G, F.bid, 2);
        pg8::EpiMerge E{(const bt*)(ws + WS_GA), (const bt*)(ws + WS_GB), (bt*)(ws + WS_RA)};
        pg8::gemm_phase<pg8::EpiMerge, pg8::StaticOrder, true, true>(F.lds, g, S, E);
    } DBG_CHECK(5); SEAM(5); STAMP(5);
    if (IN(6)) {
        pg8::Gemm g{(const bt*)(ws + WS_RA), nullptr, (const bt*)(ws + WS_WOUT), nullptr, D / 64, 0, D}; g.id_ = 6; pg8::StaticOrder S; S.init(M, D, F.G, F.bid);
        pg8::EpiRes1 E{F.in[I_XP], F.in[I_XS], (bt*)F.out, F.in[I_BOUT], (const float*)(ws + WS_MODF)};
        pg8::gemm_phase<pg8::EpiRes1, pg8::StaticOrder, true, true>(F.lds, g, S, E);
    } DBG_CHECK(6); SEAM(6); STAMP(6);
    if (IN(7)) { phase_ln1(F, (const bf16*)F.out, (float*)(ws + WS_STATS), (bf16*)(ws + WS_RB)); } DBG_CHECK(7); SEAM(7); STAMP(7);
#if MK_TRUNC == 7
    { xcd_barrier(bar); const bf16* src = (const bf16*)(ws + WS_RB); for (size_t i = (size_t)F.bid * 512 + F.tid; i < (size_t)M * D; i += (size_t)F.G * 512) F.out[i] = bf_lo((unsigned)src[i]); return; }
#endif
    if (IN(8)) {
        pg8::Gemm g{(const bt*)(ws + WS_RB), nullptr, (const bt*)(ws + WS_W1), nullptr, D / 64, 0, D}; g.id_ = 8; pg8::StaticOrder S; S.init(M, DFF, F.G, F.bid);
        pg8::EpiRelu2 E{(bt*)(ws + WS_HM), F.in[I_B1]};
        pg8::gemm_phase<pg8::EpiRelu2, pg8::StaticOrder, true, true>(F.lds, g, S, E);
    } DBG_CHECK(8); SEAM(8); STAMP(8);
#if MK_TRUNC == 8
    { xcd_barrier(bar); const bf16* src = (const bf16*)(ws + WS_HM); for (size_t i = (size_t)F.bid * 512 + F.tid; i < (size_t)M * D; i += (size_t)F.G * 512) F.out[i] = bf_lo((unsigned)src[i * 4 + (i & 3)]); return; }
#endif
    if (IN(9)) {
        pg8::Gemm g{(const bt*)(ws + WS_HM), nullptr, (const bt*)(ws + WS_W2), nullptr, DFF / 64, 0, DFF}; g.id_ = 9; pg8::StaticOrder S; S.init(M, D, F.G, F.bid);
        pg8::EpiRes2 E{(const bt*)F.out, (const float*)(ws + WS_STATS), F.in[I_LN1G], F.in[I_LN1B], (bt*)(ws + WS_RA), F.in[I_B2], (const float*)(ws + WS_MODF)};
        pg8::gemm_phase<pg8::EpiRes2, pg8::StaticOrder, true, true>(F.lds, g, S, E);
    } DBG_CHECK(9); SEAM(9); STAMP(9);
#if MK_TRUNC == 9
    { xcd_barrier(bar); const bf16* src = (const bf16*)(ws + WS_RA); for (size_t i = (size_t)F.bid * 512 + F.tid; i < (size_t)M * D; i += (size_t)F.G * 512) F.out[i] = bf_lo((unsigned)src[i]); return; }
#endif
    if (IN(10)) { phase_ln2(F, (const bf16*)(ws + WS_RA)); }
#if MK_STAMP
    STAMP(10); __syncthreads();
    if (F.bid == (MK_STAMP >= 100 ? MK_TB : 0) && F.tid == 0) { asm volatile("s_waitcnt vmcnt(0)" ::: "memory"); F.out[(size_t)(MK_STAMP >= 100 ? MK_TB : 0) * 64 * D] += (MK_STAMP == 120 || MK_STAMP == 130) ? (float)(F.MISC[18] - F.MISC[17]) * (1.0f / 1000.0f) : (MK_STAMP >= 110) ? (float)F.MISC[16] * (16.0f / 21000.0f) : (float)(F.MISC[21] - F.MISC[20]) * (1.0f / 1000.0f); }
#endif
#if MK_DEBUG
    xcd_barrier(bar); dbg_encode(F);
#endif
#undef IN
#undef SEAM
}

#ifndef MK_SPLIT
#define MK_SPLIT 0
#endif
extern "C" void kernel_launch(void* const* d_in, const int* in_sizes, int n_in, void* d_out, int out_size, void* d_ws, size_t ws_size, hipStream_t stream) {
    static int grid = 0;
    if (grid == 0) {
        if (n_in != 33 || ws_size < WS_END) { fprintf(stderr, "kernel_launch: unexpected inputs (n_in %d, ws %zu)\n", n_in, ws_size); grid = -1; return; }
        int dev = 0, cus = 0, per_cu = 0;
        if (hipGetDevice(&dev) != hipSuccess || hipDeviceGetAttribute(&cus, hipDeviceAttributeMultiprocessorCount, dev) != hipSuccess) { grid = -1; return; }
        if (hipFuncSetAttribute((const void*)mk_fwd, hipFuncAttributeMaxDynamicSharedMemorySize, LDS_BYTES) != hipSuccess) { fprintf(stderr, "kernel_launch: hipFuncSetAttribute failed\n"); grid = -1; return; }
        if (hipOccupancyMaxActiveBlocksPerMultiprocessor(&per_cu, (const void*)mk_fwd, NWAVES * 64, LDS_BYTES) != hipSuccess || per_cu < 1) fprintf(stderr, "kernel_launch: occupancy query says %d blocks per CU\n", per_cu);
        (void)hipGetLastError();
        grid = cus;
    }
    if (grid < 0) return;
    (void)hipMemsetAsync((char*)d_ws + WS_CTL, 0, CTL_ZERO_BYTES, stream);
    Args a{};
    for (int i = 0; i < 33; ++i) a.in[i] = (const float*)d_in[i];
    a.out = (float*)d_out; a.ws = (unsigned char*)d_ws;
#if MK_SPLIT
    for (int p = 0; p <= 10; ++p) { a.ph_lo = p; a.ph_hi = p + 1; hipLaunchKernelGGL(mk_fwd, dim3(grid), dim3(NWAVES * 64), LDS_BYTES, stream, a); }
#else
    a.ph_lo = 0; a.ph_hi = 11;
    hipLaunchKernelGGL(mk_fwd, dim3(grid), dim3(NWAVES * 64), LDS_BYTES, stream, a);
#endif
    const hipError_t le = hipPeekAtLastError();
    if (le != hipSuccess) fprintf(stderr, "kernel_launch: launch failed: %s\n", hipGetErrorName(le));
}
```

```cpp
#include <hip/hip_runtime.h>
#include <cstdio>
#include <cstdint>
#ifndef MK_DEBUG
#define MK_DEBUG 0
#endif
#ifndef MK_DEBUG_FORCE
#define MK_DEBUG_FORCE 0
#endif
#ifndef MK_STAMP
#define MK_STAMP 0
#endif
#ifndef MK_TB
#define MK_TB 0
#endif
#ifndef MK_SA
#define MK_SA 4
#endif
#ifndef MK_SB
#define MK_SB 5
#endif
#ifndef MK_OLDPOOL
#define MK_OLDPOOL 0
#endif
#ifndef MK_NOPR
#define MK_NOPR 0
#endif
#ifndef MK_POISON
#define MK_POISON 0
#endif
#ifndef MK_TRUNC
#define MK_TRUNC 0
#endif
#ifndef MK_HSLEEP
#define MK_HSLEEP 0
#endif
#ifndef MK_TSEL
#define MK_TSEL 2
#endif
#ifndef MK_NOS0
#define MK_NOS0 0
#endif
#ifndef MK_NOUL
#define MK_NOUL 0
#endif
#ifndef MK_GPH
#define MK_GPH 8
#endif
#ifndef MK_GUI
#define MK_GUI 1
#endif
namespace pg8 {
#define PG8_LAS __attribute__((address_space(3)))
typedef unsigned short bf16_t;
typedef short bf16x8 __attribute__((ext_vector_type(8)));
typedef float f32x4 __attribute__((ext_vector_type(4)));
typedef unsigned u32x4 __attribute__((ext_vector_type(4)));
constexpr int BM = 256, BK = 64, HALF = 128, HTB = HALF * BK * 2  , STAGE_BYTES = 8 * HTB, NXCD = 8, WGM = 8;

__host__ __device__ __forceinline__ int lds_byte(int r, int c) { const int st = (r >> 4) * 2 + (c >> 5), rr = r & 15, cc = c & 31, ob = rr * 64 + cc * 2; return st * 1024 + (ob ^ (((ob >> 9) & 1) << 5)); }
__host__ __device__ __forceinline__ void stage_rc(int b, int& R, int& C) { const int st = b / 1024, sb = b % 1024, swz = sb ^ (((sb >> 9) & 1) << 5); R = (st >> 1) * 16 + swz / 64; C = (st & 1) * 32 + (swz % 64) / 2; }
__host__ __device__ __forceinline__ int perm32(int rho) { const int n = rho >> 4, i = rho & 15; return 8 * (i >> 2) + 4 * n + (i & 3); }

struct Unit { int pm, pn, part; };
struct Gemm { const bf16_t *A0, *A1, *B0, *B1; int nt0, nt1, ld; int id_ = 0;
    __device__ __forceinline__ const char* a(int part) const { return (const char*)(part ? A1 : A0); }
    __device__ __forceinline__ const char* b(int part) const { return (const char*)(part ? B1 : B0); }
    __device__ __forceinline__ int nt(int part) const { return part ? nt1 : nt0; } };

struct StaticOrder {
    int nM, nN, nwg, G, c, np;
    __host__ __device__ void init(int M, int N, int G_, int c_, int np_ = 1) { nM = M / BM; nN = N / BM; nwg = nM * nN; G = G_; c = c_; np = np_; }
    __host__ __device__ bool next(int ii, Unit& u) const {
        const int i = (np == 2) ? (ii >> 1) : ii; u.part = (np == 2) ? (ii & 1) : 0;
        const long L = (long)i * G + c; if (L >= nwg) return false;
        int wgid = (int)L; { const int q = nwg / NXCD, r = nwg % NXCD, xcd = wgid % NXCD, off = wgid / NXCD; wgid = (xcd < r ? xcd * (q + 1) : r * (q + 1) + (xcd - r) * q) + off; }
        const int nig = WGM * nN, gid = wgid / nig, fm = gid * WGM, gsz = (nM - fm) < WGM ? (nM - fm) : WGM;
        u.pm = fm + ((wgid % nig) % gsz); u.pn = (wgid % nig) / gsz; return true;
    }
    __device__ __forceinline__ void a_ready(const Unit&) const {}
    __device__ __forceinline__ void done(const Unit&) const {}
};
__device__ __forceinline__ unsigned cvt_pk_bf16(float lo, float hi) { unsigned r; asm volatile("v_cvt_pk_bf16_f32 %0, %1, %2" : "=v"(r) : "v"(lo), "v"(hi)); return r; }
typedef float f32x2 __attribute__((ext_vector_type(2)));
#if MK_STAMP == 130
#define GST(id) do { if (g.id_ == MK_GPH && blockIdx.x == MK_TB && threadIdx.x == 0 && ui == MK_GUI) { if ((id) == MK_SA) ((volatile PG8_LAS unsigned*)(lds + 131072 + 320))[17] = (unsigned)__builtin_amdgcn_s_memrealtime(); if ((id) == MK_SB) ((volatile PG8_LAS unsigned*)(lds + 131072 + 320))[18] = (unsigned)__builtin_amdgcn_s_memrealtime(); } } while (0)
#else
#define GST(id) do { } while (0)
#endif
template <class Epi, class Sched, bool ALIGN_EPI = false, bool SP2 = false>
__device__ __forceinline__ void gemm_phase(PG8_LAS unsigned char* lds, const Gemm g, const Sched& S, const Epi& E) {
    const int tid = threadIdx.x, wid = __builtin_amdgcn_readfirstlane(tid >> 6), lane = tid & 63, wr = wid >> 2, wc = wid & 3, fr = lane & 15, fq = lane >> 4;
    const int K = g.ld;
    unsigned voffA[2], voffB[2];
#pragma unroll
    for (int i = 0; i < 2; ++i) { int R, C; stage_rc(tid * 16 + i * 8192, R, C); const int Rb = Epi::PERM ? ((R & ~31) + perm32(R & 31)) : R;
        voffA[i] = (unsigned)(R * K + C) * 2u; voffB[i] = (unsigned)(Rb * K + C) * 2u; }
    const size_t kstep = (size_t)(BK * 2);
    const size_t hstep = (size_t)HALF * K * 2;
    const size_t tstep = 2 * hstep;
    const unsigned ldsw = (unsigned)wid * 1024u;
    const int aoff = lds_byte(wr * 64 + fr, fq * 8), boff = lds_byte(wc * 32 + fr, fq * 8);
#define PG8_SA(b, h) (((b) * 2 + (h)) * HTB)
#define PG8_SB(b, h) ((4 + (b) * 2 + (h)) * HTB)
#define PG8_STAGE(bufoff, gbase, voff) do { _Pragma("unroll") for (int _i = 0; _i < 2; ++_i) \
        __builtin_amdgcn_global_load_lds((const unsigned*)((const char*)(gbase) + (voff)[_i]), (PG8_LAS unsigned*)(lds + (bufoff) + ldsw + _i * 8192), 16, 0, 0); } while (0)
#define PG8_LDA(dst, b, h) do { _Pragma("unroll") for (int m = 0; m < 4; ++m) _Pragma("unroll") for (int k = 0; k < 2; ++k) dst[m][k] = *(const PG8_LAS bf16x8*)(lds + PG8_SA(b, h) + aoff + m * 2048 + k * 1024); } while (0)
#define PG8_LDB(dst, b, h) do { _Pragma("unroll") for (int n = 0; n < 2; ++n) _Pragma("unroll") for (int k = 0; k < 2; ++k) dst[n][k] = *(const PG8_LAS bf16x8*)(lds + PG8_SB(b, h) + boff + n * 2048 + k * 1024); } while (0)
#define PG8_MMA(ai, bj, At, Bt) do { __builtin_amdgcn_s_setprio(1); _Pragma("unroll") for (int m = 0; m < 4; ++m) _Pragma("unroll") for (int n = 0; n < 2; ++n) _Pragma("unroll") for (int k = 0; k < 2; ++k) \
        acc[ai][bj][m][n] = __builtin_amdgcn_mfma_f32_16x16x32_bf16(Bt[n][k], At[m][k], acc[ai][bj][m][n], 0, 0, 0); __builtin_amdgcn_s_setprio(0); } while (0)
#define PG8_WAIT_V(n) asm volatile("s_waitcnt vmcnt(" #n ")" ::: "memory")
#define PG8_WAIT_L(n) asm volatile("s_waitcnt lgkmcnt(" #n ")" ::: "memory")
#define PG8_BAR __builtin_amdgcn_s_barrier()
#define PG8_SCHED __builtin_amdgcn_sched_barrier(0)
    Unit cur, nxt; int ui = 0;
    if (!S.next(0, cur)) return;
    f32x4 acc[2][2][4][2];
#pragma unroll
    for (int a = 0; a < 2; ++a)
#pragma unroll
        for (int b = 0; b < 2; ++b)
#pragma unroll
            for (int m = 0; m < 4; ++m)
#pragma unroll
                for (int n = 0; n < 2; ++n) acc[a][b][m][n] = (f32x4){0.f, 0.f, 0.f, 0.f};
    bf16x8 At[4][2], B0[2][2], B1[2][2];
    const char* cA = g.a(cur.part) + (size_t)cur.pm * tstep; const char* cB = g.b(cur.part) + (size_t)cur.pn * tstep;
    S.a_ready(cur);
    if constexpr (SP2) {
        PG8_STAGE(PG8_SB(0, 0), cB, voffB); PG8_STAGE(PG8_SB(0, 1), cB + hstep, voffB); PG8_STAGE(PG8_SA(0, 0), cA, voffA); PG8_STAGE(PG8_SA(0, 1), cA + hstep, voffA);
        if (wr == 1) PG8_BAR;
        PG8_WAIT_V(2); PG8_BAR;
        PG8_STAGE(PG8_SB(1, 0), cB + kstep, voffB); PG8_STAGE(PG8_SA(1, 0), cA + kstep, voffA); PG8_STAGE(PG8_SB(1, 1), cB + hstep + kstep, voffB);
        PG8_WAIT_V(6); PG8_BAR;
    } else {
        PG8_STAGE(PG8_SB(0, 0), cB, voffB); PG8_STAGE(PG8_SA(0, 0), cA, voffA); PG8_STAGE(PG8_SB(0, 1), cB + hstep, voffB); PG8_STAGE(PG8_SA(0, 1), cA + hstep, voffA);
        if (wr == 1) PG8_BAR;
        PG8_WAIT_V(4); PG8_BAR;
        PG8_STAGE(PG8_SB(1, 0), cB + kstep, voffB); PG8_STAGE(PG8_SA(1, 0), cA + kstep, voffA); PG8_STAGE(PG8_SB(1, 1), cB + hstep + kstep, voffB);
        PG8_WAIT_V(6); PG8_BAR;
    }
    for (;;) {
        const bool has_next = S.next(ui + 1, nxt);
        const char* nA = has_next ? g.a(nxt.part) + (size_t)nxt.pm * tstep : cA; const char* nB = has_next ? g.b(nxt.part) + (size_t)nxt.pn * tstep : cB;
        const int nt = g.nt(cur.part);
        GST(0);
        for (int t = 0; t < nt; t += 2) {
            const bool last = (t == nt - 2);
            const char* a1 = cA + (size_t)(t + 1) * kstep;
            const char* a2 = last ? nA : cA + (size_t)(t + 2) * kstep; const char* b2 = last ? nB : cB + (size_t)(t + 2) * kstep;
            const char* a3 = a2 + kstep; const char* b3 = b2 + kstep;
            if (last && has_next) S.a_ready(nxt);
            if constexpr (SP2) {
            PG8_LDB(B0, 0, 0); PG8_LDB(B1, 0, 1); PG8_SCHED; PG8_LDA(At, 0, 0); PG8_STAGE(PG8_SA(1, 1), a1 + hstep, voffA); PG8_WAIT_V(8); PG8_WAIT_L(0); PG8_BAR; PG8_MMA(0, 0, At, B0); PG8_MMA(0, 1, At, B1); PG8_BAR; PG8_SCHED;
            PG8_LDA(At, 0, 1); PG8_STAGE(PG8_SB(0, 0), b2, voffB); PG8_STAGE(PG8_SB(0, 1), b2 + hstep, voffB); PG8_STAGE(PG8_SA(0, 0), a2, voffA); PG8_WAIT_V(8); PG8_WAIT_L(0); PG8_BAR; PG8_MMA(1, 0, At, B0); PG8_MMA(1, 1, At, B1); PG8_BAR; PG8_SCHED;
            PG8_LDB(B0, 1, 0); PG8_LDB(B1, 1, 1); PG8_SCHED; PG8_LDA(At, 1, 0); PG8_STAGE(PG8_SA(0, 1), a2 + hstep, voffA); PG8_WAIT_V(8); PG8_WAIT_L(0); PG8_BAR; PG8_MMA(0, 0, At, B0); PG8_MMA(0, 1, At, B1); PG8_BAR; PG8_SCHED;
            PG8_LDA(At, 1, 1); PG8_STAGE(PG8_SB(1, 0), b3, voffB); PG8_STAGE(PG8_SB(1, 1), b3 + hstep, voffB); PG8_STAGE(PG8_SA(1, 0), a3, voffA); PG8_WAIT_V(8); PG8_WAIT_L(0); PG8_BAR; PG8_MMA(1, 0, At, B0); PG8_MMA(1, 1, At, B1); PG8_BAR; PG8_SCHED;
            } else {
            PG8_LDB(B0, 0, 0); PG8_SCHED; PG8_LDA(At, 0, 0); PG8_STAGE(PG8_SA(1, 1), a1 + hstep, voffA);
            PG8_WAIT_L(8); PG8_BAR; PG8_WAIT_L(0); PG8_MMA(0, 0, At, B0); PG8_BAR; PG8_SCHED;
            PG8_LDB(B1, 0, 1); PG8_STAGE(PG8_SB(0, 0), b2, voffB);
            PG8_BAR; PG8_WAIT_L(0); PG8_MMA(0, 1, At, B1); PG8_BAR;
            PG8_LDA(At, 0, 1); PG8_STAGE(PG8_SA(0, 0), a2, voffA);
            PG8_BAR; PG8_WAIT_L(0); PG8_MMA(1, 0, At, B0); PG8_BAR; PG8_SCHED;
            PG8_STAGE(PG8_SB(0, 1), b2 + hstep, voffB);
            PG8_WAIT_V(6); PG8_BAR; PG8_MMA(1, 1, At, B1); PG8_BAR;
            PG8_LDB(B0, 1, 0); PG8_SCHED; PG8_LDA(At, 1, 0); PG8_STAGE(PG8_SA(0, 1), a2 + hstep, voffA);
            PG8_WAIT_L(8); PG8_BAR; PG8_WAIT_L(0); PG8_MMA(0, 0, At, B0); PG8_BAR; PG8_SCHED;
            PG8_LDB(B1, 1, 1); PG8_STAGE(PG8_SB(1, 0), b3, voffB);
            PG8_BAR; PG8_WAIT_L(0); PG8_MMA(0, 1, At, B1); PG8_BAR;
            PG8_LDA(At, 1, 1); PG8_STAGE(PG8_SA(1, 0), a3, voffA);
            PG8_BAR; PG8_WAIT_L(0); PG8_MMA(1, 0, At, B0); PG8_BAR; PG8_SCHED;
            PG8_STAGE(PG8_SB(1, 1), b3 + hstep, voffB);
            PG8_WAIT_V(6); PG8_BAR; PG8_MMA(1, 1, At, B1); PG8_BAR;
            }
        }
        GST(1);
        if constexpr (ALIGN_EPI) { if (wr == 0) PG8_BAR; }
        GST(2);
        if constexpr (!Epi::AFTER_DRAIN) { E(acc, cur, wr, wc, fr, fq); S.done(cur); }
        GST(3);
        if (!has_next) break;
        if (!E.keep(cur)) {
#pragma unroll
        for (int a = 0; a < 2; ++a)
#pragma unroll
            for (int b = 0; b < 2; ++b)
#pragma unroll
                for (int m = 0; m < 4; ++m)
#pragma unroll
                    for (int n = 0; n < 2; ++n) acc[a][b][m][n] = (f32x4){0.f, 0.f, 0.f, 0.f};
        }
        cur = nxt; cA = nA; cB = nB; ++ui;
        if constexpr (ALIGN_EPI) { if (wr == 1) PG8_BAR; }
    }
    PG8_WAIT_V(0);
    if constexpr (!ALIGN_EPI) { if (wr == 0) PG8_BAR; }
    PG8_BAR;
    if constexpr (Epi::AFTER_DRAIN) { E.fused(acc, cur, wr, wc, fr, fq, lds, wid, lane); S.done(cur); }
#undef PG8_SA
#undef PG8_SB
#undef PG8_STAGE
#undef PG8_LDA
#undef PG8_LDB
#undef PG8_MMA
#undef PG8_WAIT_V
#undef PG8_WAIT_L
#undef PG8_BAR
#undef PG8_SCHED
}
}
#define GAS __attribute__((address_space(1)))
#define LAS __attribute__((address_space(3)))
typedef unsigned short bf16;
typedef unsigned v4u __attribute__((ext_vector_type(4)));
typedef float f32x4 __attribute__((ext_vector_type(4)));
typedef short bf16x8 __attribute__((ext_vector_type(8)));
typedef GAS unsigned gu32;
typedef GAS unsigned long long gu64;
#define RLX_AGENT __ATOMIC_RELAXED, __HIP_MEMORY_SCOPE_AGENT
#define LDS_WAIT() asm volatile("s_waitcnt lgkmcnt(0)" ::: "memory")
#define VM_WAIT() asm volatile("s_waitcnt vmcnt(0)" ::: "memory")
__device__ __forceinline__ unsigned long long rt() { return __builtin_amdgcn_s_memrealtime(); }
__device__ __forceinline__ unsigned f2bf(float f) { unsigned u = __builtin_bit_cast(unsigned, f); return (u + 0x7fffu + ((u >> 16) & 1u)) >> 16; }
__device__ __forceinline__ unsigned pk2(float lo, float hi) { return f2bf(lo) | (f2bf(hi) << 16); }

#define XB_TMO      128
#define XB_XCNT(j)  (256  + 64 * (j))
#define XB_XSUB(j)  (1280 + 64 * (j))
#define XB_XGEN(j)  (2304 + 64 * (j))
#define XB_TOP      3328
#define XB_TOPGEN   3392
#define XCD_BAR_WORDS 3456
#define XB_SPIN_CAP (1u << 18)

__device__ __forceinline__ unsigned xb_ld(unsigned* p)              { return __hip_atomic_load(p, __ATOMIC_RELAXED, __HIP_MEMORY_SCOPE_AGENT); }
__device__ __forceinline__ unsigned xb_add(unsigned* p, unsigned v) { return __hip_atomic_fetch_add(p, v, __ATOMIC_RELAXED, __HIP_MEMORY_SCOPE_AGENT); }
__device__ __forceinline__ unsigned xb_xcc_id() { return (unsigned)__builtin_amdgcn_s_getreg((3 << 11) | 20) & 0xFu; }
#define XB_SPIN(cond, bar) do { unsigned _sp = 0; while (cond) { __builtin_amdgcn_s_sleep(1); \
    if ((++_sp & 255u) == 0u) { if (xb_ld(&(bar)[XB_TMO])) break; if (_sp > XB_SPIN_CAP) { atomicAdd(&(bar)[XB_TMO], 1u); break; } } } } while (0)

struct XcdBarrier {
    unsigned* bar; unsigned x;
    volatile LAS unsigned* st;
};

__device__ __forceinline__ XcdBarrier xcd_barrier_post(unsigned* bar, volatile LAS unsigned* st) {
    XcdBarrier b; b.bar = bar; b.x = xb_xcc_id(); b.st = st;
    if (threadIdx.x == 0) (void)xb_add(&bar[XB_XCNT(b.x)], 1u);
    return b;
}
__device__ __forceinline__ void xcd_barrier_complete(unsigned* bar, unsigned x, unsigned& nloc, unsigned& nx) {
    const unsigned G = gridDim.x * gridDim.y * gridDim.z;
    unsigned sum, cnt, mine, sp = 0u;
    for (;;) {
        sum = 0u; cnt = 0u; mine = 0u;
#pragma unroll
        for (unsigned j = 0; j < 16; ++j) { const unsigned c = xb_ld(&bar[XB_XCNT(j)]); sum += c; cnt += (c > 0u) ? 1u : 0u; mine = (j == x) ? c : mine; }
        if (sum == G) break;
        __builtin_amdgcn_s_sleep(1);
        if ((++sp & 255u) == 0u) { if (xb_ld(&bar[XB_TMO])) break; if (sp > XB_SPIN_CAP) { atomicAdd(&bar[XB_TMO], 1u); break; } }
    }
    nloc = mine > 0u ? mine : 1u; nx = cnt > 0u ? cnt : 1u;
}

__device__ __forceinline__ void xcd_barrier(const XcdBarrier& b) {
    asm volatile("s_waitcnt vmcnt(0)" ::: "memory");
    __syncthreads();
    if (threadIdx.x == 0) {
        unsigned* bar = b.bar;
        __builtin_amdgcn_s_waitcnt(0);
        unsigned nloc = b.st[0], nx = b.st[1];
        if (nloc == 0u) { xcd_barrier_complete(bar, b.x, nloc, nx); b.st[0] = nloc; b.st[1] = nx; }
        const unsigned old = xb_add(&bar[XB_XSUB(b.x)], 1u);
        const unsigned gen = old / nloc;
        if (old + 1u == (gen + 1u) * nloc) {
            __builtin_amdgcn_fence(__ATOMIC_RELEASE, "agent");
            asm volatile("s_waitcnt vmcnt(0)" ::: "memory");
            const unsigned og = xb_add(&bar[XB_TOP], 1u);
            const unsigned tg = og / nx;
            if (og + 1u == (tg + 1u) * nx) xb_add(&bar[XB_TOPGEN], 1u);
            else XB_SPIN(xb_ld(&bar[XB_TOPGEN]) == tg, bar);
            __builtin_amdgcn_fence(__ATOMIC_ACQUIRE, "agent");
            xb_add(&bar[XB_XGEN(b.x)], 1u);
            asm volatile("s_waitcnt vmcnt(0)" ::: "memory");
        } else {
            XB_SPIN(xb_ld(&bar[XB_XGEN(b.x)]) == gen, bar);
            __builtin_amdgcn_fence(__ATOMIC_ACQUIRE, "agent");
            asm volatile("s_waitcnt vmcnt(0)" ::: "memory");
        }
    }
    __syncthreads();
}
constexpr int D = 1024, M_CTX = 8192, M = 16384, L_CTX = 256, L_LAT = 1024, NB_CTX = 32, NB_LAT = 8;
constexpr int DIN = 3584, DFF = 4096, DPOOL = 512, NGRP = 64, NST = 64, HG = 16;
constexpr float DN_ALPHA = 1.189207115002721f;
constexpr float LN_EPS = 1e-6f;
constexpr int NWAVES = 8;

constexpr size_t MiB = 1u << 20;
constexpr size_t WS_CTL = 0, CTL_ZERO_BYTES = 64 * 1024;
constexpr size_t WS_MODP = 1 * MiB;
constexpr size_t WS_MODF = 2 * MiB;
constexpr size_t WS_STATS = 2 * MiB + 256 * 1024;
constexpr size_t WS_LAMB = 244 * MiB;
constexpr size_t WS_BB2 = 244 * MiB + 256 * 1024;
constexpr size_t WS_V2 = 245 * MiB + 512 * 1024;
constexpr size_t WS_G2 = 246 * MiB + 768 * 1024;
constexpr size_t WS_BB   = 3 * MiB;
constexpr size_t WS_CT   = 3 * MiB + 512 * 1024;
constexpr size_t WS_WIN = 4 * MiB, WS_WGLU = 11 * MiB, WS_WPA = 13 * MiB, WS_WPB = 15 * MiB, WS_WOUT = 17 * MiB, WS_W1 = 19 * MiB, WS_W2 = 27 * MiB, WS_WPOOL = 35 * MiB;
constexpr size_t WS_RA = 36 * MiB;
constexpr size_t WS_RB = 68 * MiB;
constexpr size_t WS_UB = 100 * MiB;
constexpr size_t WS_GA = 116 * MiB, WS_GB = 148 * MiB;
constexpr size_t WS_P  = 180 * MiB;
constexpr size_t WS_HM = 100 * MiB;
constexpr size_t WS_V  = 212 * MiB;
constexpr size_t WS_END = 248 * MiB;
constexpr int CW_BAR = 1024;

constexpr int RING_BYTES = 131072, LDSCTL_OFF = RING_BYTES, MISC_OFF = LDSCTL_OFF + 320, LDS_BYTES = 147456;

typedef unsigned u32x2 __attribute__((ext_vector_type(2)));
typedef float f32x16 __attribute__((ext_vector_type(16)));
__device__ __forceinline__ float bf_lo(unsigned w) { return __builtin_bit_cast(float, w << 16); }
__device__ __forceinline__ float bf_hi(unsigned w) { return __builtin_bit_cast(float, w & 0xffff0000u); }
__device__ __forceinline__ float fsigmoid(float x) { return __builtin_amdgcn_rcpf(1.0f + __builtin_amdgcn_exp2f(-1.4426950408889634f * x)); }
__device__ __forceinline__ float gelu_tanh(float x) { const float u = x * (1.5957691216057308f + 0.0713548162726f * x * x); return x * fsigmoid(u); }

namespace pg8 {
#define EPI_LOOP_BEGIN _Pragma("unroll") for (int ai = 0; ai < 2; ++ai) _Pragma("unroll") for (int m = 0; m < 4; ++m) { const int row = u.pm * BM + ai * HALF + wr * 64 + m * 16 + fr; _Pragma("unroll") for (int bj = 0; bj < 2; ++bj) { const int cl = bj * HALF + wc * 32 + 8 * fq;
#define EPI_LOOP_END } }
__device__ __forceinline__ u32x4 pack8(const f32x4& a, const f32x4& b) { u32x4 w; w.x = cvt_pk_bf16(a[0], a[1]); w.y = cvt_pk_bf16(a[2], a[3]); w.z = cvt_pk_bf16(b[0], b[1]); w.w = cvt_pk_bf16(b[2], b[3]); return w; }
__device__ __forceinline__ void unpack8(const u32x4& w, f32x4& a, f32x4& b) { a = (f32x4){bf_lo(w.x), bf_hi(w.x), bf_lo(w.y), bf_hi(w.y)}; b = (f32x4){bf_lo(w.z), bf_hi(w.z), bf_lo(w.w), bf_hi(w.w)}; }

struct EpiIn {
    static constexpr bool PERM = true, AFTER_DRAIN = false;
    bf16_t *ua, *ub, *ga, *gb; const float* bias;
    __device__ __forceinline__ bool keep(const Unit&) const { return false; }
    __device__ __forceinline__ int nstores(const Unit&) const { return 16; }
    __device__ __forceinline__ void operator()(f32x4 (&acc)[2][2][4][2], const Unit& u, int wr, int wc, int fr, int fq) const {
        if (u.pn < 6) {
            bf16_t* base; int ldc, c0;
            if (u.pn < 4) { base = ua; ldc = D; c0 = u.pn * BM; } else { base = ub; ldc = DPOOL; c0 = (u.pn - 4) * BM; }
            EPI_LOOP_BEGIN
                const float* bp = bias + u.pn * BM + cl; f32x4 v0 = acc[ai][bj][m][0] + *(const f32x4*)bp, v1 = acc[ai][bj][m][1] + *(const f32x4*)(bp + 4);
                *(u32x4*)(base + (size_t)row * ldc + c0 + cl) = pack8(v0, v1);
            EPI_LOOP_END
        } else {
            const int jt = u.pn - 6, clq = wc * 32 + 8 * fq, col = 128 * jt + clq;
            const float* ba = bias + 1536 + col; const float* bb = bias + 2560 + col;
            const f32x4 ba0 = *(const f32x4*)ba, ba1 = *(const f32x4*)(ba + 4), bb0 = *(const f32x4*)bb, bb1 = *(const f32x4*)(bb + 4);
#pragma unroll
            for (int ai = 0; ai < 2; ++ai)
#pragma unroll
                for (int m = 0; m < 4; ++m) { const int row = u.pm * BM + ai * HALF + wr * 64 + m * 16 + fr;
                    f32x4 a0 = acc[ai][0][m][0] + ba0, a1 = acc[ai][0][m][1] + ba1, b0 = acc[ai][1][m][0] + bb0, b1 = acc[ai][1][m][1] + bb1;
#pragma unroll
                    for (int j = 0; j < 4; ++j) { const float s0 = fsigmoid(b0[j]), s1 = fsigmoid(b1[j]); a0[j] = fsigmoid(a0[j]) * __builtin_amdgcn_rcpf(fmaxf(s0, 1e-30f)); a1[j] = fsigmoid(a1[j]) * __builtin_amdgcn_rcpf(fmaxf(s1, 1e-30f)); b0[j] = s0; b1[j] = s1; }
                    *(u32x4*)(ga + (size_t)row * D + col) = pack8(a0, a1); *(u32x4*)(gb + (size_t)row * D + col) = pack8(b0, b1); }
        }
    }
};
struct EpiGlu {
    static constexpr bool PERM = true, AFTER_DRAIN = false;
    const bf16_t* v; bf16_t* o; const float* bias;
    __device__ __forceinline__ bool keep(const Unit&) const { return false; }
    __device__ __forceinline__ int nstores(const Unit&) const { return 16; }
    __device__ __forceinline__ void operator()(f32x4 (&acc)[2][2][4][2], const Unit& u, int wr, int wc, int fr, int fq) const {
        EPI_LOOP_BEGIN
            const int col = u.pn * BM + cl; const float* bp = bias + col; f32x4 t0 = acc[ai][bj][m][0] + *(const f32x4*)bp, t1 = acc[ai][bj][m][1] + *(const f32x4*)(bp + 4);
            f32x4 x0, x1; unpack8(*(const u32x4*)(v + (size_t)row * D + col), x0, x1);
#pragma unroll
            for (int j = 0; j < 4; ++j) { t0[j] = x0[j] * fsigmoid(t0[j]); t1[j] = x1[j] * fsigmoid(t1[j]); }
            *(u32x4*)(o + (size_t)row * D + col) = pack8(t0, t1);
        EPI_LOOP_END
    }
};
struct EpiMerge {
    static constexpr bool PERM = true, AFTER_DRAIN = false;
    const bf16_t *ga, *gb; bf16_t* o;
    __device__ __forceinline__ bool keep(const Unit& u) const { return u.part == 0; }
    __device__ __forceinline__ int nstores(const Unit& u) const { return u.part == 0 ? 0 : 16; }
    __device__ __forceinline__ void operator()(f32x4 (&acc)[2][2][4][2], const Unit& u, int wr, int wc, int fr, int fq) const {
        EPI_LOOP_BEGIN
            const size_t off = (size_t)row * D + u.pn * BM + cl;
            if (u.part == 0) { f32x4 a0, a1; unpack8(*(const u32x4*)(ga + off), a0, a1); acc[ai][bj][m][0] *= a0; acc[ai][bj][m][1] *= a1; }
            else { f32x4 b0, b1; unpack8(*(const u32x4*)(gb + off), b0, b1); *(u32x4*)(o + off) = pack8(acc[ai][bj][m][0] * b0, acc[ai][bj][m][1] * b1); }
        EPI_LOOP_END
    }
};
struct EpiRes1 {
    static constexpr bool PERM = true, AFTER_DRAIN = false;
    const float *x_ctx, *x_lat; bf16_t* out; const float* bias; const float* modf;
    __device__ __forceinline__ bool keep(const Unit&) const { return false; }
    __device__ __forceinline__ int nstores(const Unit&) const { return 16; }
    __device__ __forceinline__ void operator()(f32x4 (&acc)[2][2][4][2], const Unit& u, int wr, int wc, int fr, int fq) const {
        const int r0 = u.pm * BM; const int bidx = r0 < M_CTX ? 0 : 1 + (r0 - M_CTX) / L_LAT;
        const float* gate = modf + (size_t)bidx * 6 * D + 2 * D; const float* bs = r0 < M_CTX ? x_ctx : x_lat - (size_t)M_CTX * D;
        EPI_LOOP_BEGIN
            const int col = u.pn * BM + cl; const size_t off = (size_t)row * D + col;
            const f32x4 g0 = *(const f32x4*)(gate + col), g1 = *(const f32x4*)(gate + col + 4), c0 = *(const f32x4*)(bias + col), c1 = *(const f32x4*)(bias + col + 4);
            const f32x4 x0 = *(const f32x4*)(bs + off), x1 = *(const f32x4*)(bs + off + 4);
            *(u32x4*)(out + off) = pack8(x0 * DN_ALPHA + g0 * (acc[ai][bj][m][0] + c0), x1 * DN_ALPHA + g1 * (acc[ai][bj][m][1] + c1));
        EPI_LOOP_END
    }
};
struct EpiRes2 {
    static constexpr bool PERM = true, AFTER_DRAIN = false;
    const bf16_t* r1; const float* stats; const float *lg, *lb; bf16_t* out; const float* bias; const float* modf;
    __device__ __forceinline__ bool keep(const Unit&) const { return false; }
    __device__ __forceinline__ int nstores(const Unit&) const { return 16; }
    __device__ __forceinline__ void operator()(f32x4 (&acc)[2][2][4][2], const Unit& u, int wr, int wc, int fr, int fq) const {
        const int r0 = u.pm * BM; const int bidx = r0 < M_CTX ? 0 : 1 + (r0 - M_CTX) / L_LAT;
        const float* gate = modf + (size_t)bidx * 6 * D + 5 * D;
        EPI_LOOP_BEGIN
            const int col = u.pn * BM + cl; const size_t off = (size_t)row * D + col;
            const f32x4 g0 = *(const f32x4*)(gate + col), g1 = *(const f32x4*)(gate + col + 4), c0 = *(const f32x4*)(bias + col), c1 = *(const f32x4*)(bias + col + 4);
            const f32x4 lg0 = *(const f32x4*)(lg + col), lg1 = *(const f32x4*)(lg + col + 4), lb0 = *(const f32x4*)(lb + col), lb1 = *(const f32x4*)(lb + col + 4);
            const float mu = stats[2 * row], rs = stats[2 * row + 1];
            f32x4 x0, x1; unpack8(*(const u32x4*)(r1 + off), x0, x1);
            x0 = (x0 - mu) * rs * lg0 + lb0; x1 = (x1 - mu) * rs * lg1 + lb1;
            *(u32x4*)(out + off) = pack8(x0 * DN_ALPHA + g0 * (acc[ai][bj][m][0] + c0), x1 * DN_ALPHA + g1 * (acc[ai][bj][m][1] + c1));
        EPI_LOOP_END
    }
};
struct EpiRelu2 {
    static constexpr bool PERM = true, AFTER_DRAIN = false;
    bf16_t* o; const float* bias;
    __device__ __forceinline__ bool keep(const Unit&) const { return false; }
    __device__ __forceinline__ int nstores(const Unit&) const { return 16; }
    __device__ __forceinline__ void operator()(f32x4 (&acc)[2][2][4][2], const Unit& u, int wr, int wc, int fr, int fq) const {
        EPI_LOOP_BEGIN
            const int col = u.pn * BM + cl; f32x4 t0 = acc[ai][bj][m][0] + *(const f32x4*)(bias + col), t1 = acc[ai][bj][m][1] + *(const f32x4*)(bias + col + 4);
#pragma unroll
            for (int j = 0; j < 4; ++j) { const float a = fmaxf(t0[j], 0.f), b = fmaxf(t1[j], 0.f); t0[j] = a * a; t1[j] = b * b; }
            *(u32x4*)(o + (size_t)row * DFF + col) = pack8(t0, t1);
        EPI_LOOP_END
    }
};
}
struct Frame {
    LAS unsigned char* lds;
    volatile LAS unsigned* MISC;
    gu32* ctl;
    int tid, lane, wave, G, bid;
    const float* in[33]; float* out; unsigned char* ws;
};
enum { I_XP = 0, I_XS, I_STATE, I_C, I_CCTX, I_WADA, I_BADA, I_WIN, I_BIN, I_LAMRE, I_LAMIM, I_LOGDT, I_BRE, I_BIM, I_CRE, I_CIM, I_S5D, I_WGLU, I_BGLU, I_WPA, I_WPOOL, I_PSCALE, I_WPB,
       I_WOUT, I_BOUT, I_LN1G, I_LN1B, I_W1, I_B1, I_W2, I_B2, I_LN2G, I_LN2B };

__device__ __forceinline__ float wave_sum(float v) {
#pragma unroll
    for (int o = 1; o < 64; o <<= 1) v += __shfl_xor(v, o);
    return v;
}
template <bool GATEPERM = false> __device__ __forceinline__ void p0_transpose_item(const float* W, int N, bf16* WT, int ldt, LAS unsigned* scr, int item, int lane) {
    const int nblk = N / 64, kb = item / nblk, nb = item % nblk, k0 = 64 * kb, n0 = 64 * nb, q = lane & 15, kp = lane >> 4;
    const int n0o = !GATEPERM || n0 < 1536 ? n0 : (n0 < 2560 ? 1536 + 256 * ((n0 - 1536) >> 7) + ((n0 - 1536) & 127) : 1536 + 256 * ((n0 - 2560) >> 7) + 128 + ((n0 - 2560) & 127));
    f32x4 v0[8], v1[8];
#pragma unroll
    for (int i = 0; i < 8; ++i) { const float* p = W + (size_t)(k0 + 8 * i + 2 * kp) * N + n0 + 4 * q; v0[i] = *(const f32x4*)p; v1[i] = *(const f32x4*)(p + N); }
#pragma unroll
    for (int i = 0; i < 8; ++i)
#pragma unroll
        for (int j = 0; j < 4; ++j) scr[(4 * q + j) * 33 + 4 * i + kp] = pk2(v0[i][j], v1[i][j]);
    LDS_WAIT(); asm volatile("" ::: "memory");
    const int kc = lane & 7;
#pragma unroll
    for (int jj = 0; jj < 8; ++jj) { const int n = 8 * jj + (lane >> 3); const LAS unsigned* s = scr + n * 33 + 4 * kc;
        v4u o; o.x = s[0]; o.y = s[1]; o.z = s[2]; o.w = s[3];
        *(GAS v4u*)(WT + (size_t)(n0o + n) * ldt + k0 + 8 * kc) = o; }
    LDS_WAIT(); asm volatile("" ::: "memory");
}

__device__ __forceinline__ void phase0(Frame& F) {
    unsigned char* ws = F.ws;
    if (F.bid < 96) {
        const int cc = F.bid % 24, kq = F.bid / 24, k0 = kq * 256 + F.wave * 32;
        LAS float* sv = (LAS float*)(F.lds) + F.wave * 288;
        LAS float* red = (LAS float*)(F.lds + 16384);
        if (F.lane < 32) {
#pragma unroll
            for (int r = 0; r < 9; ++r) { const float cv = r == 0 ? F.in[I_CCTX][k0 + F.lane] : F.in[I_C][(size_t)(r - 1) * D + k0 + F.lane]; sv[r * 32 + F.lane] = cv * fsigmoid(cv); }
        }
        LDS_WAIT(); asm volatile("" ::: "memory");
        f32x4 a[9];
#pragma unroll
        for (int r = 0; r < 9; ++r) a[r] = (f32x4){0.f, 0.f, 0.f, 0.f};
        const float* wp = F.in[I_WADA] + (size_t)k0 * 6144 + cc * 256 + F.lane * 4;
#pragma unroll 8
        for (int k = 0; k < 32; ++k) { const f32x4 w = *(const f32x4*)(wp + (size_t)k * 6144);
#pragma unroll
            for (int r = 0; r < 9; ++r) a[r] += w * sv[r * 32 + k]; }
#pragma unroll
        for (int r = 0; r < 9; ++r) *(LAS f32x4*)(red + (F.wave * 9 + r) * 256 + F.lane * 4) = a[r];
        __syncthreads();
        float* mp = (float*)(ws + WS_MODP) + (size_t)kq * 9 * 6144;
        for (int i = F.tid; i < 9 * 256; i += NWAVES * 64) { const int r = i >> 8, c = i & 255; float s = 0.f;
#pragma unroll
            for (int w = 0; w < 8; ++w) s += red[(w * 9 + r) * 256 + c];
            mp[(size_t)r * 6144 + cc * 256 + c] = s; }
        __syncthreads();
    }
    for (int wt = (F.G >= 112 ? F.bid - (F.G - 16) : F.bid) * NWAVES + F.wave; wt >= 0 && wt < 2 * NGRP; wt += (F.G >= 112 ? 16 : F.G) * NWAVES) {
        const int dir = wt >> 6, g = wt & 63, p = F.lane, it = wt * 64 + p;
        const float lr = F.in[I_LAMRE][it], li = F.in[I_LAMIM][it], dt = expf(F.in[I_LOGDT][wt]);
        const float zr = lr * dt, zi = li * dt, e = expf(zr); float sn, cs; sincosf(zi, &sn, &cs);
        const float lbr = e * cs, lbi = e * sn, l2r = lbr * lbr - lbi * lbi, l2i = 2.f * lbr * lbi;
        const float sh = sinf(0.5f * zi); const float nr = expm1f(zr) * cs - 2.f * sh * sh, ni = lbi;
        const float den = 1.f / (lr * lr + li * li); const float wr_ = (nr * lr + ni * li) * den, wi_ = (ni * lr - nr * li) * den;
        *(f32x4*)((float*)(ws + WS_LAMB) + (size_t)it * 4) = (f32x4){lbr, lbi, l2r, l2i};
        float br[16], bi[16], ar[16], ai[16], cr[16], ci[16];
#pragma unroll
        for (int h = 0; h < 16; ++h) { const float r0 = F.in[I_BRE][(size_t)it * 16 + h], i0 = F.in[I_BIM][(size_t)it * 16 + h];
            br[h] = wr_ * r0 - wi_ * i0; bi[h] = wr_ * i0 + wi_ * r0; ar[h] = lbr * br[h] - lbi * bi[h]; ai[h] = lbr * bi[h] + lbi * br[h];
            const size_t cix = ((size_t)wt * 16 + h) * 64 + p; cr[h] = F.in[I_CRE][cix]; ci[h] = F.in[I_CIM][cix]; }
        { bf16* bb = (bf16*)(ws + WS_BB2);
#pragma unroll
          for (int i = 0; i < 2; ++i)
#pragma unroll
            for (int part = 0; part < 2; ++part) { unsigned o[8];
#pragma unroll
              for (int h = 0; h < 8; ++h) { const float v0 = i == 0 ? (part == 0 ? ar[2 * h] : ai[2 * h]) : (part == 0 ? br[2 * h] : bi[2 * h]), v1 = i == 0 ? (part == 0 ? ar[2 * h + 1] : ai[2 * h + 1]) : (part == 0 ? br[2 * h + 1] : bi[2 * h + 1]); o[h] = pk2(v0, v1); }
              v4u* d = (v4u*)(bb + ((size_t)((i * 128 + wt) * 2 + part) * 64 + p) * 16); d[0] = (v4u){o[0], o[1], o[2], o[3]}; d[1] = (v4u){o[4], o[5], o[6], o[7]}; } }
        { bf16* v2 = (bf16*)(ws + WS_V2) + (size_t)wt * 2 * 16 * 128;
#pragma unroll
          for (int h = 0; h < 16; ++h) { const float c1r = cr[h] * lbr - ci[h] * lbi, c1i = cr[h] * lbi + ci[h] * lbr, c2r = cr[h] * l2r - ci[h] * l2i, c2i = cr[h] * l2i + ci[h] * l2r;
              *(unsigned*)(v2 + (0 * 16 + h) * 128 + 2 * p) = pk2(c1r, -c1i); *(unsigned*)(v2 + (1 * 16 + h) * 128 + 2 * p) = pk2(c2r, -c2i); } }
        { LAS unsigned* sc = (LAS unsigned*)(F.lds + F.wave * 16384);
#pragma unroll
          for (int h = 0; h < 16; ++h) { sc[h * 64 + p] = pk2(cr[h], -ci[h]); sc[1024 + h * 64 + p] = pk2(br[h], bi[h]); sc[2048 + h * 64 + p] = pk2(ar[h], ai[h]); }
          LDS_WAIT(); asm volatile("" ::: "memory");
          f32x4 k0 = (f32x4){0.f, 0.f, 0.f, 0.f}, k1 = (f32x4){0.f, 0.f, 0.f, 0.f};
#pragma unroll
          for (int ks = 0; ks < 4; ++ks) { const int o = (F.lane & 15) * 64 + 16 * ks + 4 * (F.lane >> 4);
              const bf16x8 af = *(const LAS bf16x8*)(sc + o), b0 = *(const LAS bf16x8*)(sc + 1024 + o), b1 = *(const LAS bf16x8*)(sc + 2048 + o);
              k0 = __builtin_amdgcn_mfma_f32_16x16x32_bf16(af, b0, k0, 0, 0, 0); k1 = __builtin_amdgcn_mfma_f32_16x16x32_bf16(af, b1, k1, 0, 0, 0); }
          bf16* g2 = (bf16*)(ws + WS_G2) + (size_t)wt * 2 * 16 * 32; const int hp = F.lane & 15;
#pragma unroll
          for (int r = 0; r < 4; ++r) { const int h = 4 * (F.lane >> 4) + r; const float kd = k0[r] + (h == hp ? F.in[I_S5D][dir * D + g * 16 + h] : 0.f);
              g2[(0 * 16 + h) * 32 + hp] = (bf16)f2bf(kd); g2[(0 * 16 + h) * 32 + 16 + hp] = (bf16)0; g2[(1 * 16 + h) * 32 + hp] = (bf16)f2bf(k1[r]); g2[(1 * 16 + h) * 32 + 16 + hp] = (bf16)f2bf(kd); }
          LDS_WAIT(); asm volatile("" ::: "memory"); }
    }
    {
        LAS unsigned* scr = (LAS unsigned*)(F.lds + F.wave * 16384);
        const int gw = F.bid * NWAVES + F.wave, NGW = F.G * NWAVES;
        constexpr int I_IN = (D / 64) * (DIN / 64), I_SQ = (D / 64) * (D / 64), I_PB = (DPOOL / 64) * (D / 64), I_1 = (D / 64) * (DFF / 64), I_2 = (DFF / 64) * (D / 64), I_PL = 4 * 2 * 2;
        constexpr int NITEMS = I_IN + 3 * I_SQ + I_PB + I_1 + I_2 + I_PL;
        for (int it = gw; it < NITEMS; it += NGW) {
            int r = it;
            if (r < I_1) { p0_transpose_item(F.in[I_W1], DFF, (bf16*)(ws + WS_W1), D, scr, r, F.lane); continue; } r -= I_1;
            if (r < I_2) { p0_transpose_item(F.in[I_W2], D, (bf16*)(ws + WS_W2), DFF, scr, r, F.lane); continue; } r -= I_2;
            if (r < I_IN) { p0_transpose_item<true>(F.in[I_WIN], DIN, (bf16*)(ws + WS_WIN), D, scr, r, F.lane); continue; } r -= I_IN;
            if (r < I_SQ) { p0_transpose_item(F.in[I_WGLU], D, (bf16*)(ws + WS_WGLU), D, scr, r, F.lane); continue; } r -= I_SQ;
            if (r < I_SQ) { p0_transpose_item(F.in[I_WPA], D, (bf16*)(ws + WS_WPA), D, scr, r, F.lane); continue; } r -= I_SQ;
            if (r < I_SQ) { p0_transpose_item(F.in[I_WOUT], D, (bf16*)(ws + WS_WOUT), D, scr, r, F.lane); continue; } r -= I_SQ;
            if (r < I_PB) { p0_transpose_item(F.in[I_WPB], D, (bf16*)(ws + WS_WPB), D, scr, r, F.lane); continue; } r -= I_PB;
            { const int gi = r >> 2; p0_transpose_item(F.in[I_WPOOL] + (size_t)gi * 128 * 128, 128, (bf16*)(ws + WS_WPOOL) + (size_t)gi * 128 * 128, 128, scr, r & 3, F.lane); }
        }
    }
}

__device__ __forceinline__ f32x4 mod4(Frame& F, int bidx, int idx) {
    const float* mp = (const float*)(F.ws + WS_MODP) + (size_t)bidx * 6144 + idx;
    f32x4 s = *(const f32x4*)(F.in[I_BADA] + idx);
#pragma unroll
    for (int q = 0; q < 4; ++q) s += *(const f32x4*)(mp + (size_t)q * 9 * 6144);
    return s;
}
__device__ __forceinline__ int batch_of_row(int r0) { return r0 < M_CTX ? 0 : 1 + (r0 - M_CTX) / L_LAT; }

__device__ __forceinline__ void phase1(Frame& F) {
    LAS f32x4* sc = (LAS f32x4*)(F.lds); LAS f32x4* sh = (LAS f32x4*)(F.lds + 4096);
    bf16* H = (bf16*)(F.ws + WS_RA);
    if (F.bid < 9) { float* mf = (float*)(F.ws + WS_MODF) + (size_t)F.bid * 6144; for (int i = F.tid; i < 6144 / 4; i += NWAVES * 64) *(f32x4*)(mf + 4 * i) = mod4(F, F.bid, 4 * i); }
    for (int rb = F.bid; rb < M / 64; rb += F.G) {
        const int r0 = rb * 64, bidx = batch_of_row(r0);
        __syncthreads();
        if (F.tid < 256) { sc[F.tid] = mod4(F, bidx, D + 4 * F.tid) + 1.0f; sh[F.tid] = mod4(F, bidx, 4 * F.tid); }
        __syncthreads();
        f32x4 xv[8][4];
#pragma unroll
        for (int j = 0; j < 8; ++j) { const int m = r0 + F.wave * 8 + j;
            const float* xrow = (m < M_CTX ? F.in[I_XP] + (size_t)m * D : F.in[I_XS] + (size_t)(m - M_CTX) * D); const GAS f32x4* xr = (const GAS f32x4*)xrow + F.lane;
#pragma unroll
            for (int q = 0; q < 4; ++q) xv[j][q] = xr[64 * q]; }
#pragma unroll
        for (int j = 0; j < 8; ++j) {
            const int m = r0 + F.wave * 8 + j;
            f32x4 v[4]; float s = 0.f;
#pragma unroll
            for (int q = 0; q < 4; ++q) { v[q] = xv[j][q]; s += (v[q].x + v[q].y) + (v[q].z + v[q].w); }
            const float mean = wave_sum(s) * (1.f / D); float s2 = 0.f;
#pragma unroll
            for (int q = 0; q < 4; ++q) { v[q] = v[q] - mean; s2 += (v[q].x * v[q].x + v[q].y * v[q].y) + (v[q].z * v[q].z + v[q].w * v[q].w); }
            const float rstd = 1.f / sqrtf(wave_sum(s2) * (1.f / D) + LN_EPS);
            GAS u32x2* o8 = (GAS u32x2*)(H + (size_t)m * D) + F.lane;
#pragma unroll
            for (int q = 0; q < 4; ++q) { const f32x4 y = v[q] * rstd * sc[F.lane + 64 * q] + sh[F.lane + 64 * q]; u32x2 w; w.x = pg8::cvt_pk_bf16(y.x, y.y); w.y = pg8::cvt_pk_bf16(y.z, y.w); o8[64 * q] = w; }
        }
    }
}

__device__ __forceinline__ void unpack4(const u32x2 w, f32x4& v) { v = (f32x4){bf_lo(w.x), bf_hi(w.x), bf_lo(w.y), bf_hi(w.y)}; }
__device__ __forceinline__ void phase_ln1(Frame& F, const bf16* R1, float* stats, bf16* H2) {
    LAS f32x4* sc = (LAS f32x4*)(F.lds); LAS f32x4* sh = (LAS f32x4*)(F.lds + 4096);
    const float* lg = F.in[I_LN1G]; const float* lb = F.in[I_LN1B];
    for (int rb = F.bid; rb < M / 64; rb += F.G) {
        const int r0 = rb * 64, bidx = batch_of_row(r0);
        __syncthreads();
        const float* mf = (const float*)(F.ws + WS_MODF) + (size_t)bidx * 6144;
        if (F.tid < 256) { sc[F.tid] = *(const f32x4*)(mf + 4 * D + 4 * F.tid) + 1.0f; sh[F.tid] = *(const f32x4*)(mf + 3 * D + 4 * F.tid); }
        __syncthreads();
        f32x4 gg[4], bb[4];
#pragma unroll
        for (int q = 0; q < 4; ++q) { gg[q] = *(const f32x4*)(lg + 4 * (F.lane + 64 * q)); bb[q] = *(const f32x4*)(lb + 4 * (F.lane + 64 * q)); }
        u32x2 raw[8][4];
#pragma unroll
        for (int j = 0; j < 8; ++j)
#pragma unroll
            for (int q = 0; q < 4; ++q) raw[j][q] = ((const GAS u32x2*)(R1 + (size_t)(r0 + F.wave * 8 + j) * D))[F.lane + 64 * q];
#pragma unroll
        for (int j = 0; j < 8; ++j) {
            const int m = r0 + F.wave * 8 + j;
            f32x4 v[4]; float s = 0.f;
#pragma unroll
            for (int q = 0; q < 4; ++q) { unpack4(raw[j][q], v[q]); s += (v[q].x + v[q].y) + (v[q].z + v[q].w); }
            float mean = wave_sum(s) * (1.f / D), s2 = 0.f;
#pragma unroll
            for (int q = 0; q < 4; ++q) { v[q] = v[q] - mean; s2 += (v[q].x * v[q].x + v[q].y * v[q].y) + (v[q].z * v[q].z + v[q].w * v[q].w); }
            float rstd = 1.f / sqrtf(wave_sum(s2) * (1.f / D) + LN_EPS);
            if (F.lane == 0) { stats[2 * m] = mean; stats[2 * m + 1] = rstd; }
            s = 0.f;
#pragma unroll
            for (int q = 0; q < 4; ++q) { v[q] = v[q] * rstd * gg[q] + bb[q]; s += (v[q].x + v[q].y) + (v[q].z + v[q].w); }
            mean = wave_sum(s) * (1.f / D); s2 = 0.f;
#pragma unroll
            for (int q = 0; q < 4; ++q) { v[q] = v[q] - mean; s2 += (v[q].x * v[q].x + v[q].y * v[q].y) + (v[q].z * v[q].z + v[q].w * v[q].w); }
            rstd = 1.f / sqrtf(wave_sum(s2) * (1.f / D) + LN_EPS);
            GAS u32x2* o8 = (GAS u32x2*)(H2 + (size_t)m * D) + F.lane;
#pragma unroll
            for (int q = 0; q < 4; ++q) { const f32x4 y = v[q] * rstd * sc[F.lane + 64 * q] + sh[F.lane + 64 * q]; u32x2 w; w.x = pg8::cvt_pk_bf16(y.x, y.y); w.y = pg8::cvt_pk_bf16(y.z, y.w); o8[64 * q] = w; }
        }
    }
}
__device__ __forceinline__ void phase_ln2(Frame& F, const bf16* R2) {
    const float* lg = F.in[I_LN2G]; const float* lb = F.in[I_LN2B];
    f32x4 gg[4], bb[4];
#pragma unroll
    for (int q = 0; q < 4; ++q) { gg[q] = *(const f32x4*)(lg + 4 * (F.lane + 64 * q)); bb[q] = *(const f32x4*)(lb + 4 * (F.lane + 64 * q)); }
    for (int rb = F.bid; rb < M / 64; rb += F.G) {
        const int r0 = rb * 64;
        u32x2 raw[8][4];
#pragma unroll
        for (int j = 0; j < 8; ++j)
#pragma unroll
            for (int q = 0; q < 4; ++q) raw[j][q] = ((const GAS u32x2*)(R2 + (size_t)(r0 + F.wave * 8 + j) * D))[F.lane + 64 * q];
#pragma unroll
        for (int j = 0; j < 8; ++j) {
            const int m = r0 + F.wave * 8 + j;
            f32x4 v[4]; float s = 0.f;
#pragma unroll
            for (int q = 0; q < 4; ++q) { unpack4(raw[j][q], v[q]); s += (v[q].x + v[q].y) + (v[q].z + v[q].w); }
            const float mean = wave_sum(s) * (1.f / D); float s2 = 0.f;
#pragma unroll
            for (int q = 0; q < 4; ++q) { v[q] = v[q] - mean; s2 += (v[q].x * v[q].x + v[q].y * v[q].y) + (v[q].z * v[q].z + v[q].w * v[q].w); }
            const float rstd = 1.f / sqrtf(wave_sum(s2) * (1.f / D) + LN_EPS);
            GAS f32x4* xr = (GAS f32x4*)(F.out + (size_t)m * D) + F.lane;
#pragma unroll
            for (int q = 0; q < 4; ++q) xr[64 * q] = v[q] * rstd * gg[q] + bb[q];
        }
    }
}
constexpr int S5_ROWB = 288, S5_WAVEB = 32 * S5_ROWB;
__device__ __forceinline__ void s5_task(Frame& F, bool lat, int seq0, int nseq, int gq) {
    const int lane = F.lane, n = lane & 31, hf = lane >> 5, g = gq * 4 + (F.wave >> 1), dir = F.wave & 1, wt = dir * 64 + g;
    const int L = lat ? L_LAT : L_CTX, nch = L / 64;
    const bf16* UA = (const bf16*)(F.ws + WS_RB); bf16* V = (bf16*)(F.ws + WS_RA); float* PART = F.out;
    LAS unsigned char* sl = F.lds + F.wave * S5_WAVEB;
    bf16x8 Bf[2][2][2], Vf[2][4], Gf[2];
    { const bf16* bb = (const bf16*)(F.ws + WS_BB2);
#pragma unroll
      for (int i = 0; i < 2; ++i)
#pragma unroll
        for (int q = 0; q < 2; ++q)
#pragma unroll
          for (int part = 0; part < 2; ++part) Bf[i][q][part] = *(const bf16x8*)(bb + ((size_t)((i * 128 + wt) * 2 + part) * 64 + (n + 32 * q)) * 16 + 8 * hf);
      const bf16* v2 = (const bf16*)(F.ws + WS_V2) + (size_t)wt * 2 * 16 * 128 + (lane & 15) * 128 + 8 * (lane >> 4);
#pragma unroll
      for (int j = 0; j < 2; ++j)
#pragma unroll
        for (int ks = 0; ks < 4; ++ks) Vf[j][ks] = *(const bf16x8*)(v2 + j * 16 * 128 + 32 * ks);
      const bf16* g2 = (const bf16*)(F.ws + WS_G2) + (size_t)wt * 2 * 16 * 32 + (lane & 15) * 32 + 8 * (lane >> 4);
#pragma unroll
      for (int j = 0; j < 2; ++j) Gf[j] = *(const bf16x8*)(g2 + j * 16 * 32); }
    const int p = n + 32 * hf;
    const float lr = ((const float*)(F.ws + WS_LAMB))[((size_t)wt * 64 + p) * 4 + 2], li = ((const float*)(F.ws + WS_LAMB))[((size_t)wt * 64 + p) * 4 + 3];
  for (int sq = 0; sq < nseq; ++sq) {
    const int seq = seq0 + sq, tokbase = lat ? (M_CTX + seq * L_LAT) : seq * L_CTX;
    float sr = 0.f, si = 0.f;
    if (lat) { const float* st = F.in[I_STATE] + ((size_t)(seq * 2 + dir) * 2) * 4096 + g * 64 + p; sr = st[0]; si = st[4096]; }
    const int blkA = 16 * ((n >> 2) & 1) + (n & 3) + 4 * (n >> 3);
    const int tA0 = dir ? 63 - 2 * blkA : 2 * blkA, tA1 = dir ? 62 - 2 * blkA : 2 * blkA + 1;
    const bf16* ua_lane = UA + (size_t)tokbase * D + g * 16 + 8 * hf;
    const bf16* ub_lane = UA + (size_t)tokbase * D + g * 16 + 8 * ((lane >> 4) & 1);
    const int tU0 = dir ? 63 - (2 * (lane & 15) + hf) : 2 * (lane & 15) + hf, tU1 = dir ? 63 - (2 * (16 + (lane & 15)) + hf) : 2 * (16 + (lane & 15)) + hf;
    const int h0 = 4 * (lane >> 4), colg = g * 16 + h0;
    bf16x8 A0 = *(const bf16x8*)(ua_lane + (size_t)((dir ? L - 64 : 0) + tA0) * D), A1 = *(const bf16x8*)(ua_lane + (size_t)((dir ? L - 64 : 0) + tA1) * D);
    for (int c = 0; c < nch; ++c) {
        const int t0 = dir ? L - 64 * (c + 1) : 64 * c;
        if (c == nch / 2) { asm volatile("s_waitcnt vmcnt(0)" ::: "memory"); __syncthreads(); }
        const f32x16 z16 = {0.f, 0.f, 0.f, 0.f, 0.f, 0.f, 0.f, 0.f, 0.f, 0.f, 0.f, 0.f, 0.f, 0.f, 0.f, 0.f};
        f32x16 x00 = __builtin_amdgcn_mfma_f32_32x32x16_bf16(A0, Bf[0][0][0], z16, 0, 0, 0);
        f32x16 x01 = __builtin_amdgcn_mfma_f32_32x32x16_bf16(A0, Bf[0][0][1], z16, 0, 0, 0);
        f32x16 x10 = __builtin_amdgcn_mfma_f32_32x32x16_bf16(A0, Bf[0][1][0], z16, 0, 0, 0);
        f32x16 x11 = __builtin_amdgcn_mfma_f32_32x32x16_bf16(A0, Bf[0][1][1], z16, 0, 0, 0);
        x00 = __builtin_amdgcn_mfma_f32_32x32x16_bf16(A1, Bf[1][0][0], x00, 0, 0, 0);
        x01 = __builtin_amdgcn_mfma_f32_32x32x16_bf16(A1, Bf[1][0][1], x01, 0, 0, 0);
        x10 = __builtin_amdgcn_mfma_f32_32x32x16_bf16(A1, Bf[1][1][0], x10, 0, 0, 0);
        x11 = __builtin_amdgcn_mfma_f32_32x32x16_bf16(A1, Bf[1][1][1], x11, 0, 0, 0);
        const bf16x8 Ub0 = *(const bf16x8*)(ub_lane + (size_t)(t0 + tU0) * D), Ub1 = *(const bf16x8*)(ub_lane + (size_t)(t0 + tU1) * D);
        if (c + 1 < nch) { const int t1 = dir ? L - 64 * (c + 2) : 64 * (c + 1); A0 = *(const bf16x8*)(ua_lane + (size_t)(t1 + tA0) * D); A1 = *(const bf16x8*)(ua_lane + (size_t)(t1 + tA1) * D); }
        float xr0[16], xi0[16], xr1[16], xi1[16];
#pragma unroll
        for (int i = 0; i < 16; ++i) {
            { auto r = __builtin_amdgcn_permlane32_swap(__float_as_uint(x00[i]), __float_as_uint(x10[i]), false, false); xr0[i] = __uint_as_float(r[0]); xr1[i] = __uint_as_float(r[1]); }
            { auto r = __builtin_amdgcn_permlane32_swap(__float_as_uint(x01[i]), __float_as_uint(x11[i]), false, false); xi0[i] = __uint_as_float(r[0]); xi1[i] = __uint_as_float(r[1]); }
        }
        LAS unsigned* srow = (LAS unsigned*)(sl + p * 4);
#pragma unroll
        for (int i = 0; i < 16; ++i) { srow[i * (S5_ROWB / 4)] = pg8::cvt_pk_bf16(sr, si); const float nr = __builtin_fmaf(lr, sr, __builtin_fmaf(-li, si, xr0[i])), ni = __builtin_fmaf(lr, si, __builtin_fmaf(li, sr, xi0[i])); sr = nr; si = ni; }
#pragma unroll
        for (int i = 0; i < 16; ++i) { srow[(16 + i) * (S5_ROWB / 4)] = pg8::cvt_pk_bf16(sr, si); const float nr = __builtin_fmaf(lr, sr, __builtin_fmaf(-li, si, xr1[i])), ni = __builtin_fmaf(lr, si, __builtin_fmaf(li, sr, xi1[i])); sr = nr; si = ni; }
        asm volatile("" ::: "memory");
        f32x4 y[2][2];
#pragma unroll
        for (int ct = 0; ct < 2; ++ct) { bf16x8 sb[4];
#pragma unroll
            for (int ks = 0; ks < 4; ++ks) sb[ks] = *(const LAS bf16x8*)(sl + (16 * ct + (lane & 15)) * S5_ROWB + (32 * ks + 8 * (lane >> 4)) * 2);
#pragma unroll
            for (int j = 0; j < 2; ++j) { f32x4 a = (f32x4){0.f, 0.f, 0.f, 0.f};
#pragma unroll
                for (int ks = 0; ks < 4; ++ks) a = __builtin_amdgcn_mfma_f32_16x16x32_bf16(Vf[j][ks], sb[ks], a, 0, 0, 0);
                y[ct][j] = __builtin_amdgcn_mfma_f32_16x16x32_bf16(Gf[j], ct == 0 ? Ub0 : Ub1, a, 0, 0, 0); } }
        asm volatile("" ::: "memory");
        size_t off[2][2];
#pragma unroll
        for (int ct = 0; ct < 2; ++ct)
#pragma unroll
          for (int j = 0; j < 2; ++j) { const int tau = 2 * (16 * ct + (lane & 15)) + j; off[ct][j] = (size_t)(tokbase + t0 + (dir ? 63 - tau : tau)) * D + colg; }
        if (c < nch / 2) {
#pragma unroll
            for (int ct = 0; ct < 2; ++ct)
#pragma unroll
              for (int j = 0; j < 2; ++j) *(f32x4*)(PART + off[ct][j]) = y[ct][j];
        } else {
            f32x4 pv[2][2];
#pragma unroll
            for (int ct = 0; ct < 2; ++ct)
#pragma unroll
              for (int j = 0; j < 2; ++j) pv[ct][j] = *(const f32x4*)(PART + off[ct][j]);
#pragma unroll
            for (int ct = 0; ct < 2; ++ct)
#pragma unroll
              for (int j = 0; j < 2; ++j) { const f32x4 t = y[ct][j] + pv[ct][j];
                u32x2 w; w.x = pg8::cvt_pk_bf16(gelu_tanh(t.x), gelu_tanh(t.y)); w.y = pg8::cvt_pk_bf16(gelu_tanh(t.z), gelu_tanh(t.w)); *(u32x2*)(V + off[ct][j]) = w; }
        }
    }
    if (!lat) { float* o = F.out + (size_t)M * D + ((size_t)(seq * 2 + dir) * 2) * 4096 + g * 64 + p; o[0] = sr; o[4096] = si; }
  }
}

constexpr int PL_ROWB = 1056;
#if MK_STAMP == 120
#define PST(id) do { if (F.bid == MK_TB && F.tid == 0) { if ((id) == MK_SA) F.MISC[17] = (unsigned)__builtin_amdgcn_s_memrealtime(); if ((id) == MK_SB) F.MISC[18] = (unsigned)__builtin_amdgcn_s_memrealtime(); } } while (0)
#else
#define PST(id) do { } while (0)
#endif
__device__ __forceinline__ void pool_task(Frame& F, int tile) {
    PST(0);
    const int tok0 = tile * 64; const bool lat = tile >= M_CTX / 64; const int npr = lat ? 64 : L_CTX, off = lat ? 0 : (tile & 3) * 64;
    const bf16* UB = (const bf16*)(F.ws + WS_UB); bf16* P = (bf16*)(F.ws + WS_P); const bf16* WPT = (const bf16*)(F.ws + WS_WPOOL);
    LAS unsigned char* ul = F.lds;
    const int lane = F.lane, gi3 = F.wave >> 1, oh = F.wave & 1;
    bf16x8 Wf[4][4];
#pragma unroll
    for (int ot = 0; ot < 4; ++ot)
#pragma unroll
        for (int ks = 0; ks < 4; ++ks) Wf[ot][ks] = *(const bf16x8*)(WPT + ((size_t)gi3 * 128 + 64 * oh + 16 * ot + (lane & 15)) * 128 + 32 * ks + 8 * (lane >> 4));
    f32x4 psc[4];
#pragma unroll
    for (int ot = 0; ot < 4; ++ot) psc[ot] = *(const f32x4*)(F.in[I_PSCALE] + gi3 * 128 + 64 * oh + 4 * (lane >> 4) + 16 * ot);
    __syncthreads();
    PST(1);
    { v4u v[10];
#pragma unroll
      for (int q = 0; q < 10; ++q) { const int i = F.tid + q * 512, j = i >> 6, pc = i & 63; const int tt = off + j - 8, ttc = min(max(tt, 0), npr - 1);
          v[q] = *(const v4u*)(UB + (size_t)(tok0 - off + ttc) * DPOOL + pc * 8); }
#pragma unroll
      for (int q = 0; q < 10; ++q) { const int i = F.tid + q * 512, j = i >> 6, pc = i & 63; const int tt = off + j - 8; const bool ok = tt >= 0 && tt < npr;
          v4u w = v[q]; w.x = ok ? w.x : 0u; w.y = ok ? w.y : 0u; w.z = ok ? w.z : 0u; w.w = ok ? w.w : 0u; *(LAS v4u*)(ul + j * PL_ROWB + pc * 16) = w; } }
    __syncthreads();
    PST(2);
    unsigned pm[32];
    { const int cp = F.tid & 255, th = F.tid >> 8, gi = cp >> 6, w = 2 << gi, hw = w >> 1; const LAS unsigned char* ucol = ul + cp * 4 + (th * 32 + 8) * PL_ROWB;
      float s0 = 0.f, s1 = 0.f;
      for (int d = -hw; d < hw; ++d) { const unsigned x = *(const LAS unsigned*)(ucol + d * PL_ROWB); s0 += bf_lo(x); s1 += bf_hi(x); }
      const int tt0 = off + th * 32;
#pragma unroll
      for (int j = 0; j < 32; ++j) {
          const unsigned xc = *(const LAS unsigned*)(ucol + j * PL_ROWB); const int tt = tt0 + j; const float inv = __builtin_amdgcn_rcpf((float)(min(tt - hw + w, npr) - max(tt - hw, 0)));
          pm[j] = pg8::cvt_pk_bf16(s0 * inv - bf_lo(xc), s1 * inv - bf_hi(xc));
          const unsigned xa = *(const LAS unsigned*)(ucol + (j + hw) * PL_ROWB), xs = *(const LAS unsigned*)(ucol + (j - hw) * PL_ROWB);
          s0 += bf_lo(xa) - bf_lo(xs); s1 += bf_hi(xa) - bf_hi(xs); }
      PST(3);
      __syncthreads();
#pragma unroll
      for (int j = 0; j < 32; ++j) *(LAS unsigned*)(ul + (th * 32 + j) * PL_ROWB + cp * 4) = pm[j]; }
    __syncthreads();
    PST(4);
    { const int obase = gi3 * 128 + 64 * oh + 4 * (lane >> 4);
#pragma unroll
      for (int tt = 0; tt < 4; ++tt) { bf16x8 pb[4];
#pragma unroll
          for (int ks = 0; ks < 4; ++ks) pb[ks] = *(const LAS bf16x8*)(ul + (16 * tt + (lane & 15)) * PL_ROWB + (gi3 * 128 + 32 * ks + 8 * (lane >> 4)) * 2);
#pragma unroll
          for (int ot = 0; ot < 4; ++ot) { f32x4 a = (f32x4){0.f, 0.f, 0.f, 0.f};
#pragma unroll
              for (int ks = 0; ks < 4; ++ks) a = __builtin_amdgcn_mfma_f32_16x16x32_bf16(Wf[ot][ks], pb[ks], a, 0, 0, 0);
              const int o0 = obase + 16 * ot; a = a * psc[ot]; u32x2 wv; wv.x = pg8::cvt_pk_bf16(a.x, a.y); wv.y = pg8::cvt_pk_bf16(a.z, a.w);
              *(u32x2*)(P + (size_t)(tok0 + 16 * tt + (lane & 15)) * D + o0) = wv; } } }
    PST(5);
}

constexpr int PH_ROWB = 528;
__device__ __forceinline__ void pool_half(Frame& F, int pm, int gp) {
    const bool lat = pm >= M_CTX / 256; const bf16* UB = (const bf16*)(F.ws + WS_UB) + (size_t)pm * 256 * DPOOL + gp * 256; bf16* P = (bf16*)(F.ws + WS_P) + (size_t)pm * 256 * D + gp * 256;
    const bf16* WPT = (const bf16*)(F.ws + WS_WPOOL); LAS unsigned char* ul = F.lds; const int lane = F.lane;
    const int gl = F.wave >> 2, oq = F.wave & 3, gi3 = gp * 2 + gl;
    bf16x8 Wf[2][4]; f32x4 psc[2];
#pragma unroll
    for (int ot = 0; ot < 2; ++ot) { psc[ot] = *(const f32x4*)(F.in[I_PSCALE] + gi3 * 128 + 32 * oq + 16 * ot + 4 * (lane >> 4));
#pragma unroll
        for (int ks = 0; ks < 4; ++ks) Wf[ot][ks] = *(const bf16x8*)(WPT + ((size_t)gi3 * 128 + 32 * oq + 16 * ot + (lane & 15)) * 128 + 32 * ks + 8 * (lane >> 4)); }
    for (int h = 0; h < 2; ++h) {
        __syncthreads();
        { v4u v[10];
#pragma unroll
          for (int q = 0; q < 10; ++q) { const int i = F.tid + q * 512, r = i >> 5, pc = i & 31; int T; if (!lat) T = 128 * h + r - 8; else { const int sg = r >= 80 ? 1 : 0, rr = r - 80 * sg; T = 128 * h + 64 * sg + rr - 8; }
              const int Tc = min(max(T, 0), 255); v[q] = *(const v4u*)(UB + (size_t)Tc * DPOOL + pc * 8); }
#pragma unroll
          for (int q = 0; q < 10; ++q) { const int i = F.tid + q * 512, r = i >> 5, pc = i & 31; bool ok;
              if (!lat) { const int T = 128 * h + r - 8; ok = r < 144 && T >= 0 && T < 256; } else { const int sg = r >= 80 ? 1 : 0, rr = r - 80 * sg; ok = rr >= 8 && rr < 72; }
              v4u w = v[q]; w.x = ok ? w.x : 0u; w.y = ok ? w.y : 0u; w.z = ok ? w.z : 0u; w.w = ok ? w.w : 0u; *(LAS v4u*)(ul + r * PH_ROWB + pc * 16) = w; } }
        __syncthreads();
        unsigned pmv[32];
        { const int cp = F.tid & 127, tq = F.tid >> 7, w = 2 << (gp * 2 + (cp >> 6)), hw = w >> 1; const int t0 = 32 * tq;
          const int r0 = lat ? 80 * (t0 >> 6) + 8 + (t0 & 63) : 8 + t0; const LAS unsigned char* ucol = ul + cp * 4 + r0 * PH_ROWB;
          float s0 = 0.f, s1 = 0.f;
          for (int d = -hw; d < hw; ++d) { const unsigned x = *(const LAS unsigned*)(ucol + d * PH_ROWB); s0 += bf_lo(x); s1 += bf_hi(x); }
          const int tt0 = lat ? (t0 & 63) : 128 * h + t0, npr = lat ? 64 : 256;
#pragma unroll
          for (int j = 0; j < 32; ++j) {
              const unsigned xc = *(const LAS unsigned*)(ucol + j * PH_ROWB); const int tt = tt0 + j; const float inv = __builtin_amdgcn_rcpf((float)(min(tt - hw + w, npr) - max(tt - hw, 0)));
              pmv[j] = pg8::cvt_pk_bf16(s0 * inv - bf_lo(xc), s1 * inv - bf_hi(xc));
              const unsigned xa = *(const LAS unsigned*)(ucol + (j + hw) * PH_ROWB), xs = *(const LAS unsigned*)(ucol + (j - hw) * PH_ROWB);
              s0 += bf_lo(xa) - bf_lo(xs); s1 += bf_hi(xa) - bf_hi(xs); }
          __syncthreads();
#pragma unroll
          for (int j = 0; j < 32; ++j) *(LAS unsigned*)(ul + (t0 + j) * PH_ROWB + cp * 4) = pmv[j]; }
        __syncthreads();
#pragma unroll
        for (int tt = 0; tt < 8; ++tt) { bf16x8 pb[4];
#pragma unroll
            for (int ks = 0; ks < 4; ++ks) pb[ks] = *(const LAS bf16x8*)(ul + (16 * tt + (lane & 15)) * PH_ROWB + (gl * 128 + 32 * ks + 8 * (lane >> 4)) * 2);
#pragma unroll
            for (int ot = 0; ot < 2; ++ot) { f32x4 a = (f32x4){0.f, 0.f, 0.f, 0.f};
#pragma unroll
                for (int ks = 0; ks < 4; ++ks) a = __builtin_amdgcn_mfma_f32_16x16x32_bf16(Wf[ot][ks], pb[ks], a, 0, 0, 0);
                a = a * psc[ot]; u32x2 wv; wv.x = pg8::cvt_pk_bf16(a.x, a.y); wv.y = pg8::cvt_pk_bf16(a.z, a.w);
                *(u32x2*)(P + (size_t)(128 * h + 16 * tt + (lane & 15)) * D + gl * 128 + 32 * oq + 16 * ot + 4 * (lane >> 4)) = wv; } }
    }
    __syncthreads();
}
constexpr int PLO_ROWB = 288;
__device__ __forceinline__ void pool_task_old(Frame& F, int tile) {
    const int tok0 = tile * 64; const bool lat = tile >= M_CTX / 64; const int npr = lat ? 64 : L_CTX, off = lat ? 0 : (tile & 3) * 64;
    const bf16* UB = (const bf16*)(F.ws + WS_UB); bf16* P = (bf16*)(F.ws + WS_P); const bf16* WPT = (const bf16*)(F.ws + WS_WPOOL);
    LAS unsigned char* ul = F.lds; LAS unsigned char* pl = F.lds + 80 * PLO_ROWB;
    const int lane = F.lane;
    for (int gi = 0; gi < 4; ++gi) {
        const int w = 2 << gi, hw = w >> 1;
        __syncthreads();
        for (int i = F.tid; i < 80 * 16; i += NWAVES * 64) { const int j = i >> 4, pc = i & 15; const int tt = off + j - 8; v4u v = (v4u){0u, 0u, 0u, 0u};
            if (tt >= 0 && tt < npr) v = *(const v4u*)(UB + (size_t)(tok0 - off + tt) * DPOOL + gi * 128 + pc * 8);
            *(LAS v4u*)(ul + j * PLO_ROWB + pc * 16) = v; }
        __syncthreads();
        { const int cp = F.tid & 63, tr = F.tid >> 6; const LAS unsigned char* ucol = ul + cp * 4;
          int tt = off + tr * 8; int lo = max(tt - hw, 0), hi = min(tt - hw + w, npr); float s0 = 0.f, s1 = 0.f;
          for (int q = lo; q < hi; ++q) { const unsigned x = *(const LAS unsigned*)(ucol + (q - off + 8) * PLO_ROWB); s0 += bf_lo(x); s1 += bf_hi(x); }
          for (int j = 0; j < 8; ++j) {
              const unsigned xc = *(const LAS unsigned*)(ucol + (tr * 8 + j + 8) * PLO_ROWB); const float inv = 1.0f / (float)(hi - lo);
              *(LAS unsigned*)(pl + (tr * 8 + j) * PLO_ROWB + cp * 4) = pg8::cvt_pk_bf16(s0 * inv - bf_lo(xc), s1 * inv - bf_hi(xc));
              ++tt; const int nlo = max(tt - hw, 0), nhi = min(tt - hw + w, npr);
              if (nhi > hi) { const unsigned x = *(const LAS unsigned*)(ucol + (hi - off + 8) * PLO_ROWB); s0 += bf_lo(x); s1 += bf_hi(x); }
              if (nlo > lo) { const unsigned x = *(const LAS unsigned*)(ucol + (lo - off + 8) * PLO_ROWB); s0 -= bf_lo(x); s1 -= bf_hi(x); }
              lo = nlo; hi = nhi; } }
        __syncthreads();
        { bf16x8 Wf[4];
#pragma unroll
          for (int ks = 0; ks < 4; ++ks) Wf[ks] = *(const bf16x8*)(WPT + ((size_t)gi * 128 + 16 * F.wave + (lane & 15)) * 128 + 32 * ks + 8 * (lane >> 4));
          const int o0 = gi * 128 + 16 * F.wave + 4 * (lane >> 4); const f32x4 ps = *(const f32x4*)(F.in[I_PSCALE] + o0);
#pragma unroll
          for (int tt = 0; tt < 4; ++tt) { f32x4 a = (f32x4){0.f, 0.f, 0.f, 0.f};
#pragma unroll
              for (int ks = 0; ks < 4; ++ks) { const bf16x8 pb = *(const LAS bf16x8*)(pl + (16 * tt + (lane & 15)) * PLO_ROWB + (32 * ks + 8 * (lane >> 4)) * 2);
                  a = __builtin_amdgcn_mfma_f32_16x16x32_bf16(Wf[ks], pb, a, 0, 0, 0); }
              a = a * ps; u32x2 wv; wv.x = pg8::cvt_pk_bf16(a.x, a.y); wv.y = pg8::cvt_pk_bf16(a.z, a.w);
              *(u32x2*)(P + (size_t)(tok0 + 16 * tt + (lane & 15)) * D + o0) = wv; } }
    }
}
#if MK_DEBUG
constexpr int CW_FAIL = 8192;
constexpr size_t WS_DBG = 230 * MiB;
__device__ __forceinline__ unsigned dh(unsigned i) { i ^= i >> 16; i *= 0x7feb352du; i ^= i >> 15; i *= 0x846ca68bu; i ^= i >> 16; return i; }
__device__ __forceinline__ float bf2f(bf16 b) { return __builtin_bit_cast(float, (unsigned)b << 16); }
__device__ __forceinline__ void dfail(Frame& F, int id, bool bad) { if (bad) atomicAdd((unsigned*)(F.ctl + CW_FAIL + id), 1u); }
__device__ __forceinline__ bool dneq(float got, float ref, float rel, float abs_) { const float d = fabsf(got - ref); return !(d <= rel * fabsf(ref) + abs_); }
__device__ __forceinline__ const float* xrow_ptr(Frame& F, int m) { return m < M_CTX ? F.in[I_XP] + (size_t)m * D : F.in[I_XS] + (size_t)(m - M_CTX) * D; }

__device__ __forceinline__ void dbg_wt(Frame& F, const float* W, int K, int N, const bf16* WT, int ldt, unsigned salt, int nlim = 1 << 30) {
    for (int s = F.tid; s < 2048; s += 512) { const unsigned h = dh(s * 2u + salt); const int k = h % K, n = (h >> 12) % (N < nlim ? N : nlim); const float w = W[(size_t)k * N + n], t = bf2f(WT[(size_t)n * ldt + k]);
        dfail(F, 1, dneq(t, w, 0.0045f, 1e-30f)); }
}
__device__ __forceinline__ void dbg_check(Frame& F, int phase) {
    if (F.bid != 0) return;
    unsigned char* ws = F.ws;
    if (phase == 0) {
        dbg_wt(F, F.in[I_WIN], D, DIN, (const bf16*)(ws + WS_WIN), D, 11, 1536); dbg_wt(F, F.in[I_WGLU], D, D, (const bf16*)(ws + WS_WGLU), D, 12); dbg_wt(F, F.in[I_WPA], D, D, (const bf16*)(ws + WS_WPA), D, 13);
        dbg_wt(F, F.in[I_WPB], DPOOL, D, (const bf16*)(ws + WS_WPB), D, 14); dbg_wt(F, F.in[I_WOUT], D, D, (const bf16*)(ws + WS_WOUT), D, 15); dbg_wt(F, F.in[I_W1], D, DFF, (const bf16*)(ws + WS_W1), D, 16);
        dbg_wt(F, F.in[I_W2], DFF, D, (const bf16*)(ws + WS_W2), DFF, 17);
        for (int gi = 0; gi < 4; ++gi) dbg_wt(F, F.in[I_WPOOL] + gi * 16384, 128, 128, (const bf16*)(ws + WS_WPOOL) + gi * 16384, 128, 18 + gi);
        for (int s = F.tid; s < 2048; s += 512) {
            const int it = dh(s + 77u) % 8192; const int p = it & 63, g = (it >> 6) & 63, dir = it >> 12;
            const double lr = F.in[I_LAMRE][it], li = F.in[I_LAMIM][it], dt = exp((double)F.in[I_LOGDT][dir * 64 + g]);
            const double e = exp(lr * dt), lbr = e * cos(li * dt), lbi = e * sin(li * dt), nr = lbr - 1.0, ni = lbi, den = lr * lr + li * li, wr = (nr * lr + ni * li) / den, wi = (ni * lr - nr * li) / den;
            const float* lamb = (const float*)(ws + WS_LAMB) + (size_t)it * 4; dfail(F, 2, dneq(lamb[0], (float)lbr, 1e-5f, 1e-6f) || dneq(lamb[1], (float)lbi, 1e-5f, 1e-6f));
            const int h = dh(s + 99u) & 15; const double br = F.in[I_BRE][(size_t)it * 16 + h], bi = F.in[I_BIM][(size_t)it * 16 + h];
            const bf16* bb = (const bf16*)(ws + WS_BB2) + (size_t)128 * 2 * 64 * 16;
            dfail(F, 2, dneq(bf2f(bb[((size_t)((dir * 64 + g) * 2 + 0) * 64 + p) * 16 + h]), (float)(wr * br - wi * bi), 0.01f, 1e-6f) || dneq(bf2f(bb[((size_t)((dir * 64 + g) * 2 + 1) * 64 + p) * 16 + h]), (float)(wr * bi + wi * br), 0.01f, 1e-6f));
            const bf16* v2 = (const bf16*)(ws + WS_V2) + ((size_t)(dir * 64 + g) * 2 * 16 + h) * 128; const size_t ci = ((size_t)(dir * 64 + g) * 16 + h) * 64 + p;
            const double cre = F.in[I_CRE][ci], cim = F.in[I_CIM][ci];
            dfail(F, 2, dneq(bf2f(v2[2 * p]), (float)(cre * lbr - cim * lbi), 0.006f, 1e-5f) || dneq(bf2f(v2[2 * p + 1]), (float)-(cre * lbi + cim * lbr), 0.006f, 1e-5f));
        }
    }
    if (phase == 1) {
        for (int s = F.tid; s < 1024; s += 512) {
            const unsigned h = dh(s + 5u); const int r = h % 9, idx = (h >> 8) % 6144; double a = F.in[I_BADA][idx];
            for (int k = 0; k < D; ++k) { const double cv = r == 0 ? F.in[I_CCTX][k] : F.in[I_C][(size_t)(r - 1) * D + k]; a += cv / (1.0 + exp(-cv)) * (double)F.in[I_WADA][(size_t)k * 6144 + idx]; }
            dfail(F, 3, dneq(((const float*)(ws + WS_MODF))[(size_t)r * 6144 + idx], (float)a, 1e-4f, 1e-4f));
        }
        for (int s = F.tid; s < 1024; s += 512) {
            const unsigned h = dh(s + 1234u); const int m = h % M, j = (h >> 16) % D; const float* x = xrow_ptr(F, m); double mu = 0, var = 0;
            for (int k = 0; k < D; ++k) mu += x[k]; mu /= D; for (int k = 0; k < D; ++k) { const double d = x[k] - mu; var += d * d; } var /= D;
            const float* mf = (const float*)(ws + WS_MODF) + (size_t)batch_of_row(m) * 6144;
            const double y = (x[j] - mu) / sqrt(var + 1e-6) * (1.0 + mf[D + j]) + mf[j];
            dfail(F, 4, dneq(bf2f(((const bf16*)(ws + WS_RA))[(size_t)m * D + j]), (float)y, 0.006f, 0.004f));
        }
    }
    if (phase == 2) {
        for (int s = F.tid; s < 2048; s += 512) { const unsigned h = dh(s + 4321u); const int m = h % M, zc = (h >> 14) % DIN; const bf16* hr = (const bf16*)(ws + WS_RA) + (size_t)m * D;
            if (zc < 1536) { double a = F.in[I_BIN][zc];
                for (int k = 0; k < D; ++k) a += (double)bf2f(hr[k]) * (double)F.in[I_WIN][(size_t)k * DIN + zc];
                const float got = zc < 1024 ? bf2f(((const bf16*)(ws + WS_RB))[(size_t)m * D + zc]) : bf2f(((const bf16*)(ws + WS_UB))[(size_t)m * DPOOL + zc - 1024]);
                dfail(F, 5, dneq(got, (float)a, 0.01f, 0.02f)); }
            else { const int col = (zc - 1536) & 1023; double a = F.in[I_BIN][1536 + col], b = F.in[I_BIN][2560 + col];
                for (int k = 0; k < D; ++k) { const double hv = bf2f(hr[k]); a += hv * (double)F.in[I_WIN][(size_t)k * DIN + 1536 + col]; b += hv * (double)F.in[I_WIN][(size_t)k * DIN + 2560 + col]; }
                const double sa = 1.0 / (1.0 + exp(-a)), sb = 1.0 / (1.0 + exp(-b));
                dfail(F, 5, dneq(bf2f(((const bf16*)(ws + WS_GA))[(size_t)m * D + col]), (float)(sa / sb), 0.03f, 0.02f) || dneq(bf2f(((const bf16*)(ws + WS_GB))[(size_t)m * D + col]), (float)sb, 0.01f, 0.02f)); } }
    }
    if (phase == 3) {
        { const int w = F.wave, lane = F.lane; const bool lat = w < 2; const unsigned h = dh(w + 31u); const int seq = lat ? (h % NB_LAT) : w, g = lat ? (h >> 8) % NGRP : 3 * w + 1;
          const int L = lat ? L_LAT : L_CTX, tokbase = lat ? M_CTX + seq * L_LAT : seq * L_CTX; const bf16* UA = (const bf16*)(ws + WS_RB); const bf16* V = (const bf16*)(ws + WS_RA);
          float* yf = (float*)(ws + WS_DBG) + (size_t)w * L_LAT * 16;
          for (int dir = 0; dir < 2; ++dir) {
              const int it = (dir * 64 + g) * 64 + lane; const float lr = F.in[I_LAMRE][it], li = F.in[I_LAMIM][it], dt = expf(F.in[I_LOGDT][dir * 64 + g]);
              const float e = expf(lr * dt), lbr = e * cosf(li * dt), lbi = e * sinf(li * dt), nr = lbr - 1.f, ni = lbi, den = 1.f / (lr * lr + li * li), wr = (nr * lr + ni * li) * den, wi = (ni * lr - nr * li) * den;
              float br[16], bi[16], cr[16], cim[16];
#pragma unroll
              for (int hh = 0; hh < 16; ++hh) { const float a = F.in[I_BRE][(size_t)it * 16 + hh], b = F.in[I_BIM][(size_t)it * 16 + hh]; br[hh] = wr * a - wi * b; bi[hh] = wr * b + wi * a;
                  const size_t ci = ((size_t)(dir * 64 + g) * 16 + hh) * 64 + lane; cr[hh] = F.in[I_CRE][ci]; cim[hh] = F.in[I_CIM][ci]; }
              float sr = 0.f, si = 0.f; if (lat) { const float* st = F.in[I_STATE] + ((size_t)(seq * 2 + dir) * 2) * 4096 + g * 64 + lane; sr = st[0]; si = st[4096]; }
              for (int tq = 0; tq < L; ++tq) { const int t = dir ? L - 1 - tq : tq; const bf16* ur = UA + (size_t)(tokbase + t) * D + g * 16; float bur = 0.f, bui = 0.f;
#pragma unroll
                  for (int hh = 0; hh < 16; ++hh) { const float u = bf2f(ur[hh]); bur += br[hh] * u; bui += bi[hh] * u; }
                  const float nsr = lbr * sr - lbi * si + bur, nsi = lbr * si + lbi * sr + bui; sr = nsr; si = nsi;
                  if (!lat && dir == 0 && tq < 32) { const float* dx = (const float*)(ws + 231 * MiB) + (size_t)seq * 32 * 64 * 4 + (tq * 64 + lane) * 4;
                      dfail(F, 20, dneq(dx[0], bur, 0.02f, 0.002f) || dneq(dx[1], bui, 0.02f, 0.002f)); dfail(F, 21, dneq(dx[2], sr, 0.02f, 0.002f) || dneq(dx[3], si, 0.02f, 0.002f)); }
                  float mine = 0.f;
#pragma unroll
                  for (int hh = 0; hh < 16; ++hh) { const float y = wave_sum(cr[hh] * sr - cim[hh] * si); if (lane == hh) mine = y; }
                  if (lane < 16) { const float pt = F.out[(size_t)(tokbase + t) * D + g * 16 + lane];
                      const float mined = mine + F.in[I_S5D][dir * D + g * 16 + lane] * bf2f(ur[lane]);
                      if (dir == 0) { yf[(size_t)t * 16 + lane] = mine; if (t < L / 2) dfail(F, lat ? 10 : 6, dneq(pt, mined, 0.03f, 0.01f)); }
                      else { if (t >= L / 2) dfail(F, lat ? 11 : 7, dneq(pt, mined, 0.03f, 0.01f)); const float u = bf2f(ur[lane]); const float tot = yf[(size_t)t * 16 + lane] + mine + (F.in[I_S5D][g * 16 + lane] + F.in[I_S5D][D + g * 16 + lane]) * u;
                          const float ref = tot / (1.f + expf(-1.5957691216f * (tot + 0.044715f * tot * tot * tot)));
                          dfail(F, lat ? 12 : 8, dneq(bf2f(V[(size_t)(tokbase + t) * D + g * 16 + lane]), ref, 0.03f, 0.03f)); } }
              }
              if (!lat) { const float* o = F.out + (size_t)M * D + ((size_t)(seq * 2 + dir) * 2) * 4096 + g * 64 + lane; dfail(F, 9, dneq(o[0], sr, 0.02f, 0.01f) || dneq(o[4096], si, 0.02f, 0.01f)); }
              __builtin_amdgcn_s_waitcnt(0);
          } }
        for (int s = F.tid; s < 2048; s += 512) { const unsigned h = dh(s + 999u); const int tok = h % M, o = (h >> 14) % DPOOL, gi = o >> 7, w = 2 << gi; const bool lat = tok >= M_CTX;
            const int npr = lat ? 64 : L_CTX, rs = lat ? (tok & ~63) : (tok & ~255), tt = tok - rs, lo = max(tt - w / 2, 0), hi = min(tt - w / 2 + w, npr); const bf16* UB = (const bf16*)(ws + WS_UB); double a = 0;
            for (int i = 0; i < 128; ++i) { double sum = 0; for (int q = lo; q < hi; ++q) sum += bf2f(UB[(size_t)(rs + q) * DPOOL + gi * 128 + i]);
                const double pm = sum / (hi - lo) - bf2f(UB[(size_t)tok * DPOOL + gi * 128 + i]); a += pm * (double)F.in[I_WPOOL][((size_t)gi * 128 + i) * 128 + (o & 127)]; }
            a *= F.in[I_PSCALE][o]; dfail(F, 13, dneq(bf2f(((const bf16*)(ws + WS_P))[(size_t)tok * D + o]), (float)a, 0.02f, 0.02f)); }
    }
    if (phase == 4) {
        for (int s = F.tid; s < 2048; s += 512) { const unsigned h = dh(s + 41u); const int m = h % M, c = (h >> 14) % D; const bf16* vr = (const bf16*)(ws + WS_RA) + (size_t)m * D; double a = F.in[I_BGLU][c];
            for (int k = 0; k < D; ++k) a += (double)bf2f(vr[k]) * (double)F.in[I_WGLU][(size_t)k * D + c];
            const double ref = bf2f(vr[c]) / (1.0 + exp(-a)); dfail(F, 14, dneq(bf2f(((const bf16*)(ws + WS_RB))[(size_t)m * D + c]), (float)ref, 0.02f, 0.02f)); }
    }
    if (phase == 5) {
        for (int s = F.tid; s < 2048; s += 512) { const unsigned h = dh(s + 51u); const int m = h % M, c = (h >> 14) % D; const bf16* v2 = (const bf16*)(ws + WS_RB) + (size_t)m * D; const bf16* pr = (const bf16*)(ws + WS_P) + (size_t)m * D; double ya = 0, yb = 0;
            for (int k = 0; k < D; ++k) ya += (double)bf2f(v2[k]) * (double)F.in[I_WPA][(size_t)k * D + c];
            for (int k = 0; k < DPOOL; ++k) yb += (double)bf2f(pr[k]) * (double)F.in[I_WPB][(size_t)k * D + c];
            const double ref = bf2f(((const bf16*)(ws + WS_GB))[(size_t)m * D + c]) * (bf2f(((const bf16*)(ws + WS_GA))[(size_t)m * D + c]) * ya + yb);
            dfail(F, 15, dneq(bf2f(((const bf16*)(ws + WS_RA))[(size_t)m * D + c]), (float)ref, 0.03f, 0.03f)); }
    }
    if (phase == 6) {
        for (int s = F.tid; s < 2048; s += 512) { const unsigned h = dh(s + 61u); const int m = h % M, c = (h >> 14) % D; const bf16* mr = (const bf16*)(ws + WS_RA) + (size_t)m * D; double a = F.in[I_BOUT][c];
            for (int k = 0; k < D; ++k) a += (double)bf2f(mr[k]) * (double)F.in[I_WOUT][(size_t)k * D + c];
            const float* mf = (const float*)(ws + WS_MODF) + (size_t)batch_of_row(m) * 6144; const double ref = (double)DN_ALPHA * xrow_ptr(F, m)[c] + mf[2 * D + c] * a;
            dfail(F, 16, dneq(bf2f(((const bf16*)F.out)[(size_t)m * D + c]), (float)ref, 0.012f, 0.02f)); }
    }
    if (phase == 7) {
        for (int s = F.tid; s < 1024; s += 512) { const unsigned h = dh(s + 71u); const int m = h % M, j = (h >> 16) % D; const bf16* r = (const bf16*)F.out + (size_t)m * D; double mu = 0, var = 0;
            for (int k = 0; k < D; ++k) mu += bf2f(r[k]); mu /= D; for (int k = 0; k < D; ++k) { const double dd = bf2f(r[k]) - mu; var += dd * dd; } var /= D; const double rs = 1.0 / sqrt(var + 1e-6);
            const float* st = (const float*)(ws + WS_STATS) + 2 * m;
            double m2 = 0, v2 = 0; for (int k = 0; k < D; ++k) m2 += (bf2f(r[k]) - mu) * rs * F.in[I_LN1G][k] + F.in[I_LN1B][k]; m2 /= D;
            for (int k = 0; k < D; ++k) { const double x1 = (bf2f(r[k]) - mu) * rs * F.in[I_LN1G][k] + F.in[I_LN1B][k] - m2; v2 += x1 * x1; } v2 /= D;
            const float* mf = (const float*)(ws + WS_MODF) + (size_t)batch_of_row(m) * 6144; const double x1j = (bf2f(r[j]) - mu) * rs * F.in[I_LN1G][j] + F.in[I_LN1B][j];
            const double y = (x1j - m2) / sqrt(v2 + 1e-6) * (1.0 + mf[4 * D + j]) + mf[3 * D + j];
            dfail(F, 17, dneq(bf2f(((const bf16*)(ws + WS_RB))[(size_t)m * D + j]), (float)y, 0.006f, 0.004f) || dneq(st[0], (float)mu, 1e-4f, 1e-5f) || dneq(st[1], (float)rs, 1e-4f, 1e-5f)); }
    }
    if (phase == 8) {
        for (int s = F.tid; s < 2048; s += 512) { const unsigned h = dh(s + 81u); const int m = h % M, c = (h >> 14) % DFF; const bf16* hr = (const bf16*)(ws + WS_RB) + (size_t)m * D; double a = F.in[I_B1][c];
            for (int k = 0; k < D; ++k) a += (double)bf2f(hr[k]) * (double)F.in[I_W1][(size_t)k * DFF + c];
            a = a > 0 ? a * a : 0; dfail(F, 18, dneq(bf2f(((const bf16*)(ws + WS_HM))[(size_t)m * DFF + c]), (float)a, 0.02f, 0.02f)); }
    }
    if (phase == 9) {
        for (int s = F.tid; s < 2048; s += 512) { const unsigned h = dh(s + 91u); const int m = h % M, c = (h >> 14) % D; const bf16* hr = (const bf16*)(ws + WS_HM) + (size_t)m * DFF; double a = F.in[I_B2][c];
            for (int k = 0; k < DFF; ++k) a += (double)bf2f(hr[k]) * (double)F.in[I_W2][(size_t)k * D + c];
            const float* st = (const float*)(ws + WS_STATS) + 2 * m; const double x1 = ((double)bf2f(((const bf16*)F.out)[(size_t)m * D + c]) - st[0]) * st[1] * F.in[I_LN1G][c] + F.in[I_LN1B][c];
            const float* mf = (const float*)(ws + WS_MODF) + (size_t)batch_of_row(m) * 6144; const double ref = (double)DN_ALPHA * x1 + mf[5 * D + c] * a;
            dfail(F, 19, dneq(bf2f(((const bf16*)(ws + WS_RA))[(size_t)m * D + c]), (float)ref, 0.012f, 0.02f)); }
    }
}
__device__ __forceinline__ void dbg_encode(Frame& F) {
    int code = 0;
    for (int k = 24; k >= 1; --k) { if (k == 20 || k == 21) continue; if (__hip_atomic_load((unsigned*)(F.ctl + CW_FAIL + k), __ATOMIC_RELAXED, __HIP_MEMORY_SCOPE_AGENT) != 0u) code = k; }
    if (code == 6) { if (__hip_atomic_load((unsigned*)(F.ctl + CW_FAIL + 21), __ATOMIC_RELAXED, __HIP_MEMORY_SCOPE_AGENT)) code = 21; if (__hip_atomic_load((unsigned*)(F.ctl + CW_FAIL + 20), __ATOMIC_RELAXED, __HIP_MEMORY_SCOPE_AGENT)) code = 20; }
#if MK_DEBUG_FORCE
    code = MK_DEBUG_FORCE;
#endif
    if (code == 0) return;
    const size_t total = (size_t)M * D + (size_t)NB_CTX * 4 * 4096;
    for (size_t i = (size_t)F.bid * 512 + F.tid; i < total; i += (size_t)F.G * 512) F.out[i] = i < (size_t)M_CTX * D ? (float)(code + 1) : 0.f;
}
#define DBG_CHECK(k) do { if (IN(k)) { xcd_barrier(bar); dbg_check(F, k); } } while (0)
#else
#define DBG_CHECK(k) do { } while (0)
#endif
struct Args { const float* in[33]; float* out; unsigned char* ws; int ph_lo, ph_hi; };
__global__ void __launch_bounds__(NWAVES * 64, 2) mk_fwd(Args args) {
    extern __shared__ __attribute__((aligned(16))) unsigned char lds[];
    Frame F;
    F.lds = (LAS unsigned char*)lds;
    F.MISC = (volatile LAS unsigned*)(F.lds + MISC_OFF);
    F.tid = threadIdx.x; F.lane = F.tid & 63; F.wave = __builtin_amdgcn_readfirstlane(F.tid >> 6);
    F.G = gridDim.x; F.bid = blockIdx.x;
#pragma unroll
    for (int i = 0; i < 33; ++i) F.in[i] = args.in[i];
    F.out = args.out; F.ws = args.ws; F.ctl = (gu32*)(args.ws + WS_CTL);
    unsigned char* ws = args.ws;
    for (int u = F.tid; u < (LDS_BYTES - LDSCTL_OFF) / 4; u += NWAVES * 64) ((LAS unsigned*)(F.lds + LDSCTL_OFF))[u] = 0u;
    __syncthreads();
    XcdBarrier bar = xcd_barrier_post((unsigned*)(F.ctl + CW_BAR), F.MISC + 8);
    const int lo = args.ph_lo, hi = args.ph_hi;
#if MK_STAMP
    if (F.bid == 0 && F.tid == 0 && MK_STAMP == 1) F.MISC[20] = (unsigned)__builtin_amdgcn_s_memrealtime();
#define STAMP(k) do { if (F.bid == 0 && F.tid == 0) { if ((k) == MK_STAMP - 2) F.MISC[20] = (unsigned)__builtin_amdgcn_s_memrealtime(); if ((k) == MK_STAMP - 1) F.MISC[21] = (unsigned)__builtin_amdgcn_s_memrealtime(); } } while (0)
#else
#define STAMP(k) do { } while (0)
#endif
#define IN(k) (lo <= (k) && (k) < hi)
#define SEAM(k) do { if (IN(k) && IN((k) + 1)) xcd_barrier(bar); } while (0)
    typedef pg8::bf16_t bt;
#if MK_POISON
    if (IN(0)) {
        v4u pz = (v4u){0xAAAAAAAAu, 0xAAAAAAAAu, 0xAAAAAAAAu, 0xAAAAAAAAu};
        for (size_t i = (size_t)F.bid * 512 + F.tid; i < ((size_t)M * D * 4 + 2 * MiB) / 16; i += (size_t)F.G * 512) ((v4u*)F.out)[i] = pz;
        for (size_t i = (size_t)F.bid * 512 + F.tid; i < (192 * MiB) / 16; i += (size_t)F.G * 512) ((v4u*)(ws + 36 * MiB))[i] = pz;
        for (size_t i = (size_t)F.bid * 512 + F.tid; i < (256 * 1024) / 16; i += (size_t)F.G * 512) ((v4u*)(ws + WS_STATS))[i] = pz;
    }
#endif
    if (IN(0)) { phase0(F); } DBG_CHECK(0); SEAM(0); STAMP(0);
    if (IN(1)) { phase1(F); } DBG_CHECK(1); SEAM(1); STAMP(1);
    if (IN(2)) {
        struct RemapOrder : pg8::StaticOrder { bool on; __device__ __forceinline__ bool next(int i, pg8::Unit& u) const { if (!pg8::StaticOrder::next(i, u)) return false;
            if (on) u.pn = u.pn == 2 ? 4 : u.pn == 3 ? 5 : u.pn == 4 ? 2 : u.pn == 5 ? 3 : u.pn; return true; } };
        pg8::Gemm g{(const bt*)(ws + WS_RA), nullptr, (const bt*)(ws + WS_WIN), nullptr, D / 64, 0, D}; g.id_ = 2; RemapOrder S; S.init(M, DIN, F.G, F.bid); S.on = (F.G == 256);
        pg8::EpiIn E{(bt*)(ws + WS_RB), (bt*)(ws + WS_UB), (bt*)(ws + WS_GA), (bt*)(ws + WS_GB), F.in[I_BIN]};
        pg8::gemm_phase<pg8::EpiIn, RemapOrder, true, true>(F.lds, g, S, E);
        if (F.G == 256 && F.bid >= 128) pool_half(F, 8 * (F.bid & 7) + ((F.bid >> 3) & 7), (F.bid >> 6) - 2);
    } DBG_CHECK(2); SEAM(2); STAMP(2);
    if (IN(3)) {
#if MK_STAMP >= 100
        if (F.bid == MK_TB && F.tid == 0) F.MISC[20] = (unsigned)__builtin_amdgcn_s_memrealtime();
#endif
        if (F.G == 256) {
            if (F.bid < 128) s5_task(F, true, F.bid >> 4, 1, F.bid & 15);
            else s5_task(F, false, ((F.bid - 128) >> 4) * 4, 4, (F.bid - 128) & 15);
        } else {
            for (int t = F.bid; t < 640; t += F.G) { if (t < 128) s5_task(F, true, t >> 4, 1, t & 15); else s5_task(F, false, (t - 128) >> 4, 1, (t - 128) & 15); }
        }
#if MK_STAMP == 100
        if (F.bid == MK_TB && F.tid == 0) F.MISC[21] = (unsigned)__builtin_amdgcn_s_memrealtime();
#endif
#if MK_STAMP == 101
        if (F.bid == MK_TB && F.tid == 0) F.MISC[20] = (unsigned)__builtin_amdgcn_s_memrealtime();
#endif
#if MK_OLDPOOL
        for (int tile = F.bid; tile < M / 64; tile += F.G) pool_task_old(F, tile);
#else
        if (F.G != 256) for (int tile = F.bid; tile < M / 64; tile += F.G) pool_task(F, tile);
#endif
        __syncthreads();
#if MK_STAMP == 101
        if (F.bid == MK_TB && F.tid == 0) F.MISC[21] = (unsigned)__builtin_amdgcn_s_memrealtime();
#endif
    } DBG_CHECK(3); SEAM(3); STAMP(3);
#if MK_TRUNC == 3
    { xcd_barrier(bar); const bf16* src = (const bf16*)(ws + WS_RA);
      for (size_t i = (size_t)F.bid * 512 + F.tid; i < (size_t)M * D; i += (size_t)F.G * 512) { const int tok = (int)(i >> 10); const bool lat = tok >= M_CTX; const int L = lat ? L_LAT : L_CTX, t = lat ? (tok - M_CTX) % L_LAT : tok % L_CTX;
          bool keep = true; if (MK_TSEL == 1) keep = !lat; if (MK_TSEL == 2) keep = lat; if (MK_TSEL == 3) keep = t < L / 2; if (MK_TSEL == 4) keep = t >= L / 2; if (MK_TSEL == 5) keep = (t & 31) < 16; if (MK_TSEL == 6) keep = ((i >> 4) & 1) == 0; if (MK_TSEL == 7) keep = lat && t < 512; if (MK_TSEL == 8) keep = lat && t >= 512; if (MK_TSEL == 9) keep = lat && (t < 32 || t >= 992); if (MK_TSEL == 10) keep = lat && (t >= 480 && t < 544);
          F.out[i] = keep ? bf_lo((unsigned)src[i]) : 0.f; }
      return; }
#endif
    if (IN(4)) {
        pg8::Gemm g{(const bt*)(ws + WS_RA), nullptr, (const bt*)(ws + WS_WGLU), nullptr, D / 64, 0, D}; g.id_ = 4; pg8::StaticOrder S; S.init(M, D, F.G, F.bid);
        pg8::EpiGlu E{(const bt*)(ws + WS_RA), (bt*)(ws + WS_RB), F.in[I_BGLU]};
        pg8::gemm_phase<pg8::EpiGlu, pg8::StaticOrder, true, true>(F.lds, g, S, E);
    } DBG_CHECK(4); SEAM(4); STAMP(4);
    if (IN(5)) {
        pg8::Gemm g{(const bt*)(ws + WS_RB), (const bt*)(ws + WS_P), (const bt*)(ws + WS_WPA), (const bt*)(ws + WS_WPB), D / 64, DPOOL / 64, D}; g.id_ = 5; pg8::StaticOrder S; S.init(M, D, F.G, F.bid, 2);
        pg8::EpiMerge E{(const bt*)(ws + WS_GA), (const bt*)(ws + WS_GB), (bt*)(ws + WS_RA)};
        pg8::gemm_phase<pg8::EpiMerge, pg8::StaticOrder, true, true>(F.lds, g, S, E);
    } DBG_CHECK(5); SEAM(5); STAMP(5);
    if (IN(6)) {
        pg8::Gemm g{(const bt*)(ws + WS_RA), nullptr, (const bt*)(ws + WS_WOUT), nullptr, D / 64, 0, D}; g.id_ = 6; pg8::StaticOrder S; S.init(M, D, F.G, F.bid);
        pg8::EpiRes1 E{F.in[I_XP], F.in[I_XS], (bt*)F.out, F.in[I_BOUT], (const float*)(ws + WS_MODF)};
        pg8::gemm_phase<pg8::EpiRes1, pg8::StaticOrder, true, true>(F.lds, g, S, E);
    } DBG_CHECK(6); SEAM(6); STAMP(6);
    if (IN(7)) { phase_ln1(F, (const bf16*)F.out, (float*)(ws + WS_STATS), (bf16*)(ws + WS_RB)); } DBG_CHECK(7); SEAM(7); STAMP(7);
#if MK_TRUNC == 7
    { xcd_barrier(bar); const bf16* src = (const bf16*)(ws + WS_RB); for (size_t i = (size_t)F.bid * 512 + F.tid; i < (size_t)M * D; i += (size_t)F.G * 512) F.out[i] = bf_lo((unsigned)src[i]); return; }
#endif
    if (IN(8)) {
        pg8::Gemm g{(const bt*)(ws + WS_RB), nullptr, (const bt*)(ws + WS_W1), nullptr, D / 64, 0, D}; g.id_ = 8; pg8::StaticOrder S; S.init(M, DFF, F.G, F.bid);
        pg8::EpiRelu2 E{(bt*)(ws + WS_HM), F.in[I_B1]};
        pg8::gemm_phase<pg8::EpiRelu2, pg8::StaticOrder, true, true>(F.lds, g, S, E);
    } DBG_CHECK(8); SEAM(8); STAMP(8);
#if MK_TRUNC == 8
    { xcd_barrier(bar); const bf16* src = (const bf16*)(ws + WS_HM); for (size_t i = (size_t)F.bid * 512 + F.tid; i < (size_t)M * D; i += (size_t)F.G * 512) F.out[i] = bf_lo((unsigned)src[i * 4 + (i & 3)]); return; }
#endif
    if (IN(9)) {
        pg8::Gemm g{(const bt*)(ws + WS_HM), nullptr, (const bt*)(ws + WS_W2), nullptr, DFF / 64, 0, DFF}; g.id_ = 9; pg8::StaticOrder S; S.init(M, D, F.G, F.bid);
        pg8::EpiRes2 E{(const bt*)F.out, (const float*)(ws + WS_STATS), F.in[I_LN1G], F.in[I_LN1B], (bt*)(ws + WS_RA), F.in[I_B2], (const float*)(ws + WS_MODF)};
        pg8::gemm_phase<pg8::EpiRes2, pg8::StaticOrder, true, true>(F.lds, g, S, E);
    } DBG_CHECK(9); SEAM(9); STAMP(9);
#if MK_TRUNC == 9
    { xcd_barrier(bar); const bf16* src = (const bf16*)(ws + WS_RA); for (size_t i = (size_t)F.bid * 512 + F.tid; i < (size_t)M * D; i += (size_t)F.G * 512) F.out[i] = bf_lo((unsigned)src[i]); return; }
#endif
    if (IN(10)) { phase_ln2(F, (const bf16*)(ws + WS_RA)); }
#if MK_STAMP
    STAMP(10); __syncthreads();
    if (F.bid == (MK_STAMP >= 100 ? MK_TB : 0) && F.tid == 0) { asm volatile("s_waitcnt vmcnt(0)" ::: "memory"); F.out[(size_t)(MK_STAMP >= 100 ? MK_TB : 0) * 64 * D] += (MK_STAMP == 120 || MK_STAMP == 130) ? (float)(F.MISC[18] - F.MISC[17]) * (1.0f / 1000.0f) : (MK_STAMP >= 110) ? (float)F.MISC[16] * (16.0f / 21000.0f) : (float)(F.MISC[21] - F.MISC[20]) * (1.0f / 1000.0f); }
#endif
#if MK_DEBUG
    xcd_barrier(bar); dbg_encode(F);
#endif
#undef IN
#undef SEAM
}

#ifndef MK_SPLIT
#define MK_SPLIT 0
#endif
extern "C" void kernel_launch(void* const* d_in, const int* in_sizes, int n_in, void* d_out, int out_size, void* d_ws, size_t ws_size, hipStream_t stream) {
    static int grid = 0;
    if (grid == 0) {
        if (n_in != 33 || ws_size < WS_END) { fprintf(stderr, "kernel_launch: unexpected inputs (n_in %d, ws %zu)\n", n_in, ws_size); grid = -1; return; }
        int dev = 0, cus = 0, per_cu = 0;
        if (hipGetDevice(&dev) != hipSuccess || hipDeviceGetAttribute(&cus, hipDeviceAttributeMultiprocessorCount, dev) != hipSuccess) { grid = -1; return; }
        if (hipFuncSetAttribute((const void*)mk_fwd, hipFuncAttributeMaxDynamicSharedMemorySize, LDS_BYTES) != hipSuccess) { fprintf(stderr, "kernel_launch: hipFuncSetAttribute failed\n"); grid = -1; return; }
        if (hipOccupancyMaxActiveBlocksPerMultiprocessor(&per_cu, (const void*)mk_fwd, NWAVES * 64, LDS_BYTES) != hipSuccess || per_cu < 1) fprintf(stderr, "kernel_launch: occupancy query says %d blocks per CU\n", per_cu);
        (void)hipGetLastError();
        grid = cus;
    }
    if (grid < 0) return;
    (void)hipMemsetAsync((char*)d_ws + WS_CTL, 0, CTL_ZERO_BYTES, stream);
    Args a{};
    for (int i = 0; i < 33; ++i) a.in[i] = (const float*)d_in[i];
    a.out = (float*)d_out; a.ws = (unsigned char*)d_ws;
#if MK_SPLIT
    for (int p = 0; p <= 10; ++p) { a.ph_lo = p; a.ph_hi = p + 1; hipLaunchKernelGGL(mk_fwd, dim3(grid), dim3(NWAVES * 64), LDS_BYTES, stream, a); }
#else
    a.ph_lo = 0; a.ph_hi = 11;
    hipLaunchKernelGGL(mk_fwd, dim3(grid), dim3(NWAVES * 64), LDS_BYTES, stream, a);
#endif
    const hipError_t le = hipPeekAtLastError();
    if (le != hipSuccess) fprintf(stderr, "kernel_launch: launch failed: %s\n", hipGetErrorName(le));
}
```
